# Optimizing an MI355X kernel written in HIP

```python
import jax, jax.numpy as jnp
from jax import lax
import numpy as np

D_MODEL = 1024
BATCH = 16
SEQ = 256
DEPTH = 1
DEC_BATCH = 8
DEC_SEQ = 2048
PAST_LEN = 512

GRID_W = 64
HEAD_DIM = 64
N_HEADS = D_MODEL // HEAD_DIM
N_KV_HEADS = N_HEADS // 4
KV_GROUP = N_HEADS // N_KV_HEADS
ROPE_THETA = 10000.0
Q_BLOCK = 128
R_DK = 128
R_HEADS = D_MODEL // R_DK
R_DV = D_MODEL // R_HEADS
CHUNK = 64
D_FF = 2816
EPS = 1e-6
ATT_W = N_HEADS * HEAD_DIM
KV_W = N_KV_HEADS * HEAD_DIM
REC_K = R_HEADS * R_DK
REC_V = R_HEADS * R_DV
IN_WIDTHS = (ATT_W, KV_W, KV_W, REC_K, REC_K, REC_K, REC_V, REC_V, D_MODEL, D_MODEL)
IN_W = sum(IN_WIDTHS)
IN_SPLITS = tuple(int(s) for s in np.cumsum(IN_WIDTHS)[:-1])

kernel_name = "hybrid_gqa_hgrn2_diffusion_step"


def rmsnorm(x, gain):
    xf = x.astype(jnp.float32)
    y = xf * lax.rsqrt(jnp.mean(xf * xf, axis=-1, keepdims=True) + EPS)
    return (y * gain.astype(jnp.float32)).astype(x.dtype)


def axial_angles(n_tokens):
    rows = n_tokens // GRID_W
    row = jnp.repeat(jnp.arange(rows, dtype=jnp.float32), GRID_W)
    col = jnp.tile(jnp.arange(GRID_W, dtype=jnp.float32), rows)
    half = HEAD_DIM // 2
    inv_freq = 1.0 / (ROPE_THETA ** (jnp.arange(0, half, 2, dtype=jnp.float32) / half))
    return row[:, None] * inv_freq, col[:, None] * inv_freq


def _rotate(xa, ang):
    x1, x2 = jnp.split(xa, 2, axis=-1)
    cos = jnp.cos(ang)[None, :, None, :]
    sin = jnp.sin(ang)[None, :, None, :]
    return jnp.concatenate([x1 * cos - x2 * sin, x1 * sin + x2 * cos], axis=-1)


def apply_axial_rope(x, ang_row, ang_col):
    xf = x.astype(jnp.float32)
    half = HEAD_DIM // 2
    return jnp.concatenate([_rotate(xf[..., :half], ang_row), _rotate(xf[..., half:], ang_col)], axis=-1).astype(x.dtype)


def block_attention(q, k, v):
    B, Lq = q.shape[0], q.shape[1]
    nb = Lq // Q_BLOCK
    qb = q.reshape(B, nb, Q_BLOCK, N_KV_HEADS, KV_GROUP, HEAD_DIM).transpose(1, 0, 2, 3, 4, 5)
    kf = k.astype(jnp.float32)
    vf = v.astype(jnp.float32)
    scale = HEAD_DIM ** -0.5

    def one_block(qblk):
        s = jnp.einsum("bqkgd,bskd->bkgqs", qblk.astype(jnp.float32), kf) * scale
        p = jax.nn.softmax(s, axis=-1)
        return jnp.einsum("bkgqs,bskd->bqkgd", p, vf)

    o = lax.map(one_block, qb)
    return o.transpose(1, 0, 2, 3, 4, 5).reshape(B, Lq, ATT_W).astype(q.dtype)


def chunk_recurrence(q, k, v, g, s0):
    B, L, H, _ = q.shape
    DV = v.shape[-1]
    nc = L // CHUNK

    def to_chunks(a):
        return a.reshape(B, nc, CHUNK, H, a.shape[-1]).transpose(1, 0, 3, 2, 4)

    causal = jnp.tril(jnp.ones((CHUNK, CHUNK), jnp.float32))

    def step(S, inp):
        qc, kc, vc, gc = inp
        b = jnp.cumsum(gc, axis=2)
        b_last = b[:, :, -1:, :]
        q_dec = qc * jnp.exp(b)
        k_dec = kc * jnp.exp(-b)
        scores = jnp.einsum("bhtk,bhsk->bhts", q_dec, k_dec) * causal
        o = jnp.einsum("bhts,bhsv->bhtv", scores, vc) + jnp.einsum("bhtk,bhkv->bhtv", q_dec, S)
        S_new = jnp.exp(b_last[:, :, 0, :])[..., None] * S + jnp.einsum("bhsk,bhsv->bhkv", kc * jnp.exp(b_last - b), vc)
        return S_new, o

    S_fin, o = lax.scan(step, s0.astype(jnp.float32), (to_chunks(q), to_chunks(k), to_chunks(v), to_chunks(g)))
    return o.transpose(1, 0, 3, 2, 4).reshape(B, L, H, DV), S_fin


def token_mixer(h, w_in, w_o, q_gain, k_gain, r_gain, lb, ang_row, ang_col, ctx_k, ctx_v, s0_fwd, s0_bwd):
    B, L, _ = h.shape
    f32 = jnp.float32
    aq, ak, av, rq, rf_fwd, rf_bwd, ri, rg, za, zr = jnp.split(h @ w_in, IN_SPLITS, axis=-1)
    q = rmsnorm(aq.reshape(B, L, N_HEADS, HEAD_DIM), q_gain)
    k = rmsnorm(ak.reshape(B, L, N_KV_HEADS, HEAD_DIM), k_gain)
    v = av.reshape(B, L, N_KV_HEADS, HEAD_DIM)
    if ctx_k is None:
        k_all, v_all = k, v
    else:
        q = apply_axial_rope(q, ang_row, ang_col)
        k = apply_axial_rope(k, ang_row, ang_col)
        k_all = jnp.concatenate([k, ctx_k.astype(k.dtype)], axis=1)
        v_all = jnp.concatenate([v, ctx_v.astype(v.dtype)], axis=1)
    attn = block_attention(q, k_all, v_all)
    rqf = jax.nn.silu(rq.astype(f32)).reshape(B, L, R_HEADS, R_DK) * (R_DK ** -0.5)
    rif = ri.astype(f32).reshape(B, L, R_HEADS, R_DV)

    def gates(zf, lb_d):
        f = lb_d + (1.0 - lb_d) * jax.nn.sigmoid(zf.astype(f32).reshape(B, L, R_HEADS, R_DK))
        return 1.0 - f, jnp.log(f)

    k_f, g_f = gates(rf_fwd, lb[0])
    k_b, g_b = gates(rf_bwd, lb[1])
    if s0_fwd is None:
        s0_fwd = jnp.zeros((B, R_HEADS, R_DK, R_DV), f32)
        s0_bwd = jnp.zeros((B, R_HEADS, R_DK, R_DV), f32)
    o_f, S_f = chunk_recurrence(rqf, k_f, rif, g_f, s0_fwd)
    o_b, S_b = chunk_recurrence(rqf[:, ::-1], k_b[:, ::-1], rif[:, ::-1], g_b[:, ::-1], s0_bwd)
    o_rec = rmsnorm(o_f + o_b[:, ::-1], r_gain) * jax.nn.silu(rg.astype(f32)).reshape(B, L, R_HEADS, R_DV)
    rec = o_rec.reshape(B, L, REC_V).astype(h.dtype)
    merged = jax.nn.sigmoid(za) * attn + jax.nn.sigmoid(zr) * rec
    return merged @ w_o, k, v, S_f, S_b


def conv_ffn(h, w_up, conv_w, conv_b, w_down):
    u = h @ w_up
    up = jnp.pad(u, ((0, 0), (1, 1), (0, 0)))
    u = up[:, :-2] * conv_w[0] + up[:, 1:-1] * conv_w[1] + up[:, 2:] * conv_w[2] + conv_b
    a, b = jnp.split(u, 2, axis=-1)
    return (jax.nn.silu(a) * b) @ w_down


def adaln(cond, w, b):
    mod = (jax.nn.silu(cond) @ w + b).reshape(cond.shape[0], 6, D_MODEL)
    return tuple(mod[:, i][:, None, :] for i in range(6))


def setup_inputs(seed: int = 0) -> dict:
    key = jax.random.key(seed)
    ks = jax.random.split(key, 24)
    d = D_MODEL

    def nrm(k, shape, s):
        return jax.random.normal(k, shape, jnp.float32) * s

    return {
        "x_prompt": nrm(ks[0], (BATCH, SEQ, d), 1.0),
        "x_sample": nrm(ks[1], (DEC_BATCH, DEC_SEQ, d), 1.0),
        "c": nrm(ks[2], (DEC_BATCH, d), 1.0),
        "cache_k": nrm(ks[3], (DEC_BATCH, DEPTH, PAST_LEN, N_KV_HEADS, HEAD_DIM), 1.0),
        "cache_v": nrm(ks[4], (DEC_BATCH, DEPTH, PAST_LEN, N_KV_HEADS, HEAD_DIM), 1.0),
        "state_hgrn": nrm(ks[5], (DEC_BATCH, DEPTH, 2, R_HEADS, R_DK, R_DV), 0.5),
        "c_ctx": nrm(ks[6], (d,), 1.0),
        "ada_w": nrm(ks[7], (DEPTH, d, 6 * d), 0.5 * d ** -0.5),
        "ada_b": nrm(ks[8], (DEPTH, 6 * d), 0.02),
        "norm1": 1.0 + nrm(ks[9], (DEPTH, d), 0.02),
        "norm2": 1.0 + nrm(ks[10], (DEPTH, d), 0.02),
        "w_in": nrm(ks[11], (DEPTH, d, IN_W), d ** -0.5),
        "q_norm": 1.0 + nrm(ks[12], (DEPTH, HEAD_DIM), 0.02),
        "k_norm": 1.0 + nrm(ks[13], (DEPTH, HEAD_DIM), 0.02),
        "hgrn_lb_logits": nrm(ks[14], (2, DEPTH + 1, REC_K), 0.1),
        "hgrn_norm": 1.0 + nrm(ks[15], (DEPTH, R_DV), 0.02),
        "w_o": nrm(ks[16], (DEPTH, d, d), d ** -0.5),
        "w_up": nrm(ks[17], (DEPTH, d, 2 * D_FF), d ** -0.5),
        "conv_w": nrm(ks[18], (DEPTH, 3, 2 * D_FF), 3 ** -0.5),
        "conv_b": nrm(ks[19], (DEPTH, 2 * D_FF), 0.02),
        "w_down": nrm(ks[20], (DEPTH, D_FF, d), D_FF ** -0.5),
        "final_norm": 1.0 + nrm(ks[21], (d,), 0.02),
    }


def reference(x_prompt, x_sample, c, cache_k, cache_v, state_hgrn, c_ctx, ada_w, ada_b, norm1, norm2,
              w_in, q_norm, k_norm, hgrn_lb_logits, hgrn_norm, w_o, w_up, conv_w, conv_b, w_down, final_norm):
    lb_all = jnp.cumsum(jax.nn.softmax(hgrn_lb_logits.astype(jnp.float32), axis=1), axis=1)
    ang_row, ang_col = axial_angles(x_sample.shape[1])
    xp, xs = x_prompt, x_sample
    new_k, new_v, new_s = [], [], []
    for l in range(DEPTH):
        lb = lb_all[:, l].reshape(2, R_HEADS, R_DK)
        sh1, sc1, g1, sh2, sc2, g2 = adaln(c_ctx[None, :], ada_w[l], ada_b[l])
        h = rmsnorm(xp, norm1[l]) * (1.0 + sc1) + sh1
        out, k_c, v_c, s_f, s_b = token_mixer(h, w_in[l], w_o[l], q_norm[l], k_norm[l], hgrn_norm[l], lb,
                                              None, None, None, None, None, None)
        xp = xp + g1 * out
        h = rmsnorm(xp, norm2[l]) * (1.0 + sc2) + sh2
        xp = xp + g2 * conv_ffn(h, w_up[l], conv_w[l], conv_b[l], w_down[l])
        new_k.append(k_c)
        new_v.append(v_c)
        new_s.append(jnp.stack([s_f, s_b], axis=1).astype(xp.dtype))
        sh1, sc1, g1, sh2, sc2, g2 = adaln(c, ada_w[l], ada_b[l])
        h = rmsnorm(xs, norm1[l]) * (1.0 + sc1) + sh1
        out, _, _, _, _ = token_mixer(h, w_in[l], w_o[l], q_norm[l], k_norm[l], hgrn_norm[l], lb,
                                      ang_row, ang_col, cache_k[:, l], cache_v[:, l],
                                      state_hgrn[:, l, 0], state_hgrn[:, l, 1])
        xs = xs + g1 * out
        h = rmsnorm(xs, norm2[l]) * (1.0 + sc2) + sh2
        xs = xs + g2 * conv_ffn(h, w_up[l], conv_w[l], conv_b[l], w_down[l])
    y_prompt = rmsnorm(xp, final_norm)
    y_sample = rmsnorm(xs, final_norm)
    new_cache_k = jnp.stack(new_k, axis=1)
    new_cache_v = jnp.stack(new_v, axis=1)
    new_state_hgrn = jnp.stack(new_s, axis=1)
    return (y_prompt, y_sample, new_cache_k, new_cache_v, new_state_hgrn)
```

```cpp
#include <hip/hip_runtime.h>
#include <hip/hip_cooperative_groups.h>
#include <hip/hip_bf16.h>
#include <cstdio>
#include <cstdint>
#include <cmath>
namespace cg = cooperative_groups;

constexpr int DM = 1024, NPR = 4096  , MTOT = 20480, MH = 10240  ;
constexpr int INW = 8704, DFF = 2816, UPW = 5632;
constexpr int KVP = 256;
constexpr float EPS = 1e-6f;
constexpr float QSCALE = 0.125f * 1.4426950408889634f;

#define GAS __attribute__((address_space(1)))
#define LAS __attribute__((address_space(3)))
typedef unsigned short bf16_t;
typedef float f32x2 __attribute__((ext_vector_type(2)));
typedef unsigned u32x2 __attribute__((ext_vector_type(2)));
typedef float f32x16 __attribute__((ext_vector_type(16)));

__device__ __forceinline__ float bf2f(unsigned short h) { return __uint_as_float(((unsigned)h) << 16); }
__device__ __forceinline__ float bflo(unsigned w) { return __uint_as_float(w << 16); }
__device__ __forceinline__ float bfhi(unsigned w) { return __uint_as_float(w & 0xffff0000u); }
__device__ __forceinline__ float fsigmoid(float x) { return __builtin_amdgcn_rcpf(1.0f + __expf(-x)); }
__device__ __forceinline__ float fsilu(float x) { return x * fsigmoid(x); }
__device__ __forceinline__ unsigned pkh2(float a, float b) { _Float16 ha = (_Float16)a, hb = (_Float16)b; return (unsigned)__builtin_bit_cast(unsigned short, ha) | ((unsigned)__builtin_bit_cast(unsigned short, hb) << 16); }
__device__ __forceinline__ float h2f(unsigned short h) { return (float)__builtin_bit_cast(_Float16, h); }
__device__ __forceinline__ float wave_sum(float v) {
#pragma unroll
    for (int o = 1; o < 64; o <<= 1) v += __shfl_xor(v, o);
    return v;
}
__device__ __forceinline__ int mod_of_row(int grow) { return grow < NPR ? 0 : 1 + ((grow - NPR) >> 11); }
__device__ __forceinline__ int kv_row(int grow, int hf) {
    if (grow < NPR) return grow;
    const int s = grow - NPR, b = s >> 11, t = s & 2047;
    return (hf ? (b - 3) * 2560 : NPR + b * 2560) + t;
}

namespace pg8 {
#define PG8_LAS __attribute__((address_space(3)))
typedef unsigned short bf16_t;
typedef short bf16x8 __attribute__((ext_vector_type(8)));
typedef float f32x4 __attribute__((ext_vector_type(4)));
typedef unsigned u32x4 __attribute__((ext_vector_type(4)));
constexpr int BM = 256, BK = 64, HALF = 128, HTB = HALF * BK * 2  , STAGE_BYTES = 8 * HTB, NXCD = 8, WGM = 8;

__host__ __device__ __forceinline__ int lds_byte(int r, int c) { const int st = (r >> 4) * 2 + (c >> 5), rr = r & 15, cc = c & 31, ob = rr * 64 + cc * 2; return st * 1024 + (ob ^ (((ob >> 9) & 1) << 5)); }
__host__ __device__ __forceinline__ void stage_rc(int b, int& R, int& C) { const int st = b / 1024, sb = b % 1024, swz = sb ^ (((sb >> 9) & 1) << 5); R = (st >> 1) * 16 + swz / 64; C = (st & 1) * 32 + (swz % 64) / 2; }
__host__ __device__ __forceinline__ int perm32(int rho) { const int n = rho >> 4, i = rho & 15; return 8 * (i >> 2) + 4 * n + (i & 3); }

struct Unit { int pm, pn; };
struct Gemm { const bf16_t* A; const bf16_t* Bt; int M, N, K; };

struct StaticOrder {
    int nM, nN, nwg, G, c;
    __host__ __device__ void init(int M, int N, int G_, int c_) { nM = M / BM; nN = N / BM; nwg = nM * nN; G = G_; c = c_; }
    __host__ __device__ bool next(int i, Unit& u) const {
        const long L = (long)i * G + c; if (L >= nwg) return false;
        int wgid = (int)L; { const int q = nwg / NXCD, r = nwg % NXCD, xcd = wgid % NXCD, off = wgid / NXCD; wgid = (xcd < r ? xcd * (q + 1) : r * (q + 1) + (xcd - r) * q) + off; }
        const int nig = WGM * nN, gid = wgid / nig, fm = gid * WGM, gsz = (nM - fm) < WGM ? (nM - fm) : WGM;
        u.pm = fm + ((wgid % nig) % gsz); u.pn = (wgid % nig) / gsz; return true;
    }
    __device__ __forceinline__ void a_ready(const Unit&) const {}
    __device__ __forceinline__ void done(const Unit&) const {}
};

__device__ __forceinline__ unsigned cvt_pk_bf16(float lo, float hi) { unsigned r; asm volatile("v_cvt_pk_bf16_f32 %0, %1, %2" : "=v"(r) : "v"(lo), "v"(hi)); return r; }
__device__ __forceinline__ u32x2 pk4(f32x4 v) { u32x2 w; w.x = cvt_pk_bf16(v[0], v[1]); w.y = cvt_pk_bf16(v[2], v[3]); return w; }

#define EPI_FENCE() asm volatile("" ::: "memory")
struct EpiInProj {
    static constexpr bool PERM = false, AFTER_DRAIN = false;
    bf16_t *Q, *Kb, *Vb, *RQ, *GF, *GB, *RI, *ZA, *PP; float *nck, *ncv; const float *qg, *kg, *lbt; const float* rope; int hf;
    __device__ __forceinline__ void operator()(const f32x4 (&acc)[2][2][4][2], const Unit& u, int wr, int wc, int fr, int fq) const {
        const int T = u.pn;
        const int lrow0 = u.pm * BM + wr * 64 + fr;
        if (T <= 4) {
            const bool isq = T < 4; const float* gain = (isq ? qg : kg) + 4 * fq;
#pragma unroll
            for (int ai = 0; ai < 2; ++ai)
#pragma unroll
                for (int m = 0; m < 4; ++m) {
                    const int lrow = lrow0 + ai * HALF + m * 16, grow = hf * MH + lrow;
                    float ss = 0.f;
#pragma unroll
                    for (int bj = 0; bj < 2; ++bj)
#pragma unroll
                        for (int n = 0; n < 2; ++n) { const f32x4 v = acc[ai][bj][m][n]; ss += (v[0] * v[0] + v[1] * v[1]) + (v[2] * v[2] + v[3] * v[3]); }
                    ss += __shfl_xor(ss, 16); ss += __shfl_xor(ss, 32);
                    const float rs = __builtin_amdgcn_rsqf(ss * (1.0f / 64.0f) + EPS);
                    const bool latent = grow >= NPR;
                    const int t = (grow - NPR) & 2047;
#pragma unroll
                    for (int bj = 0; bj < 2; ++bj) {
                        f32x4 x1 = acc[ai][bj][m][0] * rs * *(const f32x4*)(gain + 32 * bj), x2 = acc[ai][bj][m][1] * rs * *(const f32x4*)(gain + 32 * bj + 16);
                        if (latent) {
                            const int pos = bj ? (t & 63) : (t >> 6);
                            const f32x4 cs0 = *(const f32x4*)(rope + (pos * 16 + 4 * fq) * 2), cs1 = *(const f32x4*)(rope + (pos * 16 + 4 * fq) * 2 + 4);
                            const f32x4 c = {cs0[0], cs0[2], cs1[0], cs1[2]}, s = {cs0[1], cs0[3], cs1[1], cs1[3]};
                            const f32x4 y1 = x1 * c - x2 * s, y2 = x1 * s + x2 * c; x1 = y1; x2 = y2;
                        }
                        if (isq) {
                            bf16_t* qp = Q + (unsigned)(lrow * DM + (4 * T + wc) * 64 + 4 * fq + 32 * bj);
                            *(u32x2*)(qp) = pk4(x1 * QSCALE); *(u32x2*)(qp + 16) = pk4(x2 * QSCALE);
                        } else {
                            bf16_t* kp = Kb + (unsigned)(kv_row(grow, hf) * KVP + wc * 64 + 4 * fq + 32 * bj);
                            *(u32x2*)(kp) = pk4(x1); *(u32x2*)(kp + 16) = pk4(x2);
                            if (!latent) { float* op = nck + (unsigned)(grow * KVP + wc * 64 + 4 * fq + 32 * bj); *(f32x4*)(op) = x1; *(f32x4*)(op + 16) = x2; }
                        }
                    }
                    EPI_FENCE();
                }
        } else if (T == 5) {
#pragma unroll
            for (int ai = 0; ai < 2; ++ai)
#pragma unroll
                for (int m = 0; m < 4; ++m) {
                    const int lrow = lrow0 + ai * HALF + m * 16, grow = hf * MH + lrow;
                    bf16_t* vp = Vb + (unsigned)(kv_row(grow, hf) * KVP + wc * 64 + 4 * fq);
#pragma unroll
                    for (int bj = 0; bj < 2; ++bj)
#pragma unroll
                        for (int n = 0; n < 2; ++n) *(u32x2*)(vp + 32 * bj + 16 * n) = pk4(acc[ai][bj][m][n]);
                    if (grow < NPR) { float* op = ncv + (unsigned)(grow * KVP + wc * 64 + 4 * fq);
#pragma unroll
                        for (int bj = 0; bj < 2; ++bj)
#pragma unroll
                            for (int n = 0; n < 2; ++n) *(f32x4*)(op + 32 * bj + 16 * n) = acc[ai][bj][m][n]; }
                    EPI_FENCE();
                }
        } else if (T < 10) {
            bf16_t* base = RQ + (T - 6) * 256 + wc * 64;
#pragma unroll
            for (int ai = 0; ai < 2; ++ai)
#pragma unroll
                for (int m = 0; m < 4; ++m) { bf16_t* rp = base + (unsigned)((lrow0 + ai * HALF + m * 16) * DM + 4 * fq);
#pragma unroll
                    for (int bj = 0; bj < 2; ++bj)
#pragma unroll
                        for (int n = 0; n < 2; ++n) { const f32x4 v = acc[ai][bj][m][n]; f32x4 o;
#pragma unroll
                            for (int j = 0; j < 4; ++j) o[j] = fsilu(v[j]) * 0.08838834764831845f;
                            *(u32x2*)(rp + 32 * bj + 16 * n) = pk4(o); }
                    EPI_FENCE(); }
        } else if (T < 18) {
            const int d = T >= 14; const int colb = ((T - 10) & 3) * 256 + wc * 64;
            bf16_t* base = (d ? GB : GF) + colb; const float* lbp = lbt + d * 1024 + colb + 4 * fq;
#pragma unroll
            for (int ai = 0; ai < 2; ++ai)
#pragma unroll
                for (int m = 0; m < 4; ++m) { bf16_t* rp = base + (unsigned)((lrow0 + ai * HALF + m * 16) * DM + 4 * fq);
#pragma unroll
                    for (int bj = 0; bj < 2; ++bj)
#pragma unroll
                        for (int n = 0; n < 2; ++n) { const f32x4 v = acc[ai][bj][m][n]; const f32x4 lb = *(const f32x4*)(lbp + 32 * bj + 16 * n); float g[4];
#pragma unroll
                            for (int j = 0; j < 4; ++j) { const float l = lb[j]; g[j] = __logf(l + (1.0f - l) * fsigmoid(v[j])); }
                            u32x2 w; w.x = pkh2(g[0], g[1]); w.y = pkh2(g[2], g[3]); *(u32x2*)(rp + 32 * bj + 16 * n) = w; }
                    EPI_FENCE(); }
        } else if (T < 26) {
            const bool sig = T >= 22; bf16_t* base = (sig ? ZA : RI) + ((T - 18) & 3) * 256 + wc * 64;
#pragma unroll
            for (int ai = 0; ai < 2; ++ai)
#pragma unroll
                for (int m = 0; m < 4; ++m) { bf16_t* rp = base + (unsigned)((lrow0 + ai * HALF + m * 16) * DM + 4 * fq);
#pragma unroll
                    for (int bj = 0; bj < 2; ++bj)
#pragma unroll
                        for (int n = 0; n < 2; ++n) { f32x4 v = acc[ai][bj][m][n];
                            if (sig) {
#pragma unroll
                                for (int j = 0; j < 4; ++j) v[j] = fsigmoid(v[j]); }
                            *(u32x2*)(rp + 32 * bj + 16 * n) = pk4(v); }
                    EPI_FENCE(); }
        } else {
            bf16_t* base = PP + (T - 26) * 128 + wc * 32;
#pragma unroll
            for (int ai = 0; ai < 2; ++ai)
#pragma unroll
                for (int m = 0; m < 4; ++m) { bf16_t* rp = base + (unsigned)((lrow0 + ai * HALF + m * 16) * DM + 4 * fq);
#pragma unroll
                    for (int n = 0; n < 2; ++n) { const f32x4 a = acc[ai][0][m][n], b = acc[ai][1][m][n]; f32x4 o;
#pragma unroll
                        for (int j = 0; j < 4; ++j) o[j] = fsilu(a[j]) * fsigmoid(b[j]);
                        *(u32x2*)(rp + 16 * n) = pk4(o); }
                    EPI_FENCE(); }
        }
    }
};

struct EpiResid {
    static constexpr bool PERM = false, AFTER_DRAIN = false;
    const float* basep; const float* bases; float* out; const float* modb; int goff; int hf;
    __device__ __forceinline__ void operator()(const f32x4 (&acc)[2][2][4][2], const Unit& u, int wr, int wc, int fr, int fq) const {
        const int grow0 = hf * MH + u.pm * BM; const int mi = mod_of_row(grow0);
        const int col0 = u.pn * BM + wc * 64 + 4 * fq;
        const float* base = grow0 < NPR ? basep + (size_t)grow0 * DM : bases + (size_t)(grow0 - NPR) * DM;
        float* ob = out + (size_t)grow0 * DM;
        const float* gp = modb + mi * 6144 + goff + col0;
#pragma unroll
        for (int ai = 0; ai < 2; ++ai)
#pragma unroll
            for (int m = 0; m < 4; ++m) { const unsigned off = (unsigned)((ai * HALF + wr * 64 + m * 16 + fr) * DM + col0);
#pragma unroll
                for (int bj = 0; bj < 2; ++bj)
#pragma unroll
                    for (int n = 0; n < 2; ++n) { const f32x4 b = *(const f32x4*)(base + off + 32 * bj + 16 * n); const f32x4 gt = *(const f32x4*)(gp + 32 * bj + 16 * n);
                        *(f32x4*)(ob + off + 32 * bj + 16 * n) = b + gt * acc[ai][bj][m][n]; }
                EPI_FENCE(); }
    }
};

struct EpiPlain {
    static constexpr bool PERM = false, AFTER_DRAIN = false;
    bf16_t* O; int ldc;
    __device__ __forceinline__ void operator()(const f32x4 (&acc)[2][2][4][2], const Unit& u, int wr, int wc, int fr, int fq) const {
        bf16_t* base = O + u.pn * BM + wc * 64 + 4 * fq;
#pragma unroll
        for (int ai = 0; ai < 2; ++ai)
#pragma unroll
            for (int m = 0; m < 4; ++m) { bf16_t* rp = base + (size_t)(u.pm * BM + ai * HALF + wr * 64 + m * 16 + fr) * ldc;
#pragma unroll
                for (int bj = 0; bj < 2; ++bj)
#pragma unroll
                    for (int n = 0; n < 2; ++n) *(u32x2*)(rp + 32 * bj + 16 * n) = pk4(acc[ai][bj][m][n]); }
    }
};

template <class Epi, class Sched, bool ALIGN_EPI = false, bool SP2 = false>
__device__ __forceinline__ void gemm_phase(PG8_LAS unsigned char* lds, const Gemm g, const Sched& S, const Epi& E) {
    int tid_o = threadIdx.x; asm volatile("" : "+v"(tid_o));
    const int tid = tid_o, wid = __builtin_amdgcn_readfirstlane(tid >> 6), lane = tid & 63, wr = wid >> 2, wc = wid & 3, fr = lane & 15, fq = lane >> 4;
    const int K = g.K, nt = K / BK;
    unsigned voffA[2], voffB[2];
#pragma unroll
    for (int i = 0; i < 2; ++i) { int R, C; stage_rc(tid * 16 + i * 8192, R, C); const int Rb = Epi::PERM ? ((R & ~31) + perm32(R & 31)) : R;
        voffA[i] = (unsigned)(R * K + C) * 2u; voffB[i] = (unsigned)(Rb * K + C) * 2u; }
    const size_t kstep = (size_t)(BK * 2);
    const size_t hstep = (size_t)HALF * K * 2;
    const size_t tstep = 2 * hstep;
    const unsigned ldsw = (unsigned)wid * 1024u;
    const int aoff = lds_byte(wr * 64 + fr, fq * 8), boff = lds_byte(wc * 32 + fr, fq * 8);
#define PG8_SA(b, h) (((b) * 2 + (h)) * HTB)
#define PG8_SB(b, h) ((4 + (b) * 2 + (h)) * HTB)
#define PG8_STAGE(bufoff, gbase, voff) do { _Pragma("unroll") for (int _i = 0; _i < 2; ++_i) \
        __builtin_amdgcn_global_load_lds((const unsigned*)((const char*)(gbase) + (voff)[_i]), (PG8_LAS unsigned*)(lds + (bufoff) + ldsw + _i * 8192), 16, 0, 0); } while (0)
#define PG8_LDA(dst, b, h) do { _Pragma("unroll") for (int m = 0; m < 4; ++m) _Pragma("unroll") for (int k = 0; k < 2; ++k) dst[m][k] = *(const PG8_LAS bf16x8*)(lds + PG8_SA(b, h) + aoff + m * 2048 + k * 1024); } while (0)
#define PG8_LDB(dst, b, h) do { _Pragma("unroll") for (int n = 0; n < 2; ++n) _Pragma("unroll") for (int k = 0; k < 2; ++k) dst[n][k] = *(const PG8_LAS bf16x8*)(lds + PG8_SB(b, h) + boff + n * 2048 + k * 1024); } while (0)
#define PG8_MMA(ai, bj, At, Bt) do { __builtin_amdgcn_s_setprio(1); _Pragma("unroll") for (int m = 0; m < 4; ++m) _Pragma("unroll") for (int n = 0; n < 2; ++n) _Pragma("unroll") for (int k = 0; k < 2; ++k) \
        acc[ai][bj][m][n] = __builtin_amdgcn_mfma_f32_16x16x32_bf16(Bt[n][k], At[m][k], acc[ai][bj][m][n], 0, 0, 0); __builtin_amdgcn_s_setprio(0); } while (0)
#define PG8_WAIT_V(n) asm volatile("s_waitcnt vmcnt(" #n ")" ::: "memory")
#define PG8_WAIT_L(n) asm volatile("s_waitcnt lgkmcnt(" #n ")" ::: "memory")
#define PG8_BAR __builtin_amdgcn_s_barrier()
#define PG8_SCHED __builtin_amdgcn_sched_barrier(0)
    Unit cur, nxt; int ui = 0;
    if (!S.next(0, cur)) return;
    f32x4 acc[2][2][4][2];
#pragma unroll
    for (int a = 0; a < 2; ++a)
#pragma unroll
        for (int b = 0; b < 2; ++b)
#pragma unroll
            for (int m = 0; m < 4; ++m)
#pragma unroll
                for (int n = 0; n < 2; ++n) acc[a][b][m][n] = (f32x4){0.f, 0.f, 0.f, 0.f};
    bf16x8 At[4][2], B0[2][2], B1[2][2];
    const char* cA = (const char*)g.A + (size_t)cur.pm * tstep; const char* cB = (const char*)g.Bt + (size_t)cur.pn * tstep;
    S.a_ready(cur);
    if constexpr (SP2) {
        PG8_STAGE(PG8_SB(0, 0), cB, voffB); PG8_STAGE(PG8_SB(0, 1), cB + hstep, voffB); PG8_STAGE(PG8_SA(0, 0), cA, voffA); PG8_STAGE(PG8_SA(0, 1), cA + hstep, voffA);
        if (wr == 1) PG8_BAR;
        PG8_WAIT_V(2); PG8_BAR;
        PG8_STAGE(PG8_SB(1, 0), cB + kstep, voffB); PG8_STAGE(PG8_SA(1, 0), cA + kstep, voffA); PG8_STAGE(PG8_SB(1, 1), cB + hstep + kstep, voffB);
        PG8_WAIT_V(6); PG8_BAR;
    } else {
        PG8_STAGE(PG8_SB(0, 0), cB, voffB); PG8_STAGE(PG8_SA(0, 0), cA, voffA); PG8_STAGE(PG8_SB(0, 1), cB + hstep, voffB); PG8_STAGE(PG8_SA(0, 1), cA + hstep, voffA);
        if (wr == 1) PG8_BAR;
        PG8_WAIT_V(4); PG8_BAR;
        PG8_STAGE(PG8_SB(1, 0), cB + kstep, voffB); PG8_STAGE(PG8_SA(1, 0), cA + kstep, voffA); PG8_STAGE(PG8_SB(1, 1), cB + hstep + kstep, voffB);
        PG8_WAIT_V(6); PG8_BAR;
    }
    for (;;) {
        const bool has_next = S.next(ui + 1, nxt);
        const char* nA = has_next ? (const char*)g.A + (size_t)nxt.pm * tstep : cA; const char* nB = has_next ? (const char*)g.Bt + (size_t)nxt.pn * tstep : cB;
        for (int t = 0; t < nt; t += 2) {
            const bool last = (t == nt - 2);
            const char* a1 = cA + (size_t)(t + 1) * kstep;
            const char* a2 = last ? nA : cA + (size_t)(t + 2) * kstep; const char* b2 = last ? nB : cB + (size_t)(t + 2) * kstep;
            const char* a3 = a2 + kstep; const char* b3 = b2 + kstep;
            if (last && has_next) S.a_ready(nxt);
            if constexpr (SP2) {
            PG8_LDB(B0, 0, 0); PG8_LDB(B1, 0, 1); PG8_SCHED; PG8_LDA(At, 0, 0); PG8_STAGE(PG8_SA(1, 1), a1 + hstep, voffA);
            PG8_WAIT_V(8); PG8_WAIT_L(0); PG8_BAR; PG8_MMA(0, 0, At, B0); PG8_MMA(0, 1, At, B1); PG8_BAR; PG8_SCHED;
            PG8_LDA(At, 0, 1); PG8_STAGE(PG8_SB(0, 0), b2, voffB); PG8_STAGE(PG8_SB(0, 1), b2 + hstep, voffB); PG8_STAGE(PG8_SA(0, 0), a2, voffA);
            PG8_WAIT_V(8); PG8_WAIT_L(0); PG8_BAR; PG8_MMA(1, 0, At, B0); PG8_MMA(1, 1, At, B1); PG8_BAR; PG8_SCHED;
            PG8_LDB(B0, 1, 0); PG8_LDB(B1, 1, 1); PG8_SCHED; PG8_LDA(At, 1, 0); PG8_STAGE(PG8_SA(0, 1), a2 + hstep, voffA);
            PG8_WAIT_V(8); PG8_WAIT_L(0); PG8_BAR; PG8_MMA(0, 0, At, B0); PG8_MMA(0, 1, At, B1); PG8_BAR; PG8_SCHED;
            PG8_LDA(At, 1, 1); PG8_STAGE(PG8_SB(1, 0), b3, voffB); PG8_STAGE(PG8_SB(1, 1), b3 + hstep, voffB); PG8_STAGE(PG8_SA(1, 0), a3, voffA);
            PG8_WAIT_V(8); PG8_WAIT_L(0); PG8_BAR; PG8_MMA(1, 0, At, B0); PG8_MMA(1, 1, At, B1); PG8_BAR; PG8_SCHED;
            } else {
            PG8_LDB(B0, 0, 0); PG8_SCHED; PG8_LDA(At, 0, 0); PG8_STAGE(PG8_SA(1, 1), a1 + hstep, voffA);
            PG8_WAIT_L(8); PG8_BAR; PG8_WAIT_L(0); PG8_MMA(0, 0, At, B0); PG8_BAR; PG8_SCHED;
            PG8_LDB(B1, 0, 1); PG8_STAGE(PG8_SB(0, 0), b2, voffB);
            PG8_BAR; PG8_WAIT_L(0); PG8_MMA(0, 1, At, B1); PG8_BAR;
            PG8_LDA(At, 0, 1); PG8_STAGE(PG8_SA(0, 0), a2, voffA);
            PG8_BAR; PG8_WAIT_L(0); PG8_MMA(1, 0, At, B0); PG8_BAR; PG8_SCHED;
            PG8_STAGE(PG8_SB(0, 1), b2 + hstep, voffB);
            PG8_WAIT_V(6); PG8_BAR; PG8_MMA(1, 1, At, B1); PG8_BAR;
            PG8_LDB(B0, 1, 0); PG8_SCHED; PG8_LDA(At, 1, 0); PG8_STAGE(PG8_SA(0, 1), a2 + hstep, voffA);
            PG8_WAIT_L(8); PG8_BAR; PG8_WAIT_L(0); PG8_MMA(0, 0, At, B0); PG8_BAR; PG8_SCHED;
            PG8_LDB(B1, 1, 1); PG8_STAGE(PG8_SB(1, 0), b3, voffB);
            PG8_BAR; PG8_WAIT_L(0); PG8_MMA(0, 1, At, B1); PG8_BAR;
            PG8_LDA(At, 1, 1); PG8_STAGE(PG8_SA(1, 0), a3, voffA);
            PG8_BAR; PG8_WAIT_L(0); PG8_MMA(1, 0, At, B0); PG8_BAR; PG8_SCHED;
            PG8_STAGE(PG8_SB(1, 1), b3 + hstep, voffB);
            PG8_WAIT_V(6); PG8_BAR; PG8_MMA(1, 1, At, B1); PG8_BAR;
            }
        }
        if constexpr (ALIGN_EPI) { if (wr == 0) PG8_BAR; }
        if constexpr (!Epi::AFTER_DRAIN) { E(acc, cur, wr, wc, fr, fq); S.done(cur); }
        if (!has_next) break;
#pragma unroll
        for (int a = 0; a < 2; ++a)
#pragma unroll
            for (int b = 0; b < 2; ++b)
#pragma unroll
                for (int m = 0; m < 4; ++m)
#pragma unroll
                    for (int n = 0; n < 2; ++n) acc[a][b][m][n] = (f32x4){0.f, 0.f, 0.f, 0.f};
        cur = nxt; cA = nA; cB = nB; ++ui;
        if constexpr (ALIGN_EPI) { if (wr == 1) PG8_BAR; }
    }
    PG8_WAIT_V(0);
    if constexpr (!ALIGN_EPI) { if (wr == 0) PG8_BAR; }
    PG8_BAR;
    if constexpr (Epi::AFTER_DRAIN) { E.fused(acc, cur, wr, wc, fr, fq, lds, wid, lane); S.done(cur); }
#undef PG8_SA
#undef PG8_SB
#undef PG8_STAGE
#undef PG8_LDA
#undef PG8_LDB
#undef PG8_MMA
#undef PG8_WAIT_V
#undef PG8_WAIT_L
#undef PG8_BAR
#undef PG8_SCHED
}
}

namespace attn_body {
using bf16=__hip_bfloat16;
using bf16x8=__attribute__((ext_vector_type(8)))short;
using s16x4=__attribute__((ext_vector_type(4)))short;
using f32x16=__attribute__((ext_vector_type(16)))float;
using u32x4=__attribute__((ext_vector_type(4)))unsigned;
constexpr int NHEAD=16,D=64,DM=NHEAD*D,KVPITCH=256;
constexpr int NW=8,QBLK=32,QB=QBLK*NW,KVBLK=64;
constexpr int ATTN_PITCH=DM, ATTN_UNIT_ROWS=QB;
__device__ __forceinline__ int crow(int r,int hi){return (r&3)+8*(r>>2)+4*hi;}
#define SBAR() __builtin_amdgcn_sched_barrier(0)
__device__ __forceinline__ void cmask(f32x16&p0,f32x16&p1,int jb,int qrel,int hi){
  const float NEG=-INFINITY; int kb=64*jb+4*hi;
  #pragma unroll
  for(int r=0;r<16;++r){int kv=kb+(r&3)+8*(r>>2); if(kv>qrel)p0[r]=NEG; if(kv+32>qrel)p1[r]=NEG;}
}

constexpr int NSLOT=3, SLOTB=8192;
constexpr int LDS_K=0, LDS_V=NSLOT*SLOTB, LDS_WS=2*NSLOT*SLOTB, LDS_OST=LDS_WS+NW*64*4, LDS_BYTES=LDS_OST+NW*4096;
constexpr float C2=0.125f*1.4426950408889634f;
__device__ __forceinline__ void glds16(const void*gsrc,unsigned lds_dst){unsigned keep;
  asm volatile("s_mov_b32 %0, m0\n\ts_mov_b32 m0, %2\n\ts_nop 0\n\tglobal_load_lds_dwordx4 %1, off\n\ts_mov_b32 m0, %0":"=&s"(keep):"v"(gsrc),"s"(lds_dst):"memory");}
__device__ __forceinline__ float max3f(float a,float b,float c){float r;asm("v_max3_f32 %0, %1, %2, %3":"=v"(r):"v"(a),"v"(b),"v"(c));return r;}
__device__ __forceinline__ float max2f(float a,float b){float r;asm("v_max_f32_e32 %0, %1, %2":"=v"(r):"v"(a),"v"(b));return r;}
__device__ __forceinline__ float fadd_s(float a,float b){float r;asm("v_add_f32_e32 %0, %1, %2":"=v"(r):"v"(a),"v"(b));return r;}
__device__ __forceinline__ float fsub_s(float a,float b){float r;asm("v_sub_f32_e32 %0, %1, %2":"=v"(r):"v"(a),"v"(b));return r;}
typedef float f32x2_t __attribute__((ext_vector_type(2))); typedef __bf16 bf16x2_t __attribute__((ext_vector_type(2)));
__device__ __forceinline__ unsigned cvtpk_s(float lo,float hi){f32x2_t v={lo,hi};bf16x2_t b=__builtin_convertvector(v,bf16x2_t);return __builtin_bit_cast(unsigned,b);}
#define WAIT_BAR(N) asm volatile("s_waitcnt vmcnt(" #N ") lgkmcnt(0)\n\ts_barrier":::"memory")

__device__ __forceinline__ void qkt(f32x16&p0,f32x16&p1,const char*Kslot,const bf16x8*qr,const f32x16&negm,int r32,int hi){
  const char*kb=Kslot+hi*1024+r32*16;
  #pragma unroll
  for(int d0=0;d0<4;++d0){
    const bf16x8 b0=*reinterpret_cast<const bf16x8*>(kb+d0*2048);
    const bf16x8 b1=*reinterpret_cast<const bf16x8*>(kb+d0*2048+512);
    if(d0==0){p0=__builtin_amdgcn_mfma_f32_32x32x16_bf16(b0,qr[0],negm,0,0,0);p1=__builtin_amdgcn_mfma_f32_32x32x16_bf16(b1,qr[0],negm,0,0,0);}
    else{p0=__builtin_amdgcn_mfma_f32_32x32x16_bf16(b0,qr[d0],p0,0,0,0);p1=__builtin_amdgcn_mfma_f32_32x32x16_bf16(b1,qr[d0],p1,0,0,0);}}
}
typedef __attribute__((address_space(3))) const char* lds_cptr;
typedef short v4i16_t __attribute__((ext_vector_type(4)));
__device__ __forceinline__ void kload8(bf16x8*kf,lds_cptr kp){
  kf[0]=*(const __attribute__((address_space(3))) bf16x8*)(kp);      kf[1]=*(const __attribute__((address_space(3))) bf16x8*)(kp+512);
  kf[2]=*(const __attribute__((address_space(3))) bf16x8*)(kp+2048); kf[3]=*(const __attribute__((address_space(3))) bf16x8*)(kp+2560);
  kf[4]=*(const __attribute__((address_space(3))) bf16x8*)(kp+4096); kf[5]=*(const __attribute__((address_space(3))) bf16x8*)(kp+4608);
  kf[6]=*(const __attribute__((address_space(3))) bf16x8*)(kp+6144); kf[7]=*(const __attribute__((address_space(3))) bf16x8*)(kp+6656);
}
__device__ __forceinline__ void kload2(bf16x8*kf,lds_cptr kp,int j){ kf[2*j]=*(const __attribute__((address_space(3))) bf16x8*)(kp+j*2048); kf[2*j+1]=*(const __attribute__((address_space(3))) bf16x8*)(kp+j*2048+512); }
__device__ __forceinline__ s16x4 vtr(lds_cptr p){ return __builtin_bit_cast(s16x4,__builtin_amdgcn_ds_read_tr16_b64_v4i16((__attribute__((address_space(3))) v4i16_t*)p)); }
__device__ __forceinline__ float rowmax(const f32x16&p0,const f32x16&p1){
  float a=max3f(p0[0],p0[1],p1[0]),b=max3f(p0[2],p0[3],p1[1]);a=max3f(a,p1[2],p1[3]);
  #pragma unroll
  for(int r=4;r<16;r+=4){a=max3f(a,p0[r],p0[r+1]);b=max3f(b,p0[r+2],p0[r+3]);a=max3f(a,p1[r],p1[r+1]);b=max3f(b,p1[r+2],p1[r+3]);}
  const float m=max2f(a,b);
  auto rr=__builtin_amdgcn_permlane32_swap(__float_as_uint(m),__float_as_uint(m),false,false);
  return max2f(__uint_as_float(rr[0]),__uint_as_float(rr[1]));
}
__device__ __forceinline__ void pv(f32x16*o,int vb,bf16x8 pa0,bf16x8 pa1,bf16x8 pa2,bf16x8 pa3){
  #pragma unroll
  for(int d0=0;d0<2;++d0){s16x4 lo[4],hi[4];
    #pragma unroll
    for(int ks=0;ks<4;++ks){
      asm volatile("ds_read_b64_tr_b16 %0,%1 offset:%c2":"=&v"(lo[ks]):"v"(vb),"i"(d0*4096+ks*1024):"memory");
      asm volatile("ds_read_b64_tr_b16 %0,%1 offset:%c2":"=&v"(hi[ks]):"v"(vb),"i"(d0*4096+ks*1024+512):"memory");}
    asm volatile("s_waitcnt lgkmcnt(0)":::"memory");SBAR();
    #define PK(k) (bf16x8){lo[k][0],lo[k][1],lo[k][2],lo[k][3],hi[k][0],hi[k][1],hi[k][2],hi[k][3]}
    o[d0]=__builtin_amdgcn_mfma_f32_32x32x16_bf16(pa0,PK(0),o[d0],0,0,0);
    o[d0]=__builtin_amdgcn_mfma_f32_32x32x16_bf16(pa1,PK(1),o[d0],0,0,0);
    o[d0]=__builtin_amdgcn_mfma_f32_32x32x16_bf16(pa2,PK(2),o[d0],0,0,0);
    o[d0]=__builtin_amdgcn_mfma_f32_32x32x16_bf16(pa3,PK(3),o[d0],0,0,0);
    #undef PK
  }
}

#ifndef ATTN_STORE16
#define ATTN_STORE16(p,v) (*(u32x4*)(p)=(v))
#endif
template<int THRL> __device__ __forceinline__ void attn_unit(const bf16*Qu,const bf16*__restrict__ Kh,const bf16*__restrict__ Vh,bf16*Ou,const int NT,char*shm){
  int tid_o=threadIdx.x; asm volatile("":"+v"(tid_o));
  const int tid=tid_o,lane=tid&63,r32=lane&31,hi=lane>>5; const int wid=__builtin_amdgcn_readfirstlane(tid>>6);
  const bf16*Qw=Qu+(long)(wid*QBLK)*DM;
  const unsigned lds0=(unsigned)(uintptr_t)shm;
  float*wsf=(float*)(shm+LDS_WS)+wid*64;
  const bf16*ksrc=Kh+(long)lane*KVPITCH+wid*8;
  const bf16*vsrc=Vh+(long)(16*(wid&3)+(lane>>2))*KVPITCH+(wid>>2)*32+(lane&3)*8;
  const unsigned kdst=lds0+LDS_K+wid*1024, vdst=lds0+LDS_V+wid*1024;
  #define DMA_K(t,slot) glds16(ksrc+(long)(t)*KVBLK*KVPITCH,(unsigned)__builtin_amdgcn_readfirstlane(kdst+(slot)))
  #define DMA_V(t,slot) glds16(vsrc+(long)(t)*KVBLK*KVPITCH,(unsigned)__builtin_amdgcn_readfirstlane(vdst+(slot)))
  const int vb0=(int)(lds0+LDS_V)+((lane>>4)&1)*32+(lane&3)*8+(4*hi+((lane&15)>>2))*64;
  const char*Kbase=shm+LDS_K; bf16x8 kf[8];
  const lds_cptr shm3=(lds_cptr)shm; const lds_cptr kp0=shm3+LDS_K+hi*1024+r32*16; const lds_cptr vp0=shm3+LDS_V+((lane>>4)&1)*32+(lane&3)*8+(4*hi+((lane&15)>>2))*64;
  DMA_K(0,0);DMA_V(0,0);DMA_K(1,SLOTB);
  bf16x8 qr[4];
  #pragma unroll
  for(int d0=0;d0<4;++d0)qr[d0]=*reinterpret_cast<const bf16x8*>(&Qw[(long)r32*DM+d0*16+hi*8]);
  float mhat=0.f,l_reg=0.f;f32x16 o[2];o[0]=f32x16{};o[1]=f32x16{};f32x16 negm=f32x16{};asm volatile("":"+v"(negm));
  #define CMASK(P0,P1,t) do{}while(0)
  bool resc=false;
  #define START(P0,P1) do{ const float rm=rowmax(P0,P1); resc=false; \
    { const float dl=rm; mhat=fadd_s(mhat,dl); \
      _Pragma("unroll") for(int r=0;r<16;++r){P0[r]=fsub_s(P0[r],dl);P1[r]=fsub_s(P1[r],dl);} \
      _Pragma("unroll") for(int r=0;r<16;++r)negm[r]=-mhat; asm volatile("":"+v"(negm)); } \
    _Pragma("unroll") for(int r=0;r<16;++r)P0[r]=__builtin_amdgcn_exp2f(P0[r]); }while(0)
  #define RESC() do{ if(resc){ asm volatile("s_waitcnt lgkmcnt(0)":::"memory"); \
      _Pragma("unroll") for(int d_=0;d_<2;++d_) _Pragma("unroll") for(int r=0;r<16;++r)o[d_][r]*=wsf[crow(r,hi)]; } }while(0)
  f32x16 pA0,pA1,pB0,pB1;
  int sl_prev=0,sl_cur=0,sl_next=SLOTB;
  #define ROT() do{sl_prev=sl_cur;sl_cur=sl_next;sl_next=(sl_next==(NSLOT-1)*SLOTB)?0:sl_next+SLOTB;}while(0)
  DMA_K(2,2*SLOTB);
  WAIT_BAR(3);
  qkt(pA0,pA1,Kbase,qr,negm,r32,hi);asm volatile("s_nop 15\n\ts_nop 7":"+v"(pA0),"+v"(pA1));CMASK(pA0,pA1,0);
  START(pA0,pA1);
  _Pragma("unroll") for(int r=0;r<16;++r)pA1[r]=__builtin_amdgcn_exp2f(pA1[r]);
  WAIT_BAR(0);
  DMA_K(3,0);DMA_V(1,SLOTB);
  ROT();
  kload8(kf,kp0+sl_cur);
  WAIT_BAR(2);
  s16x4 vlo[8],vhi[8]; u32x4 pw0,pw1,pw2,pw3;
  #define PKW(P,B) cvtpk_s(P[B],P[B+1])
  #define PAF(k) __builtin_bit_cast(bf16x8,pw##k)
  #define VFR(i) (bf16x8){vlo[i][0],vlo[i][1],vlo[i][2],vlo[i][3],vhi[i][0],vhi[i][1],vhi[i][2],vhi[i][3]}
  #define PIN(x) asm volatile("":"+v"(x))
  #define MX3(a,b,c) __builtin_fmaxf(__builtin_fmaxf((a),(b)),(c))
  #define GAPA(MF,A0,A1,A2,A3,W0,W1,PW) do{ MF; sacc+=A0; sacc+=A1; sacc+=A2; sacc+=A3; PIN(sacc); W0; W1; PIN(PW); SBAR(); }while(0)
  #define EX(v) __builtin_amdgcn_exp2f(v)
  #define GAPB(MF,X,B) do{ MF; X[B]=EX(X[B]); X[B+1]=EX(X[B+1]); X[B+2]=EX(X[B+2]); X[B+3]=EX(X[B+3]); PIN(X); SBAR(); }while(0)
  #define VRD(i) do{ vlo[i]=vtr(vp_+(((i)>>2)*4096+((i)&3)*1024)); vhi[i]=vtr(vp_+(((i)>>2)*4096+((i)&3)*1024+512)); }while(0)
  #define KRD(G,j) do{ if(G){ kload2(kf,kp0+sl_next,j); SBAR(); } }while(0)
  #define STEP(C0,C1,P0,P1,t,GK,GV,GL) do{ SBAR(); \
    const lds_cptr vp_=vp0+sl_prev; \
    VRD(0); SBAR(); float sacc=(P0[0]+P0[1]); \
    GAPA(C0=__builtin_amdgcn_mfma_f32_32x32x16_bf16(kf[0],qr[0],negm,0,0,0), P0[2],P0[3],P0[4],P0[5],     pw0[0]=PKW(P0,0), pw0[1]=PKW(P0,2), pw0); \
    VRD(4); SBAR(); GAPA(C1=__builtin_amdgcn_mfma_f32_32x32x16_bf16(kf[1],qr[0],negm,0,0,0), P0[6],P0[7],P0[8],P0[9],     pw0[2]=PKW(P0,4), pw0[3]=PKW(P0,6), pw0); \
    VRD(1); SBAR(); GAPA(C0=__builtin_amdgcn_mfma_f32_32x32x16_bf16(kf[2],qr[1],C0,0,0,0),   P0[10],P0[11],P0[12],P0[13], pw1[0]=PKW(P0,8), pw1[1]=PKW(P0,10), pw1); \
    VRD(5); SBAR(); GAPA(C1=__builtin_amdgcn_mfma_f32_32x32x16_bf16(kf[3],qr[1],C1,0,0,0),   P0[14],P0[15],P1[0],P1[1],   pw1[2]=PKW(P0,12),pw1[3]=PKW(P0,14), pw1); \
    VRD(2); SBAR(); GAPA(C0=__builtin_amdgcn_mfma_f32_32x32x16_bf16(kf[4],qr[2],C0,0,0,0),   P1[2],P1[3],P1[4],P1[5],     pw2[0]=PKW(P1,0), pw2[1]=PKW(P1,2), pw2); \
    VRD(6); SBAR(); GAPA(C1=__builtin_amdgcn_mfma_f32_32x32x16_bf16(kf[5],qr[2],C1,0,0,0),   P1[6],P1[7],P1[8],P1[9],     pw2[2]=PKW(P1,4), pw2[3]=PKW(P1,6), pw2); \
    VRD(3); SBAR(); GAPA(C0=__builtin_amdgcn_mfma_f32_32x32x16_bf16(kf[6],qr[3],C0,0,0,0),   P1[10],P1[11],P1[12],P1[13], pw3[0]=PKW(P1,8), pw3[1]=PKW(P1,10), pw3); \
    VRD(7); SBAR(); GAPA(C1=__builtin_amdgcn_mfma_f32_32x32x16_bf16(kf[7],qr[3],C1,0,0,0),   P1[14],P1[15],0.f,0.f,       pw3[2]=PKW(P1,12),pw3[3]=PKW(P1,14), pw3); \
    l_reg+=sacc; \
    if(GK){DMA_K((t)+3,sl_cur);} if(GV){DMA_V((t)+1,sl_next);} \
    CMASK(C0,C1,t); \
    { float a=MX3(C0[0],C0[1],C1[0]),b=MX3(C0[2],C0[3],C1[1]); a=MX3(a,C1[2],C1[3]); \
      _Pragma("unroll") for(int r=4;r<16;r+=4){a=MX3(a,C0[r],C0[r+1]);b=MX3(b,C0[r+2],C0[r+3]);a=MX3(a,C1[r],C1[r+1]);b=MX3(b,C1[r+2],C1[r+3]);} \
      float rm=__builtin_fmaxf(a,b); { auto rr=__builtin_amdgcn_permlane32_swap(__float_as_uint(rm),__float_as_uint(rm),false,false); rm=__builtin_fmaxf(__uint_as_float(rr[0]),__uint_as_float(rr[1])); } \
      resc=false; \
      if(__builtin_expect(__any(rm>(float)THRL),0)){ const float dl=__builtin_fmaxf(rm,0.f); mhat+=dl; \
        _Pragma("unroll") for(int r=0;r<16;++r){C0[r]-=dl;C1[r]-=dl;} \
        _Pragma("unroll") for(int r=0;r<16;++r)negm[r]=-mhat; asm volatile("":"+v"(negm)); \
        const float f=__builtin_amdgcn_exp2f(-dl); l_reg*=f; if(hi==0)wsf[r32]=f; resc=true; } } \
    SBAR(); \
    GAPB(o[0]=__builtin_amdgcn_mfma_f32_32x32x16_bf16(PAF(0),VFR(0),o[0],0,0,0), C0,0); \
    GAPB(o[1]=__builtin_amdgcn_mfma_f32_32x32x16_bf16(PAF(0),VFR(4),o[1],0,0,0), C0,4); \
    KRD(GL,0); GAPB(o[0]=__builtin_amdgcn_mfma_f32_32x32x16_bf16(PAF(1),VFR(1),o[0],0,0,0), C0,8); \
    KRD(GL,1); GAPB(o[1]=__builtin_amdgcn_mfma_f32_32x32x16_bf16(PAF(1),VFR(5),o[1],0,0,0), C0,12); \
    KRD(GL,2); GAPB(o[0]=__builtin_amdgcn_mfma_f32_32x32x16_bf16(PAF(2),VFR(2),o[0],0,0,0), C1,0); \
    KRD(GL,3); GAPB(o[1]=__builtin_amdgcn_mfma_f32_32x32x16_bf16(PAF(2),VFR(6),o[1],0,0,0), C1,4); \
    GAPB(o[0]=__builtin_amdgcn_mfma_f32_32x32x16_bf16(PAF(3),VFR(3),o[0],0,0,0), C1,8); \
    GAPB(o[1]=__builtin_amdgcn_mfma_f32_32x32x16_bf16(PAF(3),VFR(7),o[1],0,0,0), C1,12); \
    }while(0)
  int t=1;
  for(;t+5<NT;t+=2){
    STEP(pB0,pB1,pA0,pA1,t,true,true,true);     WAIT_BAR(2); RESC(); ROT();
    STEP(pA0,pA1,pB0,pB1,t+1,true,true,true);   WAIT_BAR(2); RESC(); ROT();
  }
  #define ENDW(tt) do{ if((tt)+3<NT){WAIT_BAR(2);} else if((tt)+2<NT){WAIT_BAR(1);} else {WAIT_BAR(0);} }while(0)
  for(;t+1<NT;t+=2){
    STEP(pB0,pB1,pA0,pA1,t,(t+3<NT),(t+1<NT),(t+1<NT));       ENDW(t);   RESC(); ROT();
    STEP(pA0,pA1,pB0,pB1,t+1,(t+4<NT),(t+2<NT),(t+2<NT));     ENDW(t+1); RESC(); ROT();
  }
  STEP(pB0,pB1,pA0,pA1,NT-1,false,false,false); RESC();
  { float sacc=pB0[0]+pB0[1]; _Pragma("unroll") for(int r=2;r<16;++r)sacc+=pB0[r]; _Pragma("unroll") for(int r=0;r<16;++r)sacc+=pB1[r]; l_reg+=sacc;
    pw0=(u32x4){PKW(pB0,0),PKW(pB0,2),PKW(pB0,4),PKW(pB0,6)};pw1=(u32x4){PKW(pB0,8),PKW(pB0,10),PKW(pB0,12),PKW(pB0,14)};pw2=(u32x4){PKW(pB1,0),PKW(pB1,2),PKW(pB1,4),PKW(pB1,6)};pw3=(u32x4){PKW(pB1,8),PKW(pB1,10),PKW(pB1,12),PKW(pB1,14)};
    SBAR(); pv(o,vb0+sl_cur,PAF(0),PAF(1),PAF(2),PAF(3)); }
  #undef PKW
  #undef PAF
  #undef VFR
  #undef PIN
  #undef MX3
  #undef GAPA
  #undef GAPB
  #undef EX
  #undef VRD
  #undef KRD
  #undef STEP
  #undef ENDW
  {auto rr=__builtin_amdgcn_permlane32_swap(__float_as_uint(l_reg),__float_as_uint(l_reg),false,false);l_reg=__uint_as_float(rr[0])+__uint_as_float(rr[1]);}
  if(hi==0)wsf[32+r32]=l_reg;asm volatile("s_waitcnt lgkmcnt(0)":::"memory");
  float rli[16];
  #pragma unroll
  for(int r=0;r<16;++r)rli[r]=__builtin_amdgcn_rcpf(wsf[32+crow(r,hi)]);
  bf16*Ow=Ou+(long)(wid*QBLK)*DM;
  { bf16*stg=(bf16*)(shm+LDS_OST)+wid*2048;
    #pragma unroll
    for(int r=0;r<16;++r){const int orow=crow(r,hi);
      #pragma unroll
      for(int d0=0;d0<2;++d0)stg[orow*64+d0*32+r32]=__float2bfloat16(o[d0][r]*rli[r]);}
    asm volatile("s_waitcnt lgkmcnt(0)":::"memory");
    #pragma unroll
    for(int i=0;i<4;++i){const int row=i*8+(lane>>3),ch=lane&7; const u32x4 v=*(const u32x4*)(stg+row*64+ch*8); ATTN_STORE16(Ow+(long)row*DM+ch*8,v);} }
  asm volatile("s_waitcnt lgkmcnt(0)\n\ts_barrier":::"memory");
  #undef DMA_K
  #undef DMA_V
  #undef CMASK
  #undef START
  #undef RESC
  #undef ROT
}
constexpr int ATTN_LDS_BYTES=LDS_BYTES;
#undef SBAR
#undef WAIT_BAR
}

#ifndef MK_SINGLE
#define MK_SINGLE 1
#endif
constexpr int NWAVES = 8, NTHR = 512;
constexpr size_t MiB = 1u << 20;
constexpr size_t WS_CTL = 0, WS_MOD = 4096, CTL_ZERO_BYTES = 4096 + 9 * 6144 * 4, WS_ROPE = 512 * 1024, WS_LBT = 528 * 1024, WS_MODB = 768 * 1024;
constexpr size_t WS_WIN = 2 * MiB, WS_WO = 19 * MiB, WS_WUP = 21 * MiB, WS_WDN = 32 * MiB;
constexpr size_t WS_H = 38 * MiB, WS_Q = 58 * MiB, WS_ZA = 78 * MiB, WS_RQ = 98 * MiB, WS_GF = 118 * MiB, WS_GB = 138 * MiB, WS_RI = 158 * MiB, WS_PP = 178 * MiB, WS_K = 198 * MiB, WS_V = 205 * MiB;
constexpr size_t WS_U = 58 * MiB, WS_ACT = 168 * MiB, WS_END = 223 * MiB;
constexpr int RING_BYTES = 131072, LDS_BYTES = 147456;
constexpr int N_PHASES = 21;

typedef unsigned v4u __attribute__((ext_vector_type(4)));
#define LDS_WAIT() asm volatile("s_waitcnt lgkmcnt(0)" ::: "memory")
__device__ __forceinline__ unsigned f2bf(float f) { unsigned u = __builtin_bit_cast(unsigned, f); return (u + 0x7fffu + ((u >> 16) & 1u)) >> 16; }
__device__ __forceinline__ unsigned pk2(float lo, float hi) { return pg8::cvt_pk_bf16(lo, hi); }

struct Args { const float* in[22]; float* out; unsigned char* ws; int ph_lo, ph_hi; };

__device__ __forceinline__ void p0_transpose_item(const float* W, int K, int N, bf16_t* WT, int prow0, int lc0, LAS float* scr, int kb, int lane) {
    const int k0 = 64 * kb;
#pragma unroll 8
    for (int i = 0; i < 32; ++i) { const int kk = 2 * i + (lane >> 5); scr[kk * 33 + (lane & 31)] = W[(size_t)(k0 + kk) * N + lc0 + (lane & 31)]; }
    LDS_WAIT(); asm volatile("" ::: "memory");
    const int c = lane & 7;
#pragma unroll
    for (int j = 0; j < 4; ++j) { const int n = (lane >> 3) + 8 * j; const LAS float* s = scr + (8 * c) * 33 + n;
        v4u o; o.x = pk2(s[0 * 33], s[1 * 33]); o.y = pk2(s[2 * 33], s[3 * 33]); o.z = pk2(s[4 * 33], s[5 * 33]); o.w = pk2(s[6 * 33], s[7 * 33]);
        *(v4u*)(WT + (size_t)(prow0 + n) * K + k0 + 8 * c) = o; }
    LDS_WAIT(); asm volatile("" ::: "memory");
}

__device__ __forceinline__ void p0_prep(const __attribute__((address_space(4))) Args* a, LAS unsigned char* lds, int gw, int NGW, int wave, int lane) {
    LAS float* scr = (LAS float*)(lds + wave * 16384);
    unsigned char* ws = a->ws;
    const float* w_in = a->in[11]; const float* w_o = a->in[16]; const float* w_up = a->in[17]; const float* w_dn = a->in[20];
    constexpr int I_IN = 16 * 272, I_O = 16 * 32, I_UP = 16 * 176, I_DN = 44 * 32, I_T = I_IN + I_O + I_UP + I_DN, I_ADA = 96 * 16, I_ROPE = 16, I_LB = 32;
    for (int it = gw; it < I_T + I_ADA + I_ROPE + I_LB; it += NGW) {
        int r = it;
        if (r < I_T) {
            const float* W; int K, N, kb, pg; bf16_t* WT; bool isin = false;
            if (r < I_IN) { W = w_in; K = 1024; N = INW; kb = r / 272; pg = r % 272; WT = (bf16_t*)(ws + WS_WIN); isin = true; }
            else if ((r -= I_IN) < I_O) { W = w_o; K = 1024; N = 1024; kb = r / 32; pg = r % 32; WT = (bf16_t*)(ws + WS_WO); }
            else if ((r -= I_O) < I_UP) { W = w_up; K = 1024; N = UPW; kb = r / 176; pg = r % 176; WT = (bf16_t*)(ws + WS_WUP); }
            else { r -= I_UP; W = w_dn; K = DFF; N = 1024; kb = r / 32; pg = r % 32; WT = (bf16_t*)(ws + WS_WDN); }
            const int T = pg >> 3, g = pg & 7, bj = g >> 2, wc = g & 3;
            int lc0 = T * 256 + wc * 64 + bj * 32;
            if (isin && T >= 22) lc0 = (T < 26) ? 6656 + (T - 22) * 256 + wc * 64 + bj * 32 : (bj ? 7680 : 5632) + (T - 26) * 128 + wc * 32;
            p0_transpose_item(W, K, N, WT, pg * 32, lc0, scr, kb, lane);
        } else if ((r -= I_T) < I_ADA) {
            const int g = r >> 4, kc = r & 15, n0 = g * 64 + lane, k0 = kc * 64;
            const float* c_in = a->in[2]; const float* cctx = a->in[6]; const float* adaw = a->in[7];
#pragma unroll
            for (int i = 0; i < 9; ++i) { const float cv = (i == 0) ? cctx[k0 + lane] : c_in[(i - 1) * 1024 + k0 + lane]; scr[lane * 12 + i] = fsilu(cv); }
            LDS_WAIT(); asm volatile("" ::: "memory");
            float acc[9];
#pragma unroll
            for (int i = 0; i < 9; ++i) acc[i] = 0.f;
#pragma unroll 8
            for (int kk = 0; kk < 64; ++kk) { const float w = adaw[(size_t)(k0 + kk) * 6144 + n0];
                const pg8::f32x4 s0 = *(const LAS pg8::f32x4*)(scr + kk * 12), s1 = *(const LAS pg8::f32x4*)(scr + kk * 12 + 4); const float s8 = scr[kk * 12 + 8];
                acc[0] += s0[0] * w; acc[1] += s0[1] * w; acc[2] += s0[2] * w; acc[3] += s0[3] * w; acc[4] += s1[0] * w; acc[5] += s1[1] * w; acc[6] += s1[2] * w; acc[7] += s1[3] * w; acc[8] += s8 * w; }
            float* mod = (float*)(ws + WS_MOD);
#pragma unroll
            for (int i = 0; i < 9; ++i) atomicAdd(mod + i * 6144 + n0, acc[i]);
            LDS_WAIT(); asm volatile("" ::: "memory");
        } else if ((r -= I_ADA) >= I_ROPE) {
            r -= I_ROPE; const int idx = r * 64 + lane, d = idx >> 10, cch = idx & 1023; const float* lg = a->in[14];
            ((float*)(ws + WS_LBT))[idx] = fsigmoid(lg[d * 2048 + cch] - lg[d * 2048 + 1024 + cch]);
        } else {
            const int idx = r * 64 + lane, pos = idx >> 4, i = idx & 15;
            const float invf = exp2f(-(float)i * 0.8304820237218406f); const float ang = (float)pos * invf;
            const float n = rintf(ang * 0.15915494309189535f); float rr = fmaf(-n, 6.2831854820251465f, ang); rr = fmaf(-n, -1.7484555e-7f, rr);
            float* rope = (float*)(ws + WS_ROPE); rope[idx * 2] = __cosf(rr); rope[idx * 2 + 1] = __sinf(rr);
        }
    }
}

template <int MODE> __device__ __forceinline__ void norm_row(const float* xrow, const float* gain, const float* mod, const float* adab, int shoff, int scoff, bf16_t* obf, float* of32, int lane) {
    const pg8::f32x4* xr = (const pg8::f32x4*)xrow + lane;
    pg8::f32x4 v[4]; float s = 0.f;
#pragma unroll
    for (int j = 0; j < 4; ++j) { v[j] = xr[64 * j]; s += (v[j][0] * v[j][0] + v[j][1] * v[j][1]) + (v[j][2] * v[j][2] + v[j][3] * v[j][3]); }
    const float rstd = __builtin_amdgcn_rsqf(wave_sum(s) * (1.0f / 1024.0f) + EPS);
#pragma unroll
    for (int j = 0; j < 4; ++j) { const int c = 4 * (lane + 64 * j); const pg8::f32x4 g = *(const pg8::f32x4*)(gain + c); pg8::f32x4 y = v[j] * rstd * g;
        if (MODE == 0) { const pg8::f32x4 sh = *(const pg8::f32x4*)(mod + shoff + c) + *(const pg8::f32x4*)(adab + shoff + c), sc = *(const pg8::f32x4*)(mod + scoff + c) + *(const pg8::f32x4*)(adab + scoff + c);
            y = y * (sc + 1.0f) + sh; u32x2 w; w.x = pk2(y[0], y[1]); w.y = pk2(y[2], y[3]); *(u32x2*)(obf + c) = w; }
        else *(pg8::f32x4*)(of32 + c) = y; }
}

constexpr int R_QD = 0, R_KD = 17408, R_K2T = 34816, R_VT = 53248, R_SC = 71680, R_ST = 80896, R_XCH = 115712, R_DEC = 119808;
__device__ __forceinline__ int crow(int r, int hi) { return (r & 3) + 8 * (r >> 2) + 4 * hi; }
__device__ __forceinline__ void rec_scan(LAS unsigned char* lds, const bf16_t* RQ, bf16_t* G, const bf16_t* RI, int lrow0, int L, int rh, int dir, const float* s0, float* sfin) {
    int tid_o = threadIdx.x; asm volatile("" : "+v"(tid_o));
    const int tid = tid_o, lane = tid & 63, w = __builtin_amdgcn_readfirstlane(tid >> 6), r32 = lane & 31, hi = lane >> 5;
    const int kb = w >> 1, dvt0 = (w & 1) * 2;
    const int colb = rh * 128;
    f32x16 S[2];
#pragma unroll
    for (int x = 0; x < 2; ++x)
#pragma unroll
        for (int r = 0; r < 16; ++r) S[x][r] = s0 ? s0[(size_t)(kb * 32 + crow(r, hi)) * 128 + (dvt0 + x) * 32 + r32] : 0.f;
#define REC_WRITE_ST() do { _Pragma("unroll") for (int x = 0; x < 2; ++x) _Pragma("unroll") for (int g = 0; g < 4; ++g) { u32x2 wv; wv.x = pk2(S[x][4 * g], S[x][4 * g + 1]); wv.y = pk2(S[x][4 * g + 2], S[x][4 * g + 3]); \
        *(LAS u32x2*)(lds + R_ST + ((dvt0 + x) * 32 + r32) * 272 + (kb * 32 + 8 * g + 4 * hi) * 2) = wv; } } while (0)
    REC_WRITE_ST();
    const int nc = L >> 6;
    unsigned gq[8], qq[8], vv[8];
#define REC_ROW(c, i) (dir ? (lrow0 + L - 1 - ((c) * 64 + (i))) : (lrow0 + (c) * 64 + (i)))
#define REC_LOAD(c) do { _Pragma("unroll") for (int i = 0; i < 8; ++i) { const size_t off = (size_t)REC_ROW(c, 8 * w + i) * DM + colb + 2 * lane; \
        gq[i] = *(const unsigned*)(G + off); qq[i] = *(const unsigned*)(RQ + off); vv[i] = *(const unsigned*)(RI + off); } } while (0)
    REC_LOAD(0);
    for (int c = 0; c < nc; ++c) {
        float g0[8], g1[8], q0[8], q1[8]; unsigned vk[8];
#pragma unroll
        for (int i = 0; i < 8; ++i) { g0[i] = h2f((unsigned short)(gq[i] & 0xffffu)); g1[i] = h2f((unsigned short)(gq[i] >> 16)); q0[i] = bflo(qq[i]); q1[i] = bfhi(qq[i]); vk[i] = vv[i]; }
        if (c + 1 < nc) REC_LOAD(c + 1);
        float b0[8], b1[8];
        b0[0] = g0[0]; b1[0] = g1[0];
#pragma unroll
        for (int i = 1; i < 8; ++i) { b0[i] = b0[i - 1] + g0[i]; b1[i] = b1[i - 1] + g1[i]; }
        *(LAS f32x2*)(lds + R_XCH + (w * 128 + 2 * lane) * 4) = (f32x2){b0[7], b1[7]};
        __syncthreads();
        float p0 = 0.f, p1 = 0.f, t0 = 0.f, t1 = 0.f;
#pragma unroll
        for (int ww = 0; ww < 8; ++ww) { const f32x2 x = *(const LAS f32x2*)(lds + R_XCH + (ww * 128 + 2 * lane) * 4); if (ww < w) { p0 += x[0]; p1 += x[1]; } t0 += x[0]; t1 += x[1]; }
        if (w == 0) *(LAS f32x2*)(lds + R_DEC + 2 * lane * 4) = (f32x2){__expf(t0), __expf(t1)};
        unsigned k2a[4], k2b[4], va[4], vb[4];
#pragma unroll
        for (int i = 0; i < 8; ++i) {
            const float bb0 = p0 + b0[i], bb1 = p1 + b1[i];
            const float kk0 = 1.0f - __expf(g0[i]), kk1 = 1.0f - __expf(g1[i]);
            const float qd0 = q0[i] * __expf(bb0), qd1 = q1[i] * __expf(bb1);
            const float kd0 = kk0 * __expf(-bb0), kd1 = kk1 * __expf(-bb1);
            const float kt0 = kk0 * __expf(t0 - bb0), kt1 = kk1 * __expf(t1 - bb1);
            const int ti = 8 * w + i;
            *(LAS unsigned*)(lds + R_QD + ti * 272 + lane * 4) = pk2(qd0, qd1);
            *(LAS unsigned*)(lds + R_KD + ti * 272 + lane * 4) = pk2(kd0, kd1);
            const unsigned f0 = f2bf(kt0), f1 = f2bf(kt1);
            if (i & 1) { k2a[i >> 1] |= f0 << 16; k2b[i >> 1] |= f1 << 16; va[i >> 1] |= (vk[i] & 0xffffu) << 16; vb[i >> 1] |= vk[i] & 0xffff0000u; }
            else { k2a[i >> 1] = f0; k2b[i >> 1] = f1; va[i >> 1] = vk[i] & 0xffffu; vb[i >> 1] = vk[i] >> 16; }
        }
        *(LAS v4u*)(lds + R_K2T + (2 * lane) * 144 + 16 * w) = (v4u){k2a[0], k2a[1], k2a[2], k2a[3]};
        *(LAS v4u*)(lds + R_K2T + (2 * lane + 1) * 144 + 16 * w) = (v4u){k2b[0], k2b[1], k2b[2], k2b[3]};
        *(LAS v4u*)(lds + R_VT + (2 * lane) * 144 + 16 * w) = (v4u){va[0], va[1], va[2], va[3]};
        *(LAS v4u*)(lds + R_VT + (2 * lane + 1) * 144 + 16 * w) = (v4u){vb[0], vb[1], vb[2], vb[3]};
        __syncthreads();
        if (w < 4) {
            const int ti = w >> 1, si = w & 1;
            f32x16 sc;
#pragma unroll
            for (int r = 0; r < 16; ++r) sc[r] = 0.f;
            if (w != 1) {
#pragma unroll
                for (int ks = 0; ks < 8; ++ks) {
                    const pg8::bf16x8 af = *(const LAS pg8::bf16x8*)(lds + R_QD + (ti * 32 + r32) * 272 + (16 * ks + 8 * hi) * 2);
                    const pg8::bf16x8 bf = *(const LAS pg8::bf16x8*)(lds + R_KD + (si * 32 + r32) * 272 + (16 * ks + 8 * hi) * 2);
                    sc = __builtin_amdgcn_mfma_f32_32x32x16_bf16(af, bf, sc, 0, 0, 0);
                }
            }
#pragma unroll
            for (int r = 0; r < 16; ++r) { const int t = ti * 32 + crow(r, hi), s = si * 32 + r32; const float v = (t >= s) ? sc[r] : 0.f;
                *(LAS unsigned short*)(lds + R_SC + t * 144 + s * 2) = (unsigned short)f2bf(v); }
        }
        __syncthreads();
        {
            const int to = w >> 2, dvo = w & 3;
            f32x16 o;
#pragma unroll
            for (int r = 0; r < 16; ++r) o[r] = 0.f;
#pragma unroll
            for (int ks = 0; ks < 4; ++ks) {
                const pg8::bf16x8 af = *(const LAS pg8::bf16x8*)(lds + R_SC + (to * 32 + r32) * 144 + (16 * ks + 8 * hi) * 2);
                const pg8::bf16x8 bf = *(const LAS pg8::bf16x8*)(lds + R_VT + (dvo * 32 + r32) * 144 + (16 * ks + 8 * hi) * 2);
                o = __builtin_amdgcn_mfma_f32_32x32x16_bf16(af, bf, o, 0, 0, 0);
            }
#pragma unroll
            for (int ks = 0; ks < 8; ++ks) {
                const pg8::bf16x8 af = *(const LAS pg8::bf16x8*)(lds + R_QD + (to * 32 + r32) * 272 + (16 * ks + 8 * hi) * 2);
                const pg8::bf16x8 bf = *(const LAS pg8::bf16x8*)(lds + R_ST + (dvo * 32 + r32) * 272 + (16 * ks + 8 * hi) * 2);
                o = __builtin_amdgcn_mfma_f32_32x32x16_bf16(af, bf, o, 0, 0, 0);
            }
#pragma unroll
            for (int r = 0; r < 16; ++r) { const int t = to * 32 + crow(r, hi); G[(size_t)REC_ROW(c, t) * DM + colb + dvo * 32 + r32] = (bf16_t)f2bf(o[r]); }
            float dec[16];
#pragma unroll
            for (int r = 0; r < 16; ++r) dec[r] = *(const LAS float*)(lds + R_DEC + (kb * 32 + crow(r, hi)) * 4);
#pragma unroll
            for (int x = 0; x < 2; ++x)
#pragma unroll
                for (int r = 0; r < 16; ++r) S[x][r] *= dec[r];
#pragma unroll
            for (int ks = 0; ks < 4; ++ks) {
                const pg8::bf16x8 af = *(const LAS pg8::bf16x8*)(lds + R_K2T + (kb * 32 + r32) * 144 + (16 * ks + 8 * hi) * 2);
#pragma unroll
                for (int x = 0; x < 2; ++x) {
                    const pg8::bf16x8 bf = *(const LAS pg8::bf16x8*)(lds + R_VT + ((dvt0 + x) * 32 + r32) * 144 + (16 * ks + 8 * hi) * 2);
                    S[x] = __builtin_amdgcn_mfma_f32_32x32x16_bf16(af, bf, S[x], 0, 0, 0);
                }
            }
        }
        __syncthreads();
        REC_WRITE_ST();
    }
    if (sfin) {
#pragma unroll
        for (int x = 0; x < 2; ++x)
#pragma unroll
            for (int r = 0; r < 16; ++r) sfin[(size_t)(kb * 32 + crow(r, hi)) * 128 + (dvt0 + x) * 32 + r32] = S[x][r];
    }
#undef REC_WRITE_ST
#undef REC_ROW
#undef REC_LOAD
}

__global__ void __launch_bounds__(NTHR, 2) fwd_mega(Args args) {
    extern __shared__ __attribute__((aligned(16))) unsigned char lds_raw[];
    LAS unsigned char* lds = (LAS unsigned char*)lds_raw;
    const int G = gridDim.x, bx = blockIdx.x, NGW = G * NWAVES;
typedef const __attribute__((address_space(4))) Args* KArgs;
#define PH_IDS() int tid = threadIdx.x; asm volatile("" : "+v"(tid)); const int lane = tid & 63, wave = __builtin_amdgcn_readfirstlane(tid >> 6), gw = bx * NWAVES + wave; (void)lane; (void)gw; \
    KArgs ap = (KArgs)__builtin_amdgcn_kernarg_segment_ptr(); asm volatile("" : "+s"(ap)); unsigned char* const ws = ap->ws; float* const dout = ap->out; (void)ws; (void)dout;
#define AIN(i) (ap->in[i])
#define WSB(off) ((bf16_t*)(ws + (off)))
#define WSF(off) ((float*)(ws + (off)))
    const int lo = args.ph_lo, hi_ph = args.ph_hi;
    cg::grid_group grid = cg::this_grid();
#ifndef PHMASK
#define PHMASK 0xFFFF
#endif
#define PEN(j) (((PHMASK) >> (j)) & 1)
#define IN(k) (lo <= (k) && (k) < hi_ph)
#define SEAM(k) do { if (IN(k) && IN((k) + 1)) grid.sync(); } while (0)

    if (PEN(10) && IN(0)) { PH_IDS(); p0_prep(ap, lds, gw, NGW, wave, lane); SEAM(0); }

    for (int hf = 0; hf < 2; ++hf) {
        const int pb = 1 + hf * 10;
        if (PEN(0) && IN(pb + 0)) { PH_IDS();
            const float* xp = AIN(0); const float* xs = AIN(1); const float* adab = AIN(8); const float* mod = WSF(WS_MOD); bf16_t* H = WSB(WS_H); bf16_t* Kb = WSB(WS_K); bf16_t* Vb = WSB(WS_V);
            for (int r = gw; r < MH; r += NGW) { const int grow = hf * MH + r; const float* src = grow < NPR ? xp + (size_t)grow * DM : xs + (size_t)(grow - NPR) * DM;
                norm_row<0>(src, AIN(9), mod + mod_of_row(grow) * 6144, adab, 0, 1024, H + (size_t)r * DM, nullptr, lane); }
            if (hf == 0) { float* modb = WSF(WS_MODB); for (int i = gw * 64 + lane; i < 9 * 6144; i += NGW * 64) modb[i] = mod[i] + adab[i % 6144]; }
            const int nb = hf ? 5 : 3, b0 = hf ? 3 : 0;
            for (int r = gw; r < 2 * nb * 512; r += NGW) { const int kv = r / (nb * 512), rr = r % (nb * 512), b = rr >> 9, p = rr & 511;
                const float* src = (kv ? AIN(4) : AIN(3)) + ((size_t)(b0 + b) * 512 + p) * KVP + 4 * lane;
                bf16_t* dst = (kv ? Vb : Kb) + (size_t)((hf ? b * 2560 : NPR + b * 2560) + 2048 + p) * KVP + 4 * lane;
                const pg8::f32x4 v = *(const pg8::f32x4*)src; u32x2 wv; wv.x = pk2(v[0], v[1]); wv.y = pk2(v[2], v[3]); *(u32x2*)dst = wv; }
            SEAM(pb + 0);
        }
        if (PEN(1) && IN(pb + 1)) { PH_IDS();
            pg8::Gemm g{WSB(WS_H), WSB(WS_WIN), MH, INW, DM}; pg8::StaticOrder S; S.init(MH, INW, G, bx);
            float* nck = dout + (size_t)MTOT * DM; float* ncv = nck + (size_t)NPR * KVP;
            pg8::EpiInProj E{WSB(WS_Q), WSB(WS_K), WSB(WS_V), WSB(WS_RQ), WSB(WS_GF), WSB(WS_GB), WSB(WS_RI), WSB(WS_ZA), WSB(WS_PP), nck, ncv, AIN(12), AIN(13), WSF(WS_LBT), WSF(WS_ROPE), hf};
            pg8::gemm_phase<pg8::EpiInProj, pg8::StaticOrder, true, true>(lds, g, S, E);
            SEAM(pb + 1);
        }
        if (PEN(2) && IN(pb + 2)) { PH_IDS();
            const int nlong = hf ? 80 : 48, nbig = hf ? 640 : 384, nshort = hf ? 0 : 256, nsmall = hf ? 0 : 256;
            const int ntot = nlong + nbig + nshort + nsmall;
            LAS int* slot = (LAS int*)(lds + RING_BYTES); unsigned* ctl = (unsigned*)(ws + WS_CTL);
            bf16_t* Qb = WSB(WS_Q); bf16_t* Kb = WSB(WS_K); bf16_t* Vb = WSB(WS_V); bf16_t* RQ = WSB(WS_RQ); bf16_t* GF = WSB(WS_GF); bf16_t* GB = WSB(WS_GB); bf16_t* RI = WSB(WS_RI);
            float* nst = dout + (size_t)MTOT * DM + 2 * (size_t)NPR * KVP;
            for (;;) {
                __syncthreads();
                if (tid == 0) *slot = (int)atomicAdd(ctl + 64 * hf, 1u);
                __syncthreads();
                int it = *slot;
                if (it >= ntot) break;
                if (it < nlong) {
                    const int b = it >> 4, rh = (it >> 1) & 7, dir = it & 1; const int bglob = hf ? 3 + b : b;
                    rec_scan(lds, RQ, dir ? GB : GF, RI, (hf ? 0 : NPR) + b * 2048, 2048, rh, dir, AIN(5) + (size_t)((bglob * 2 + dir) * 8 + rh) * 16384, nullptr);
                } else if ((it -= nlong) < nbig) {
                    const int gq = it & 3, qb = (it >> 2) & 7, kvh = (it >> 5) & 3, b = it >> 7, h = kvh * 4 + gq;
                    const int lrow0 = (hf ? 0 : NPR) + b * 2048 + qb * 256, kvr0 = (hf ? 0 : NPR) + b * 2560;
                    attn_body::attn_unit<8>((const attn_body::bf16*)(Qb + (size_t)lrow0 * DM + h * 64), (const attn_body::bf16*)(Kb + (size_t)kvr0 * KVP + kvh * 64), (const attn_body::bf16*)(Vb + (size_t)kvr0 * KVP + kvh * 64),
                                            (attn_body::bf16*)(Qb + (size_t)lrow0 * DM + h * 64), 40, (char*)lds_raw);
                } else if ((it -= nbig) < nshort) {
                    const int seq = it >> 4, rh = (it >> 1) & 7, dir = it & 1;
                    rec_scan(lds, RQ, dir ? GB : GF, RI, seq * 256, 256, rh, dir, nullptr, nst + (size_t)((seq * 2 + dir) * 8 + rh) * 16384);
                } else {
                    it -= nshort; const int seq = it >> 4, h = it & 15, kvh = h >> 2;
                    attn_body::attn_unit<8>((const attn_body::bf16*)(Qb + (size_t)(seq * 256) * DM + h * 64), (const attn_body::bf16*)(Kb + (size_t)(seq * 256) * KVP + kvh * 64), (const attn_body::bf16*)(Vb + (size_t)(seq * 256) * KVP + kvh * 64),
                                            (attn_body::bf16*)(Qb + (size_t)(seq * 256) * DM + h * 64), 4, (char*)lds_raw);
                }
            }
            SEAM(pb + 2);
        }
        if (PEN(3) && IN(pb + 3)) { PH_IDS();
            const float* hg = AIN(15); bf16_t* Qb = WSB(WS_Q); bf16_t* ZA = WSB(WS_ZA); bf16_t* GF = WSB(WS_GF); bf16_t* GB = WSB(WS_GB); bf16_t* PP = WSB(WS_PP); bf16_t* H = WSB(WS_H);
            for (int r = gw; r < MH; r += NGW) {
                const size_t off = (size_t)r * DM + 16 * lane;
                v4u o[2], z[2], f[2], bq[2], p[2];
#pragma unroll
                for (int e = 0; e < 2; ++e) { o[e] = *(const v4u*)(Qb + off + 8 * e); z[e] = *(const v4u*)(ZA + off + 8 * e); f[e] = *(const v4u*)(GF + off + 8 * e); bq[e] = *(const v4u*)(GB + off + 8 * e); p[e] = *(const v4u*)(PP + off + 8 * e); }
                float s[16]; float ss = 0.f;
#pragma unroll
                for (int e = 0; e < 2; ++e)
#pragma unroll
                    for (int q = 0; q < 4; ++q) { s[8 * e + 2 * q] = bflo(f[e][q]) + bflo(bq[e][q]); s[8 * e + 2 * q + 1] = bfhi(f[e][q]) + bfhi(bq[e][q]); }
#pragma unroll
                for (int q = 0; q < 16; ++q) ss += s[q] * s[q];
                ss += __shfl_xor(ss, 1); ss += __shfl_xor(ss, 2); ss += __shfl_xor(ss, 4);
                const float rs = __builtin_amdgcn_rsqf(ss * (1.0f / 128.0f) + EPS);
                const int gc = (16 * lane) & 127;
                v4u outw[2];
#pragma unroll
                for (int e = 0; e < 2; ++e)
#pragma unroll
                    for (int q = 0; q < 4; ++q) {
                        const int i0 = 8 * e + 2 * q;
                        const float m0 = bflo(o[e][q]) * bflo(z[e][q]) + bflo(p[e][q]) * (s[i0] * rs * hg[gc + i0]);
                        const float m1 = bfhi(o[e][q]) * bfhi(z[e][q]) + bfhi(p[e][q]) * (s[i0 + 1] * rs * hg[gc + i0 + 1]);
                        outw[e][q] = pk2(m0, m1);
                    }
                *(v4u*)(H + off) = outw[0]; *(v4u*)(H + off + 8) = outw[1];
            }
            SEAM(pb + 3);
        }
        if (PEN(4) && IN(pb + 4)) { PH_IDS();
            pg8::Gemm g{WSB(WS_H), WSB(WS_WO), MH, DM, DM}; pg8::StaticOrder S; S.init(MH, DM, G, bx);
            pg8::EpiResid E{AIN(0), AIN(1), dout, WSF(WS_MODB), 2048, hf};
            pg8::gemm_phase<pg8::EpiResid, pg8::StaticOrder, true, true>(lds, g, S, E);
            SEAM(pb + 4);
        }
        if (PEN(5) && IN(pb + 5)) { PH_IDS();
            for (int r = gw; r < MH; r += NGW) { const int grow = hf * MH + r;
                norm_row<0>(dout + (size_t)grow * DM, AIN(10), WSF(WS_MOD) + mod_of_row(grow) * 6144, AIN(8), 3072, 4096, WSB(WS_H) + (size_t)r * DM, nullptr, lane); }
            SEAM(pb + 5);
        }
        if (PEN(6) && IN(pb + 6)) { PH_IDS();
            pg8::Gemm g{WSB(WS_H), WSB(WS_WUP), MH, UPW, DM}; pg8::StaticOrder S; S.init(MH, UPW, G, bx);
            pg8::EpiPlain E{WSB(WS_U), UPW};
            pg8::gemm_phase<pg8::EpiPlain, pg8::StaticOrder, true, true>(lds, g, S, E);
            SEAM(pb + 6);
        }
        if (PEN(7) && IN(pb + 7)) { PH_IDS();
            const float* cw = AIN(18); const float* cb = AIN(19); const bf16_t* U = WSB(WS_U); bf16_t* ACT = WSB(WS_ACT);
            for (int r = gw; r < MH; r += NGW) {
                const int grow = hf * MH + r; const int t = grow < NPR ? (grow & 255) : ((grow - NPR) & 2047); const int Ls = grow < NPR ? 256 : 2048;
                const bool hp = t > 0, hn = t < Ls - 1;
                const bf16_t* ur = U + (size_t)r * UPW;
                for (int st = 0; st < 11; ++st) {
                    const int c = (st * 64 + lane) * 4;
                    float res[2][4];
#pragma unroll
                    for (int ab = 0; ab < 2; ++ab) {
                        const int cc = c + ab * DFF;
                        const u32x2 u1 = *(const u32x2*)(ur + cc);
                        u32x2 u0 = {0u, 0u}, u2 = {0u, 0u};
                        if (hp) u0 = *(const u32x2*)(ur - UPW + cc);
                        if (hn) u2 = *(const u32x2*)(ur + UPW + cc);
                        const pg8::f32x4 w0 = *(const pg8::f32x4*)(cw + cc), w1 = *(const pg8::f32x4*)(cw + UPW + cc), w2 = *(const pg8::f32x4*)(cw + 2 * UPW + cc), bb = *(const pg8::f32x4*)(cb + cc);
                        res[ab][0] = w0[0] * bflo(u0.x) + w1[0] * bflo(u1.x) + w2[0] * bflo(u2.x) + bb[0];
                        res[ab][1] = w0[1] * bfhi(u0.x) + w1[1] * bfhi(u1.x) + w2[1] * bfhi(u2.x) + bb[1];
                        res[ab][2] = w0[2] * bflo(u0.y) + w1[2] * bflo(u1.y) + w2[2] * bflo(u2.y) + bb[2];
                        res[ab][3] = w0[3] * bfhi(u0.y) + w1[3] * bfhi(u1.y) + w2[3] * bfhi(u2.y) + bb[3];
                    }
                    u32x2 wv; wv.x = pk2(fsilu(res[0][0]) * res[1][0], fsilu(res[0][1]) * res[1][1]); wv.y = pk2(fsilu(res[0][2]) * res[1][2], fsilu(res[0][3]) * res[1][3]);
                    *(u32x2*)(ACT + (size_t)r * DFF + c) = wv;
                }
            }
            SEAM(pb + 7);
        }
        if (PEN(8) && IN(pb + 8)) { PH_IDS();
            pg8::Gemm g{WSB(WS_ACT), WSB(WS_WDN), MH, DM, DFF}; pg8::StaticOrder S; S.init(MH, DM, G, bx);
            pg8::EpiResid E{dout, dout + (size_t)NPR * DM, dout, WSF(WS_MODB), 5120, hf};
            pg8::gemm_phase<pg8::EpiResid, pg8::StaticOrder, true, true>(lds, g, S, E);
            SEAM(pb + 8);
        }
        if (PEN(9) && IN(pb + 9)) { PH_IDS();
            for (int r = gw; r < MH; r += NGW) { const int grow = hf * MH + r; float* row = dout + (size_t)grow * DM;
                norm_row<1>(row, AIN(21), nullptr, nullptr, 0, 0, nullptr, row, lane); }
            SEAM(pb + 9);
        }
    }
#undef IN
#undef SEAM
}

extern "C" void kernel_launch(void* const* d_in, const int* in_sizes, int n_in, void* d_out, int out_size, void* d_ws, size_t ws_size, hipStream_t stream) {
    static int grid = 0;
    if (grid == 0) {
        if (n_in != 22 || ws_size < WS_END) { fprintf(stderr, "kernel_launch: unexpected n_in %d / ws_size %zu\n", n_in, ws_size); grid = -1; return; }
        int dev = 0, cus = 0, per_cu = 0;
        hipGetDevice(&dev); hipDeviceGetAttribute(&cus, hipDeviceAttributeMultiprocessorCount, dev);
        if (hipFuncSetAttribute((const void*)fwd_mega, hipFuncAttributeMaxDynamicSharedMemorySize, LDS_BYTES) != hipSuccess) { fprintf(stderr, "kernel_launch: hipFuncSetAttribute failed\n"); grid = -1; return; }
        if (hipOccupancyMaxActiveBlocksPerMultiprocessor(&per_cu, (const void*)fwd_mega, NTHR, LDS_BYTES) != hipSuccess || per_cu < 1) { fprintf(stderr, "kernel_launch: occupancy query says %d\n", per_cu); per_cu = 1; }
        (void)hipGetLastError();
        grid = cus;
    }
    if (grid < 0) return;
    hipMemsetAsync((char*)d_ws + WS_CTL, 0, CTL_ZERO_BYTES, stream);
    Args a{};
    for (int i = 0; i < 22; ++i) a.in[i] = (const float*)d_in[i];
    a.out = (float*)d_out; a.ws = (unsigned char*)d_ws;
#if MK_SINGLE
    a.ph_lo = 0; a.ph_hi = N_PHASES;
    void* kargs[] = {&a};
    hipError_t e = hipLaunchCooperativeKernel((const void*)fwd_mega, dim3(grid), dim3(NTHR), kargs, LDS_BYTES, stream);
    if (e != hipSuccess) fprintf(stderr, "kernel_launch: cooperative launch failed: %s (grid %d)\n", hipGetErrorString(e), grid);
#else
    for (int p = 0; p < N_PHASES; ++p) { a.ph_lo = p; a.ph_hi = p + 1; hipLaunchKernelGGL(fwd_mega, dim3(grid), dim3(NTHR), LDS_BYTES, stream, a); }
#endif
}
```

```cpp
#include <hip/hip_runtime.h>
#include <hip/hip_cooperative_groups.h>
#include <hip/hip_bf16.h>
#include <cstdio>
#include <cstdint>
#include <cmath>
namespace cg = cooperative_groups;

constexpr int DM = 1024, NPR = 4096  , MTOT = 20480, MH = 10240  ;
constexpr int INW = 8704, DFF = 2816, UPW = 5632;
constexpr int KVP = 256;
constexpr float EPS = 1e-6f;
constexpr float QSCALE = 0.125f * 1.4426950408889634f;

#define GAS __attribute__((address_space(1)))
#define LAS __attribute__((address_space(3)))
typedef unsigned short bf16_t;
typedef float f32x2 __attribute__((ext_vector_type(2)));
typedef unsigned u32x2 __attribute__((ext_vector_type(2)));
typedef float f32x16 __attribute__((ext_vector_type(16)));

__device__ __forceinline__ float bf2f(unsigned short h) { return __uint_as_float(((unsigned)h) << 16); }
__device__ __forceinline__ float bflo(unsigned w) { return __uint_as_float(w << 16); }
__device__ __forceinline__ float bfhi(unsigned w) { return __uint_as_float(w & 0xffff0000u); }
__device__ __forceinline__ float fsigmoid(float x) { return __builtin_amdgcn_rcpf(1.0f + __expf(-x)); }
__device__ __forceinline__ float fsilu(float x) { return x * fsigmoid(x); }
__device__ __forceinline__ unsigned pkh2(float a, float b) { _Float16 ha = (_Float16)a, hb = (_Float16)b; return (unsigned)__builtin_bit_cast(unsigned short, ha) | ((unsigned)__builtin_bit_cast(unsigned short, hb) << 16); }
__device__ __forceinline__ float h2f(unsigned short h) { return (float)__builtin_bit_cast(_Float16, h); }
__device__ __forceinline__ float wave_sum(float v) {
#pragma unroll
    for (int o = 1; o < 64; o <<= 1) v += __shfl_xor(v, o);
    return v;
}
__device__ __forceinline__ int mod_of_row(int grow) { return grow < NPR ? 0 : 1 + ((grow - NPR) >> 11); }
__device__ __forceinline__ int kv_row(int grow, int hf) {
    if (grow < NPR) return grow;
    const int s = grow - NPR, b = s >> 11, t = s & 2047;
    return (hf ? (b - 3) * 2560 : NPR + b * 2560) + t;
}

namespace pg8 {
#define PG8_LAS __attribute__((address_space(3)))
typedef unsigned short bf16_t;
typedef short bf16x8 __attribute__((ext_vector_type(8)));
typedef float f32x4 __attribute__((ext_vector_type(4)));
typedef unsigned u32x4 __attribute__((ext_vector_type(4)));
constexpr int BM = 256, BK = 64, HALF = 128, HTB = HALF * BK * 2  , STAGE_BYTES = 8 * HTB, NXCD = 8, WGM = 8;

__host__ __device__ __forceinline__ int lds_byte(int r, int c) { const int st = (r >> 4) * 2 + (c >> 5), rr = r & 15, cc = c & 31, ob = rr * 64 + cc * 2; return st * 1024 + (ob ^ (((ob >> 9) & 1) << 5)); }
__host__ __device__ __forceinline__ void stage_rc(int b, int& R, int& C) { const int st = b / 1024, sb = b % 1024, swz = sb ^ (((sb >> 9) & 1) << 5); R = (st >> 1) * 16 + swz / 64; C = (st & 1) * 32 + (swz % 64) / 2; }
__host__ __device__ __forceinline__ int perm32(int rho) { const int n = rho >> 4, i = rho & 15; return 8 * (i >> 2) + 4 * n + (i & 3); }

struct Unit { int pm, pn; };
struct Gemm { const bf16_t* A; const bf16_t* Bt; int M, N, K; };

struct StaticOrder {
    int nM, nN, nwg, G, c;
    __host__ __device__ void init(int M, int N, int G_, int c_) { nM = M / BM; nN = N / BM; nwg = nM * nN; G = G_; c = c_; }
    __host__ __device__ bool next(int i, Unit& u) const {
        const long L = (long)i * G + c; if (L >= nwg) return false;
        int wgid = (int)L; { const int q = nwg / NXCD, r = nwg % NXCD, xcd = wgid % NXCD, off = wgid / NXCD; wgid = (xcd < r ? xcd * (q + 1) : r * (q + 1) + (xcd - r) * q) + off; }
        const int nig = WGM * nN, gid = wgid / nig, fm = gid * WGM, gsz = (nM - fm) < WGM ? (nM - fm) : WGM;
        u.pm = fm + ((wgid % nig) % gsz); u.pn = (wgid % nig) / gsz; return true;
    }
    __device__ __forceinline__ void a_ready(const Unit&) const {}
    __device__ __forceinline__ void done(const Unit&) const {}
};

__device__ __forceinline__ unsigned cvt_pk_bf16(float lo, float hi) { unsigned r; asm volatile("v_cvt_pk_bf16_f32 %0, %1, %2" : "=v"(r) : "v"(lo), "v"(hi)); return r; }
__device__ __forceinline__ u32x2 pk4(f32x4 v) { u32x2 w; w.x = cvt_pk_bf16(v[0], v[1]); w.y = cvt_pk_bf16(v[2], v[3]); return w; }

#define EPI_FENCE() asm volatile("" ::: "memory")
struct EpiInProj {
    static constexpr bool PERM = false, AFTER_DRAIN = false;
    bf16_t *Q, *Kb, *Vb, *RQ, *GF, *GB, *RI, *ZA, *PP; float *nck, *ncv; const float *qg, *kg, *lbt; const float* rope; int hf;
    __device__ __forceinline__ void operator()(const f32x4 (&acc)[2][2][4][2], const Unit& u, int wr, int wc, int fr, int fq) const {
        const int T = u.pn;
        const int lrow0 = u.pm * BM + wr * 64 + fr;
        if (T <= 4) {
            const bool isq = T < 4; const float* gain = (isq ? qg : kg) + 4 * fq;
#pragma unroll
            for (int ai = 0; ai < 2; ++ai)
#pragma unroll
                for (int m = 0; m < 4; ++m) {
                    const int lrow = lrow0 + ai * HALF + m * 16, grow = hf * MH + lrow;
                    float ss = 0.f;
#pragma unroll
                    for (int bj = 0; bj < 2; ++bj)
#pragma unroll
                        for (int n = 0; n < 2; ++n) { const f32x4 v = acc[ai][bj][m][n]; ss += (v[0] * v[0] + v[1] * v[1]) + (v[2] * v[2] + v[3] * v[3]); }
                    ss += __shfl_xor(ss, 16); ss += __shfl_xor(ss, 32);
                    const float rs = __builtin_amdgcn_rsqf(ss * (1.0f / 64.0f) + EPS);
                    const bool latent = grow >= NPR;
                    const int t = (grow - NPR) & 2047;
#pragma unroll
                    for (int bj = 0; bj < 2; ++bj) {
                        f32x4 x1 = acc[ai][bj][m][0] * rs * *(const f32x4*)(gain + 32 * bj), x2 = acc[ai][bj][m][1] * rs * *(const f32x4*)(gain + 32 * bj + 16);
                        if (latent) {
                            const int pos = bj ? (t & 63) : (t >> 6);
                            const f32x4 cs0 = *(const f32x4*)(rope + (pos * 16 + 4 * fq) * 2), cs1 = *(const f32x4*)(rope + (pos * 16 + 4 * fq) * 2 + 4);
                            const f32x4 c = {cs0[0], cs0[2], cs1[0], cs1[2]}, s = {cs0[1], cs0[3], cs1[1], cs1[3]};
                            const f32x4 y1 = x1 * c - x2 * s, y2 = x1 * s + x2 * c; x1 = y1; x2 = y2;
                        }
                        if (isq) {
                            bf16_t* qp = Q + (unsigned)(lrow * DM + (4 * T + wc) * 64 + 4 * fq + 32 * bj);
                            *(u32x2*)(qp) = pk4(x1 * QSCALE); *(u32x2*)(qp + 16) = pk4(x2 * QSCALE);
                        } else {
                            bf16_t* kp = Kb + (unsigned)(kv_row(grow, hf) * KVP + wc * 64 + 4 * fq + 32 * bj);
                            *(u32x2*)(kp) = pk4(x1); *(u32x2*)(kp + 16) = pk4(x2);
                            if (!latent) { float* op = nck + (unsigned)(grow * KVP + wc * 64 + 4 * fq + 32 * bj); *(f32x4*)(op) = x1; *(f32x4*)(op + 16) = x2; }
                        }
                    }
                    EPI_FENCE();
                }
        } else if (T == 5) {
#pragma unroll
            for (int ai = 0; ai < 2; ++ai)
#pragma unroll
                for (int m = 0; m < 4; ++m) {
                    const int lrow = lrow0 + ai * HALF + m * 16, grow = hf * MH + lrow;
                    bf16_t* vp = Vb + (unsigned)(kv_row(grow, hf) * KVP + wc * 64 + 4 * fq);
#pragma unroll
                    for (int bj = 0; bj < 2; ++bj)
#pragma unroll
                        for (int n = 0; n < 2; ++n) *(u32x2*)(vp + 32 * bj + 16 * n) = pk4(acc[ai][bj][m][n]);
                    if (grow < NPR) { float* op = ncv + (unsigned)(grow * KVP + wc * 64 + 4 * fq);
#pragma unroll
                        for (int bj = 0; bj < 2; ++bj)
#pragma unroll
                            for (int n = 0; n < 2; ++n) *(f32x4*)(op + 32 * bj + 16 * n) = acc[ai][bj][m][n]; }
                    EPI_FENCE();
                }
        } else if (T < 10) {
            bf16_t* base = RQ + (T - 6) * 256 + wc * 64;
#pragma unroll
            for (int ai = 0; ai < 2; ++ai)
#pragma unroll
                for (int m = 0; m < 4; ++m) { bf16_t* rp = base + (unsigned)((lrow0 + ai * HALF + m * 16) * DM + 4 * fq);
#pragma unroll
                    for (int bj = 0; bj < 2; ++bj)
#pragma unroll
                        for (int n = 0; n < 2; ++n) { const f32x4 v = acc[ai][bj][m][n]; f32x4 o;
#pragma unroll
                            for (int j = 0; j < 4; ++j) o[j] = fsilu(v[j]) * 0.08838834764831845f;
                            *(u32x2*)(rp + 32 * bj + 16 * n) = pk4(o); }
                    EPI_FENCE(); }
        } else if (T < 18) {
            const int d = T >= 14; const int colb = ((T - 10) & 3) * 256 + wc * 64;
            bf16_t* base = (d ? GB : GF) + colb; const float* lbp = lbt + d * 1024 + colb + 4 * fq;
#pragma unroll
            for (int ai = 0; ai < 2; ++ai)
#pragma unroll
                for (int m = 0; m < 4; ++m) { bf16_t* rp = base + (unsigned)((lrow0 + ai * HALF + m * 16) * DM + 4 * fq);
#pragma unroll
                    for (int bj = 0; bj < 2; ++bj)
#pragma unroll
                        for (int n = 0; n < 2; ++n) { const f32x4 v = acc[ai][bj][m][n]; const f32x4 lb = *(const f32x4*)(lbp + 32 * bj + 16 * n); float g[4];
#pragma unroll
                            for (int j = 0; j < 4; ++j) { const float l = lb[j]; g[j] = __logf(l + (1.0f - l) * fsigmoid(v[j])); }
                            u32x2 w; w.x = pkh2(g[0], g[1]); w.y = pkh2(g[2], g[3]); *(u32x2*)(rp + 32 * bj + 16 * n) = w; }
                    EPI_FENCE(); }
        } else if (T < 26) {
            const bool sig = T >= 22; bf16_t* base = (sig ? ZA : RI) + ((T - 18) & 3) * 256 + wc * 64;
#pragma unroll
            for (int ai = 0; ai < 2; ++ai)
#pragma unroll
                for (int m = 0; m < 4; ++m) { bf16_t* rp = base + (unsigned)((lrow0 + ai * HALF + m * 16) * DM + 4 * fq);
#pragma unroll
                    for (int bj = 0; bj < 2; ++bj)
#pragma unroll
                        for (int n = 0; n < 2; ++n) { f32x4 v = acc[ai][bj][m][n];
                            if (sig) {
#pragma unroll
                                for (int j = 0; j < 4; ++j) v[j] = fsigmoid(v[j]); }
                            *(u32x2*)(rp + 32 * bj + 16 * n) = pk4(v); }
                    EPI_FENCE(); }
        } else {
            bf16_t* base = PP + (T - 26) * 128 + wc * 32;
#pragma unroll
            for (int ai = 0; ai < 2; ++ai)
#pragma unroll
                for (int m = 0; m < 4; ++m) { bf16_t* rp = base + (unsigned)((lrow0 + ai * HALF + m * 16) * DM + 4 * fq);
#pragma unroll
                    for (int n = 0; n < 2; ++n) { const f32x4 a = acc[ai][0][m][n], b = acc[ai][1][m][n]; f32x4 o;
#pragma unroll
                        for (int j = 0; j < 4; ++j) o[j] = fsilu(a[j]) * fsigmoid(b[j]);
                        *(u32x2*)(rp + 16 * n) = pk4(o); }
                    EPI_FENCE(); }
        }
    }
};

struct EpiResid {
    static constexpr bool PERM = false, AFTER_DRAIN = false;
    const float* basep; const float* bases; float* out; const float* modb; int goff; int hf;
    __device__ __forceinline__ void operator()(const f32x4 (&acc)[2][2][4][2], const Unit& u, int wr, int wc, int fr, int fq) const {
        const int grow0 = hf * MH + u.pm * BM; const int mi = mod_of_row(grow0);
        const int col0 = u.pn * BM + wc * 64 + 4 * fq;
        const float* base = grow0 < NPR ? basep + (size_t)grow0 * DM : bases + (size_t)(grow0 - NPR) * DM;
        float* ob = out + (size_t)grow0 * DM;
        const float* gp = modb + mi * 6144 + goff + col0;
#pragma unroll
        for (int ai = 0; ai < 2; ++ai)
#pragma unroll
            for (int m = 0; m < 4; ++m) { const unsigned off = (unsigned)((ai * HALF + wr * 64 + m * 16 + fr) * DM + col0);
#pragma unroll
                for (int bj = 0; bj < 2; ++bj)
#pragma unroll
                    for (int n = 0; n < 2; ++n) { const f32x4 b = *(const f32x4*)(base + off + 32 * bj + 16 * n); const f32x4 gt = *(const f32x4*)(gp + 32 * bj + 16 * n);
                        *(f32x4*)(ob + off + 32 * bj + 16 * n) = b + gt * acc[ai][bj][m][n]; }
                EPI_FENCE(); }
    }
};

struct EpiPlain {
    static constexpr bool PERM = false, AFTER_DRAIN = false;
    bf16_t* O; int ldc;
    __device__ __forceinline__ void operator()(const f32x4 (&acc)[2][2][4][2], const Unit& u, int wr, int wc, int fr, int fq) const {
        bf16_t* base = O + u.pn * BM + wc * 64 + 4 * fq;
#pragma unroll
        for (int ai = 0; ai < 2; ++ai)
#pragma unroll
            for (int m = 0; m < 4; ++m) { bf16_t* rp = base + (size_t)(u.pm * BM + ai * HALF + wr * 64 + m * 16 + fr) * ldc;
#pragma unroll
                for (int bj = 0; bj < 2; ++bj)
#pragma unroll
                    for (int n = 0; n < 2; ++n) *(u32x2*)(rp + 32 * bj + 16 * n) = pk4(acc[ai][bj][m][n]); }
    }
};

template <class Epi, class Sched, bool ALIGN_EPI = false, bool SP2 = false>
__device__ __forceinline__ void gemm_phase(PG8_LAS unsigned char* lds, const Gemm g, const Sched& S, const Epi& E) {
    int tid_o = threadIdx.x; asm volatile("" : "+v"(tid_o));
    const int tid = tid_o, wid = __builtin_amdgcn_readfirstlane(tid >> 6), lane = tid & 63, wr = wid >> 2, wc = wid & 3, fr = lane & 15, fq = lane >> 4;
    const int K = g.K, nt = K / BK;
    unsigned voffA[2], voffB[2];
#pragma unroll
    for (int i = 0; i < 2; ++i) { int R, C; stage_rc(tid * 16 + i * 8192, R, C); const int Rb = Epi::PERM ? ((R & ~31) + perm32(R & 31)) : R;
        voffA[i] = (unsigned)(R * K + C) * 2u; voffB[i] = (unsigned)(Rb * K + C) * 2u; }
    const size_t kstep = (size_t)(BK * 2);
    const size_t hstep = (size_t)HALF * K * 2;
    const size_t tstep = 2 * hstep;
    const unsigned ldsw = (unsigned)wid * 1024u;
    const int aoff = lds_byte(wr * 64 + fr, fq * 8), boff = lds_byte(wc * 32 + fr, fq * 8);
#define PG8_SA(b, h) (((b) * 2 + (h)) * HTB)
#define PG8_SB(b, h) ((4 + (b) * 2 + (h)) * HTB)
#define PG8_STAGE(bufoff, gbase, voff) do { _Pragma("unroll") for (int _i = 0; _i < 2; ++_i) \
        __builtin_amdgcn_global_load_lds((const unsigned*)((const char*)(gbase) + (voff)[_i]), (PG8_LAS unsigned*)(lds + (bufoff) + ldsw + _i * 8192), 16, 0, 0); } while (0)
#define PG8_LDA(dst, b, h) do { _Pragma("unroll") for (int m = 0; m < 4; ++m) _Pragma("unroll") for (int k = 0; k < 2; ++k) dst[m][k] = *(const PG8_LAS bf16x8*)(lds + PG8_SA(b, h) + aoff + m * 2048 + k * 1024); } while (0)
#define PG8_LDB(dst, b, h) do { _Pragma("unroll") for (int n = 0; n < 2; ++n) _Pragma("unroll") for (int k = 0; k < 2; ++k) dst[n][k] = *(const PG8_LAS bf16x8*)(lds + PG8_SB(b, h) + boff + n * 2048 + k * 1024); } while (0)
#define PG8_MMA(ai, bj, At, Bt) do { __builtin_amdgcn_s_setprio(1); _Pragma("unroll") for (int m = 0; m < 4; ++m) _Pragma("unroll") for (int n = 0; n < 2; ++n) _Pragma("unroll") for (int k = 0; k < 2; ++k) \
        acc[ai][bj][m][n] = __builtin_amdgcn_mfma_f32_16x16x32_bf16(Bt[n][k], At[m][k], acc[ai][bj][m][n], 0, 0, 0); __builtin_amdgcn_s_setprio(0); } while (0)
#define PG8_WAIT_V(n) asm volatile("s_waitcnt vmcnt(" #n ")" ::: "memory")
#define PG8_WAIT_L(n) asm volatile("s_waitcnt lgkmcnt(" #n ")" ::: "memory")
#define PG8_BAR __builtin_amdgcn_s_barrier()
#define PG8_SCHED __builtin_amdgcn_sched_barrier(0)
    Unit cur, nxt; int ui = 0;
    if (!S.next(0, cur)) return;
    f32x4 acc[2][2][4][2];
#pragma unroll
    for (int a = 0; a < 2; ++a)
#pragma unroll
        for (int b = 0; b < 2; ++b)
#pragma unroll
            for (int m = 0; m < 4; ++m)
#pragma unroll
                for (int n = 0; n < 2; ++n) acc[a][b][m][n] = (f32x4){0.f, 0.f, 0.f, 0.f};
    bf16x8 At[4][2], B0[2][2], B1[2][2];
    const char* cA = (const char*)g.A + (size_t)cur.pm * tstep; const char* cB = (const char*)g.Bt + (size_t)cur.pn * tstep;
    S.a_ready(cur);
    if constexpr (SP2) {
        PG8_STAGE(PG8_SB(0, 0), cB, voffB); PG8_STAGE(PG8_SB(0, 1), cB + hstep, voffB); PG8_STAGE(PG8_SA(0, 0), cA, voffA); PG8_STAGE(PG8_SA(0, 1), cA + hstep, voffA);
        if (wr == 1) PG8_BAR;
        PG8_WAIT_V(2); PG8_BAR;
        PG8_STAGE(PG8_SB(1, 0), cB + kstep, voffB); PG8_STAGE(PG8_SA(1, 0), cA + kstep, voffA); PG8_STAGE(PG8_SB(1, 1), cB + hstep + kstep, voffB);
        PG8_WAIT_V(6); PG8_BAR;
    } else {
        PG8_STAGE(PG8_SB(0, 0), cB, voffB); PG8_STAGE(PG8_SA(0, 0), cA, voffA); PG8_STAGE(PG8_SB(0, 1), cB + hstep, voffB); PG8_STAGE(PG8_SA(0, 1), cA + hstep, voffA);
        if (wr == 1) PG8_BAR;
        PG8_WAIT_V(4); PG8_BAR;
        PG8_STAGE(PG8_SB(1, 0), cB + kstep, voffB); PG8_STAGE(PG8_SA(1, 0), cA + kstep, voffA); PG8_STAGE(PG8_SB(1, 1), cB + hstep + kstep, voffB);
        PG8_WAIT_V(6); PG8_BAR;
    }
    for (;;) {
        const bool has_next = S.next(ui + 1, nxt);
        const char* nA = has_next ? (const char*)g.A + (size_t)nxt.pm * tstep : cA; const char* nB = has_next ? (const char*)g.Bt + (size_t)nxt.pn * tstep : cB;
        for (int t = 0; t < nt; t += 2) {
            const bool last = (t == nt - 2);
            const char* a1 = cA + (size_t)(t + 1) * kstep;
            const char* a2 = last ? nA : cA + (size_t)(t + 2) * kstep; const char* b2 = last ? nB : cB + (size_t)(t + 2) * kstep;
            const char* a3 = a2 + kstep; const char* b3 = b2 + kstep;
            if (last && has_next) S.a_ready(nxt);
            if constexpr (SP2) {
            PG8_LDB(B0, 0, 0); PG8_LDB(B1, 0, 1); PG8_SCHED; PG8_LDA(At, 0, 0); PG8_STAGE(PG8_SA(1, 1), a1 + hstep, voffA);
            PG8_WAIT_V(8); PG8_WAIT_L(0); PG8_BAR; PG8_MMA(0, 0, At, B0); PG8_MMA(0, 1, At, B1); PG8_BAR; PG8_SCHED;
            PG8_LDA(At, 0, 1); PG8_STAGE(PG8_SB(0, 0), b2, voffB); PG8_STAGE(PG8_SB(0, 1), b2 + hstep, voffB); PG8_STAGE(PG8_SA(0, 0), a2, voffA);
            PG8_WAIT_V(8); PG8_WAIT_L(0); PG8_BAR; PG8_MMA(1, 0, At, B0); PG8_MMA(1, 1, At, B1); PG8_BAR; PG8_SCHED;
            PG8_LDB(B0, 1, 0); PG8_LDB(B1, 1, 1); PG8_SCHED; PG8_LDA(At, 1, 0); PG8_STAGE(PG8_SA(0, 1), a2 + hstep, voffA);
            PG8_WAIT_V(8); PG8_WAIT_L(0); PG8_BAR; PG8_MMA(0, 0, At, B0); PG8_MMA(0, 1, At, B1); PG8_BAR; PG8_SCHED;
            PG8_LDA(At, 1, 1); PG8_STAGE(PG8_SB(1, 0), b3, voffB); PG8_STAGE(PG8_SB(1, 1), b3 + hstep, voffB); PG8_STAGE(PG8_SA(1, 0), a3, voffA);
            PG8_WAIT_V(8); PG8_WAIT_L(0); PG8_BAR; PG8_MMA(1, 0, At, B0); PG8_MMA(1, 1, At, B1); PG8_BAR; PG8_SCHED;
            } else {
            PG8_LDB(B0, 0, 0); PG8_SCHED; PG8_LDA(At, 0, 0); PG8_STAGE(PG8_SA(1, 1), a1 + hstep, voffA);
            PG8_WAIT_L(8); PG8_BAR; PG8_WAIT_L(0); PG8_MMA(0, 0, At, B0); PG8_BAR; PG8_SCHED;
            PG8_LDB(B1, 0, 1); PG8_STAGE(PG8_SB(0, 0), b2, voffB);
            PG8_BAR; PG8_WAIT_L(0); PG8_MMA(0, 1, At, B1); PG8_BAR;
            PG8_LDA(At, 0, 1); PG8_STAGE(PG8_SA(0, 0), a2, voffA);
            PG8_BAR; PG8_WAIT_L(0); PG8_MMA(1, 0, At, B0); PG8_BAR; PG8_SCHED;
            PG8_STAGE(PG8_SB(0, 1), b2 + hstep, voffB);
            PG8_WAIT_V(6); PG8_BAR; PG8_MMA(1, 1, At, B1); PG8_BAR;
            PG8_LDB(B0, 1, 0); PG8_SCHED; PG8_LDA(At, 1, 0); PG8_STAGE(PG8_SA(0, 1), a2 + hstep, voffA);
            PG8_WAIT_L(8); PG8_BAR; PG8_WAIT_L(0); PG8_MMA(0, 0, At, B0); PG8_BAR; PG8_SCHED;
            PG8_LDB(B1, 1, 1); PG8_STAGE(PG8_SB(1, 0), b3, voffB);
            PG8_BAR; PG8_WAIT_L(0); PG8_MMA(0, 1, At, B1); PG8_BAR;
            PG8_LDA(At, 1, 1); PG8_STAGE(PG8_SA(1, 0), a3, voffA);
            PG8_BAR; PG8_WAIT_L(0); PG8_MMA(1, 0, At, B0); PG8_BAR; PG8_SCHED;
            PG8_STAGE(PG8_SB(1, 1), b3 + hstep, voffB);
            PG8_WAIT_V(6); PG8_BAR; PG8_MMA(1, 1, At, B1); PG8_BAR;
            }
        }
        if constexpr (ALIGN_EPI) { if (wr == 0) PG8_BAR; }
        if constexpr (!Epi::AFTER_DRAIN) { E(acc, cur, wr, wc, fr, fq); S.done(cur); }
        if (!has_next) break;
#pragma unroll
        for (int a = 0; a < 2; ++a)
#pragma unroll
            for (int b = 0; b < 2; ++b)
#pragma unroll
                for (int m = 0; m < 4; ++m)
#pragma unroll
                    for (int n = 0; n < 2; ++n) acc[a][b][m][n] = (f32x4){0.f, 0.f, 0.f, 0.f};
        cur = nxt; cA = nA; cB = nB; ++ui;
        if constexpr (ALIGN_EPI) { if (wr == 1) PG8_BAR; }
    }
    PG8_WAIT_V(0);
    if constexpr (!ALIGN_EPI) { if (wr == 0) PG8_BAR; }
    PG8_BAR;
    if constexpr (Epi::AFTER_DRAIN) { E.fused(acc, cur, wr, wc, fr, fq, lds, wid, lane); S.done(cur); }
#undef PG8_SA
#undef PG8_SB
#undef PG8_STAGE
#undef PG8_LDA
#undef PG8_LDB
#undef PG8_MMA
#undef PG8_WAIT_V
#undef PG8_WAIT_L
#undef PG8_BAR
#undef PG8_SCHED
}
}

namespace attn_body {
using bf16=__hip_bfloat16;
using bf16x8=__attribute__((ext_vector_type(8)))short;
using s16x4=__attribute__((ext_vector_type(4)))short;
using f32x16=__attribute__((ext_vector_type(16)))float;
using u32x4=__attribute__((ext_vector_type(4)))unsigned;
constexpr int NHEAD=16,D=64,DM=NHEAD*D,KVPITCH=256;
constexpr int NW=8,QBLK=32,QB=QBLK*NW,KVBLK=64;
constexpr int ATTN_PITCH=DM, ATTN_UNIT_ROWS=QB;
__device__ __forceinline__ int crow(int r,int hi){return (r&3)+8*(r>>2)+4*hi;}
#define SBAR() __builtin_amdgcn_sched_barrier(0)
__device__ __forceinline__ void cmask(f32x16&p0,f32x16&p1,int jb,int qrel,int hi){
  const float NEG=-INFINITY; int kb=64*jb+4*hi;
  #pragma unroll
  for(int r=0;r<16;++r){int kv=kb+(r&3)+8*(r>>2); if(kv>qrel)p0[r]=NEG; if(kv+32>qrel)p1[r]=NEG;}
}

constexpr int NSLOT=3, SLOTB=8192;
constexpr int LDS_K=0, LDS_V=NSLOT*SLOTB, LDS_WS=2*NSLOT*SLOTB, LDS_OST=LDS_WS+NW*64*4, LDS_BYTES=LDS_OST+NW*4096;
constexpr float C2=0.125f*1.4426950408889634f;
__device__ __forceinline__ void glds16(const void*gsrc,unsigned lds_dst){unsigned keep;
  asm volatile("s_mov_b32 %0, m0\n\ts_mov_b32 m0, %2\n\ts_nop 0\n\tglobal_load_lds_dwordx4 %1, off\n\ts_mov_b32 m0, %0":"=&s"(keep):"v"(gsrc),"s"(lds_dst):"memory");}
__device__ __forceinline__ float max3f(float a,float b,float c){float r;asm("v_max3_f32 %0, %1, %2, %3":"=v"(r):"v"(a),"v"(b),"v"(c));return r;}
__device__ __forceinline__ float max2f(float a,float b){float r;asm("v_max_f32_e32 %0, %1, %2":"=v"(r):"v"(a),"v"(b));return r;}
__device__ __forceinline__ float fadd_s(float a,float b){float r;asm("v_add_f32_e32 %0, %1, %2":"=v"(r):"v"(a),"v"(b));return r;}
__device__ __forceinline__ float fsub_s(float a,float b){float r;asm("v_sub_f32_e32 %0, %1, %2":"=v"(r):"v"(a),"v"(b));return r;}
typedef float f32x2_t __attribute__((ext_vector_type(2))); typedef __bf16 bf16x2_t __attribute__((ext_vector_type(2)));
__device__ __forceinline__ unsigned cvtpk_s(float lo,float hi){f32x2_t v={lo,hi};bf16x2_t b=__builtin_convertvector(v,bf16x2_t);return __builtin_bit_cast(unsigned,b);}
#define WAIT_BAR(N) asm volatile("s_waitcnt vmcnt(" #N ") lgkmcnt(0)\n\ts_barrier":::"memory")

__device__ __forceinline__ void qkt(f32x16&p0,f32x16&p1,const char*Kslot,const bf16x8*qr,const f32x16&negm,int r32,int hi){
  const char*kb=Kslot+hi*1024+r32*16;
  #pragma unroll
  for(int d0=0;d0<4;++d0){
    const bf16x8 b0=*reinterpret_cast<const bf16x8*>(kb+d0*2048);
    const bf16x8 b1=*reinterpret_cast<const bf16x8*>(kb+d0*2048+512);
    if(d0==0){p0=__builtin_amdgcn_mfma_f32_32x32x16_bf16(b0,qr[0],negm,0,0,0);p1=__builtin_amdgcn_mfma_f32_32x32x16_bf16(b1,qr[0],negm,0,0,0);}
    else{p0=__builtin_amdgcn_mfma_f32_32x32x16_bf16(b0,qr[d0],p0,0,0,0);p1=__builtin_amdgcn_mfma_f32_32x32x16_bf16(b1,qr[d0],p1,0,0,0);}}
}
typedef __attribute__((address_space(3))) const char* lds_cptr;
typedef short v4i16_t __attribute__((ext_vector_type(4)));
__device__ __forceinline__ void kload8(bf16x8*kf,lds_cptr kp){
  kf[0]=*(const __attribute__((address_space(3))) bf16x8*)(kp);      kf[1]=*(const __attribute__((address_space(3))) bf16x8*)(kp+512);
  kf[2]=*(const __attribute__((address_space(3))) bf16x8*)(kp+2048); kf[3]=*(const __attribute__((address_space(3))) bf16x8*)(kp+2560);
  kf[4]=*(const __attribute__((address_space(3))) bf16x8*)(kp+4096); kf[5]=*(const __attribute__((address_space(3))) bf16x8*)(kp+4608);
  kf[6]=*(const __attribute__((address_space(3))) bf16x8*)(kp+6144); kf[7]=*(const __attribute__((address_space(3))) bf16x8*)(kp+6656);
}
__device__ __forceinline__ void kload2(bf16x8*kf,lds_cptr kp,int j){ kf[2*j]=*(const __attribute__((address_space(3))) bf16x8*)(kp+j*2048); kf[2*j+1]=*(const __attribute__((address_space(3))) bf16x8*)(kp+j*2048+512); }
__device__ __forceinline__ s16x4 vtr(lds_cptr p){ return __builtin_bit_cast(s16x4,__builtin_amdgcn_ds_read_tr16_b64_v4i16((__attribute__((address_space(3))) v4i16_t*)p)); }
__device__ __forceinline__ float rowmax(const f32x16&p0,const f32x16&p1){
  float a=max3f(p0[0],p0[1],p1[0]),b=max3f(p0[2],p0[3],p1[1]);a=max3f(a,p1[2],p1[3]);
  #pragma unroll
  for(int r=4;r<16;r+=4){a=max3f(a,p0[r],p0[r+1]);b=max3f(b,p0[r+2],p0[r+3]);a=max3f(a,p1[r],p1[r+1]);b=max3f(b,p1[r+2],p1[r+3]);}
  const float m=max2f(a,b);
  auto rr=__builtin_amdgcn_permlane32_swap(__float_as_uint(m),__float_as_uint(m),false,false);
  return max2f(__uint_as_float(rr[0]),__uint_as_float(rr[1]));
}
__device__ __forceinline__ void pv(f32x16*o,int vb,bf16x8 pa0,bf16x8 pa1,bf16x8 pa2,bf16x8 pa3){
  #pragma unroll
  for(int d0=0;d0<2;++d0){s16x4 lo[4],hi[4];
    #pragma unroll
    for(int ks=0;ks<4;++ks){
      asm volatile("ds_read_b64_tr_b16 %0,%1 offset:%c2":"=&v"(lo[ks]):"v"(vb),"i"(d0*4096+ks*1024):"memory");
      asm volatile("ds_read_b64_tr_b16 %0,%1 offset:%c2":"=&v"(hi[ks]):"v"(vb),"i"(d0*4096+ks*1024+512):"memory");}
    asm volatile("s_waitcnt lgkmcnt(0)":::"memory");SBAR();
    #define PK(k) (bf16x8){lo[k][0],lo[k][1],lo[k][2],lo[k][3],hi[k][0],hi[k][1],hi[k][2],hi[k][3]}
    o[d0]=__builtin_amdgcn_mfma_f32_32x32x16_bf16(pa0,PK(0),o[d0],0,0,0);
    o[d0]=__builtin_amdgcn_mfma_f32_32x32x16_bf16(pa1,PK(1),o[d0],0,0,0);
    o[d0]=__builtin_amdgcn_mfma_f32_32x32x16_bf16(pa2,PK(2),o[d0],0,0,0);
    o[d0]=__builtin_amdgcn_mfma_f32_32x32x16_bf16(pa3,PK(3),o[d0],0,0,0);
    #undef PK
  }
}

#ifndef ATTN_STORE16
#define ATTN_STORE16(p,v) (*(u32x4*)(p)=(v))
#endif
template<int THRL> __device__ __forceinline__ void attn_unit(const bf16*Qu,const bf16*__restrict__ Kh,const bf16*__restrict__ Vh,bf16*Ou,const int NT,char*shm,const bool wr_=true){
  int tid_o=threadIdx.x; asm volatile("":"+v"(tid_o));
  const int tid=tid_o,lane=tid&63,r32=lane&31,hi=lane>>5; const int wid=__builtin_amdgcn_readfirstlane(tid>>6);
  const bf16*Qw=Qu+(long)(wid*QBLK)*DM;
  const unsigned lds0=(unsigned)(uintptr_t)shm;
  float*wsf=(float*)(shm+LDS_WS)+wid*64;
  const bf16*ksrc=Kh+(long)lane*KVPITCH+wid*8;
  const bf16*vsrc=Vh+(long)(16*(wid&3)+(lane>>2))*KVPITCH+(wid>>2)*32+(lane&3)*8;
  const unsigned kdst=lds0+LDS_K+wid*1024, vdst=lds0+LDS_V+wid*1024;
  #define DMA_K(t,slot) glds16(ksrc+(long)(t)*KVBLK*KVPITCH,(unsigned)__builtin_amdgcn_readfirstlane(kdst+(slot)))
  #define DMA_V(t,slot) glds16(vsrc+(long)(t)*KVBLK*KVPITCH,(unsigned)__builtin_amdgcn_readfirstlane(vdst+(slot)))
  const int vb0=(int)(lds0+LDS_V)+((lane>>4)&1)*32+(lane&3)*8+(4*hi+((lane&15)>>2))*64;
  const char*Kbase=shm+LDS_K; bf16x8 kf[8];
  const lds_cptr shm3=(lds_cptr)shm; const lds_cptr kp0=shm3+LDS_K+hi*1024+r32*16; const lds_cptr vp0=shm3+LDS_V+((lane>>4)&1)*32+(lane&3)*8+(4*hi+((lane&15)>>2))*64;
  DMA_K(0,0);DMA_V(0,0);DMA_K(1,SLOTB);
  bf16x8 qr[4];
  #pragma unroll
  for(int d0=0;d0<4;++d0)qr[d0]=*reinterpret_cast<const bf16x8*>(&Qw[(long)r32*DM+d0*16+hi*8]);
  float mhat=0.f,l_reg=0.f;f32x16 o[2];o[0]=f32x16{};o[1]=f32x16{};f32x16 negm=f32x16{};asm volatile("":"+v"(negm));
  #define CMASK(P0,P1,t) do{}while(0)
  bool resc=false;
  #define START(P0,P1) do{ const float rm=rowmax(P0,P1); resc=false; \
    { const float dl=rm; mhat=fadd_s(mhat,dl); \
      _Pragma("unroll") for(int r=0;r<16;++r){P0[r]=fsub_s(P0[r],dl);P1[r]=fsub_s(P1[r],dl);} \
      _Pragma("unroll") for(int r=0;r<16;++r)negm[r]=-mhat; asm volatile("":"+v"(negm)); } \
    _Pragma("unroll") for(int r=0;r<16;++r)P0[r]=__builtin_amdgcn_exp2f(P0[r]); }while(0)
  #define RESC() do{ if(resc){ asm volatile("s_waitcnt lgkmcnt(0)":::"memory"); \
      _Pragma("unroll") for(int d_=0;d_<2;++d_) _Pragma("unroll") for(int r=0;r<16;++r)o[d_][r]*=wsf[crow(r,hi)]; } }while(0)
  f32x16 pA0,pA1,pB0,pB1;
  int sl_prev=0,sl_cur=0,sl_next=SLOTB;
  #define ROT() do{sl_prev=sl_cur;sl_cur=sl_next;sl_next=(sl_next==(NSLOT-1)*SLOTB)?0:sl_next+SLOTB;}while(0)
  DMA_K(2,2*SLOTB);
  WAIT_BAR(3);
  qkt(pA0,pA1,Kbase,qr,negm,r32,hi);asm volatile("s_nop 15\n\ts_nop 7":"+v"(pA0),"+v"(pA1));CMASK(pA0,pA1,0);
  START(pA0,pA1);
  _Pragma("unroll") for(int r=0;r<16;++r)pA1[r]=__builtin_amdgcn_exp2f(pA1[r]);
  WAIT_BAR(0);
  DMA_K(3,0);DMA_V(1,SLOTB);
  ROT();
  kload8(kf,kp0+sl_cur);
  WAIT_BAR(2);
  s16x4 vlo[8],vhi[8]; u32x4 pw0,pw1,pw2,pw3;
  #define PKW(P,B) cvtpk_s(P[B],P[B+1])
  #define PAF(k) __builtin_bit_cast(bf16x8,pw##k)
  #define VFR(i) (bf16x8){vlo[i][0],vlo[i][1],vlo[i][2],vlo[i][3],vhi[i][0],vhi[i][1],vhi[i][2],vhi[i][3]}
  #define PIN(x) asm volatile("":"+v"(x))
  #define MX3(a,b,c) __builtin_fmaxf(__builtin_fmaxf((a),(b)),(c))
  #define GAPA(MF,A0,A1,A2,A3,W0,W1,PW) do{ MF; sacc+=A0; sacc+=A1; sacc+=A2; sacc+=A3; PIN(sacc); W0; W1; PIN(PW); SBAR(); }while(0)
  #define EX(v) __builtin_amdgcn_exp2f(v)
  #define GAPB(MF,X,B) do{ MF; X[B]=EX(X[B]); X[B+1]=EX(X[B+1]); X[B+2]=EX(X[B+2]); X[B+3]=EX(X[B+3]); PIN(X); SBAR(); }while(0)
  #define VRD(i) do{ vlo[i]=vtr(vp_+(((i)>>2)*4096+((i)&3)*1024)); vhi[i]=vtr(vp_+(((i)>>2)*4096+((i)&3)*1024+512)); }while(0)
  #define KRD(G,j) do{ if(G){ kload2(kf,kp0+sl_next,j); SBAR(); } }while(0)
  #define STEP(C0,C1,P0,P1,t,GK,GV,GL) do{ SBAR(); \
    const lds_cptr vp_=vp0+sl_prev; \
    VRD(0); SBAR(); float sacc=(P0[0]+P0[1]); \
    GAPA(C0=__builtin_amdgcn_mfma_f32_32x32x16_bf16(kf[0],qr[0],negm,0,0,0), P0[2],P0[3],P0[4],P0[5],     pw0[0]=PKW(P0,0), pw0[1]=PKW(P0,2), pw0); \
    VRD(4); SBAR(); GAPA(C1=__builtin_amdgcn_mfma_f32_32x32x16_bf16(kf[1],qr[0],negm,0,0,0), P0[6],P0[7],P0[8],P0[9],     pw0[2]=PKW(P0,4), pw0[3]=PKW(P0,6), pw0); \
    VRD(1); SBAR(); GAPA(C0=__builtin_amdgcn_mfma_f32_32x32x16_bf16(kf[2],qr[1],C0,0,0,0),   P0[10],P0[11],P0[12],P0[13], pw1[0]=PKW(P0,8), pw1[1]=PKW(P0,10), pw1); \
    VRD(5); SBAR(); GAPA(C1=__builtin_amdgcn_mfma_f32_32x32x16_bf16(kf[3],qr[1],C1,0,0,0),   P0[14],P0[15],P1[0],P1[1],   pw1[2]=PKW(P0,12),pw1[3]=PKW(P0,14), pw1); \
    VRD(2); SBAR(); GAPA(C0=__builtin_amdgcn_mfma_f32_32x32x16_bf16(kf[4],qr[2],C0,0,0,0),   P1[2],P1[3],P1[4],P1[5],     pw2[0]=PKW(P1,0), pw2[1]=PKW(P1,2), pw2); \
    VRD(6); SBAR(); GAPA(C1=__builtin_amdgcn_mfma_f32_32x32x16_bf16(kf[5],qr[2],C1,0,0,0),   P1[6],P1[7],P1[8],P1[9],     pw2[2]=PKW(P1,4), pw2[3]=PKW(P1,6), pw2); \
    VRD(3); SBAR(); GAPA(C0=__builtin_amdgcn_mfma_f32_32x32x16_bf16(kf[6],qr[3],C0,0,0,0),   P1[10],P1[11],P1[12],P1[13], pw3[0]=PKW(P1,8), pw3[1]=PKW(P1,10), pw3); \
    VRD(7); SBAR(); GAPA(C1=__builtin_amdgcn_mfma_f32_32x32x16_bf16(kf[7],qr[3],C1,0,0,0),   P1[14],P1[15],0.f,0.f,       pw3[2]=PKW(P1,12),pw3[3]=PKW(P1,14), pw3); \
    l_reg+=sacc; \
    if(GK){DMA_K((t)+3,sl_cur);} if(GV){DMA_V((t)+1,sl_next);} \
    CMASK(C0,C1,t); \
    { float a=MX3(C0[0],C0[1],C1[0]),b=MX3(C0[2],C0[3],C1[1]); a=MX3(a,C1[2],C1[3]); \
      _Pragma("unroll") for(int r=4;r<16;r+=4){a=MX3(a,C0[r],C0[r+1]);b=MX3(b,C0[r+2],C0[r+3]);a=MX3(a,C1[r],C1[r+1]);b=MX3(b,C1[r+2],C1[r+3]);} \
      float rm=__builtin_fmaxf(a,b); { auto rr=__builtin_amdgcn_permlane32_swap(__float_as_uint(rm),__float_as_uint(rm),false,false); rm=__builtin_fmaxf(__uint_as_float(rr[0]),__uint_as_float(rr[1])); } \
      resc=false; \
      if(__builtin_expect(__any(rm>(float)THRL),0)){ const float dl=__builtin_fmaxf(rm,0.f); mhat+=dl; \
        _Pragma("unroll") for(int r=0;r<16;++r){C0[r]-=dl;C1[r]-=dl;} \
        _Pragma("unroll") for(int r=0;r<16;++r)negm[r]=-mhat; asm volatile("":"+v"(negm)); \
        const float f=__builtin_amdgcn_exp2f(-dl); l_reg*=f; if(hi==0)wsf[r32]=f; resc=true; } } \
    SBAR(); \
    GAPB(o[0]=__builtin_amdgcn_mfma_f32_32x32x16_bf16(PAF(0),VFR(0),o[0],0,0,0), C0,0); \
    GAPB(o[1]=__builtin_amdgcn_mfma_f32_32x32x16_bf16(PAF(0),VFR(4),o[1],0,0,0), C0,4); \
    KRD(GL,0); GAPB(o[0]=__builtin_amdgcn_mfma_f32_32x32x16_bf16(PAF(1),VFR(1),o[0],0,0,0), C0,8); \
    KRD(GL,1); GAPB(o[1]=__builtin_amdgcn_mfma_f32_32x32x16_bf16(PAF(1),VFR(5),o[1],0,0,0), C0,12); \
    KRD(GL,2); GAPB(o[0]=__builtin_amdgcn_mfma_f32_32x32x16_bf16(PAF(2),VFR(2),o[0],0,0,0), C1,0); \
    KRD(GL,3); GAPB(o[1]=__builtin_amdgcn_mfma_f32_32x32x16_bf16(PAF(2),VFR(6),o[1],0,0,0), C1,4); \
    GAPB(o[0]=__builtin_amdgcn_mfma_f32_32x32x16_bf16(PAF(3),VFR(3),o[0],0,0,0), C1,8); \
    GAPB(o[1]=__builtin_amdgcn_mfma_f32_32x32x16_bf16(PAF(3),VFR(7),o[1],0,0,0), C1,12); \
    }while(0)
  int t=1;
  for(;t+5<NT;t+=2){
    STEP(pB0,pB1,pA0,pA1,t,true,true,true);     WAIT_BAR(2); RESC(); ROT();
    STEP(pA0,pA1,pB0,pB1,t+1,true,true,true);   WAIT_BAR(2); RESC(); ROT();
  }
  #define ENDW(tt) do{ if((tt)+3<NT){WAIT_BAR(2);} else if((tt)+2<NT){WAIT_BAR(1);} else {WAIT_BAR(0);} }while(0)
  for(;t+1<NT;t+=2){
    STEP(pB0,pB1,pA0,pA1,t,(t+3<NT),(t+1<NT),(t+1<NT));       ENDW(t);   RESC(); ROT();
    STEP(pA0,pA1,pB0,pB1,t+1,(t+4<NT),(t+2<NT),(t+2<NT));     ENDW(t+1); RESC(); ROT();
  }
  STEP(pB0,pB1,pA0,pA1,NT-1,false,false,false); RESC();
  { float sacc=pB0[0]+pB0[1]; _Pragma("unroll") for(int r=2;r<16;++r)sacc+=pB0[r]; _Pragma("unroll") for(int r=0;r<16;++r)sacc+=pB1[r]; l_reg+=sacc;
    pw0=(u32x4){PKW(pB0,0),PKW(pB0,2),PKW(pB0,4),PKW(pB0,6)};pw1=(u32x4){PKW(pB0,8),PKW(pB0,10),PKW(pB0,12),PKW(pB0,14)};pw2=(u32x4){PKW(pB1,0),PKW(pB1,2),PKW(pB1,4),PKW(pB1,6)};pw3=(u32x4){PKW(pB1,8),PKW(pB1,10),PKW(pB1,12),PKW(pB1,14)};
    SBAR(); pv(o,vb0+sl_cur,PAF(0),PAF(1),PAF(2),PAF(3)); }
  #undef PKW
  #undef PAF
  #undef VFR
  #undef PIN
  #undef MX3
  #undef GAPA
  #undef GAPB
  #undef EX
  #undef VRD
  #undef KRD
  #undef STEP
  #undef ENDW
  {auto rr=__builtin_amdgcn_permlane32_swap(__float_as_uint(l_reg),__float_as_uint(l_reg),false,false);l_reg=__uint_as_float(rr[0])+__uint_as_float(rr[1]);}
  if(hi==0)wsf[32+r32]=l_reg;asm volatile("s_waitcnt lgkmcnt(0)":::"memory");
  float rli[16];
  #pragma unroll
  for(int r=0;r<16;++r)rli[r]=__builtin_amdgcn_rcpf(wsf[32+crow(r,hi)]);
  bf16*Ow=Ou+(long)(wid*QBLK)*DM;
  { bf16*stg=(bf16*)(shm+LDS_OST)+wid*2048;
    #pragma unroll
    for(int r=0;r<16;++r){const int orow=crow(r,hi);
      #pragma unroll
      for(int d0=0;d0<2;++d0)stg[orow*64+d0*32+r32]=__float2bfloat16(o[d0][r]*rli[r]);}
    asm volatile("s_waitcnt lgkmcnt(0)":::"memory");
    #pragma unroll
    for(int i=0;i<4;++i){const int row=i*8+(lane>>3),ch=lane&7; const u32x4 v=*(const u32x4*)(stg+row*64+ch*8); if(wr_)ATTN_STORE16(Ow+(long)row*DM+ch*8,v);} }
  asm volatile("s_waitcnt lgkmcnt(0)\n\ts_barrier":::"memory");
  #undef DMA_K
  #undef DMA_V
  #undef CMASK
  #undef START
  #undef RESC
  #undef ROT
}
constexpr int ATTN_LDS_BYTES=LDS_BYTES;
#undef SBAR
#undef WAIT_BAR
}

#ifndef MK_SINGLE
#define MK_SINGLE 1
#endif
constexpr int NWAVES = 8, NTHR = 512;
constexpr size_t MiB = 1u << 20;
constexpr size_t WS_CTL = 0, WS_BAR = 8192, WS_MOD = 32768, CTL_ZERO_BYTES = 32768 + 9 * 6144 * 4, WS_ROPE = 512 * 1024, WS_LBT = 528 * 1024, WS_MODB = 768 * 1024;
constexpr size_t WS_WIN = 2 * MiB, WS_WO = 19 * MiB, WS_WUP = 21 * MiB, WS_WDN = 32 * MiB;
constexpr size_t WS_H = 38 * MiB, WS_Q = 58 * MiB, WS_ZA = 78 * MiB, WS_RQ = 98 * MiB, WS_GF = 118 * MiB, WS_GB = 138 * MiB, WS_RI = 158 * MiB, WS_PP = 178 * MiB, WS_K = 198 * MiB, WS_V = 205 * MiB;
constexpr size_t WS_U = 58 * MiB, WS_ACT = 168 * MiB, WS_END = 223 * MiB;
constexpr int RING_BYTES = 131072, LDS_BYTES = 147456;
constexpr int N_PHASES = 21;

typedef unsigned v4u __attribute__((ext_vector_type(4)));
#define LDS_WAIT() asm volatile("s_waitcnt lgkmcnt(0)" ::: "memory")
__device__ __forceinline__ unsigned f2bf(float f) { unsigned u = __builtin_bit_cast(unsigned, f); return (u + 0x7fffu + ((u >> 16) & 1u)) >> 16; }
__device__ __forceinline__ unsigned pk2(float lo, float hi) { return pg8::cvt_pk_bf16(lo, hi); }

#define RLX_AGENT __ATOMIC_RELAXED, __HIP_MEMORY_SCOPE_AGENT
#define XB_TMO      128
#define XB_XCNT(j)  (256  + 64 * (j))
#define XB_XSUB(j)  (1280 + 64 * (j))
#define XB_XGEN(j)  (2304 + 64 * (j))
#define XB_TOP      3328
#define XB_TOPGEN   3392
#define XCD_BAR_WORDS 3456
#define XB_SPIN_CAP (1u << 18)

__device__ __forceinline__ unsigned xb_ld(unsigned* p)              { return __hip_atomic_load(p, __ATOMIC_RELAXED, __HIP_MEMORY_SCOPE_AGENT); }
__device__ __forceinline__ unsigned xb_add(unsigned* p, unsigned v) { return __hip_atomic_fetch_add(p, v, __ATOMIC_RELAXED, __HIP_MEMORY_SCOPE_AGENT); }
__device__ __forceinline__ unsigned xb_xcc_id() { return (unsigned)__builtin_amdgcn_s_getreg((3 << 11) | 20) & 0xFu; }
#define XB_SPIN(cond, bar) do { unsigned _sp = 0; while (cond) { __builtin_amdgcn_s_sleep(1); \
    if ((++_sp & 255u) == 0u) { if (xb_ld(&(bar)[XB_TMO])) break; if (_sp > XB_SPIN_CAP) { atomicAdd(&(bar)[XB_TMO], 1u); break; } } } } while (0)

struct XcdBarrier {
    unsigned* bar; unsigned x;
    volatile LAS unsigned* st;
};

__device__ __forceinline__ XcdBarrier xcd_barrier_post(unsigned* bar, volatile LAS unsigned* st) {
    XcdBarrier b; b.bar = bar; b.x = xb_xcc_id(); b.st = st;
    if (threadIdx.x == 0) (void)xb_add(&bar[XB_XCNT(b.x)], 1u);
    return b;
}
__device__ __forceinline__ void xcd_barrier_complete(unsigned* bar, unsigned x, unsigned& nloc, unsigned& nx) {
    const unsigned G = gridDim.x * gridDim.y * gridDim.z;
    unsigned sum, cnt, mine, sp = 0u;
    for (;;) {
        sum = 0u; cnt = 0u; mine = 0u;
#pragma unroll
        for (unsigned j = 0; j < 16; ++j) { const unsigned c = xb_ld(&bar[XB_XCNT(j)]); sum += c; cnt += (c > 0u) ? 1u : 0u; mine = (j == x) ? c : mine; }
        if (sum == G) break;
        __builtin_amdgcn_s_sleep(1);
        if ((++sp & 255u) == 0u) { if (xb_ld(&bar[XB_TMO])) break; if (sp > XB_SPIN_CAP) { atomicAdd(&bar[XB_TMO], 1u); break; } }
    }
    nloc = mine > 0u ? mine : 1u; nx = cnt > 0u ? cnt : 1u;
}

__device__ __forceinline__ void xcd_barrier(const XcdBarrier& b) {
    asm volatile("s_waitcnt vmcnt(0)" ::: "memory");
    __syncthreads();
    if (threadIdx.x == 0) {
        unsigned* bar = b.bar;
        __builtin_amdgcn_s_waitcnt(0);
        unsigned nloc = b.st[0], nx = b.st[1];
        if (nloc == 0u) { xcd_barrier_complete(bar, b.x, nloc, nx); b.st[0] = nloc; b.st[1] = nx; }
        const unsigned old = xb_add(&bar[XB_XSUB(b.x)], 1u);
        const unsigned gen = old / nloc;
        if (old + 1u == (gen + 1u) * nloc) {
            __builtin_amdgcn_fence(__ATOMIC_RELEASE, "agent");
            asm volatile("s_waitcnt vmcnt(0)" ::: "memory");
            const unsigned og = xb_add(&bar[XB_TOP], 1u);
            const unsigned tg = og / nx;
            if (og + 1u == (tg + 1u) * nx) xb_add(&bar[XB_TOPGEN], 1u);
            else XB_SPIN(xb_ld(&bar[XB_TOPGEN]) == tg, bar);
            __builtin_amdgcn_fence(__ATOMIC_ACQUIRE, "agent");
            xb_add(&bar[XB_XGEN(b.x)], 1u);
            asm volatile("s_waitcnt vmcnt(0)" ::: "memory");
        } else {
            XB_SPIN(xb_ld(&bar[XB_XGEN(b.x)]) == gen, bar);
            __builtin_amdgcn_fence(__ATOMIC_ACQUIRE, "agent");
            asm volatile("s_waitcnt vmcnt(0)" ::: "memory");
        }
    }
    __syncthreads();
}

struct Args { const float* in[22]; float* out; unsigned char* ws; int ph_lo, ph_hi; };

__device__ __forceinline__ void p0_transpose_item(const float* W, int K, int N, bf16_t* WT, int prow0, int lc0, LAS float* scr, int kb, int lane) {
    const int k0 = 64 * kb;
#pragma unroll 8
    for (int i = 0; i < 32; ++i) { const int kk = 2 * i + (lane >> 5); scr[kk * 33 + (lane & 31)] = W[(size_t)(k0 + kk) * N + lc0 + (lane & 31)]; }
    LDS_WAIT(); asm volatile("" ::: "memory");
    const int c = lane & 7;
#pragma unroll
    for (int j = 0; j < 4; ++j) { const int n = (lane >> 3) + 8 * j; const LAS float* s = scr + (8 * c) * 33 + n;
        v4u o; o.x = pk2(s[0 * 33], s[1 * 33]); o.y = pk2(s[2 * 33], s[3 * 33]); o.z = pk2(s[4 * 33], s[5 * 33]); o.w = pk2(s[6 * 33], s[7 * 33]);
        *(v4u*)(WT + (size_t)(prow0 + n) * K + k0 + 8 * c) = o; }
    LDS_WAIT(); asm volatile("" ::: "memory");
}

__device__ __forceinline__ void p0_prep(const __attribute__((address_space(4))) Args* a, LAS unsigned char* lds, int gw, int NGW, int wave, int lane, bool skip_ada = false) {
    LAS float* scr = (LAS float*)(lds + wave * 16384);
    unsigned char* ws = a->ws;
    const float* w_in = a->in[11]; const float* w_o = a->in[16]; const float* w_up = a->in[17]; const float* w_dn = a->in[20];
    constexpr int I_IN = 16 * 272, I_O = 16 * 32, I_UP = 16 * 176, I_DN = 44 * 32, I_T = I_IN + I_O + I_UP + I_DN, I_ADA = 96 * 16, I_ROPE = 16, I_LB = 32;
    for (int it = gw; it < I_T + I_ADA + I_ROPE + I_LB; it += NGW) {
        int r = it;
        if (r < I_T) {
            const float* W; int K, N, kb, pg; bf16_t* WT; bool isin = false;
            if (r < I_IN) { W = w_in; K = 1024; N = INW; kb = r / 272; pg = r % 272; WT = (bf16_t*)(ws + WS_WIN); isin = true; }
            else if ((r -= I_IN) < I_O) { W = w_o; K = 1024; N = 1024; kb = r / 32; pg = r % 32; WT = (bf16_t*)(ws + WS_WO); }
            else if ((r -= I_O) < I_UP) { W = w_up; K = 1024; N = UPW; kb = r / 176; pg = r % 176; WT = (bf16_t*)(ws + WS_WUP); }
            else { r -= I_UP; W = w_dn; K = DFF; N = 1024; kb = r / 32; pg = r % 32; WT = (bf16_t*)(ws + WS_WDN); }
            const int T = pg >> 3, g = pg & 7, bj = g >> 2, wc = g & 3;
            int lc0 = T * 256 + wc * 64 + bj * 32;
            if (isin && T >= 22) lc0 = (T < 26) ? 6656 + (T - 22) * 256 + wc * 64 + bj * 32 : (bj ? 7680 : 5632) + (T - 26) * 128 + wc * 32;
            p0_transpose_item(W, K, N, WT, pg * 32, lc0, scr, kb, lane);
        } else if ((r -= I_T) < I_ADA) {
            if (skip_ada) continue;
            const int g = r >> 4, kc = r & 15, n0 = g * 64 + lane, k0 = kc * 64;
            const float* c_in = a->in[2]; const float* cctx = a->in[6]; const float* adaw = a->in[7];
#pragma unroll
            for (int i = 0; i < 9; ++i) { const float cv = (i == 0) ? cctx[k0 + lane] : c_in[(i - 1) * 1024 + k0 + lane]; scr[lane * 12 + i] = fsilu(cv); }
            LDS_WAIT(); asm volatile("" ::: "memory");
            float acc[9];
#pragma unroll
            for (int i = 0; i < 9; ++i) acc[i] = 0.f;
#pragma unroll 8
            for (int kk = 0; kk < 64; ++kk) { const float w = adaw[(size_t)(k0 + kk) * 6144 + n0];
                const pg8::f32x4 s0 = *(const LAS pg8::f32x4*)(scr + kk * 12), s1 = *(const LAS pg8::f32x4*)(scr + kk * 12 + 4); const float s8 = scr[kk * 12 + 8];
                acc[0] += s0[0] * w; acc[1] += s0[1] * w; acc[2] += s0[2] * w; acc[3] += s0[3] * w; acc[4] += s1[0] * w; acc[5] += s1[1] * w; acc[6] += s1[2] * w; acc[7] += s1[3] * w; acc[8] += s8 * w; }
            float* mod = (float*)(ws + WS_MOD);
#pragma unroll
            for (int i = 0; i < 9; ++i) atomicAdd(mod + i * 6144 + n0, acc[i]);
            LDS_WAIT(); asm volatile("" ::: "memory");
        } else if ((r -= I_ADA) >= I_ROPE) {
            r -= I_ROPE; const int idx = r * 64 + lane, d = idx >> 10, cch = idx & 1023; const float* lg = a->in[14];
            ((float*)(ws + WS_LBT))[idx] = fsigmoid(lg[d * 2048 + cch] - lg[d * 2048 + 1024 + cch]);
        } else {
            const int idx = r * 64 + lane, pos = idx >> 4, i = idx & 15;
            const float invf = exp2f(-(float)i * 0.8304820237218406f); const float ang = (float)pos * invf;
            const float n = rintf(ang * 0.15915494309189535f); float rr = fmaf(-n, 6.2831854820251465f, ang); rr = fmaf(-n, -1.7484555e-7f, rr);
            float* rope = (float*)(ws + WS_ROPE); rope[idx * 2] = __cosf(rr); rope[idx * 2 + 1] = __sinf(rr);
        }
    }
}

template <int MODE> __device__ __forceinline__ void norm_row(const float* xrow, const float* gain, const float* mod, const float* adab, int shoff, int scoff, bf16_t* obf, float* of32, int lane) {
    const pg8::f32x4* xr = (const pg8::f32x4*)xrow + lane;
    pg8::f32x4 v[4]; float s = 0.f;
#pragma unroll
    for (int j = 0; j < 4; ++j) { v[j] = xr[64 * j]; s += (v[j][0] * v[j][0] + v[j][1] * v[j][1]) + (v[j][2] * v[j][2] + v[j][3] * v[j][3]); }
    const float rstd = __builtin_amdgcn_rsqf(wave_sum(s) * (1.0f / 1024.0f) + EPS);
#pragma unroll
    for (int j = 0; j < 4; ++j) { const int c = 4 * (lane + 64 * j); const pg8::f32x4 g = *(const pg8::f32x4*)(gain + c); pg8::f32x4 y = v[j] * rstd * g;
        if (MODE == 0) { const pg8::f32x4 sh = *(const pg8::f32x4*)(mod + shoff + c) + *(const pg8::f32x4*)(adab + shoff + c), sc = *(const pg8::f32x4*)(mod + scoff + c) + *(const pg8::f32x4*)(adab + scoff + c);
            y = y * (sc + 1.0f) + sh; u32x2 w; w.x = pk2(y[0], y[1]); w.y = pk2(y[2], y[3]); *(u32x2*)(obf + c) = w; }
        else *(pg8::f32x4*)(of32 + c) = y; }
}

constexpr int R_QD = 0, R_KD = 17408, R_K2T = 34816, R_VT = 53248, R_SC = 71680, R_ST = 80896, R_XCH = 115712, R_DEC = 119808;
__device__ __forceinline__ int crow(int r, int hi) { return (r & 3) + 8 * (r >> 2) + 4 * hi; }
__device__ __forceinline__ void rec_scan(LAS unsigned char* lds, const bf16_t* RQ, bf16_t* G, const bf16_t* RI, int lrow0, int L, int rh, int dir, const float* s0, float* sfin, const bool wr_ = true) {
    int tid_o = threadIdx.x; asm volatile("" : "+v"(tid_o));
    const int tid = tid_o, lane = tid & 63, w = __builtin_amdgcn_readfirstlane(tid >> 6), r32 = lane & 31, hi = lane >> 5;
    const int kb = w >> 1, dvt0 = (w & 1) * 2;
    const int colb = rh * 128;
    f32x16 S[2];
#pragma unroll
    for (int x = 0; x < 2; ++x)
#pragma unroll
        for (int r = 0; r < 16; ++r) S[x][r] = s0 ? s0[(size_t)(kb * 32 + crow(r, hi)) * 128 + (dvt0 + x) * 32 + r32] : 0.f;
#define REC_WRITE_ST() do { _Pragma("unroll") for (int x = 0; x < 2; ++x) _Pragma("unroll") for (int g = 0; g < 4; ++g) { u32x2 wv; wv.x = pk2(S[x][4 * g], S[x][4 * g + 1]); wv.y = pk2(S[x][4 * g + 2], S[x][4 * g + 3]); \
        *(LAS u32x2*)(lds + R_ST + ((dvt0 + x) * 32 + r32) * 272 + (kb * 32 + 8 * g + 4 * hi) * 2) = wv; } } while (0)
    REC_WRITE_ST();
    const int nc = L >> 6;
    unsigned gq[8], qq[8], vv[8];
#define REC_ROW(c, i) (dir ? (lrow0 + L - 1 - ((c) * 64 + (i))) : (lrow0 + (c) * 64 + (i)))
#define REC_LOAD(c) do { _Pragma("unroll") for (int i = 0; i < 8; ++i) { const size_t off = (size_t)REC_ROW(c, 8 * w + i) * DM + colb + 2 * lane; \
        gq[i] = *(const unsigned*)(G + off); qq[i] = *(const unsigned*)(RQ + off); vv[i] = *(const unsigned*)(RI + off); } } while (0)
    REC_LOAD(0);
    for (int c = 0; c < nc; ++c) {
        float g0[8], g1[8], q0[8], q1[8]; unsigned vk[8];
#pragma unroll
        for (int i = 0; i < 8; ++i) { g0[i] = h2f((unsigned short)(gq[i] & 0xffffu)); g1[i] = h2f((unsigned short)(gq[i] >> 16)); q0[i] = bflo(qq[i]); q1[i] = bfhi(qq[i]); vk[i] = vv[i]; }
        if (c + 1 < nc) REC_LOAD(c + 1);
        float b0[8], b1[8];
        b0[0] = g0[0]; b1[0] = g1[0];
#pragma unroll
        for (int i = 1; i < 8; ++i) { b0[i] = b0[i - 1] + g0[i]; b1[i] = b1[i - 1] + g1[i]; }
        *(LAS f32x2*)(lds + R_XCH + (w * 128 + 2 * lane) * 4) = (f32x2){b0[7], b1[7]};
        __syncthreads();
        float p0 = 0.f, p1 = 0.f, t0 = 0.f, t1 = 0.f;
#pragma unroll
        for (int ww = 0; ww < 8; ++ww) { const f32x2 x = *(const LAS f32x2*)(lds + R_XCH + (ww * 128 + 2 * lane) * 4); if (ww < w) { p0 += x[0]; p1 += x[1]; } t0 += x[0]; t1 += x[1]; }
        if (w == 0) *(LAS f32x2*)(lds + R_DEC + 2 * lane * 4) = (f32x2){__expf(t0), __expf(t1)};
        unsigned k2a[4], k2b[4], va[4], vb[4];
#pragma unroll
        for (int i = 0; i < 8; ++i) {
            const float bb0 = p0 + b0[i], bb1 = p1 + b1[i];
            const float kk0 = 1.0f - __expf(g0[i]), kk1 = 1.0f - __expf(g1[i]);
            const float qd0 = q0[i] * __expf(bb0), qd1 = q1[i] * __expf(bb1);
            const float kd0 = kk0 * __expf(-bb0), kd1 = kk1 * __expf(-bb1);
            const float kt0 = kk0 * __expf(t0 - bb0), kt1 = kk1 * __expf(t1 - bb1);
            const int ti = 8 * w + i;
            *(LAS unsigned*)(lds + R_QD + ti * 272 + lane * 4) = pk2(qd0, qd1);
            *(LAS unsigned*)(lds + R_KD + ti * 272 + lane * 4) = pk2(kd0, kd1);
            const unsigned f0 = f2bf(kt0), f1 = f2bf(kt1);
            if (i & 1) { k2a[i >> 1] |= f0 << 16; k2b[i >> 1] |= f1 << 16; va[i >> 1] |= (vk[i] & 0xffffu) << 16; vb[i >> 1] |= vk[i] & 0xffff0000u; }
            else { k2a[i >> 1] = f0; k2b[i >> 1] = f1; va[i >> 1] = vk[i] & 0xffffu; vb[i >> 1] = vk[i] >> 16; }
        }
        *(LAS v4u*)(lds + R_K2T + (2 * lane) * 144 + 16 * w) = (v4u){k2a[0], k2a[1], k2a[2], k2a[3]};
        *(LAS v4u*)(lds + R_K2T + (2 * lane + 1) * 144 + 16 * w) = (v4u){k2b[0], k2b[1], k2b[2], k2b[3]};
        *(LAS v4u*)(lds + R_VT + (2 * lane) * 144 + 16 * w) = (v4u){va[0], va[1], va[2], va[3]};
        *(LAS v4u*)(lds + R_VT + (2 * lane + 1) * 144 + 16 * w) = (v4u){vb[0], vb[1], vb[2], vb[3]};
        __syncthreads();
        if (w < 4) {
            const int ti = w >> 1, si = w & 1;
            f32x16 sc;
#pragma unroll
            for (int r = 0; r < 16; ++r) sc[r] = 0.f;
            if (w != 1) {
#pragma unroll
                for (int ks = 0; ks < 8; ++ks) {
                    const pg8::bf16x8 af = *(const LAS pg8::bf16x8*)(lds + R_QD + (ti * 32 + r32) * 272 + (16 * ks + 8 * hi) * 2);
                    const pg8::bf16x8 bf = *(const LAS pg8::bf16x8*)(lds + R_KD + (si * 32 + r32) * 272 + (16 * ks + 8 * hi) * 2);
                    sc = __builtin_amdgcn_mfma_f32_32x32x16_bf16(af, bf, sc, 0, 0, 0);
                }
            }
#pragma unroll
            for (int r = 0; r < 16; ++r) { const int t = ti * 32 + crow(r, hi), s = si * 32 + r32; const float v = (t >= s) ? sc[r] : 0.f;
                *(LAS unsigned short*)(lds + R_SC + t * 144 + s * 2) = (unsigned short)f2bf(v); }
        }
        __syncthreads();
        {
            const int to = w >> 2, dvo = w & 3;
            f32x16 o;
#pragma unroll
            for (int r = 0; r < 16; ++r) o[r] = 0.f;
#pragma unroll
            for (int ks = 0; ks < 4; ++ks) {
                const pg8::bf16x8 af = *(const LAS pg8::bf16x8*)(lds + R_SC + (to * 32 + r32) * 144 + (16 * ks + 8 * hi) * 2);
                const pg8::bf16x8 bf = *(const LAS pg8::bf16x8*)(lds + R_VT + (dvo * 32 + r32) * 144 + (16 * ks + 8 * hi) * 2);
                o = __builtin_amdgcn_mfma_f32_32x32x16_bf16(af, bf, o, 0, 0, 0);
            }
#pragma unroll
            for (int ks = 0; ks < 8; ++ks) {
                const pg8::bf16x8 af = *(const LAS pg8::bf16x8*)(lds + R_QD + (to * 32 + r32) * 272 + (16 * ks + 8 * hi) * 2);
                const pg8::bf16x8 bf = *(const LAS pg8::bf16x8*)(lds + R_ST + (dvo * 32 + r32) * 272 + (16 * ks + 8 * hi) * 2);
                o = __builtin_amdgcn_mfma_f32_32x32x16_bf16(af, bf, o, 0, 0, 0);
            }
            if (wr_)
#pragma unroll
            for (int r = 0; r < 16; ++r) { const int t = to * 32 + crow(r, hi); G[(size_t)REC_ROW(c, t) * DM + colb + dvo * 32 + r32] = (bf16_t)f2bf(o[r]); }
            float dec[16];
#pragma unroll
            for (int r = 0; r < 16; ++r) dec[r] = *(const LAS float*)(lds + R_DEC + (kb * 32 + crow(r, hi)) * 4);
#pragma unroll
            for (int x = 0; x < 2; ++x)
#pragma unroll
                for (int r = 0; r < 16; ++r) S[x][r] *= dec[r];
#pragma unroll
            for (int ks = 0; ks < 4; ++ks) {
                const pg8::bf16x8 af = *(const LAS pg8::bf16x8*)(lds + R_K2T + (kb * 32 + r32) * 144 + (16 * ks + 8 * hi) * 2);
#pragma unroll
                for (int x = 0; x < 2; ++x) {
                    const pg8::bf16x8 bf = *(const LAS pg8::bf16x8*)(lds + R_VT + ((dvt0 + x) * 32 + r32) * 144 + (16 * ks + 8 * hi) * 2);
                    S[x] = __builtin_amdgcn_mfma_f32_32x32x16_bf16(af, bf, S[x], 0, 0, 0);
                }
            }
        }
        __syncthreads();
        REC_WRITE_ST();
    }
    if (sfin && wr_) {
#pragma unroll
        for (int x = 0; x < 2; ++x)
#pragma unroll
            for (int r = 0; r < 16; ++r) sfin[(size_t)(kb * 32 + crow(r, hi)) * 128 + (dvt0 + x) * 32 + r32] = S[x][r];
    }
#undef REC_WRITE_ST
#undef REC_ROW
#undef REC_LOAD
}

__global__ void __launch_bounds__(NTHR, 2) fwd_mega(Args args) {
    extern __shared__ __attribute__((aligned(16))) unsigned char lds_raw[];
    LAS unsigned char* lds = (LAS unsigned char*)lds_raw;
    const int G = gridDim.x, bx = blockIdx.x, NGW = G * NWAVES;
typedef const __attribute__((address_space(4))) Args* KArgs;
#define PH_IDS() int tid = threadIdx.x; asm volatile("" : "+v"(tid)); const int lane = tid & 63, wave = __builtin_amdgcn_readfirstlane(tid >> 6), gw = bx * NWAVES + wave; (void)lane; (void)gw; \
    KArgs ap = (KArgs)__builtin_amdgcn_kernarg_segment_ptr(); asm volatile("" : "+s"(ap)); unsigned char* const ws = ap->ws; float* const dout = ap->out; (void)ws; (void)dout;
#define AIN(i) (ap->in[i])
#define WSB(off) ((bf16_t*)(ws + (off)))
#define WSF(off) ((float*)(ws + (off)))
    const int lo = args.ph_lo, hi_ph = args.ph_hi;
    volatile LAS unsigned* bst = (volatile LAS unsigned*)(lds + RING_BYTES + 64);
    if (threadIdx.x < 2) bst[threadIdx.x] = 0u;
    __syncthreads();
    XcdBarrier xbar = xcd_barrier_post((unsigned*)(args.ws + WS_BAR), bst);
    cg::grid_group grid = cg::this_grid();
#ifndef PHMASK
#define PHMASK 0xFFFF
#endif
#define PEN(j) (((PHMASK) >> (j)) & 1)
#ifndef DUPMASK
#define DUPMASK 0
#endif
#define DUP(j) (((DUPMASK) >> (j)) & 1)
#define IN(k) (lo <= (k) && (k) < hi_ph)
#define SEAM(k) do { if (IN(k) && IN((k) + 1)) { if ((k) == 0) grid.sync(); else xcd_barrier(xbar); } } while (0)

    if (PEN(10) && IN(0)) { PH_IDS(); p0_prep(ap, lds, gw, NGW, wave, lane); if (DUP(10)) p0_prep(ap, lds, gw, NGW, wave, lane, true); SEAM(0); }

    for (int hf = 0; hf < 2; ++hf) {
        const int pb = 1 + hf * 10;
        if (PEN(0) && IN(pb + 0)) { PH_IDS(); for (int rep_ = 0; rep_ <= DUP(0); ++rep_) {
            const float* xp = AIN(0); const float* xs = AIN(1); const float* adab = AIN(8); const float* mod = WSF(WS_MOD); bf16_t* H = WSB(WS_H); bf16_t* Kb = WSB(WS_K); bf16_t* Vb = WSB(WS_V);
            for (int r = gw; r < MH; r += NGW) { const int grow = hf * MH + r; const float* src = grow < NPR ? xp + (size_t)grow * DM : xs + (size_t)(grow - NPR) * DM;
                norm_row<0>(src, AIN(9), mod + mod_of_row(grow) * 6144, adab, 0, 1024, H + (size_t)r * DM, nullptr, lane); }
            if (hf == 0) { float* modb = WSF(WS_MODB); for (int i = gw * 64 + lane; i < 9 * 6144; i += NGW * 64) modb[i] = mod[i] + adab[i % 6144]; }
            const int nb = hf ? 5 : 3, b0 = hf ? 3 : 0;
            for (int r = gw; r < 2 * nb * 512; r += NGW) { const int kv = r / (nb * 512), rr = r % (nb * 512), b = rr >> 9, p = rr & 511;
                const float* src = (kv ? AIN(4) : AIN(3)) + ((size_t)(b0 + b) * 512 + p) * KVP + 4 * lane;
                bf16_t* dst = (kv ? Vb : Kb) + (size_t)((hf ? b * 2560 : NPR + b * 2560) + 2048 + p) * KVP + 4 * lane;
                const pg8::f32x4 v = *(const pg8::f32x4*)src; u32x2 wv; wv.x = pk2(v[0], v[1]); wv.y = pk2(v[2], v[3]); *(u32x2*)dst = wv; }
            }
            SEAM(pb + 0);
        }
        if (PEN(1) && IN(pb + 1)) { PH_IDS(); for (int rep_ = 0; rep_ <= DUP(1); ++rep_) {
            pg8::Gemm g{WSB(WS_H), WSB(WS_WIN), MH, INW, DM}; pg8::StaticOrder S; S.init(MH, INW, G, bx);
            float* nck = dout + (size_t)MTOT * DM; float* ncv = nck + (size_t)NPR * KVP;
            pg8::EpiInProj E{WSB(WS_Q), WSB(WS_K), WSB(WS_V), WSB(WS_RQ), WSB(WS_GF), WSB(WS_GB), WSB(WS_RI), WSB(WS_ZA), WSB(WS_PP), nck, ncv, AIN(12), AIN(13), WSF(WS_LBT), WSF(WS_ROPE), hf};
            pg8::gemm_phase<pg8::EpiInProj, pg8::StaticOrder, true, true>(lds, g, S, E);
            }
            SEAM(pb + 1);
        }
        if (PEN(2) && IN(pb + 2)) { PH_IDS(); for (int rep_ = 0; rep_ <= DUP(2); ++rep_) {
            const int nlong = hf ? 80 : 48, nbig = hf ? 640 : 384, nshort = hf ? 0 : 256, nsmall = hf ? 0 : 256;
#ifndef DUPREC
#define DUPREC 0
#endif
#ifndef DUPATT
#define DUPATT 0
#endif
            const int ndl = DUPREC ? nlong : 0, nda = DUPATT ? nbig : 0;
            const int ntot = ndl + nda + nlong + nbig + nshort + nsmall;
            LAS int* slot = (LAS int*)(lds + RING_BYTES); unsigned* ctl = (unsigned*)(ws + WS_CTL);
            bf16_t* Qb = WSB(WS_Q); bf16_t* Kb = WSB(WS_K); bf16_t* Vb = WSB(WS_V); bf16_t* RQ = WSB(WS_RQ); bf16_t* GF = WSB(WS_GF); bf16_t* GB = WSB(WS_GB); bf16_t* RI = WSB(WS_RI);
            float* nst = dout + (size_t)MTOT * DM + 2 * (size_t)NPR * KVP;
            for (;;) {
                __syncthreads();
                if (tid == 0) *slot = (int)atomicAdd(ctl + 64 * hf, 1u);
                __syncthreads();
                int it = *slot;
                if (it >= ntot) break;
                bool wr = true;
                if (it < ndl) wr = false; else { it -= ndl; if (it < nda) { wr = false; it += nlong; } else it -= nda; }
                if (it < nlong) {
                    const int b = it >> 4, rh = (it >> 1) & 7, dir = it & 1; const int bglob = hf ? 3 + b : b;
                    rec_scan(lds, RQ, dir ? GB : GF, RI, (hf ? 0 : NPR) + b * 2048, 2048, rh, dir, AIN(5) + (size_t)((bglob * 2 + dir) * 8 + rh) * 16384, nullptr, wr);
                } else if ((it -= nlong) < nbig) {
                    const int gq = it & 3, qb = (it >> 2) & 7, kvh = (it >> 5) & 3, b = it >> 7, h = kvh * 4 + gq;
                    const int lrow0 = (hf ? 0 : NPR) + b * 2048 + qb * 256, kvr0 = (hf ? 0 : NPR) + b * 2560;
                    attn_body::attn_unit<8>((const attn_body::bf16*)(Qb + (size_t)lrow0 * DM + h * 64), (const attn_body::bf16*)(Kb + (size_t)kvr0 * KVP + kvh * 64), (const attn_body::bf16*)(Vb + (size_t)kvr0 * KVP + kvh * 64),
                                            (attn_body::bf16*)(Qb + (size_t)lrow0 * DM + h * 64), 40, (char*)lds_raw, wr);
                } else if ((it -= nbig) < nshort) {
                    const int seq = it >> 4, rh = (it >> 1) & 7, dir = it & 1;
                    rec_scan(lds, RQ, dir ? GB : GF, RI, seq * 256, 256, rh, dir, nullptr, nst + (size_t)((seq * 2 + dir) * 8 + rh) * 16384);
                } else {
                    it -= nshort; const int seq = it >> 4, h = it & 15, kvh = h >> 2;
                    attn_body::attn_unit<8>((const attn_body::bf16*)(Qb + (size_t)(seq * 256) * DM + h * 64), (const attn_body::bf16*)(Kb + (size_t)(seq * 256) * KVP + kvh * 64), (const attn_body::bf16*)(Vb + (size_t)(seq * 256) * KVP + kvh * 64),
                                            (attn_body::bf16*)(Qb + (size_t)(seq * 256) * DM + h * 64), 4, (char*)lds_raw);
                }
            }
            }
            SEAM(pb + 2);
        }
        if (PEN(3) && IN(pb + 3)) { PH_IDS(); for (int rep_ = 0; rep_ <= DUP(3); ++rep_) {
            const float* hg = AIN(15); bf16_t* Qb = WSB(WS_Q); bf16_t* ZA = WSB(WS_ZA); bf16_t* GF = WSB(WS_GF); bf16_t* GB = WSB(WS_GB); bf16_t* PP = WSB(WS_PP); bf16_t* H = WSB(WS_H);
            for (int r = gw; r < MH; r += NGW) {
                const size_t off = (size_t)r * DM + 16 * lane;
                v4u o[2], z[2], f[2], bq[2], p[2];
#pragma unroll
                for (int e = 0; e < 2; ++e) { o[e] = *(const v4u*)(Qb + off + 8 * e); z[e] = *(const v4u*)(ZA + off + 8 * e); f[e] = *(const v4u*)(GF + off + 8 * e); bq[e] = *(const v4u*)(GB + off + 8 * e); p[e] = *(const v4u*)(PP + off + 8 * e); }
                float s[16]; float ss = 0.f;
#pragma unroll
                for (int e = 0; e < 2; ++e)
#pragma unroll
                    for (int q = 0; q < 4; ++q) { s[8 * e + 2 * q] = bflo(f[e][q]) + bflo(bq[e][q]); s[8 * e + 2 * q + 1] = bfhi(f[e][q]) + bfhi(bq[e][q]); }
#pragma unroll
                for (int q = 0; q < 16; ++q) ss += s[q] * s[q];
                ss += __shfl_xor(ss, 1); ss += __shfl_xor(ss, 2); ss += __shfl_xor(ss, 4);
                const float rs = __builtin_amdgcn_rsqf(ss * (1.0f / 128.0f) + EPS);
                const int gc = (16 * lane) & 127;
                v4u outw[2];
#pragma unroll
                for (int e = 0; e < 2; ++e)
#pragma unroll
                    for (int q = 0; q < 4; ++q) {
                        const int i0 = 8 * e + 2 * q;
                        const float m0 = bflo(o[e][q]) * bflo(z[e][q]) + bflo(p[e][q]) * (s[i0] * rs * hg[gc + i0]);
                        const float m1 = bfhi(o[e][q]) * bfhi(z[e][q]) + bfhi(p[e][q]) * (s[i0 + 1] * rs * hg[gc + i0 + 1]);
                        outw[e][q] = pk2(m0, m1);
                    }
                *(v4u*)(H + off) = outw[0]; *(v4u*)(H + off + 8) = outw[1];
            }
            }
            SEAM(pb + 3);
        }
        if (PEN(4) && IN(pb + 4)) { PH_IDS(); for (int rep_ = 0; rep_ <= DUP(4); ++rep_) {
            pg8::Gemm g{WSB(WS_H), WSB(WS_WO), MH, DM, DM}; pg8::StaticOrder S; S.init(MH, DM, G, bx);
            pg8::EpiResid E{AIN(0), AIN(1), dout, WSF(WS_MODB), 2048, hf};
            pg8::gemm_phase<pg8::EpiResid, pg8::StaticOrder, true, true>(lds, g, S, E);
            }
            SEAM(pb + 4);
        }
        if (PEN(5) && IN(pb + 5)) { PH_IDS(); for (int rep_ = 0; rep_ <= DUP(5); ++rep_) {
            for (int r = gw; r < MH; r += NGW) { const int grow = hf * MH + r;
                norm_row<0>(dout + (size_t)grow * DM, AIN(10), WSF(WS_MOD) + mod_of_row(grow) * 6144, AIN(8), 3072, 4096, WSB(WS_H) + (size_t)r * DM, nullptr, lane); }
            }
            SEAM(pb + 5);
        }
        if (PEN(6) && IN(pb + 6)) { PH_IDS(); for (int rep_ = 0; rep_ <= DUP(6); ++rep_) {
            pg8::Gemm g{WSB(WS_H), WSB(WS_WUP), MH, UPW, DM}; pg8::StaticOrder S; S.init(MH, UPW, G, bx);
            pg8::EpiPlain E{WSB(WS_U), UPW};
            pg8::gemm_phase<pg8::EpiPlain, pg8::StaticOrder, true, true>(lds, g, S, E);
            }
            SEAM(pb + 6);
        }
        if (PEN(7) && IN(pb + 7)) { PH_IDS(); for (int rep_ = 0; rep_ <= DUP(7); ++rep_) {
            const float* cw = AIN(18); const float* cb = AIN(19); const bf16_t* U = WSB(WS_U); bf16_t* ACT = WSB(WS_ACT);
            for (int r = gw; r < MH; r += NGW) {
                const int grow = hf * MH + r; const int t = grow < NPR ? (grow & 255) : ((grow - NPR) & 2047); const int Ls = grow < NPR ? 256 : 2048;
                const bool hp = t > 0, hn = t < Ls - 1;
                const bf16_t* ur = U + (size_t)r * UPW;
                for (int st = 0; st < 11; ++st) {
                    const int c = (st * 64 + lane) * 4;
                    float res[2][4];
#pragma unroll
                    for (int ab = 0; ab < 2; ++ab) {
                        const int cc = c + ab * DFF;
                        const u32x2 u1 = *(const u32x2*)(ur + cc);
                        u32x2 u0 = {0u, 0u}, u2 = {0u, 0u};
                        if (hp) u0 = *(const u32x2*)(ur - UPW + cc);
                        if (hn) u2 = *(const u32x2*)(ur + UPW + cc);
                        const pg8::f32x4 w0 = *(const pg8::f32x4*)(cw + cc), w1 = *(const pg8::f32x4*)(cw + UPW + cc), w2 = *(const pg8::f32x4*)(cw + 2 * UPW + cc), bb = *(const pg8::f32x4*)(cb + cc);
                        res[ab][0] = w0[0] * bflo(u0.x) + w1[0] * bflo(u1.x) + w2[0] * bflo(u2.x) + bb[0];
                        res[ab][1] = w0[1] * bfhi(u0.x) + w1[1] * bfhi(u1.x) + w2[1] * bfhi(u2.x) + bb[1];
                        res[ab][2] = w0[2] * bflo(u0.y) + w1[2] * bflo(u1.y) + w2[2] * bflo(u2.y) + bb[2];
                        res[ab][3] = w0[3] * bfhi(u0.y) + w1[3] * bfhi(u1.y) + w2[3] * bfhi(u2.y) + bb[3];
                    }
                    u32x2 wv; wv.x = pk2(fsilu(res[0][0]) * res[1][0], fsilu(res[0][1]) * res[1][1]); wv.y = pk2(fsilu(res[0][2]) * res[1][2], fsilu(res[0][3]) * res[1][3]);
                    *(u32x2*)(ACT + (size_t)r * DFF + c) = wv;
                }
            }
            }
            SEAM(pb + 7);
        }
        if (PEN(8) && IN(pb + 8)) { PH_IDS(); for (int rep_ = 0; rep_ <= DUP(8); ++rep_) {
            pg8::Gemm g{WSB(WS_ACT), WSB(WS_WDN), MH, DM, DFF}; pg8::StaticOrder S; S.init(MH, DM, G, bx);
            pg8::EpiResid E{dout, dout + (size_t)NPR * DM, dout, WSF(WS_MODB), 5120, hf};
            pg8::gemm_phase<pg8::EpiResid, pg8::StaticOrder, true, true>(lds, g, S, E);
            }
            SEAM(pb + 8);
        }
        if (PEN(9) && IN(pb + 9)) { PH_IDS(); for (int rep_ = 0; rep_ <= DUP(9); ++rep_) {
            for (int r = gw; r < MH; r += NGW) { const int grow = hf * MH + r; float* row = dout + (size_t)grow * DM;
                norm_row<1>(row, AIN(21), nullptr, nullptr, 0, 0, nullptr, row, lane); }
            }
            SEAM(pb + 9);
        }
    }
#undef IN
#undef SEAM
}

extern "C" void kernel_launch(void* const* d_in, const int* in_sizes, int n_in, void* d_out, int out_size, void* d_ws, size_t ws_size, hipStream_t stream) {
    static int grid = 0;
    if (grid == 0) {
        if (n_in != 22 || ws_size < WS_END) { fprintf(stderr, "kernel_launch: unexpected n_in %d / ws_size %zu\n", n_in, ws_size); grid = -1; return; }
        int dev = 0, cus = 0, per_cu = 0;
        hipGetDevice(&dev); hipDeviceGetAttribute(&cus, hipDeviceAttributeMultiprocessorCount, dev);
        if (hipFuncSetAttribute((const void*)fwd_mega, hipFuncAttributeMaxDynamicSharedMemorySize, LDS_BYTES) != hipSuccess) { fprintf(stderr, "kernel_launch: hipFuncSetAttribute failed\n"); grid = -1; return; }
        if (hipOccupancyMaxActiveBlocksPerMultiprocessor(&per_cu, (const void*)fwd_mega, NTHR, LDS_BYTES) != hipSuccess || per_cu < 1) { fprintf(stderr, "kernel_launch: occupancy query says %d\n", per_cu); per_cu = 1; }
        (void)hipGetLastError();
        grid = cus;
    }
    if (grid < 0) return;
    hipMemsetAsync((char*)d_ws + WS_CTL, 0, CTL_ZERO_BYTES, stream);
    Args a{};
    for (int i = 0; i < 22; ++i) a.in[i] = (const float*)d_in[i];
    a.out = (float*)d_out; a.ws = (unsigned char*)d_ws;
#if MK_SINGLE
    a.ph_lo = 0; a.ph_hi = N_PHASES;
    void* kargs[] = {&a};
    hipError_t e = hipLaunchCooperativeKernel((const void*)fwd_mega, dim3(grid), dim3(NTHR), kargs, LDS_BYTES, stream);
    if (e != hipSuccess) fprintf(stderr, "kernel_launch: cooperative launch failed: %s (grid %d)\n", hipGetErrorString(e), grid);
#else
    for (int p = 0; p < N_PHASES; ++p) { a.ph_lo = p; a.ph_hi = p + 1; hipLaunchKernelGGL(fwd_mega, dim3(grid), dim3(NTHR), LDS_BYTES, stream, a); }
#endif
}
```

```cpp
#include <hip/hip_runtime.h>
#include <hip/hip_cooperative_groups.h>
#include <hip/hip_bf16.h>
#include <cstdio>
#include <cstdint>
#include <cmath>
namespace cg = cooperative_groups;

constexpr int DM = 1024, NPR = 4096  , MTOT = 20480, MH = 10240  ;
constexpr int INW = 8704, DFF = 2816, UPW = 5632;
constexpr int KVP = 256;
constexpr float EPS = 1e-6f;
constexpr float QSCALE = 0.125f * 1.4426950408889634f;

#define GAS __attribute__((address_space(1)))
#define LAS __attribute__((address_space(3)))
typedef unsigned short bf16_t;
typedef float f32x2 __attribute__((ext_vector_type(2)));
typedef unsigned u32x2 __attribute__((ext_vector_type(2)));
typedef float f32x16 __attribute__((ext_vector_type(16)));

__device__ __forceinline__ float bf2f(unsigned short h) { return __uint_as_float(((unsigned)h) << 16); }
__device__ __forceinline__ float bflo(unsigned w) { return __uint_as_float(w << 16); }
__device__ __forceinline__ float bfhi(unsigned w) { return __uint_as_float(w & 0xffff0000u); }
__device__ __forceinline__ float fsigmoid(float x) { return __builtin_amdgcn_rcpf(1.0f + __expf(-x)); }
__device__ __forceinline__ float fsilu(float x) { return x * fsigmoid(x); }
__device__ __forceinline__ unsigned pkh2(float a, float b) { _Float16 ha = (_Float16)a, hb = (_Float16)b; return (unsigned)__builtin_bit_cast(unsigned short, ha) | ((unsigned)__builtin_bit_cast(unsigned short, hb) << 16); }
__device__ __forceinline__ float h2f(unsigned short h) { return (float)__builtin_bit_cast(_Float16, h); }
__device__ __forceinline__ float wave_sum(float v) {
#pragma unroll
    for (int o = 1; o < 64; o <<= 1) v += __shfl_xor(v, o);
    return v;
}
__device__ __forceinline__ int mod_of_row(int grow) { return grow < NPR ? 0 : 1 + ((grow - NPR) >> 11); }
__device__ __forceinline__ int kv_row(int grow, int hf) {
    if (grow < NPR) return grow;
    const int s = grow - NPR, b = s >> 11, t = s & 2047;
    return (hf ? (b - 3) * 2560 : NPR + b * 2560) + t;
}

namespace pg8 {
#define PG8_LAS __attribute__((address_space(3)))
typedef unsigned short bf16_t;
typedef short bf16x8 __attribute__((ext_vector_type(8)));
typedef float f32x4 __attribute__((ext_vector_type(4)));
typedef unsigned u32x4 __attribute__((ext_vector_type(4)));
constexpr int BM = 256, BK = 64, HALF = 128, HTB = HALF * BK * 2  , STAGE_BYTES = 8 * HTB, NXCD = 8, WGM = 8;

__host__ __device__ __forceinline__ int lds_byte(int r, int c) { const int st = (r >> 4) * 2 + (c >> 5), rr = r & 15, cc = c & 31, ob = rr * 64 + cc * 2; return st * 1024 + (ob ^ (((ob >> 9) & 1) << 5)); }
__host__ __device__ __forceinline__ void stage_rc(int b, int& R, int& C) { const int st = b / 1024, sb = b % 1024, swz = sb ^ (((sb >> 9) & 1) << 5); R = (st >> 1) * 16 + swz / 64; C = (st & 1) * 32 + (swz % 64) / 2; }
__host__ __device__ __forceinline__ int perm32(int rho) { const int n = rho >> 4, i = rho & 15; return 8 * (i >> 2) + 4 * n + (i & 3); }

struct Unit { int pm, pn; };
struct Gemm { const bf16_t* A; const bf16_t* Bt; int M, N, K; };

struct StaticOrder {
    int nM, nN, nwg, G, c;
    __host__ __device__ void init(int M, int N, int G_, int c_) { nM = M / BM; nN = N / BM; nwg = nM * nN; G = G_; c = c_; }
    __host__ __device__ bool next(int i, Unit& u) const {
        const long L = (long)i * G + c; if (L >= nwg) return false;
        int wgid = (int)L; { const int q = nwg / NXCD, r = nwg % NXCD, xcd = wgid % NXCD, off = wgid / NXCD; wgid = (xcd < r ? xcd * (q + 1) : r * (q + 1) + (xcd - r) * q) + off; }
        const int nig = WGM * nN, gid = wgid / nig, fm = gid * WGM, gsz = (nM - fm) < WGM ? (nM - fm) : WGM;
        u.pm = fm + ((wgid % nig) % gsz); u.pn = (wgid % nig) / gsz; return true;
    }
    __device__ __forceinline__ void a_ready(const Unit&) const {}
    __device__ __forceinline__ void done(const Unit&) const {}
};

__device__ __forceinline__ unsigned cvt_pk_bf16(float lo, float hi) { unsigned r; asm volatile("v_cvt_pk_bf16_f32 %0, %1, %2" : "=v"(r) : "v"(lo), "v"(hi)); return r; }
__device__ __forceinline__ u32x2 pk4(f32x4 v) { u32x2 w; w.x = cvt_pk_bf16(v[0], v[1]); w.y = cvt_pk_bf16(v[2], v[3]); return w; }

#define EPI_FENCE() asm volatile("" ::: "memory")
struct EpiInProj {
    static constexpr bool PERM = false, AFTER_DRAIN = false;
    bf16_t *Q, *Kb, *Vb, *RQ, *GF, *GB, *RI, *ZA, *PP; float *nck, *ncv; const float *qg, *kg, *lbt; const float* rope; int hf;
    __device__ __forceinline__ void operator()(const f32x4 (&acc)[2][2][4][2], const Unit& u, int wr, int wc, int fr, int fq) const {
        const int T = u.pn;
        const int lrow0 = u.pm * BM + wr * 64 + fr;
        if (T <= 4) {
            const bool isq = T < 4; const float* gain = (isq ? qg : kg) + 4 * fq;
#pragma unroll
            for (int ai = 0; ai < 2; ++ai)
#pragma unroll
                for (int m = 0; m < 4; ++m) {
                    const int lrow = lrow0 + ai * HALF + m * 16, grow = hf * MH + lrow;
                    float ss = 0.f;
#pragma unroll
                    for (int bj = 0; bj < 2; ++bj)
#pragma unroll
                        for (int n = 0; n < 2; ++n) { const f32x4 v = acc[ai][bj][m][n]; ss += (v[0] * v[0] + v[1] * v[1]) + (v[2] * v[2] + v[3] * v[3]); }
                    ss += __shfl_xor(ss, 16); ss += __shfl_xor(ss, 32);
                    const float rs = __builtin_amdgcn_rsqf(ss * (1.0f / 64.0f) + EPS);
                    const bool latent = grow >= NPR;
                    const int t = (grow - NPR) & 2047;
#pragma unroll
                    for (int bj = 0; bj < 2; ++bj) {
                        f32x4 x1 = acc[ai][bj][m][0] * rs * *(const f32x4*)(gain + 32 * bj), x2 = acc[ai][bj][m][1] * rs * *(const f32x4*)(gain + 32 * bj + 16);
                        if (latent) {
                            const int pos = bj ? (t & 63) : (t >> 6);
                            const f32x4 cs0 = *(const f32x4*)(rope + (pos * 16 + 4 * fq) * 2), cs1 = *(const f32x4*)(rope + (pos * 16 + 4 * fq) * 2 + 4);
                            const f32x4 c = {cs0[0], cs0[2], cs1[0], cs1[2]}, s = {cs0[1], cs0[3], cs1[1], cs1[3]};
                            const f32x4 y1 = x1 * c - x2 * s, y2 = x1 * s + x2 * c; x1 = y1; x2 = y2;
                        }
                        if (isq) {
                            bf16_t* qp = Q + (unsigned)(lrow * DM + (4 * T + wc) * 64 + 4 * fq + 32 * bj);
                            *(u32x2*)(qp) = pk4(x1 * QSCALE); *(u32x2*)(qp + 16) = pk4(x2 * QSCALE);
                        } else {
                            bf16_t* kp = Kb + (unsigned)(kv_row(grow, hf) * KVP + wc * 64 + 4 * fq + 32 * bj);
                            *(u32x2*)(kp) = pk4(x1); *(u32x2*)(kp + 16) = pk4(x2);
                            if (!latent) { float* op = nck + (unsigned)(grow * KVP + wc * 64 + 4 * fq + 32 * bj); *(f32x4*)(op) = x1; *(f32x4*)(op + 16) = x2; }
                        }
                    }
                    EPI_FENCE();
                }
        } else if (T == 5) {
#pragma unroll
            for (int ai = 0; ai < 2; ++ai)
#pragma unroll
                for (int m = 0; m < 4; ++m) {
                    const int lrow = lrow0 + ai * HALF + m * 16, grow = hf * MH + lrow;
                    bf16_t* vp = Vb + (unsigned)(kv_row(grow, hf) * KVP + wc * 64 + 4 * fq);
#pragma unroll
                    for (int bj = 0; bj < 2; ++bj)
#pragma unroll
                        for (int n = 0; n < 2; ++n) *(u32x2*)(vp + 32 * bj + 16 * n) = pk4(acc[ai][bj][m][n]);
                    if (grow < NPR) { float* op = ncv + (unsigned)(grow * KVP + wc * 64 + 4 * fq);
#pragma unroll
                        for (int bj = 0; bj < 2; ++bj)
#pragma unroll
                            for (int n = 0; n < 2; ++n) *(f32x4*)(op + 32 * bj + 16 * n) = acc[ai][bj][m][n]; }
                    EPI_FENCE();
                }
        } else if (T < 10) {
            bf16_t* base = RQ + (T - 6) * 256 + wc * 64;
#pragma unroll
            for (int ai = 0; ai < 2; ++ai)
#pragma unroll
                for (int m = 0; m < 4; ++m) { bf16_t* rp = base + (unsigned)((lrow0 + ai * HALF + m * 16) * DM + 4 * fq);
#pragma unroll
                    for (int bj = 0; bj < 2; ++bj)
#pragma unroll
                        for (int n = 0; n < 2; ++n) { const f32x4 v = acc[ai][bj][m][n]; f32x4 o;
#pragma unroll
                            for (int j = 0; j < 4; ++j) o[j] = fsilu(v[j]) * 0.08838834764831845f;
                            *(u32x2*)(rp + 32 * bj + 16 * n) = pk4(o); }
                    EPI_FENCE(); }
        } else if (T < 18) {
            const int d = T >= 14; const int colb = ((T - 10) & 3) * 256 + wc * 64;
            bf16_t* base = (d ? GB : GF) + colb; const float* lbp = lbt + d * 1024 + colb + 4 * fq;
#pragma unroll
            for (int ai = 0; ai < 2; ++ai)
#pragma unroll
                for (int m = 0; m < 4; ++m) { bf16_t* rp = base + (unsigned)((lrow0 + ai * HALF + m * 16) * DM + 4 * fq);
#pragma unroll
                    for (int bj = 0; bj < 2; ++bj)
#pragma unroll
                        for (int n = 0; n < 2; ++n) { const f32x4 v = acc[ai][bj][m][n]; const f32x4 lb = *(const f32x4*)(lbp + 32 * bj + 16 * n); float g[4];
#pragma unroll
                            for (int j = 0; j < 4; ++j) { const float l = lb[j]; g[j] = __logf(l + (1.0f - l) * fsigmoid(v[j])); }
                            u32x2 w; w.x = pkh2(g[0], g[1]); w.y = pkh2(g[2], g[3]); *(u32x2*)(rp + 32 * bj + 16 * n) = w; }
                    EPI_FENCE(); }
        } else if (T < 26) {
            const bool sig = T >= 22; bf16_t* base = (sig ? ZA : RI) + ((T - 18) & 3) * 256 + wc * 64;
#pragma unroll
            for (int ai = 0; ai < 2; ++ai)
#pragma unroll
                for (int m = 0; m < 4; ++m) { bf16_t* rp = base + (unsigned)((lrow0 + ai * HALF + m * 16) * DM + 4 * fq);
#pragma unroll
                    for (int bj = 0; bj < 2; ++bj)
#pragma unroll
                        for (int n = 0; n < 2; ++n) { f32x4 v = acc[ai][bj][m][n];
                            if (sig) {
#pragma unroll
                                for (int j = 0; j < 4; ++j) v[j] = fsigmoid(v[j]); }
                            *(u32x2*)(rp + 32 * bj + 16 * n) = pk4(v); }
                    EPI_FENCE(); }
        } else {
            bf16_t* base = PP + (T - 26) * 128 + wc * 32;
#pragma unroll
            for (int ai = 0; ai < 2; ++ai)
#pragma unroll
                for (int m = 0; m < 4; ++m) { bf16_t* rp = base + (unsigned)((lrow0 + ai * HALF + m * 16) * DM + 4 * fq);
#pragma unroll
                    for (int n = 0; n < 2; ++n) { const f32x4 a = acc[ai][0][m][n], b = acc[ai][1][m][n]; f32x4 o;
#pragma unroll
                        for (int j = 0; j < 4; ++j) o[j] = fsilu(a[j]) * fsigmoid(b[j]);
                        *(u32x2*)(rp + 16 * n) = pk4(o); }
                    EPI_FENCE(); }
        }
    }
};

struct EpiResid {
    static constexpr bool PERM = false, AFTER_DRAIN = false;
    const float* basep; const float* bases; float* out; const float* modb; int goff; int hf;
    __device__ __forceinline__ void operator()(const f32x4 (&acc)[2][2][4][2], const Unit& u, int wr, int wc, int fr, int fq) const {
        const int grow0 = hf * MH + u.pm * BM; const int mi = mod_of_row(grow0);
        const int col0 = u.pn * BM + wc * 64 + 4 * fq;
        const float* base = grow0 < NPR ? basep + (size_t)grow0 * DM : bases + (size_t)(grow0 - NPR) * DM;
        float* ob = out + (size_t)grow0 * DM;
        const float* gp = modb + mi * 6144 + goff + col0;
#pragma unroll
        for (int ai = 0; ai < 2; ++ai)
#pragma unroll
            for (int m = 0; m < 4; ++m) { const unsigned off = (unsigned)((ai * HALF + wr * 64 + m * 16 + fr) * DM + col0);
#pragma unroll
                for (int bj = 0; bj < 2; ++bj)
#pragma unroll
                    for (int n = 0; n < 2; ++n) { const f32x4 b = *(const f32x4*)(base + off + 32 * bj + 16 * n); const f32x4 gt = *(const f32x4*)(gp + 32 * bj + 16 * n);
                        *(f32x4*)(ob + off + 32 * bj + 16 * n) = b + gt * acc[ai][bj][m][n]; }
                EPI_FENCE(); }
    }
};

struct EpiResidW {
    static constexpr bool PERM = false, AFTER_DRAIN = false;
    const float* basep; const float* bases; float* out; const float* modb; const float* gam; bf16_t* Hn; float* rowss; int goff; int hf;
    __device__ __forceinline__ void operator()(const f32x4 (&acc)[2][2][4][2], const Unit& u, int wr, int wc, int fr, int fq) const {
        const int grow0 = hf * MH + u.pm * BM; const int mi = mod_of_row(grow0);
        const int col0 = u.pn * BM + wc * 64 + 4 * fq;
        const float* base = grow0 < NPR ? basep + (size_t)grow0 * DM : bases + (size_t)(grow0 - NPR) * DM;
        float* ob = out + (size_t)grow0 * DM; bf16_t* hb = Hn + (size_t)(u.pm * BM) * DM; float* rs = rowss + grow0;
        const float* gp = modb + mi * 6144 + goff + col0; const float* gm = gam + mi * 1024 + col0;
#pragma unroll
        for (int ai = 0; ai < 2; ++ai)
#pragma unroll
            for (int m = 0; m < 4; ++m) { const int r = ai * HALF + wr * 64 + m * 16 + fr; const unsigned off = (unsigned)(r * DM + col0); float ss = 0.f;
#pragma unroll
                for (int bj = 0; bj < 2; ++bj)
#pragma unroll
                    for (int n = 0; n < 2; ++n) { const f32x4 b = *(const f32x4*)(base + off + 32 * bj + 16 * n); const f32x4 gt = *(const f32x4*)(gp + 32 * bj + 16 * n); const f32x4 gg = *(const f32x4*)(gm + 32 * bj + 16 * n);
                        const f32x4 x1 = b + gt * acc[ai][bj][m][n];
                        *(f32x4*)(ob + off + 32 * bj + 16 * n) = x1; *(u32x2*)(hb + off + 32 * bj + 16 * n) = pk4(x1 * gg);
                        ss += (x1[0] * x1[0] + x1[1] * x1[1]) + (x1[2] * x1[2] + x1[3] * x1[3]); }
                ss += __shfl_xor(ss, 16); ss += __shfl_xor(ss, 32);
                if (fq == 0) atomicAdd(rs + r, ss);
                EPI_FENCE(); }
    }
};

struct EpiUp {
    static constexpr bool PERM = false, AFTER_DRAIN = false;
    bf16_t* O; int ldc; const float* rowss; const float* shw; int hf;
    __device__ __forceinline__ void operator()(const f32x4 (&acc)[2][2][4][2], const Unit& u, int wr, int wc, int fr, int fq) const {
        const int grow0 = hf * MH + u.pm * BM; const int mi = mod_of_row(grow0);
        bf16_t* base = O + (size_t)(u.pm * BM) * ldc + u.pn * BM + wc * 64; const float* sp = shw + mi * UPW + u.pn * BM + wc * 64 + 4 * fq; const float* rs = rowss + grow0;
#pragma unroll
        for (int ai = 0; ai < 2; ++ai)
#pragma unroll
            for (int m = 0; m < 4; ++m) { const int r = ai * HALF + wr * 64 + m * 16 + fr; bf16_t* rp = base + (unsigned)(r * ldc + 4 * fq);
                const float rstd = __builtin_amdgcn_rsqf(rs[r] * (1.0f / 1024.0f) + EPS);
#pragma unroll
                for (int bj = 0; bj < 2; ++bj)
#pragma unroll
                    for (int n = 0; n < 2; ++n) *(u32x2*)(rp + 32 * bj + 16 * n) = pk4(acc[ai][bj][m][n] * rstd + *(const f32x4*)(sp + 32 * bj + 16 * n));
                EPI_FENCE(); }
    }
};

struct EpiPlain {
    static constexpr bool PERM = false, AFTER_DRAIN = false;
    bf16_t* O; int ldc;
    __device__ __forceinline__ void operator()(const f32x4 (&acc)[2][2][4][2], const Unit& u, int wr, int wc, int fr, int fq) const {
        bf16_t* base = O + u.pn * BM + wc * 64 + 4 * fq;
#pragma unroll
        for (int ai = 0; ai < 2; ++ai)
#pragma unroll
            for (int m = 0; m < 4; ++m) { bf16_t* rp = base + (size_t)(u.pm * BM + ai * HALF + wr * 64 + m * 16 + fr) * ldc;
#pragma unroll
                for (int bj = 0; bj < 2; ++bj)
#pragma unroll
                    for (int n = 0; n < 2; ++n) *(u32x2*)(rp + 32 * bj + 16 * n) = pk4(acc[ai][bj][m][n]); }
    }
};

template <class Epi, class Sched, bool ALIGN_EPI = false, bool SP2 = false>
__device__ __forceinline__ void gemm_phase(PG8_LAS unsigned char* lds, const Gemm g, const Sched& S, const Epi& E) {
    int tid_o = threadIdx.x; asm volatile("" : "+v"(tid_o));
    const int tid = tid_o, wid = __builtin_amdgcn_readfirstlane(tid >> 6), lane = tid & 63, wr = wid >> 2, wc = wid & 3, fr = lane & 15, fq = lane >> 4;
    const int K = g.K, nt = K / BK;
    unsigned voffA[2], voffB[2];
#pragma unroll
    for (int i = 0; i < 2; ++i) { int R, C; stage_rc(tid * 16 + i * 8192, R, C); const int Rb = Epi::PERM ? ((R & ~31) + perm32(R & 31)) : R;
        voffA[i] = (unsigned)(R * K + C) * 2u; voffB[i] = (unsigned)(Rb * K + C) * 2u; }
    const size_t kstep = (size_t)(BK * 2);
    const size_t hstep = (size_t)HALF * K * 2;
    const size_t tstep = 2 * hstep;
    const unsigned ldsw = (unsigned)wid * 1024u;
    const int aoff = lds_byte(wr * 64 + fr, fq * 8), boff = lds_byte(wc * 32 + fr, fq * 8);
#define PG8_SA(b, h) (((b) * 2 + (h)) * HTB)
#define PG8_SB(b, h) ((4 + (b) * 2 + (h)) * HTB)
#define PG8_STAGE(bufoff, gbase, voff) do { _Pragma("unroll") for (int _i = 0; _i < 2; ++_i) \
        __builtin_amdgcn_global_load_lds((const unsigned*)((const char*)(gbase) + (voff)[_i]), (PG8_LAS unsigned*)(lds + (bufoff) + ldsw + _i * 8192), 16, 0, 0); } while (0)
#define PG8_LDA(dst, b, h) do { _Pragma("unroll") for (int m = 0; m < 4; ++m) _Pragma("unroll") for (int k = 0; k < 2; ++k) dst[m][k] = *(const PG8_LAS bf16x8*)(lds + PG8_SA(b, h) + aoff + m * 2048 + k * 1024); } while (0)
#define PG8_LDB(dst, b, h) do { _Pragma("unroll") for (int n = 0; n < 2; ++n) _Pragma("unroll") for (int k = 0; k < 2; ++k) dst[n][k] = *(const PG8_LAS bf16x8*)(lds + PG8_SB(b, h) + boff + n * 2048 + k * 1024); } while (0)
#define PG8_MMA(ai, bj, At, Bt) do { __builtin_amdgcn_s_setprio(1); _Pragma("unroll") for (int m = 0; m < 4; ++m) _Pragma("unroll") for (int n = 0; n < 2; ++n) _Pragma("unroll") for (int k = 0; k < 2; ++k) \
        acc[ai][bj][m][n] = __builtin_amdgcn_mfma_f32_16x16x32_bf16(Bt[n][k], At[m][k], acc[ai][bj][m][n], 0, 0, 0); __builtin_amdgcn_s_setprio(0); } while (0)
#define PG8_WAIT_V(n) asm volatile("s_waitcnt vmcnt(" #n ")" ::: "memory")
#define PG8_WAIT_L(n) asm volatile("s_waitcnt lgkmcnt(" #n ")" ::: "memory")
#define PG8_BAR __builtin_amdgcn_s_barrier()
#define PG8_SCHED __builtin_amdgcn_sched_barrier(0)
    Unit cur, nxt; int ui = 0;
    if (!S.next(0, cur)) return;
    f32x4 acc[2][2][4][2];
#pragma unroll
    for (int a = 0; a < 2; ++a)
#pragma unroll
        for (int b = 0; b < 2; ++b)
#pragma unroll
            for (int m = 0; m < 4; ++m)
#pragma unroll
                for (int n = 0; n < 2; ++n) acc[a][b][m][n] = (f32x4){0.f, 0.f, 0.f, 0.f};
    bf16x8 At[4][2], B0[2][2], B1[2][2];
    const char* cA = (const char*)g.A + (size_t)cur.pm * tstep; const char* cB = (const char*)g.Bt + (size_t)cur.pn * tstep;
    S.a_ready(cur);
    if constexpr (SP2) {
        PG8_STAGE(PG8_SB(0, 0), cB, voffB); PG8_STAGE(PG8_SB(0, 1), cB + hstep, voffB); PG8_STAGE(PG8_SA(0, 0), cA, voffA); PG8_STAGE(PG8_SA(0, 1), cA + hstep, voffA);
        if (wr == 1) PG8_BAR;
        PG8_WAIT_V(2); PG8_BAR;
        PG8_STAGE(PG8_SB(1, 0), cB + kstep, voffB); PG8_STAGE(PG8_SA(1, 0), cA + kstep, voffA); PG8_STAGE(PG8_SB(1, 1), cB + hstep + kstep, voffB);
        PG8_WAIT_V(6); PG8_BAR;
    } else {
        PG8_STAGE(PG8_SB(0, 0), cB, voffB); PG8_STAGE(PG8_SA(0, 0), cA, voffA); PG8_STAGE(PG8_SB(0, 1), cB + hstep, voffB); PG8_STAGE(PG8_SA(0, 1), cA + hstep, voffA);
        if (wr == 1) PG8_BAR;
        PG8_WAIT_V(4); PG8_BAR;
        PG8_STAGE(PG8_SB(1, 0), cB + kstep, voffB); PG8_STAGE(PG8_SA(1, 0), cA + kstep, voffA); PG8_STAGE(PG8_SB(1, 1), cB + hstep + kstep, voffB);
        PG8_WAIT_V(6); PG8_BAR;
    }
    for (;;) {
        const bool has_next = S.next(ui + 1, nxt);
        const char* nA = has_next ? (const char*)g.A + (size_t)nxt.pm * tstep : cA; const char* nB = has_next ? (const char*)g.Bt + (size_t)nxt.pn * tstep : cB;
        for (int t = 0; t < nt; t += 2) {
            const bool last = (t == nt - 2);
            const char* a1 = cA + (size_t)(t + 1) * kstep;
            const char* a2 = last ? nA : cA + (size_t)(t + 2) * kstep; const char* b2 = last ? nB : cB + (size_t)(t + 2) * kstep;
            const char* a3 = a2 + kstep; const char* b3 = b2 + kstep;
            if (last && has_next) S.a_ready(nxt);
            if constexpr (SP2) {
            PG8_LDB(B0, 0, 0); PG8_LDB(B1, 0, 1); PG8_SCHED; PG8_LDA(At, 0, 0); PG8_STAGE(PG8_SA(1, 1), a1 + hstep, voffA);
            PG8_WAIT_V(8); PG8_WAIT_L(0); PG8_BAR; PG8_MMA(0, 0, At, B0); PG8_MMA(0, 1, At, B1); PG8_BAR; PG8_SCHED;
            PG8_LDA(At, 0, 1); PG8_STAGE(PG8_SB(0, 0), b2, voffB); PG8_STAGE(PG8_SB(0, 1), b2 + hstep, voffB); PG8_STAGE(PG8_SA(0, 0), a2, voffA);
            PG8_WAIT_V(8); PG8_WAIT_L(0); PG8_BAR; PG8_MMA(1, 0, At, B0); PG8_MMA(1, 1, At, B1); PG8_BAR; PG8_SCHED;
            PG8_LDB(B0, 1, 0); PG8_LDB(B1, 1, 1); PG8_SCHED; PG8_LDA(At, 1, 0); PG8_STAGE(PG8_SA(0, 1), a2 + hstep, voffA);
            PG8_WAIT_V(8); PG8_WAIT_L(0); PG8_BAR; PG8_MMA(0, 0, At, B0); PG8_MMA(0, 1, At, B1); PG8_BAR; PG8_SCHED;
            PG8_LDA(At, 1, 1); PG8_STAGE(PG8_SB(1, 0), b3, voffB); PG8_STAGE(PG8_SB(1, 1), b3 + hstep, voffB); PG8_STAGE(PG8_SA(1, 0), a3, voffA);
            PG8_WAIT_V(8); PG8_WAIT_L(0); PG8_BAR; PG8_MMA(1, 0, At, B0); PG8_MMA(1, 1, At, B1); PG8_BAR; PG8_SCHED;
            } else {
            PG8_LDB(B0, 0, 0); PG8_SCHED; PG8_LDA(At, 0, 0); PG8_STAGE(PG8_SA(1, 1), a1 + hstep, voffA);
            PG8_WAIT_L(8); PG8_BAR; PG8_WAIT_L(0); PG8_MMA(0, 0, At, B0); PG8_BAR; PG8_SCHED;
            PG8_LDB(B1, 0, 1); PG8_STAGE(PG8_SB(0, 0), b2, voffB);
            PG8_BAR; PG8_WAIT_L(0); PG8_MMA(0, 1, At, B1); PG8_BAR;
            PG8_LDA(At, 0, 1); PG8_STAGE(PG8_SA(0, 0), a2, voffA);
            PG8_BAR; PG8_WAIT_L(0); PG8_MMA(1, 0, At, B0); PG8_BAR; PG8_SCHED;
            PG8_STAGE(PG8_SB(0, 1), b2 + hstep, voffB);
            PG8_WAIT_V(6); PG8_BAR; PG8_MMA(1, 1, At, B1); PG8_BAR;
            PG8_LDB(B0, 1, 0); PG8_SCHED; PG8_LDA(At, 1, 0); PG8_STAGE(PG8_SA(0, 1), a2 + hstep, voffA);
            PG8_WAIT_L(8); PG8_BAR; PG8_WAIT_L(0); PG8_MMA(0, 0, At, B0); PG8_BAR; PG8_SCHED;
            PG8_LDB(B1, 1, 1); PG8_STAGE(PG8_SB(1, 0), b3, voffB);
            PG8_BAR; PG8_WAIT_L(0); PG8_MMA(0, 1, At, B1); PG8_BAR;
            PG8_LDA(At, 1, 1); PG8_STAGE(PG8_SA(1, 0), a3, voffA);
            PG8_BAR; PG8_WAIT_L(0); PG8_MMA(1, 0, At, B0); PG8_BAR; PG8_SCHED;
            PG8_STAGE(PG8_SB(1, 1), b3 + hstep, voffB);
            PG8_WAIT_V(6); PG8_BAR; PG8_MMA(1, 1, At, B1); PG8_BAR;
            }
        }
        if constexpr (ALIGN_EPI) { if (wr == 0) PG8_BAR; }
        if constexpr (!Epi::AFTER_DRAIN) { E(acc, cur, wr, wc, fr, fq); S.done(cur); }
        if (!has_next) break;
#pragma unroll
        for (int a = 0; a < 2; ++a)
#pragma unroll
            for (int b = 0; b < 2; ++b)
#pragma unroll
                for (int m = 0; m < 4; ++m)
#pragma unroll
                    for (int n = 0; n < 2; ++n) acc[a][b][m][n] = (f32x4){0.f, 0.f, 0.f, 0.f};
        cur = nxt; cA = nA; cB = nB; ++ui;
        if constexpr (ALIGN_EPI) { if (wr == 1) PG8_BAR; }
    }
    PG8_WAIT_V(0);
    if constexpr (!ALIGN_EPI) { if (wr == 0) PG8_BAR; }
    PG8_BAR;
    if constexpr (Epi::AFTER_DRAIN) { E.fused(acc, cur, wr, wc, fr, fq, lds, wid, lane); S.done(cur); }
#undef PG8_SA
#undef PG8_SB
#undef PG8_STAGE
#undef PG8_LDA
#undef PG8_LDB
#undef PG8_MMA
#undef PG8_WAIT_V
#undef PG8_WAIT_L
#undef PG8_BAR
#undef PG8_SCHED
}
}

namespace attn_body {
using bf16=__hip_bfloat16;
using bf16x8=__attribute__((ext_vector_type(8)))short;
using s16x4=__attribute__((ext_vector_type(4)))short;
using f32x16=__attribute__((ext_vector_type(16)))float;
using u32x4=__attribute__((ext_vector_type(4)))unsigned;
constexpr int NHEAD=16,D=64,DM=NHEAD*D,KVPITCH=256;
constexpr int NW=8,QBLK=32,QB=QBLK*NW,KVBLK=64;
constexpr int ATTN_PITCH=DM, ATTN_UNIT_ROWS=QB;
__device__ __forceinline__ int crow(int r,int hi){return (r&3)+8*(r>>2)+4*hi;}
#define SBAR() __builtin_amdgcn_sched_barrier(0)
__device__ __forceinline__ void cmask(f32x16&p0,f32x16&p1,int jb,int qrel,int hi){
  const float NEG=-INFINITY; int kb=64*jb+4*hi;
  #pragma unroll
  for(int r=0;r<16;++r){int kv=kb+(r&3)+8*(r>>2); if(kv>qrel)p0[r]=NEG; if(kv+32>qrel)p1[r]=NEG;}
}

constexpr int NSLOT=3, SLOTB=8192;
constexpr int LDS_K=0, LDS_V=NSLOT*SLOTB, LDS_WS=2*NSLOT*SLOTB, LDS_OST=LDS_WS+NW*64*4, LDS_BYTES=LDS_OST+NW*4096;
constexpr float C2=0.125f*1.4426950408889634f;
__device__ __forceinline__ void glds16(const void*gsrc,unsigned lds_dst){unsigned keep;
  asm volatile("s_mov_b32 %0, m0\n\ts_mov_b32 m0, %2\n\ts_nop 0\n\tglobal_load_lds_dwordx4 %1, off\n\ts_mov_b32 m0, %0":"=&s"(keep):"v"(gsrc),"s"(lds_dst):"memory");}
__device__ __forceinline__ float max3f(float a,float b,float c){float r;asm("v_max3_f32 %0, %1, %2, %3":"=v"(r):"v"(a),"v"(b),"v"(c));return r;}
__device__ __forceinline__ float max2f(float a,float b){float r;asm("v_max_f32_e32 %0, %1, %2":"=v"(r):"v"(a),"v"(b));return r;}
__device__ __forceinline__ float fadd_s(float a,float b){float r;asm("v_add_f32_e32 %0, %1, %2":"=v"(r):"v"(a),"v"(b));return r;}
__device__ __forceinline__ float fsub_s(float a,float b){float r;asm("v_sub_f32_e32 %0, %1, %2":"=v"(r):"v"(a),"v"(b));return r;}
typedef float f32x2_t __attribute__((ext_vector_type(2))); typedef __bf16 bf16x2_t __attribute__((ext_vector_type(2)));
__device__ __forceinline__ unsigned cvtpk_s(float lo,float hi){f32x2_t v={lo,hi};bf16x2_t b=__builtin_convertvector(v,bf16x2_t);return __builtin_bit_cast(unsigned,b);}
#define WAIT_BAR(N) asm volatile("s_waitcnt vmcnt(" #N ") lgkmcnt(0)\n\ts_barrier":::"memory")

__device__ __forceinline__ void qkt(f32x16&p0,f32x16&p1,const char*Kslot,const bf16x8*qr,const f32x16&negm,int r32,int hi){
  const char*kb=Kslot+hi*1024+r32*16;
  #pragma unroll
  for(int d0=0;d0<4;++d0){
    const bf16x8 b0=*reinterpret_cast<const bf16x8*>(kb+d0*2048);
    const bf16x8 b1=*reinterpret_cast<const bf16x8*>(kb+d0*2048+512);
    if(d0==0){p0=__builtin_amdgcn_mfma_f32_32x32x16_bf16(b0,qr[0],negm,0,0,0);p1=__builtin_amdgcn_mfma_f32_32x32x16_bf16(b1,qr[0],negm,0,0,0);}
    else{p0=__builtin_amdgcn_mfma_f32_32x32x16_bf16(b0,qr[d0],p0,0,0,0);p1=__builtin_amdgcn_mfma_f32_32x32x16_bf16(b1,qr[d0],p1,0,0,0);}}
}
typedef __attribute__((address_space(3))) const char* lds_cptr;
typedef short v4i16_t __attribute__((ext_vector_type(4)));
__device__ __forceinline__ void kload8(bf16x8*kf,lds_cptr kp){
  kf[0]=*(const __attribute__((address_space(3))) bf16x8*)(kp);      kf[1]=*(const __attribute__((address_space(3))) bf16x8*)(kp+512);
  kf[2]=*(const __attribute__((address_space(3))) bf16x8*)(kp+2048); kf[3]=*(const __attribute__((address_space(3))) bf16x8*)(kp+2560);
  kf[4]=*(const __attribute__((address_space(3))) bf16x8*)(kp+4096); kf[5]=*(const __attribute__((address_space(3))) bf16x8*)(kp+4608);
  kf[6]=*(const __attribute__((address_space(3))) bf16x8*)(kp+6144); kf[7]=*(const __attribute__((address_space(3))) bf16x8*)(kp+6656);
}
__device__ __forceinline__ void kload2(bf16x8*kf,lds_cptr kp,int j){ kf[2*j]=*(const __attribute__((address_space(3))) bf16x8*)(kp+j*2048); kf[2*j+1]=*(const __attribute__((address_space(3))) bf16x8*)(kp+j*2048+512); }
__device__ __forceinline__ s16x4 vtr(lds_cptr p){ return __builtin_bit_cast(s16x4,__builtin_amdgcn_ds_read_tr16_b64_v4i16((__attribute__((address_space(3))) v4i16_t*)p)); }
__device__ __forceinline__ float rowmax(const f32x16&p0,const f32x16&p1){
  float a=max3f(p0[0],p0[1],p1[0]),b=max3f(p0[2],p0[3],p1[1]);a=max3f(a,p1[2],p1[3]);
  #pragma unroll
  for(int r=4;r<16;r+=4){a=max3f(a,p0[r],p0[r+1]);b=max3f(b,p0[r+2],p0[r+3]);a=max3f(a,p1[r],p1[r+1]);b=max3f(b,p1[r+2],p1[r+3]);}
  const float m=max2f(a,b);
  auto rr=__builtin_amdgcn_permlane32_swap(__float_as_uint(m),__float_as_uint(m),false,false);
  return max2f(__uint_as_float(rr[0]),__uint_as_float(rr[1]));
}
__device__ __forceinline__ void pv(f32x16*o,int vb,bf16x8 pa0,bf16x8 pa1,bf16x8 pa2,bf16x8 pa3){
  #pragma unroll
  for(int d0=0;d0<2;++d0){s16x4 lo[4],hi[4];
    #pragma unroll
    for(int ks=0;ks<4;++ks){
      asm volatile("ds_read_b64_tr_b16 %0,%1 offset:%c2":"=&v"(lo[ks]):"v"(vb),"i"(d0*4096+ks*1024):"memory");
      asm volatile("ds_read_b64_tr_b16 %0,%1 offset:%c2":"=&v"(hi[ks]):"v"(vb),"i"(d0*4096+ks*1024+512):"memory");}
    asm volatile("s_waitcnt lgkmcnt(0)":::"memory");SBAR();
    #define PK(k) (bf16x8){lo[k][0],lo[k][1],lo[k][2],lo[k][3],hi[k][0],hi[k][1],hi[k][2],hi[k][3]}
    o[d0]=__builtin_amdgcn_mfma_f32_32x32x16_bf16(pa0,PK(0),o[d0],0,0,0);
    o[d0]=__builtin_amdgcn_mfma_f32_32x32x16_bf16(pa1,PK(1),o[d0],0,0,0);
    o[d0]=__builtin_amdgcn_mfma_f32_32x32x16_bf16(pa2,PK(2),o[d0],0,0,0);
    o[d0]=__builtin_amdgcn_mfma_f32_32x32x16_bf16(pa3,PK(3),o[d0],0,0,0);
    #undef PK
  }
}

#ifndef ATTN_STORE16
#define ATTN_STORE16(p,v) (*(u32x4*)(p)=(v))
#endif
template<int THRL> __device__ __forceinline__ void attn_unit(const bf16*Qu,const bf16*__restrict__ Kh,const bf16*__restrict__ Vh,bf16*Ou,const int NT,char*shm,const bool wr_=true){
  int tid_o=threadIdx.x; asm volatile("":"+v"(tid_o));
  const int tid=tid_o,lane=tid&63,r32=lane&31,hi=lane>>5; const int wid=__builtin_amdgcn_readfirstlane(tid>>6);
  const bf16*Qw=Qu+(long)(wid*QBLK)*DM;
  const unsigned lds0=(unsigned)(uintptr_t)shm;
  float*wsf=(float*)(shm+LDS_WS)+wid*64;
  const bf16*ksrc=Kh+(long)lane*KVPITCH+wid*8;
  const bf16*vsrc=Vh+(long)(16*(wid&3)+(lane>>2))*KVPITCH+(wid>>2)*32+(lane&3)*8;
  const unsigned kdst=lds0+LDS_K+wid*1024, vdst=lds0+LDS_V+wid*1024;
  #define DMA_K(t,slot) glds16(ksrc+(long)(t)*KVBLK*KVPITCH,(unsigned)__builtin_amdgcn_readfirstlane(kdst+(slot)))
  #define DMA_V(t,slot) glds16(vsrc+(long)(t)*KVBLK*KVPITCH,(unsigned)__builtin_amdgcn_readfirstlane(vdst+(slot)))
  const int vb0=(int)(lds0+LDS_V)+((lane>>4)&1)*32+(lane&3)*8+(4*hi+((lane&15)>>2))*64;
  const char*Kbase=shm+LDS_K; bf16x8 kf[8];
  const lds_cptr shm3=(lds_cptr)shm; const lds_cptr kp0=shm3+LDS_K+hi*1024+r32*16; const lds_cptr vp0=shm3+LDS_V+((lane>>4)&1)*32+(lane&3)*8+(4*hi+((lane&15)>>2))*64;
  DMA_K(0,0);DMA_V(0,0);DMA_K(1,SLOTB);
  bf16x8 qr[4];
  #pragma unroll
  for(int d0=0;d0<4;++d0)qr[d0]=*reinterpret_cast<const bf16x8*>(&Qw[(long)r32*DM+d0*16+hi*8]);
  float mhat=0.f,l_reg=0.f;f32x16 o[2];o[0]=f32x16{};o[1]=f32x16{};f32x16 negm=f32x16{};asm volatile("":"+v"(negm));
  #define CMASK(P0,P1,t) do{}while(0)
  bool resc=false;
  #define START(P0,P1) do{ const float rm=rowmax(P0,P1); resc=false; \
    { const float dl=rm; mhat=fadd_s(mhat,dl); \
      _Pragma("unroll") for(int r=0;r<16;++r){P0[r]=fsub_s(P0[r],dl);P1[r]=fsub_s(P1[r],dl);} \
      _Pragma("unroll") for(int r=0;r<16;++r)negm[r]=-mhat; asm volatile("":"+v"(negm)); } \
    _Pragma("unroll") for(int r=0;r<16;++r)P0[r]=__builtin_amdgcn_exp2f(P0[r]); }while(0)
  #define RESC() do{ if(resc){ asm volatile("s_waitcnt lgkmcnt(0)":::"memory"); \
      _Pragma("unroll") for(int d_=0;d_<2;++d_) _Pragma("unroll") for(int r=0;r<16;++r)o[d_][r]*=wsf[crow(r,hi)]; } }while(0)
  f32x16 pA0,pA1,pB0,pB1;
  int sl_prev=0,sl_cur=0,sl_next=SLOTB;
  #define ROT() do{sl_prev=sl_cur;sl_cur=sl_next;sl_next=(sl_next==(NSLOT-1)*SLOTB)?0:sl_next+SLOTB;}while(0)
  DMA_K(2,2*SLOTB);
  WAIT_BAR(3);
  qkt(pA0,pA1,Kbase,qr,negm,r32,hi);asm volatile("s_nop 15\n\ts_nop 7":"+v"(pA0),"+v"(pA1));CMASK(pA0,pA1,0);
  START(pA0,pA1);
  _Pragma("unroll") for(int r=0;r<16;++r)pA1[r]=__builtin_amdgcn_exp2f(pA1[r]);
  WAIT_BAR(0);
  DMA_K(3,0);DMA_V(1,SLOTB);
  ROT();
  kload8(kf,kp0+sl_cur);
  WAIT_BAR(2);
  s16x4 vlo[8],vhi[8]; u32x4 pw0,pw1,pw2,pw3;
  #define PKW(P,B) cvtpk_s(P[B],P[B+1])
  #define PAF(k) __builtin_bit_cast(bf16x8,pw##k)
  #define VFR(i) (bf16x8){vlo[i][0],vlo[i][1],vlo[i][2],vlo[i][3],vhi[i][0],vhi[i][1],vhi[i][2],vhi[i][3]}
  #define PIN(x) asm volatile("":"+v"(x))
  #define MX3(a,b,c) __builtin_fmaxf(__builtin_fmaxf((a),(b)),(c))
  #define GAPA(MF,A0,A1,A2,A3,W0,W1,PW) do{ MF; sacc+=A0; sacc+=A1; sacc+=A2; sacc+=A3; PIN(sacc); W0; W1; PIN(PW); SBAR(); }while(0)
  #define EX(v) __builtin_amdgcn_exp2f(v)
  #define GAPB(MF,X,B) do{ MF; X[B]=EX(X[B]); X[B+1]=EX(X[B+1]); X[B+2]=EX(X[B+2]); X[B+3]=EX(X[B+3]); PIN(X); SBAR(); }while(0)
  #define VRD(i) do{ vlo[i]=vtr(vp_+(((i)>>2)*4096+((i)&3)*1024)); vhi[i]=vtr(vp_+(((i)>>2)*4096+((i)&3)*1024+512)); }while(0)
  #define KRD(G,j) do{ if(G){ kload2(kf,kp0+sl_next,j); SBAR(); } }while(0)
  #define STEP(C0,C1,P0,P1,t,GK,GV,GL) do{ SBAR(); \
    const lds_cptr vp_=vp0+sl_prev; \
    VRD(0); SBAR(); float sacc=(P0[0]+P0[1]); \
    GAPA(C0=__builtin_amdgcn_mfma_f32_32x32x16_bf16(kf[0],qr[0],negm,0,0,0), P0[2],P0[3],P0[4],P0[5],     pw0[0]=PKW(P0,0), pw0[1]=PKW(P0,2), pw0); \
    VRD(4); SBAR(); GAPA(C1=__builtin_amdgcn_mfma_f32_32x32x16_bf16(kf[1],qr[0],negm,0,0,0), P0[6],P0[7],P0[8],P0[9],     pw0[2]=PKW(P0,4), pw0[3]=PKW(P0,6), pw0); \
    VRD(1); SBAR(); GAPA(C0=__builtin_amdgcn_mfma_f32_32x32x16_bf16(kf[2],qr[1],C0,0,0,0),   P0[10],P0[11],P0[12],P0[13], pw1[0]=PKW(P0,8), pw1[1]=PKW(P0,10), pw1); \
    VRD(5); SBAR(); GAPA(C1=__builtin_amdgcn_mfma_f32_32x32x16_bf16(kf[3],qr[1],C1,0,0,0),   P0[14],P0[15],P1[0],P1[1],   pw1[2]=PKW(P0,12),pw1[3]=PKW(P0,14), pw1); \
    VRD(2); SBAR(); GAPA(C0=__builtin_amdgcn_mfma_f32_32x32x16_bf16(kf[4],qr[2],C0,0,0,0),   P1[2],P1[3],P1[4],P1[5],     pw2[0]=PKW(P1,0), pw2[1]=PKW(P1,2), pw2); \
    VRD(6); SBAR(); GAPA(C1=__builtin_amdgcn_mfma_f32_32x32x16_bf16(kf[5],qr[2],C1,0,0,0),   P1[6],P1[7],P1[8],P1[9],     pw2[2]=PKW(P1,4), pw2[3]=PKW(P1,6), pw2); \
    VRD(3); SBAR(); GAPA(C0=__builtin_amdgcn_mfma_f32_32x32x16_bf16(kf[6],qr[3],C0,0,0,0),   P1[10],P1[11],P1[12],P1[13], pw3[0]=PKW(P1,8), pw3[1]=PKW(P1,10), pw3); \
    VRD(7); SBAR(); GAPA(C1=__builtin_amdgcn_mfma_f32_32x32x16_bf16(kf[7],qr[3],C1,0,0,0),   P1[14],P1[15],0.f,0.f,       pw3[2]=PKW(P1,12),pw3[3]=PKW(P1,14), pw3); \
    l_reg+=sacc; \
    if(GK){DMA_K((t)+3,sl_cur);} if(GV){DMA_V((t)+1,sl_next);} \
    CMASK(C0,C1,t); \
    { float a=MX3(C0[0],C0[1],C1[0]),b=MX3(C0[2],C0[3],C1[1]); a=MX3(a,C1[2],C1[3]); \
      _Pragma("unroll") for(int r=4;r<16;r+=4){a=MX3(a,C0[r],C0[r+1]);b=MX3(b,C0[r+2],C0[r+3]);a=MX3(a,C1[r],C1[r+1]);b=MX3(b,C1[r+2],C1[r+3]);} \
      float rm=__builtin_fmaxf(a,b); { auto rr=__builtin_amdgcn_permlane32_swap(__float_as_uint(rm),__float_as_uint(rm),false,false); rm=__builtin_fmaxf(__uint_as_float(rr[0]),__uint_as_float(rr[1])); } \
      resc=false; \
      if(__builtin_expect(__any(rm>(float)THRL),0)){ const float dl=__builtin_fmaxf(rm,0.f); mhat+=dl; \
        _Pragma("unroll") for(int r=0;r<16;++r){C0[r]-=dl;C1[r]-=dl;} \
        _Pragma("unroll") for(int r=0;r<16;++r)negm[r]=-mhat; asm volatile("":"+v"(negm)); \
        const float f=__builtin_amdgcn_exp2f(-dl); l_reg*=f; if(hi==0)wsf[r32]=f; resc=true; } } \
    SBAR(); \
    GAPB(o[0]=__builtin_amdgcn_mfma_f32_32x32x16_bf16(PAF(0),VFR(0),o[0],0,0,0), C0,0); \
    GAPB(o[1]=__builtin_amdgcn_mfma_f32_32x32x16_bf16(PAF(0),VFR(4),o[1],0,0,0), C0,4); \
    KRD(GL,0); GAPB(o[0]=__builtin_amdgcn_mfma_f32_32x32x16_bf16(PAF(1),VFR(1),o[0],0,0,0), C0,8); \
    KRD(GL,1); GAPB(o[1]=__builtin_amdgcn_mfma_f32_32x32x16_bf16(PAF(1),VFR(5),o[1],0,0,0), C0,12); \
    KRD(GL,2); GAPB(o[0]=__builtin_amdgcn_mfma_f32_32x32x16_bf16(PAF(2),VFR(2),o[0],0,0,0), C1,0); \
    KRD(GL,3); GAPB(o[1]=__builtin_amdgcn_mfma_f32_32x32x16_bf16(PAF(2),VFR(6),o[1],0,0,0), C1,4); \
    GAPB(o[0]=__builtin_amdgcn_mfma_f32_32x32x16_bf16(PAF(3),VFR(3),o[0],0,0,0), C1,8); \
    GAPB(o[1]=__builtin_amdgcn_mfma_f32_32x32x16_bf16(PAF(3),VFR(7),o[1],0,0,0), C1,12); \
    }while(0)
  int t=1;
  for(;t+5<NT;t+=2){
    STEP(pB0,pB1,pA0,pA1,t,true,true,true);     WAIT_BAR(2); RESC(); ROT();
    STEP(pA0,pA1,pB0,pB1,t+1,true,true,true);   WAIT_BAR(2); RESC(); ROT();
  }
  #define ENDW(tt) do{ if((tt)+3<NT){WAIT_BAR(2);} else if((tt)+2<NT){WAIT_BAR(1);} else {WAIT_BAR(0);} }while(0)
  for(;t+1<NT;t+=2){
    STEP(pB0,pB1,pA0,pA1,t,(t+3<NT),(t+1<NT),(t+1<NT));       ENDW(t);   RESC(); ROT();
    STEP(pA0,pA1,pB0,pB1,t+1,(t+4<NT),(t+2<NT),(t+2<NT));     ENDW(t+1); RESC(); ROT();
  }
  STEP(pB0,pB1,pA0,pA1,NT-1,false,false,false); RESC();
  { float sacc=pB0[0]+pB0[1]; _Pragma("unroll") for(int r=2;r<16;++r)sacc+=pB0[r]; _Pragma("unroll") for(int r=0;r<16;++r)sacc+=pB1[r]; l_reg+=sacc;
    pw0=(u32x4){PKW(pB0,0),PKW(pB0,2),PKW(pB0,4),PKW(pB0,6)};pw1=(u32x4){PKW(pB0,8),PKW(pB0,10),PKW(pB0,12),PKW(pB0,14)};pw2=(u32x4){PKW(pB1,0),PKW(pB1,2),PKW(pB1,4),PKW(pB1,6)};pw3=(u32x4){PKW(pB1,8),PKW(pB1,10),PKW(pB1,12),PKW(pB1,14)};
    SBAR(); pv(o,vb0+sl_cur,PAF(0),PAF(1),PAF(2),PAF(3)); }
  #undef PKW
  #undef PAF
  #undef VFR
  #undef PIN
  #undef MX3
  #undef GAPA
  #undef GAPB
  #undef EX
  #undef VRD
  #undef KRD
  #undef STEP
  #undef ENDW
  {auto rr=__builtin_amdgcn_permlane32_swap(__float_as_uint(l_reg),__float_as_uint(l_reg),false,false);l_reg=__uint_as_float(rr[0])+__uint_as_float(rr[1]);}
  if(hi==0)wsf[32+r32]=l_reg;asm volatile("s_waitcnt lgkmcnt(0)":::"memory");
  float rli[16];
  #pragma unroll
  for(int r=0;r<16;++r)rli[r]=__builtin_amdgcn_rcpf(wsf[32+crow(r,hi)]);
  bf16*Ow=Ou+(long)(wid*QBLK)*DM;
  { bf16*stg=(bf16*)(shm+LDS_OST)+wid*2048;
    #pragma unroll
    for(int r=0;r<16;++r){const int orow=crow(r,hi);
      #pragma unroll
      for(int d0=0;d0<2;++d0)stg[orow*64+d0*32+r32]=__float2bfloat16(o[d0][r]*rli[r]);}
    asm volatile("s_waitcnt lgkmcnt(0)":::"memory");
    #pragma unroll
    for(int i=0;i<4;++i){const int row=i*8+(lane>>3),ch=lane&7; const u32x4 v=*(const u32x4*)(stg+row*64+ch*8); if(wr_)ATTN_STORE16(Ow+(long)row*DM+ch*8,v);} }
  asm volatile("s_waitcnt lgkmcnt(0)\n\ts_barrier":::"memory");
  #undef DMA_K
  #undef DMA_V
  #undef CMASK
  #undef START
  #undef RESC
  #undef ROT
}
constexpr int ATTN_LDS_BYTES=LDS_BYTES;
#undef SBAR
#undef WAIT_BAR
}

#ifndef MK_SINGLE
#define MK_SINGLE 1
#endif
constexpr int NWAVES = 8, NTHR = 512;
constexpr size_t MiB = 1u << 20;
constexpr size_t WS_CTL = 0, WS_BAR = 8192, WS_MOD = 32768, WS_ROWSS = 262144, CTL_ZERO_BYTES = 262144 + 20480 * 4, WS_SHW = 1024 * 1024, WS_GAM = 1280 * 1024, WS_ROPE = 512 * 1024, WS_LBT = 528 * 1024, WS_MODB = 768 * 1024;
constexpr size_t WS_WIN = 2 * MiB, WS_WO = 19 * MiB, WS_WUP = 21 * MiB, WS_WDN = 32 * MiB;
constexpr size_t WS_H = 38 * MiB, WS_Q = 58 * MiB, WS_ZA = 78 * MiB, WS_RQ = 98 * MiB, WS_GF = 118 * MiB, WS_GB = 138 * MiB, WS_RI = 158 * MiB, WS_PP = 178 * MiB, WS_K = 198 * MiB, WS_V = 205 * MiB;
constexpr size_t WS_U = 58 * MiB, WS_ACT = 168 * MiB, WS_H2 = 223 * MiB, WS_END = 243 * MiB;
constexpr int RING_BYTES = 131072, LDS_BYTES = 147456;
constexpr int N_PHASES = 21;

typedef unsigned v4u __attribute__((ext_vector_type(4)));
#define LDS_WAIT() asm volatile("s_waitcnt lgkmcnt(0)" ::: "memory")
__device__ __forceinline__ unsigned f2bf(float f) { unsigned u = __builtin_bit_cast(unsigned, f); return (u + 0x7fffu + ((u >> 16) & 1u)) >> 16; }
__device__ __forceinline__ unsigned pk2(float lo, float hi) { return pg8::cvt_pk_bf16(lo, hi); }

#define RLX_AGENT __ATOMIC_RELAXED, __HIP_MEMORY_SCOPE_AGENT
#define XB_TMO      128
#define XB_XCNT(j)  (256  + 64 * (j))
#define XB_XSUB(j)  (1280 + 64 * (j))
#define XB_XGEN(j)  (2304 + 64 * (j))
#define XB_TOP      3328
#define XB_TOPGEN   3392
#define XCD_BAR_WORDS 3456
#define XB_SPIN_CAP (1u << 18)

__device__ __forceinline__ unsigned xb_ld(unsigned* p)              { return __hip_atomic_load(p, __ATOMIC_RELAXED, __HIP_MEMORY_SCOPE_AGENT); }
__device__ __forceinline__ unsigned xb_add(unsigned* p, unsigned v) { return __hip_atomic_fetch_add(p, v, __ATOMIC_RELAXED, __HIP_MEMORY_SCOPE_AGENT); }
__device__ __forceinline__ unsigned xb_xcc_id() { return (unsigned)__builtin_amdgcn_s_getreg((3 << 11) | 20) & 0xFu; }
#define XB_SPIN(cond, bar) do { unsigned _sp = 0; while (cond) { __builtin_amdgcn_s_sleep(1); \
    if ((++_sp & 255u) == 0u) { if (xb_ld(&(bar)[XB_TMO])) break; if (_sp > XB_SPIN_CAP) { atomicAdd(&(bar)[XB_TMO], 1u); break; } } } } while (0)

struct XcdBarrier {
    unsigned* bar; unsigned x;
    volatile LAS unsigned* st;
};

__device__ __forceinline__ XcdBarrier xcd_barrier_post(unsigned* bar, volatile LAS unsigned* st) {
    XcdBarrier b; b.bar = bar; b.x = xb_xcc_id(); b.st = st;
    if (threadIdx.x == 0) (void)xb_add(&bar[XB_XCNT(b.x)], 1u);
    return b;
}
__device__ __forceinline__ void xcd_barrier_complete(unsigned* bar, unsigned x, unsigned& nloc, unsigned& nx) {
    const unsigned G = gridDim.x * gridDim.y * gridDim.z;
    unsigned sum, cnt, mine, sp = 0u;
    for (;;) {
        sum = 0u; cnt = 0u; mine = 0u;
#pragma unroll
        for (unsigned j = 0; j < 16; ++j) { const unsigned c = xb_ld(&bar[XB_XCNT(j)]); sum += c; cnt += (c > 0u) ? 1u : 0u; mine = (j == x) ? c : mine; }
        if (sum == G) break;
        __builtin_amdgcn_s_sleep(1);
        if ((++sp & 255u) == 0u) { if (xb_ld(&bar[XB_TMO])) break; if (sp > XB_SPIN_CAP) { atomicAdd(&bar[XB_TMO], 1u); break; } }
    }
    nloc = mine > 0u ? mine : 1u; nx = cnt > 0u ? cnt : 1u;
}

__device__ __forceinline__ void xcd_barrier(const XcdBarrier& b) {
    asm volatile("s_waitcnt vmcnt(0)" ::: "memory");
    __syncthreads();
    if (threadIdx.x == 0) {
        unsigned* bar = b.bar;
        __builtin_amdgcn_s_waitcnt(0);
        unsigned nloc = b.st[0], nx = b.st[1];
        if (nloc == 0u) { xcd_barrier_complete(bar, b.x, nloc, nx); b.st[0] = nloc; b.st[1] = nx; }
        const unsigned old = xb_add(&bar[XB_XSUB(b.x)], 1u);
        const unsigned gen = old / nloc;
        if (old + 1u == (gen + 1u) * nloc) {
            __builtin_amdgcn_fence(__ATOMIC_RELEASE, "agent");
            asm volatile("s_waitcnt vmcnt(0)" ::: "memory");
            const unsigned og = xb_add(&bar[XB_TOP], 1u);
            const unsigned tg = og / nx;
            if (og + 1u == (tg + 1u) * nx) xb_add(&bar[XB_TOPGEN], 1u);
            else XB_SPIN(xb_ld(&bar[XB_TOPGEN]) == tg, bar);
            __builtin_amdgcn_fence(__ATOMIC_ACQUIRE, "agent");
            xb_add(&bar[XB_XGEN(b.x)], 1u);
            asm volatile("s_waitcnt vmcnt(0)" ::: "memory");
        } else {
            XB_SPIN(xb_ld(&bar[XB_XGEN(b.x)]) == gen, bar);
            __builtin_amdgcn_fence(__ATOMIC_ACQUIRE, "agent");
            asm volatile("s_waitcnt vmcnt(0)" ::: "memory");
        }
    }
    __syncthreads();
}

struct Args { const float* in[22]; float* out; unsigned char* ws; int ph_lo, ph_hi; };

__device__ __forceinline__ void p0_transpose_item(const float* W, int K, int N, bf16_t* WT, int prow0, int lc0, LAS float* scr, int kb, int lane) {
    const int k0 = 64 * kb;
#pragma unroll 8
    for (int i = 0; i < 32; ++i) { const int kk = 2 * i + (lane >> 5); scr[kk * 33 + (lane & 31)] = W[(size_t)(k0 + kk) * N + lc0 + (lane & 31)]; }
    LDS_WAIT(); asm volatile("" ::: "memory");
    const int c = lane & 7;
#pragma unroll
    for (int j = 0; j < 4; ++j) { const int n = (lane >> 3) + 8 * j; const LAS float* s = scr + (8 * c) * 33 + n;
        v4u o; o.x = pk2(s[0 * 33], s[1 * 33]); o.y = pk2(s[2 * 33], s[3 * 33]); o.z = pk2(s[4 * 33], s[5 * 33]); o.w = pk2(s[6 * 33], s[7 * 33]);
        *(v4u*)(WT + (size_t)(prow0 + n) * K + k0 + 8 * c) = o; }
    LDS_WAIT(); asm volatile("" ::: "memory");
}

__device__ __forceinline__ void p0_prep(const __attribute__((address_space(4))) Args* a, LAS unsigned char* lds, int gw, int NGW, int wave, int lane, bool skip_ada = false) {
    LAS float* scr = (LAS float*)(lds + wave * 16384);
    unsigned char* ws = a->ws;
    const float* w_in = a->in[11]; const float* w_o = a->in[16]; const float* w_up = a->in[17]; const float* w_dn = a->in[20];
    constexpr int I_IN = 16 * 272, I_O = 16 * 32, I_UP = 16 * 176, I_DN = 44 * 32, I_T = I_IN + I_O + I_UP + I_DN, I_ADA = 96 * 16, I_ROPE = 16, I_LB = 32;
    for (int it = gw; it < I_T + I_ADA + I_ROPE + I_LB; it += NGW) {
        int r = it;
        if (r < I_T) {
            const float* W; int K, N, kb, pg; bf16_t* WT; bool isin = false;
            if (r < I_IN) { W = w_in; K = 1024; N = INW; kb = r / 272; pg = r % 272; WT = (bf16_t*)(ws + WS_WIN); isin = true; }
            else if ((r -= I_IN) < I_O) { W = w_o; K = 1024; N = 1024; kb = r / 32; pg = r % 32; WT = (bf16_t*)(ws + WS_WO); }
            else if ((r -= I_O) < I_UP) { W = w_up; K = 1024; N = UPW; kb = r / 176; pg = r % 176; WT = (bf16_t*)(ws + WS_WUP); }
            else { r -= I_UP; W = w_dn; K = DFF; N = 1024; kb = r / 32; pg = r % 32; WT = (bf16_t*)(ws + WS_WDN); }
            const int T = pg >> 3, g = pg & 7, bj = g >> 2, wc = g & 3;
            int lc0 = T * 256 + wc * 64 + bj * 32;
            if (isin && T >= 22) lc0 = (T < 26) ? 6656 + (T - 22) * 256 + wc * 64 + bj * 32 : (bj ? 7680 : 5632) + (T - 26) * 128 + wc * 32;
            p0_transpose_item(W, K, N, WT, pg * 32, lc0, scr, kb, lane);
        } else if ((r -= I_T) < I_ADA) {
            if (skip_ada) continue;
            const int g = r >> 4, kc = r & 15, n0 = g * 64 + lane, k0 = kc * 64;
            const float* c_in = a->in[2]; const float* cctx = a->in[6]; const float* adaw = a->in[7];
#pragma unroll
            for (int i = 0; i < 9; ++i) { const float cv = (i == 0) ? cctx[k0 + lane] : c_in[(i - 1) * 1024 + k0 + lane]; scr[lane * 12 + i] = fsilu(cv); }
            LDS_WAIT(); asm volatile("" ::: "memory");
            float acc[9];
#pragma unroll
            for (int i = 0; i < 9; ++i) acc[i] = 0.f;
#pragma unroll 8
            for (int kk = 0; kk < 64; ++kk) { const float w = adaw[(size_t)(k0 + kk) * 6144 + n0];
                const pg8::f32x4 s0 = *(const LAS pg8::f32x4*)(scr + kk * 12), s1 = *(const LAS pg8::f32x4*)(scr + kk * 12 + 4); const float s8 = scr[kk * 12 + 8];
                acc[0] += s0[0] * w; acc[1] += s0[1] * w; acc[2] += s0[2] * w; acc[3] += s0[3] * w; acc[4] += s1[0] * w; acc[5] += s1[1] * w; acc[6] += s1[2] * w; acc[7] += s1[3] * w; acc[8] += s8 * w; }
            float* mod = (float*)(ws + WS_MOD);
#pragma unroll
            for (int i = 0; i < 9; ++i) atomicAdd(mod + i * 6144 + n0, acc[i]);
            LDS_WAIT(); asm volatile("" ::: "memory");
        } else if ((r -= I_ADA) >= I_ROPE) {
            r -= I_ROPE; const int idx = r * 64 + lane, d = idx >> 10, cch = idx & 1023; const float* lg = a->in[14];
            ((float*)(ws + WS_LBT))[idx] = fsigmoid(lg[d * 2048 + cch] - lg[d * 2048 + 1024 + cch]);
        } else {
            const int idx = r * 64 + lane, pos = idx >> 4, i = idx & 15;
            const float invf = exp2f(-(float)i * 0.8304820237218406f); const float ang = (float)pos * invf;
            const float n = rintf(ang * 0.15915494309189535f); float rr = fmaf(-n, 6.2831854820251465f, ang); rr = fmaf(-n, -1.7484555e-7f, rr);
            float* rope = (float*)(ws + WS_ROPE); rope[idx * 2] = __cosf(rr); rope[idx * 2 + 1] = __sinf(rr);
        }
    }
}

template <int MODE> __device__ __forceinline__ void norm_row(const float* xrow, const float* gain, const float* mod, const float* adab, int shoff, int scoff, bf16_t* obf, float* of32, int lane) {
    const pg8::f32x4* xr = (const pg8::f32x4*)xrow + lane;
    pg8::f32x4 v[4]; float s = 0.f;
#pragma unroll
    for (int j = 0; j < 4; ++j) { v[j] = xr[64 * j]; s += (v[j][0] * v[j][0] + v[j][1] * v[j][1]) + (v[j][2] * v[j][2] + v[j][3] * v[j][3]); }
    const float rstd = __builtin_amdgcn_rsqf(wave_sum(s) * (1.0f / 1024.0f) + EPS);
#pragma unroll
    for (int j = 0; j < 4; ++j) { const int c = 4 * (lane + 64 * j); const pg8::f32x4 g = *(const pg8::f32x4*)(gain + c); pg8::f32x4 y = v[j] * rstd * g;
        if (MODE == 0) { const pg8::f32x4 sh = *(const pg8::f32x4*)(mod + shoff + c) + *(const pg8::f32x4*)(adab + shoff + c), sc = *(const pg8::f32x4*)(mod + scoff + c) + *(const pg8::f32x4*)(adab + scoff + c);
            y = y * (sc + 1.0f) + sh; u32x2 w; w.x = pk2(y[0], y[1]); w.y = pk2(y[2], y[3]); *(u32x2*)(obf + c) = w; }
        else *(pg8::f32x4*)(of32 + c) = y; }
}

constexpr int R_QD = 0, R_KD = 17408, R_K2T = 34816, R_VT = 53248, R_SC = 71680, R_ST = 80896, R_XCH = 115712, R_DEC = 119808;
__device__ __forceinline__ int crow(int r, int hi) { return (r & 3) + 8 * (r >> 2) + 4 * hi; }
__device__ __forceinline__ void rec_scan(LAS unsigned char* lds, const bf16_t* RQ, bf16_t* G, const bf16_t* RI, int lrow0, int L, int rh, int dir, const float* s0, float* sfin, const bool wr_ = true) {
    int tid_o = threadIdx.x; asm volatile("" : "+v"(tid_o));
    const int tid = tid_o, lane = tid & 63, w = __builtin_amdgcn_readfirstlane(tid >> 6), r32 = lane & 31, hi = lane >> 5;
    const int kb = w >> 1, dvt0 = (w & 1) * 2;
    const int colb = rh * 128;
    f32x16 S[2];
#pragma unroll
    for (int x = 0; x < 2; ++x)
#pragma unroll
        for (int r = 0; r < 16; ++r) S[x][r] = s0 ? s0[(size_t)(kb * 32 + crow(r, hi)) * 128 + (dvt0 + x) * 32 + r32] : 0.f;
#define REC_WRITE_ST() do { _Pragma("unroll") for (int x = 0; x < 2; ++x) _Pragma("unroll") for (int g = 0; g < 4; ++g) { u32x2 wv; wv.x = pk2(S[x][4 * g], S[x][4 * g + 1]); wv.y = pk2(S[x][4 * g + 2], S[x][4 * g + 3]); \
        *(LAS u32x2*)(lds + R_ST + ((dvt0 + x) * 32 + r32) * 272 + (kb * 32 + 8 * g + 4 * hi) * 2) = wv; } } while (0)
    REC_WRITE_ST();
    const int nc = L >> 6;
    unsigned gq[8], qq[8], vv[8];
#define REC_ROW(c, i) (dir ? (lrow0 + L - 1 - ((c) * 64 + (i))) : (lrow0 + (c) * 64 + (i)))
#define REC_LOAD(c) do { _Pragma("unroll") for (int i = 0; i < 8; ++i) { const size_t off = (size_t)REC_ROW(c, 8 * w + i) * DM + colb + 2 * lane; \
        gq[i] = *(const unsigned*)(G + off); qq[i] = *(const unsigned*)(RQ + off); vv[i] = *(const unsigned*)(RI + off); } } while (0)
    REC_LOAD(0);
    for (int c = 0; c < nc; ++c) {
        float g0[8], g1[8], q0[8], q1[8]; unsigned vk[8];
#pragma unroll
        for (int i = 0; i < 8; ++i) { g0[i] = h2f((unsigned short)(gq[i] & 0xffffu)); g1[i] = h2f((unsigned short)(gq[i] >> 16)); q0[i] = bflo(qq[i]); q1[i] = bfhi(qq[i]); vk[i] = vv[i]; }
        if (c + 1 < nc) REC_LOAD(c + 1);
        float b0[8], b1[8];
        b0[0] = g0[0]; b1[0] = g1[0];
#pragma unroll
        for (int i = 1; i < 8; ++i) { b0[i] = b0[i - 1] + g0[i]; b1[i] = b1[i - 1] + g1[i]; }
        *(LAS f32x2*)(lds + R_XCH + (w * 128 + 2 * lane) * 4) = (f32x2){b0[7], b1[7]};
        __syncthreads();
        float p0 = 0.f, p1 = 0.f, t0 = 0.f, t1 = 0.f;
#pragma unroll
        for (int ww = 0; ww < 8; ++ww) { const f32x2 x = *(const LAS f32x2*)(lds + R_XCH + (ww * 128 + 2 * lane) * 4); if (ww < w) { p0 += x[0]; p1 += x[1]; } t0 += x[0]; t1 += x[1]; }
        if (w == 0) *(LAS f32x2*)(lds + R_DEC + 2 * lane * 4) = (f32x2){__expf(t0), __expf(t1)};
        unsigned k2a[4], k2b[4], va[4], vb[4];
#pragma unroll
        for (int i = 0; i < 8; ++i) {
            const float bb0 = p0 + b0[i], bb1 = p1 + b1[i];
            const float kk0 = 1.0f - __expf(g0[i]), kk1 = 1.0f - __expf(g1[i]);
            const float qd0 = q0[i] * __expf(bb0), qd1 = q1[i] * __expf(bb1);
            const float kd0 = kk0 * __expf(-bb0), kd1 = kk1 * __expf(-bb1);
            const float kt0 = kk0 * __expf(t0 - bb0), kt1 = kk1 * __expf(t1 - bb1);
            const int ti = 8 * w + i;
            *(LAS unsigned*)(lds + R_QD + ti * 272 + lane * 4) = pk2(qd0, qd1);
            *(LAS unsigned*)(lds + R_KD + ti * 272 + lane * 4) = pk2(kd0, kd1);
            const unsigned f0 = f2bf(kt0), f1 = f2bf(kt1);
            if (i & 1) { k2a[i >> 1] |= f0 << 16; k2b[i >> 1] |= f1 << 16; va[i >> 1] |= (vk[i] & 0xffffu) << 16; vb[i >> 1] |= vk[i] & 0xffff0000u; }
            else { k2a[i >> 1] = f0; k2b[i >> 1] = f1; va[i >> 1] = vk[i] & 0xffffu; vb[i >> 1] = vk[i] >> 16; }
        }
        *(LAS v4u*)(lds + R_K2T + (2 * lane) * 144 + 16 * w) = (v4u){k2a[0], k2a[1], k2a[2], k2a[3]};
        *(LAS v4u*)(lds + R_K2T + (2 * lane + 1) * 144 + 16 * w) = (v4u){k2b[0], k2b[1], k2b[2], k2b[3]};
        *(LAS v4u*)(lds + R_VT + (2 * lane) * 144 + 16 * w) = (v4u){va[0], va[1], va[2], va[3]};
        *(LAS v4u*)(lds + R_VT + (2 * lane + 1) * 144 + 16 * w) = (v4u){vb[0], vb[1], vb[2], vb[3]};
        __syncthreads();
        if (w < 4) {
            const int ti = w >> 1, si = w & 1;
            f32x16 sc;
#pragma unroll
            for (int r = 0; r < 16; ++r) sc[r] = 0.f;
            if (w != 1) {
#pragma unroll
                for (int ks = 0; ks < 8; ++ks) {
                    const pg8::bf16x8 af = *(const LAS pg8::bf16x8*)(lds + R_QD + (ti * 32 + r32) * 272 + (16 * ks + 8 * hi) * 2);
                    const pg8::bf16x8 bf = *(const LAS pg8::bf16x8*)(lds + R_KD + (si * 32 + r32) * 272 + (16 * ks + 8 * hi) * 2);
                    sc = __builtin_amdgcn_mfma_f32_32x32x16_bf16(af, bf, sc, 0, 0, 0);
                }
            }
#pragma unroll
            for (int r = 0; r < 16; ++r) { const int t = ti * 32 + crow(r, hi), s = si * 32 + r32; const float v = (t >= s) ? sc[r] : 0.f;
                *(LAS unsigned short*)(lds + R_SC + t * 144 + s * 2) = (unsigned short)f2bf(v); }
        }
        __syncthreads();
        {
            const int to = w >> 2, dvo = w & 3;
            f32x16 o;
#pragma unroll
            for (int r = 0; r < 16; ++r) o[r] = 0.f;
#pragma unroll
            for (int ks = 0; ks < 4; ++ks) {
                const pg8::bf16x8 af = *(const LAS pg8::bf16x8*)(lds + R_SC + (to * 32 + r32) * 144 + (16 * ks + 8 * hi) * 2);
                const pg8::bf16x8 bf = *(const LAS pg8::bf16x8*)(lds + R_VT + (dvo * 32 + r32) * 144 + (16 * ks + 8 * hi) * 2);
                o = __builtin_amdgcn_mfma_f32_32x32x16_bf16(af, bf, o, 0, 0, 0);
            }
#pragma unroll
            for (int ks = 0; ks < 8; ++ks) {
                const pg8::bf16x8 af = *(const LAS pg8::bf16x8*)(lds + R_QD + (to * 32 + r32) * 272 + (16 * ks + 8 * hi) * 2);
                const pg8::bf16x8 bf = *(const LAS pg8::bf16x8*)(lds + R_ST + (dvo * 32 + r32) * 272 + (16 * ks + 8 * hi) * 2);
                o = __builtin_amdgcn_mfma_f32_32x32x16_bf16(af, bf, o, 0, 0, 0);
            }
            if (wr_)
#pragma unroll
            for (int r = 0; r < 16; ++r) { const int t = to * 32 + crow(r, hi); G[(size_t)REC_ROW(c, t) * DM + colb + dvo * 32 + r32] = (bf16_t)f2bf(o[r]); }
            float dec[16];
#pragma unroll
            for (int r = 0; r < 16; ++r) dec[r] = *(const LAS float*)(lds + R_DEC + (kb * 32 + crow(r, hi)) * 4);
#pragma unroll
            for (int x = 0; x < 2; ++x)
#pragma unroll
                for (int r = 0; r < 16; ++r) S[x][r] *= dec[r];
#pragma unroll
            for (int ks = 0; ks < 4; ++ks) {
                const pg8::bf16x8 af = *(const LAS pg8::bf16x8*)(lds + R_K2T + (kb * 32 + r32) * 144 + (16 * ks + 8 * hi) * 2);
#pragma unroll
                for (int x = 0; x < 2; ++x) {
                    const pg8::bf16x8 bf = *(const LAS pg8::bf16x8*)(lds + R_VT + ((dvt0 + x) * 32 + r32) * 144 + (16 * ks + 8 * hi) * 2);
                    S[x] = __builtin_amdgcn_mfma_f32_32x32x16_bf16(af, bf, S[x], 0, 0, 0);
                }
            }
        }
        __syncthreads();
        REC_WRITE_ST();
    }
    if (sfin && wr_) {
#pragma unroll
        for (int x = 0; x < 2; ++x)
#pragma unroll
            for (int r = 0; r < 16; ++r) sfin[(size_t)(kb * 32 + crow(r, hi)) * 128 + (dvt0 + x) * 32 + r32] = S[x][r];
    }
#undef REC_WRITE_ST
#undef REC_ROW
#undef REC_LOAD
}

__global__ void __launch_bounds__(NTHR, 2) fwd_mega(Args args) {
    extern __shared__ __attribute__((aligned(16))) unsigned char lds_raw[];
    LAS unsigned char* lds = (LAS unsigned char*)lds_raw;
    const int G = gridDim.x, bx = blockIdx.x, NGW = G * NWAVES;
typedef const __attribute__((address_space(4))) Args* KArgs;
#define PH_IDS() int tid = threadIdx.x; asm volatile("" : "+v"(tid)); const int lane = tid & 63, wave = __builtin_amdgcn_readfirstlane(tid >> 6), gw = bx * NWAVES + wave; (void)lane; (void)gw; \
    KArgs ap = (KArgs)__builtin_amdgcn_kernarg_segment_ptr(); asm volatile("" : "+s"(ap)); unsigned char* const ws = ap->ws; float* const dout = ap->out; (void)ws; (void)dout;
#define AIN(i) (ap->in[i])
#define WSB(off) ((bf16_t*)(ws + (off)))
#define WSF(off) ((float*)(ws + (off)))
    const int lo = args.ph_lo, hi_ph = args.ph_hi;
    volatile LAS unsigned* bst = (volatile LAS unsigned*)(lds + RING_BYTES + 64);
    if (threadIdx.x < 2) bst[threadIdx.x] = 0u;
    __syncthreads();
    XcdBarrier xbar = xcd_barrier_post((unsigned*)(args.ws + WS_BAR), bst);
    cg::grid_group grid = cg::this_grid();
#ifndef PHMASK
#define PHMASK 0xFFFF
#endif
#define PEN(j) (((PHMASK) >> (j)) & 1)
#ifndef DUPMASK
#define DUPMASK 0
#endif
#define DUP(j) (((DUPMASK) >> (j)) & 1)
#define IN(k) (lo <= (k) && (k) < hi_ph)
#define SEAM(k) do { if (IN(k) && IN((k) + 1)) { if (lo < 0) grid.sync();     xcd_barrier(xbar); } } while (0)

    if (PEN(10) && IN(0)) { PH_IDS(); p0_prep(ap, lds, gw, NGW, wave, lane); if (DUP(10)) p0_prep(ap, lds, gw, NGW, wave, lane, true); SEAM(0); }

    for (int hf = 0; hf < 2; ++hf) {
        const int pb = 1 + hf * 10;
        if (PEN(0) && IN(pb + 0)) { PH_IDS(); for (int rep_ = 0; rep_ <= DUP(0); ++rep_) {
            const float* xp = AIN(0); const float* xs = AIN(1); const float* adab = AIN(8); const float* mod = WSF(WS_MOD); bf16_t* H = WSB(WS_H); bf16_t* Kb = WSB(WS_K); bf16_t* Vb = WSB(WS_V);
            for (int r = gw; r < MH; r += NGW) { const int grow = hf * MH + r; const float* src = grow < NPR ? xp + (size_t)grow * DM : xs + (size_t)(grow - NPR) * DM;
                norm_row<0>(src, AIN(9), mod + mod_of_row(grow) * 6144, adab, 0, 1024, H + (size_t)r * DM, nullptr, lane); }
            if (hf == 0) { float* modb = WSF(WS_MODB); for (int i = gw * 64 + lane; i < 9 * 6144; i += NGW * 64) modb[i] = mod[i] + adab[i % 6144];
                float* gam = WSF(WS_GAM); const float* n2 = AIN(10); for (int i = gw * 64 + lane; i < 9 * 1024; i += NGW * 64) { const int b = i >> 10, cc = i & 1023; gam[i] = n2[cc] * (1.0f + mod[b * 6144 + 4096 + cc] + adab[4096 + cc]); }
                float* shw = WSF(WS_SHW); const bf16_t* WUP = WSB(WS_WUP);
                for (int p = gw; p < UPW; p += NGW) {
                    const v4u w0 = *(const v4u*)(WUP + (size_t)p * DM + 16 * lane), w1 = *(const v4u*)(WUP + (size_t)p * DM + 16 * lane + 8);
                    float wv[16];
#pragma unroll
                    for (int q = 0; q < 4; ++q) { wv[2 * q] = bflo(w0[q]); wv[2 * q + 1] = bfhi(w0[q]); wv[8 + 2 * q] = bflo(w1[q]); wv[8 + 2 * q + 1] = bfhi(w1[q]); }
                    const int T = p >> 8, pl = p & 255, lc = T * 256 + ((pl >> 5) & 3) * 64 + (pl >> 7) * 32 + (pl & 31);
#pragma unroll 1
                    for (int b = 0; b < 9; ++b) { float s = 0.f;
#pragma unroll
                        for (int q = 0; q < 4; ++q) { const pg8::f32x4 a = *(const pg8::f32x4*)(mod + b * 6144 + 3072 + 16 * lane + 4 * q) + *(const pg8::f32x4*)(adab + 3072 + 16 * lane + 4 * q);
                            s += a[0] * wv[4 * q] + a[1] * wv[4 * q + 1] + a[2] * wv[4 * q + 2] + a[3] * wv[4 * q + 3]; }
                        s = wave_sum(s); if (lane == 0) shw[b * UPW + lc] = s; }
                }
            }
            const int nb = hf ? 5 : 3, b0 = hf ? 3 : 0;
            for (int r = gw; r < 2 * nb * 512; r += NGW) { const int kv = r / (nb * 512), rr = r % (nb * 512), b = rr >> 9, p = rr & 511;
                const float* src = (kv ? AIN(4) : AIN(3)) + ((size_t)(b0 + b) * 512 + p) * KVP + 4 * lane;
                bf16_t* dst = (kv ? Vb : Kb) + (size_t)((hf ? b * 2560 : NPR + b * 2560) + 2048 + p) * KVP + 4 * lane;
                const pg8::f32x4 v = *(const pg8::f32x4*)src; u32x2 wv; wv.x = pk2(v[0], v[1]); wv.y = pk2(v[2], v[3]); *(u32x2*)dst = wv; }
            }
            SEAM(pb + 0);
        }
        if (PEN(1) && IN(pb + 1)) { PH_IDS(); for (int rep_ = 0; rep_ <= DUP(1); ++rep_) {
            pg8::Gemm g{WSB(WS_H), WSB(WS_WIN), MH, INW, DM}; pg8::StaticOrder S; S.init(MH, INW, G, bx);
            float* nck = dout + (size_t)MTOT * DM; float* ncv = nck + (size_t)NPR * KVP;
            pg8::EpiInProj E{WSB(WS_Q), WSB(WS_K), WSB(WS_V), WSB(WS_RQ), WSB(WS_GF), WSB(WS_GB), WSB(WS_RI), WSB(WS_ZA), WSB(WS_PP), nck, ncv, AIN(12), AIN(13), WSF(WS_LBT), WSF(WS_ROPE), hf};
            pg8::gemm_phase<pg8::EpiInProj, pg8::StaticOrder, true, true>(lds, g, S, E);
            }
            SEAM(pb + 1);
        }
        if (PEN(2) && IN(pb + 2)) { PH_IDS(); for (int rep_ = 0; rep_ <= DUP(2); ++rep_) {
            const int nlong = hf ? 80 : 48, nbig = hf ? 640 : 384, nshort = hf ? 0 : 256, nsmall = hf ? 0 : 256;
#ifndef DUPREC
#define DUPREC 0
#endif
#ifndef DUPATT
#define DUPATT 0
#endif
            const int ndl = DUPREC ? nlong : 0, nda = DUPATT ? nbig : 0;
            const int ntot = ndl + nda + nlong + nbig + nshort + nsmall;
            LAS int* slot = (LAS int*)(lds + RING_BYTES); unsigned* ctl = (unsigned*)(ws + WS_CTL);
            bf16_t* Qb = WSB(WS_Q); bf16_t* Kb = WSB(WS_K); bf16_t* Vb = WSB(WS_V); bf16_t* RQ = WSB(WS_RQ); bf16_t* GF = WSB(WS_GF); bf16_t* GB = WSB(WS_GB); bf16_t* RI = WSB(WS_RI);
            float* nst = dout + (size_t)MTOT * DM + 2 * (size_t)NPR * KVP;
            for (;;) {
                __syncthreads();
                if (tid == 0) *slot = (int)atomicAdd(ctl + 64 * hf, 1u);
                __syncthreads();
                int it = *slot;
                if (it >= ntot) break;
                bool wr = true;
                if (it < ndl) wr = false; else { it -= ndl; if (it < nda) { wr = false; it += nlong; } else it -= nda; }
                if (it < nlong) {
                    const int b = it >> 4, rh = (it >> 1) & 7, dir = it & 1; const int bglob = hf ? 3 + b : b;
                    rec_scan(lds, RQ, dir ? GB : GF, RI, (hf ? 0 : NPR) + b * 2048, 2048, rh, dir, AIN(5) + (size_t)((bglob * 2 + dir) * 8 + rh) * 16384, nullptr, wr);
                } else if ((it -= nlong) < nbig) {
                    const int gq = it & 3, qb = (it >> 2) & 7, kvh = (it >> 5) & 3, b = it >> 7, h = kvh * 4 + gq;
                    const int lrow0 = (hf ? 0 : NPR) + b * 2048 + qb * 256, kvr0 = (hf ? 0 : NPR) + b * 2560;
                    attn_body::attn_unit<8>((const attn_body::bf16*)(Qb + (size_t)lrow0 * DM + h * 64), (const attn_body::bf16*)(Kb + (size_t)kvr0 * KVP + kvh * 64), (const attn_body::bf16*)(Vb + (size_t)kvr0 * KVP + kvh * 64),
                                            (attn_body::bf16*)(Qb + (size_t)lrow0 * DM + h * 64), 40, (char*)lds_raw, wr);
                } else if ((it -= nbig) < nshort) {
                    const int seq = it >> 4, rh = (it >> 1) & 7, dir = it & 1;
                    rec_scan(lds, RQ, dir ? GB : GF, RI, seq * 256, 256, rh, dir, nullptr, nst + (size_t)((seq * 2 + dir) * 8 + rh) * 16384);
                } else {
                    it -= nshort; const int seq = it >> 4, h = it & 15, kvh = h >> 2;
                    attn_body::attn_unit<8>((const attn_body::bf16*)(Qb + (size_t)(seq * 256) * DM + h * 64), (const attn_body::bf16*)(Kb + (size_t)(seq * 256) * KVP + kvh * 64), (const attn_body::bf16*)(Vb + (size_t)(seq * 256) * KVP + kvh * 64),
                                            (attn_body::bf16*)(Qb + (size_t)(seq * 256) * DM + h * 64), 4, (char*)lds_raw);
                }
            }
            }
            SEAM(pb + 2);
        }
        if (PEN(3) && IN(pb + 3)) { PH_IDS(); for (int rep_ = 0; rep_ <= DUP(3); ++rep_) {
            const float* hg = AIN(15); bf16_t* Qb = WSB(WS_Q); bf16_t* ZA = WSB(WS_ZA); bf16_t* GF = WSB(WS_GF); bf16_t* GB = WSB(WS_GB); bf16_t* PP = WSB(WS_PP); bf16_t* H = WSB(WS_H);
            for (int r = gw; r < MH; r += NGW) {
                const size_t off = (size_t)r * DM + 16 * lane;
                v4u o[2], z[2], f[2], bq[2], p[2];
#pragma unroll
                for (int e = 0; e < 2; ++e) { o[e] = *(const v4u*)(Qb + off + 8 * e); z[e] = *(const v4u*)(ZA + off + 8 * e); f[e] = *(const v4u*)(GF + off + 8 * e); bq[e] = *(const v4u*)(GB + off + 8 * e); p[e] = *(const v4u*)(PP + off + 8 * e); }
                float s[16]; float ss = 0.f;
#pragma unroll
                for (int e = 0; e < 2; ++e)
#pragma unroll
                    for (int q = 0; q < 4; ++q) { s[8 * e + 2 * q] = bflo(f[e][q]) + bflo(bq[e][q]); s[8 * e + 2 * q + 1] = bfhi(f[e][q]) + bfhi(bq[e][q]); }
#pragma unroll
                for (int q = 0; q < 16; ++q) ss += s[q] * s[q];
                ss += __shfl_xor(ss, 1); ss += __shfl_xor(ss, 2); ss += __shfl_xor(ss, 4);
                const float rs = __builtin_amdgcn_rsqf(ss * (1.0f / 128.0f) + EPS);
                const int gc = (16 * lane) & 127;
                v4u outw[2];
#pragma unroll
                for (int e = 0; e < 2; ++e)
#pragma unroll
                    for (int q = 0; q < 4; ++q) {
                        const int i0 = 8 * e + 2 * q;
                        const float m0 = bflo(o[e][q]) * bflo(z[e][q]) + bflo(p[e][q]) * (s[i0] * rs * hg[gc + i0]);
                        const float m1 = bfhi(o[e][q]) * bfhi(z[e][q]) + bfhi(p[e][q]) * (s[i0 + 1] * rs * hg[gc + i0 + 1]);
                        outw[e][q] = pk2(m0, m1);
                    }
                *(v4u*)(H + off) = outw[0]; *(v4u*)(H + off + 8) = outw[1];
            }
            }
            SEAM(pb + 3);
        }
        if (PEN(4) && IN(pb + 4)) { PH_IDS(); for (int rep_ = 0; rep_ <= DUP(4); ++rep_) {
            pg8::Gemm g{WSB(WS_H), WSB(WS_WO), MH, DM, DM}; pg8::StaticOrder S; S.init(MH, DM, G, bx);
            pg8::EpiResidW E{AIN(0), AIN(1), dout, WSF(WS_MODB), WSF(WS_GAM), WSB(WS_H2), WSF(WS_ROWSS), 2048, hf};
            pg8::gemm_phase<pg8::EpiResidW, pg8::StaticOrder, true, true>(lds, g, S, E);
            }
            SEAM(pb + 4);
        }
        if (PEN(6) && IN(pb + 6)) { PH_IDS(); for (int rep_ = 0; rep_ <= DUP(6); ++rep_) {
            pg8::Gemm g{WSB(WS_H2), WSB(WS_WUP), MH, UPW, DM}; pg8::StaticOrder S; S.init(MH, UPW, G, bx);
            pg8::EpiUp E{WSB(WS_U), UPW, WSF(WS_ROWSS), WSF(WS_SHW), hf};
            pg8::gemm_phase<pg8::EpiUp, pg8::StaticOrder, true, true>(lds, g, S, E);
            }
            SEAM(pb + 6);
        }
        if (PEN(7) && IN(pb + 7)) { PH_IDS(); for (int rep_ = 0; rep_ <= DUP(7); ++rep_) {
            const float* cw = AIN(18); const float* cb = AIN(19); const bf16_t* U = WSB(WS_U); bf16_t* ACT = WSB(WS_ACT);
            for (int item = gw; item < (MH / 16) * 11; item += NGW) {
                const int run = item / 11, st = item - run * 11, r0 = run * 16, grow0 = hf * MH + r0;
                const int t0 = grow0 < NPR ? (grow0 & 255) : ((grow0 - NPR) & 2047); const int Ls = grow0 < NPR ? 256 : 2048;
                const int c = (st * 64 + lane) * 4;
                const pg8::f32x4 wa0 = *(const pg8::f32x4*)(cw + c), wa1 = *(const pg8::f32x4*)(cw + UPW + c), wa2 = *(const pg8::f32x4*)(cw + 2 * UPW + c), ba = *(const pg8::f32x4*)(cb + c);
                const pg8::f32x4 wb0 = *(const pg8::f32x4*)(cw + DFF + c), wb1 = *(const pg8::f32x4*)(cw + UPW + DFF + c), wb2 = *(const pg8::f32x4*)(cw + 2 * UPW + DFF + c), bb = *(const pg8::f32x4*)(cb + DFF + c);
                const bf16_t* up = U + (size_t)r0 * UPW + c;
                u32x2 pa = {0u, 0u}, pb2 = {0u, 0u};
                if (t0 > 0) { pa = *(const u32x2*)(up - UPW); pb2 = *(const u32x2*)(up - UPW + DFF); }
                u32x2 ca = *(const u32x2*)(up), cb2 = *(const u32x2*)(up + DFF);
#pragma unroll
                for (int i = 0; i < 16; ++i) {
                    u32x2 na = {0u, 0u}, nb = {0u, 0u};
                    if (t0 + i < Ls - 1) { na = *(const u32x2*)(up + (size_t)(i + 1) * UPW); nb = *(const u32x2*)(up + (size_t)(i + 1) * UPW + DFF); }
                    pg8::f32x4 a, b;
                    a[0] = wa0[0] * bflo(pa.x) + wa1[0] * bflo(ca.x) + wa2[0] * bflo(na.x) + ba[0]; a[1] = wa0[1] * bfhi(pa.x) + wa1[1] * bfhi(ca.x) + wa2[1] * bfhi(na.x) + ba[1];
                    a[2] = wa0[2] * bflo(pa.y) + wa1[2] * bflo(ca.y) + wa2[2] * bflo(na.y) + ba[2]; a[3] = wa0[3] * bfhi(pa.y) + wa1[3] * bfhi(ca.y) + wa2[3] * bfhi(na.y) + ba[3];
                    b[0] = wb0[0] * bflo(pb2.x) + wb1[0] * bflo(cb2.x) + wb2[0] * bflo(nb.x) + bb[0]; b[1] = wb0[1] * bfhi(pb2.x) + wb1[1] * bfhi(cb2.x) + wb2[1] * bfhi(nb.x) + bb[1];
                    b[2] = wb0[2] * bflo(pb2.y) + wb1[2] * bflo(cb2.y) + wb2[2] * bflo(nb.y) + bb[2]; b[3] = wb0[3] * bfhi(pb2.y) + wb1[3] * bfhi(cb2.y) + wb2[3] * bfhi(nb.y) + bb[3];
                    u32x2 wv; wv.x = pk2(fsilu(a[0]) * b[0], fsilu(a[1]) * b[1]); wv.y = pk2(fsilu(a[2]) * b[2], fsilu(a[3]) * b[3]);
                    *(u32x2*)(ACT + (size_t)(r0 + i) * DFF + c) = wv;
                    pa = ca; pb2 = cb2; ca = na; cb2 = nb;
                }
            }
            }
            SEAM(pb + 7);
        }
        if (PEN(8) && IN(pb + 8)) { PH_IDS(); for (int rep_ = 0; rep_ <= DUP(8); ++rep_) {
            pg8::Gemm g{WSB(WS_ACT), WSB(WS_WDN), MH, DM, DFF}; pg8::StaticOrder S; S.init(MH, DM, G, bx);
            pg8::EpiResid E{dout, dout + (size_t)NPR * DM, dout, WSF(WS_MODB), 5120, hf};
            pg8::gemm_phase<pg8::EpiResid, pg8::StaticOrder, true, true>(lds, g, S, E);
            }
            SEAM(pb + 8);
        }
        if (PEN(9) && IN(pb + 9)) { PH_IDS(); for (int rep_ = 0; rep_ <= DUP(9); ++rep_) {
            for (int r = gw; r < MH; r += NGW) { const int grow = hf * MH + r; float* row = dout + (size_t)grow * DM;
                norm_row<1>(row, AIN(21), nullptr, nullptr, 0, 0, nullptr, row, lane); }
            }
            SEAM(pb + 9);
        }
    }
#undef IN
#undef SEAM
}

extern "C" void kernel_launch(void* const* d_in, const int* in_sizes, int n_in, void* d_out, int out_size, void* d_ws, size_t ws_size, hipStream_t stream) {
    static int grid = 0;
    if (grid == 0) {
        if (n_in != 22 || ws_size < WS_END) { fprintf(stderr, "kernel_launch: unexpected n_in %d / ws_size %zu\n", n_in, ws_size); grid = -1; return; }
        int dev = 0, cus = 0, per_cu = 0;
        hipGetDevice(&dev); hipDeviceGetAttribute(&cus, hipDeviceAttributeMultiprocessorCount, dev);
        if (hipFuncSetAttribute((const void*)fwd_mega, hipFuncAttributeMaxDynamicSharedMemorySize, LDS_BYTES) != hipSuccess) { fprintf(stderr, "kernel_launch: hipFuncSetAttribute failed\n"); grid = -1; return; }
        if (hipOccupancyMaxActiveBlocksPerMultiprocessor(&per_cu, (const void*)fwd_mega, NTHR, LDS_BYTES) != hipSuccess || per_cu < 1) { fprintf(stderr, "kernel_launch: occupancy query says %d\n", per_cu); per_cu = 1; }
        (void)hipGetLastError();
        grid = cus;
    }
    if (grid < 0) return;
    hipMemsetAsync((char*)d_ws + WS_CTL, 0, CTL_ZERO_BYTES, stream);
    Args a{};
    for (int i = 0; i < 22; ++i) a.in[i] = (const float*)d_in[i];
    a.out = (float*)d_out; a.ws = (unsigned char*)d_ws;
#if MK_SINGLE
    a.ph_lo = 0; a.ph_hi = N_PHASES;
    void* kargs[] = {&a};
    hipError_t e = hipLaunchCooperativeKernel((const void*)fwd_mega, dim3(grid), dim3(NTHR), kargs, LDS_BYTES, stream);
    if (e != hipSuccess) fprintf(stderr, "kernel_launch: cooperative launch failed: %s (grid %d)\n", hipGetErrorString(e), grid);
#else
    for (int p = 0; p < N_PHASES; ++p) { a.ph_lo = p; a.ph_hi = p + 1; hipLaunchKernelGGL(fwd_mega, dim3(grid), dim3(NTHR), LDS_BYTES, stream, a); }
#endif
}
```

```cpp
#include <hip/hip_runtime.h>
#include <hip/hip_cooperative_groups.h>
#include <hip/hip_bf16.h>
#include <cstdio>
#include <cstdint>
#include <cmath>
namespace cg = cooperative_groups;

constexpr int DM = 1024, NPR = 4096  , MTOT = 20480, MH = 10240  ;
constexpr int INW = 8704, DFF = 2816, UPW = 5632;
constexpr int KVP = 256;
constexpr float EPS = 1e-6f;
constexpr float QSCALE = 0.125f * 1.4426950408889634f;

#define GAS __attribute__((address_space(1)))
#define LAS __attribute__((address_space(3)))
typedef unsigned short bf16_t;
typedef float f32x2 __attribute__((ext_vector_type(2)));
typedef unsigned u32x2 __attribute__((ext_vector_type(2)));
typedef float f32x16 __attribute__((ext_vector_type(16)));

__device__ __forceinline__ float bf2f(unsigned short h) { return __uint_as_float(((unsigned)h) << 16); }
__device__ __forceinline__ float bflo(unsigned w) { return __uint_as_float(w << 16); }
__device__ __forceinline__ float bfhi(unsigned w) { return __uint_as_float(w & 0xffff0000u); }
__device__ __forceinline__ float fsigmoid(float x) { return __builtin_amdgcn_rcpf(1.0f + __expf(-x)); }
__device__ __forceinline__ float fsilu(float x) { return x * fsigmoid(x); }
__device__ __forceinline__ unsigned pkh2(float a, float b) { _Float16 ha = (_Float16)a, hb = (_Float16)b; return (unsigned)__builtin_bit_cast(unsigned short, ha) | ((unsigned)__builtin_bit_cast(unsigned short, hb) << 16); }
__device__ __forceinline__ float h2f(unsigned short h) { return (float)__builtin_bit_cast(_Float16, h); }
__device__ __forceinline__ float wave_sum(float v) {
#pragma unroll
    for (int o = 1; o < 64; o <<= 1) v += __shfl_xor(v, o);
    return v;
}
__device__ __forceinline__ int mod_of_row(int grow) { return grow < NPR ? 0 : 1 + ((grow - NPR) >> 11); }
__device__ __forceinline__ int kv_row(int grow, int hf) {
    if (grow < NPR) return grow;
    const int s = grow - NPR, b = s >> 11, t = s & 2047;
    return (hf ? (b - 3) * 2560 : NPR + b * 2560) + t;
}

namespace pg8 {
#define PG8_LAS __attribute__((address_space(3)))
typedef unsigned short bf16_t;
typedef short bf16x8 __attribute__((ext_vector_type(8)));
typedef float f32x4 __attribute__((ext_vector_type(4)));
typedef unsigned u32x4 __attribute__((ext_vector_type(4)));
constexpr int BM = 256, BK = 64, HALF = 128, HTB = HALF * BK * 2  , STAGE_BYTES = 8 * HTB, NXCD = 8, WGM = 8;

__host__ __device__ __forceinline__ int lds_byte(int r, int c) { const int st = (r >> 4) * 2 + (c >> 5), rr = r & 15, cc = c & 31, ob = rr * 64 + cc * 2; return st * 1024 + (ob ^ (((ob >> 9) & 1) << 5)); }
__host__ __device__ __forceinline__ void stage_rc(int b, int& R, int& C) { const int st = b / 1024, sb = b % 1024, swz = sb ^ (((sb >> 9) & 1) << 5); R = (st >> 1) * 16 + swz / 64; C = (st & 1) * 32 + (swz % 64) / 2; }
__host__ __device__ __forceinline__ int perm32(int rho) { const int n = rho >> 4, i = rho & 15; return 8 * (i >> 2) + 4 * n + (i & 3); }

struct Unit { int pm, pn; };
struct Gemm { const bf16_t* A; const bf16_t* Bt; int M, N, K; };

struct StaticOrder {
    int nM, nN, nwg, G, c;
    __host__ __device__ void init(int M, int N, int G_, int c_) { nM = M / BM; nN = N / BM; nwg = nM * nN; G = G_; c = c_; }
    __host__ __device__ bool next(int i, Unit& u) const {
        const long L = (long)i * G + c; if (L >= nwg) return false;
        int wgid = (int)L; { const int q = nwg / NXCD, r = nwg % NXCD, xcd = wgid % NXCD, off = wgid / NXCD; wgid = (xcd < r ? xcd * (q + 1) : r * (q + 1) + (xcd - r) * q) + off; }
        const int nig = WGM * nN, gid = wgid / nig, fm = gid * WGM, gsz = (nM - fm) < WGM ? (nM - fm) : WGM;
        u.pm = fm + ((wgid % nig) % gsz); u.pn = (wgid % nig) / gsz; return true;
    }
    __device__ __forceinline__ void a_ready(const Unit&) const {}
    __device__ __forceinline__ void done(const Unit&) const {}
};

__device__ __forceinline__ unsigned cvt_pk_bf16(float lo, float hi) { unsigned r; asm volatile("v_cvt_pk_bf16_f32 %0, %1, %2" : "=v"(r) : "v"(lo), "v"(hi)); return r; }
__device__ __forceinline__ u32x2 pk4(f32x4 v) { u32x2 w; w.x = cvt_pk_bf16(v[0], v[1]); w.y = cvt_pk_bf16(v[2], v[3]); return w; }

#define EPI_FENCE() asm volatile("" ::: "memory")
struct EpiInProj {
    static constexpr bool PERM = false, AFTER_DRAIN = false;
    bf16_t *Q, *Kb, *Vb, *RQ, *GF, *GB, *RI, *ZA, *PP; float *nck, *ncv; const float *qg, *kg, *lbt; const float* rope; int hf;
    __device__ __forceinline__ void operator()(const f32x4 (&acc)[2][2][4][2], const Unit& u, int wr, int wc, int fr, int fq) const {
        const int T = u.pn;
        const int lrow0 = u.pm * BM + wr * 64 + fr;
        if (T <= 4) {
            const bool isq = T < 4; const float* gain = (isq ? qg : kg) + 4 * fq;
#pragma unroll
            for (int ai = 0; ai < 2; ++ai)
#pragma unroll
                for (int m = 0; m < 4; ++m) {
                    const int lrow = lrow0 + ai * HALF + m * 16, grow = hf * MH + lrow;
                    float ss = 0.f;
#pragma unroll
                    for (int bj = 0; bj < 2; ++bj)
#pragma unroll
                        for (int n = 0; n < 2; ++n) { const f32x4 v = acc[ai][bj][m][n]; ss += (v[0] * v[0] + v[1] * v[1]) + (v[2] * v[2] + v[3] * v[3]); }
                    ss += __shfl_xor(ss, 16); ss += __shfl_xor(ss, 32);
                    const float rs = __builtin_amdgcn_rsqf(ss * (1.0f / 64.0f) + EPS);
                    const bool latent = grow >= NPR;
                    const int t = (grow - NPR) & 2047;
#pragma unroll
                    for (int bj = 0; bj < 2; ++bj) {
                        f32x4 x1 = acc[ai][bj][m][0] * rs * *(const f32x4*)(gain + 32 * bj), x2 = acc[ai][bj][m][1] * rs * *(const f32x4*)(gain + 32 * bj + 16);
                        if (latent) {
                            const int pos = bj ? (t & 63) : (t >> 6);
                            const f32x4 cs0 = *(const f32x4*)(rope + (pos * 16 + 4 * fq) * 2), cs1 = *(const f32x4*)(rope + (pos * 16 + 4 * fq) * 2 + 4);
                            const f32x4 c = {cs0[0], cs0[2], cs1[0], cs1[2]}, s = {cs0[1], cs0[3], cs1[1], cs1[3]};
                            const f32x4 y1 = x1 * c - x2 * s, y2 = x1 * s + x2 * c; x1 = y1; x2 = y2;
                        }
                        if (isq) {
                            bf16_t* qp = Q + (unsigned)(lrow * DM + (4 * T + wc) * 64 + 4 * fq + 32 * bj);
                            *(u32x2*)(qp) = pk4(x1 * QSCALE); *(u32x2*)(qp + 16) = pk4(x2 * QSCALE);
                        } else {
                            bf16_t* kp = Kb + (unsigned)(kv_row(grow, hf) * KVP + wc * 64 + 4 * fq + 32 * bj);
                            *(u32x2*)(kp) = pk4(x1); *(u32x2*)(kp + 16) = pk4(x2);
                            if (!latent) { float* op = nck + (unsigned)(grow * KVP + wc * 64 + 4 * fq + 32 * bj); *(f32x4*)(op) = x1; *(f32x4*)(op + 16) = x2; }
                        }
                    }
                    EPI_FENCE();
                }
        } else if (T == 5) {
#pragma unroll
            for (int ai = 0; ai < 2; ++ai)
#pragma unroll
                for (int m = 0; m < 4; ++m) {
                    const int lrow = lrow0 + ai * HALF + m * 16, grow = hf * MH + lrow;
                    bf16_t* vp = Vb + (unsigned)(kv_row(grow, hf) * KVP + wc * 64 + 4 * fq);
#pragma unroll
                    for (int bj = 0; bj < 2; ++bj)
#pragma unroll
                        for (int n = 0; n < 2; ++n) *(u32x2*)(vp + 32 * bj + 16 * n) = pk4(acc[ai][bj][m][n]);
                    if (grow < NPR) { float* op = ncv + (unsigned)(grow * KVP + wc * 64 + 4 * fq);
#pragma unroll
                        for (int bj = 0; bj < 2; ++bj)
#pragma unroll
                            for (int n = 0; n < 2; ++n) *(f32x4*)(op + 32 * bj + 16 * n) = acc[ai][bj][m][n]; }
                    EPI_FENCE();
                }
        } else if (T < 10) {
            bf16_t* base = RQ + (T - 6) * 256 + wc * 64;
#pragma unroll
            for (int ai = 0; ai < 2; ++ai)
#pragma unroll
                for (int m = 0; m < 4; ++m) { bf16_t* rp = base + (unsigned)((lrow0 + ai * HALF + m * 16) * DM + 4 * fq);
#pragma unroll
                    for (int bj = 0; bj < 2; ++bj)
#pragma unroll
                        for (int n = 0; n < 2; ++n) { const f32x4 v = acc[ai][bj][m][n]; f32x4 o;
#pragma unroll
                            for (int j = 0; j < 4; ++j) o[j] = fsilu(v[j]) * 0.08838834764831845f;
                            *(u32x2*)(rp + 32 * bj + 16 * n) = pk4(o); }
                    EPI_FENCE(); }
        } else if (T < 18) {
            const int d = T >= 14; const int colb = ((T - 10) & 3) * 256 + wc * 64;
            bf16_t* base = (d ? GB : GF) + colb; const float* lbp = lbt + d * 1024 + colb + 4 * fq;
#pragma unroll
            for (int ai = 0; ai < 2; ++ai)
#pragma unroll
                for (int m = 0; m < 4; ++m) { bf16_t* rp = base + (unsigned)((lrow0 + ai * HALF + m * 16) * DM + 4 * fq);
#pragma unroll
                    for (int bj = 0; bj < 2; ++bj)
#pragma unroll
                        for (int n = 0; n < 2; ++n) { const f32x4 v = acc[ai][bj][m][n]; const f32x4 lb = *(const f32x4*)(lbp + 32 * bj + 16 * n); float g[4];
#pragma unroll
                            for (int j = 0; j < 4; ++j) { const float l = lb[j]; g[j] = __logf(l + (1.0f - l) * fsigmoid(v[j])); }
                            u32x2 w; w.x = pkh2(g[0], g[1]); w.y = pkh2(g[2], g[3]); *(u32x2*)(rp + 32 * bj + 16 * n) = w; }
                    EPI_FENCE(); }
        } else if (T < 26) {
            const bool sig = T >= 22; bf16_t* base = (sig ? ZA : RI) + ((T - 18) & 3) * 256 + wc * 64;
#pragma unroll
            for (int ai = 0; ai < 2; ++ai)
#pragma unroll
                for (int m = 0; m < 4; ++m) { bf16_t* rp = base + (unsigned)((lrow0 + ai * HALF + m * 16) * DM + 4 * fq);
#pragma unroll
                    for (int bj = 0; bj < 2; ++bj)
#pragma unroll
                        for (int n = 0; n < 2; ++n) { f32x4 v = acc[ai][bj][m][n];
                            if (sig) {
#pragma unroll
                                for (int j = 0; j < 4; ++j) v[j] = fsigmoid(v[j]); }
                            *(u32x2*)(rp + 32 * bj + 16 * n) = pk4(v); }
                    EPI_FENCE(); }
        } else {
            bf16_t* base = PP + (T - 26) * 128 + wc * 32;
#pragma unroll
            for (int ai = 0; ai < 2; ++ai)
#pragma unroll
                for (int m = 0; m < 4; ++m) { bf16_t* rp = base + (unsigned)((lrow0 + ai * HALF + m * 16) * DM + 4 * fq);
#pragma unroll
                    for (int n = 0; n < 2; ++n) { const f32x4 a = acc[ai][0][m][n], b = acc[ai][1][m][n]; f32x4 o;
#pragma unroll
                        for (int j = 0; j < 4; ++j) o[j] = fsilu(a[j]) * fsigmoid(b[j]);
                        *(u32x2*)(rp + 16 * n) = pk4(o); }
                    EPI_FENCE(); }
        }
    }
};

struct EpiResid {
    static constexpr bool PERM = false, AFTER_DRAIN = false;
    const float* basep; const float* bases; float* out; const float* modb; int goff; int hf;
    __device__ __forceinline__ void operator()(const f32x4 (&acc)[2][2][4][2], const Unit& u, int wr, int wc, int fr, int fq) const {
        const int grow0 = hf * MH + u.pm * BM; const int mi = mod_of_row(grow0);
        const int col0 = u.pn * BM + wc * 64 + 4 * fq;
        const float* base = grow0 < NPR ? basep + (size_t)grow0 * DM : bases + (size_t)(grow0 - NPR) * DM;
        float* ob = out + (size_t)grow0 * DM;
        const float* gp = modb + mi * 6144 + goff + col0;
#pragma unroll
        for (int ai = 0; ai < 2; ++ai)
#pragma unroll
            for (int m = 0; m < 4; ++m) { const unsigned off = (unsigned)((ai * HALF + wr * 64 + m * 16 + fr) * DM + col0);
#pragma unroll
                for (int bj = 0; bj < 2; ++bj)
#pragma unroll
                    for (int n = 0; n < 2; ++n) { const f32x4 b = *(const f32x4*)(base + off + 32 * bj + 16 * n); const f32x4 gt = *(const f32x4*)(gp + 32 * bj + 16 * n);
                        *(f32x4*)(ob + off + 32 * bj + 16 * n) = b + gt * acc[ai][bj][m][n]; }
                EPI_FENCE(); }
    }
};

struct EpiResidW {
    static constexpr bool PERM = false, AFTER_DRAIN = false;
    const float* basep; const float* bases; float* out; const float* modb; const float* gam; bf16_t* Hn; float* rowss; int goff; int hf;
    __device__ __forceinline__ void operator()(const f32x4 (&acc)[2][2][4][2], const Unit& u, int wr, int wc, int fr, int fq) const {
        const int grow0 = hf * MH + u.pm * BM; const int mi = mod_of_row(grow0);
        const int col0 = u.pn * BM + wc * 64 + 4 * fq;
        const float* base = grow0 < NPR ? basep + (size_t)grow0 * DM : bases + (size_t)(grow0 - NPR) * DM;
        float* ob = out + (size_t)grow0 * DM; bf16_t* hb = Hn + (size_t)(u.pm * BM) * DM; float* rs = rowss + grow0;
        const float* gp = modb + mi * 6144 + goff + col0; const float* gm = gam + mi * 1024 + col0;
#pragma unroll
        for (int ai = 0; ai < 2; ++ai)
#pragma unroll
            for (int m = 0; m < 4; ++m) { const int r = ai * HALF + wr * 64 + m * 16 + fr; const unsigned off = (unsigned)(r * DM + col0); float ss = 0.f;
#pragma unroll
                for (int bj = 0; bj < 2; ++bj)
#pragma unroll
                    for (int n = 0; n < 2; ++n) { const f32x4 b = *(const f32x4*)(base + off + 32 * bj + 16 * n); const f32x4 gt = *(const f32x4*)(gp + 32 * bj + 16 * n); const f32x4 gg = *(const f32x4*)(gm + 32 * bj + 16 * n);
                        const f32x4 x1 = b + gt * acc[ai][bj][m][n];
                        *(f32x4*)(ob + off + 32 * bj + 16 * n) = x1; *(u32x2*)(hb + off + 32 * bj + 16 * n) = pk4(x1 * gg);
                        ss += (x1[0] * x1[0] + x1[1] * x1[1]) + (x1[2] * x1[2] + x1[3] * x1[3]); }
                ss += __shfl_xor(ss, 16); ss += __shfl_xor(ss, 32);
                if (fq == 0) atomicAdd(rs + r, ss);
                EPI_FENCE(); }
    }
};

struct EpiUp {
    static constexpr bool PERM = false, AFTER_DRAIN = false;
    bf16_t* O; int ldc; const float* rowss; const float* shw; int hf;
    __device__ __forceinline__ void operator()(const f32x4 (&acc)[2][2][4][2], const Unit& u, int wr, int wc, int fr, int fq) const {
        const int grow0 = hf * MH + u.pm * BM; const int mi = mod_of_row(grow0);
        bf16_t* base = O + (size_t)(u.pm * BM) * ldc + u.pn * BM + wc * 64; const float* sp = shw + mi * UPW + u.pn * BM + wc * 64 + 4 * fq; const float* rs = rowss + grow0;
#pragma unroll
        for (int ai = 0; ai < 2; ++ai)
#pragma unroll
            for (int m = 0; m < 4; ++m) { const int r = ai * HALF + wr * 64 + m * 16 + fr; bf16_t* rp = base + (unsigned)(r * ldc + 4 * fq);
                const float rstd = __builtin_amdgcn_rsqf(rs[r] * (1.0f / 1024.0f) + EPS);
#pragma unroll
                for (int bj = 0; bj < 2; ++bj)
#pragma unroll
                    for (int n = 0; n < 2; ++n) *(u32x2*)(rp + 32 * bj + 16 * n) = pk4(acc[ai][bj][m][n] * rstd + *(const f32x4*)(sp + 32 * bj + 16 * n));
                EPI_FENCE(); }
    }
};

struct EpiPlain {
    static constexpr bool PERM = false, AFTER_DRAIN = false;
    bf16_t* O; int ldc;
    __device__ __forceinline__ void operator()(const f32x4 (&acc)[2][2][4][2], const Unit& u, int wr, int wc, int fr, int fq) const {
        bf16_t* base = O + u.pn * BM + wc * 64 + 4 * fq;
#pragma unroll
        for (int ai = 0; ai < 2; ++ai)
#pragma unroll
            for (int m = 0; m < 4; ++m) { bf16_t* rp = base + (size_t)(u.pm * BM + ai * HALF + wr * 64 + m * 16 + fr) * ldc;
#pragma unroll
                for (int bj = 0; bj < 2; ++bj)
#pragma unroll
                    for (int n = 0; n < 2; ++n) *(u32x2*)(rp + 32 * bj + 16 * n) = pk4(acc[ai][bj][m][n]); }
    }
};

template <class Epi, class Sched, bool ALIGN_EPI = false, bool SP2 = false>
__device__ __forceinline__ void gemm_phase(PG8_LAS unsigned char* lds, const Gemm g, const Sched& S, const Epi& E) {
    int tid_o = threadIdx.x; asm volatile("" : "+v"(tid_o));
    const int tid = tid_o, wid = __builtin_amdgcn_readfirstlane(tid >> 6), lane = tid & 63, wr = wid >> 2, wc = wid & 3, fr = lane & 15, fq = lane >> 4;
    const int K = g.K, nt = K / BK;
    unsigned voffA[2], voffB[2];
#pragma unroll
    for (int i = 0; i < 2; ++i) { int R, C; stage_rc(tid * 16 + i * 8192, R, C); const int Rb = Epi::PERM ? ((R & ~31) + perm32(R & 31)) : R;
        voffA[i] = (unsigned)(R * K + C) * 2u; voffB[i] = (unsigned)(Rb * K + C) * 2u; }
    const size_t kstep = (size_t)(BK * 2);
    const size_t hstep = (size_t)HALF * K * 2;
    const size_t tstep = 2 * hstep;
    const unsigned ldsw = (unsigned)wid * 1024u;
    const int aoff = lds_byte(wr * 64 + fr, fq * 8), boff = lds_byte(wc * 32 + fr, fq * 8);
#define PG8_SA(b, h) (((b) * 2 + (h)) * HTB)
#define PG8_SB(b, h) ((4 + (b) * 2 + (h)) * HTB)
#define PG8_STAGE(bufoff, gbase, voff) do { _Pragma("unroll") for (int _i = 0; _i < 2; ++_i) \
        __builtin_amdgcn_global_load_lds((const unsigned*)((const char*)(gbase) + (voff)[_i]), (PG8_LAS unsigned*)(lds + (bufoff) + ldsw + _i * 8192), 16, 0, 0); } while (0)
#define PG8_LDA(dst, b, h) do { _Pragma("unroll") for (int m = 0; m < 4; ++m) _Pragma("unroll") for (int k = 0; k < 2; ++k) dst[m][k] = *(const PG8_LAS bf16x8*)(lds + PG8_SA(b, h) + aoff + m * 2048 + k * 1024); } while (0)
#define PG8_LDB(dst, b, h) do { _Pragma("unroll") for (int n = 0; n < 2; ++n) _Pragma("unroll") for (int k = 0; k < 2; ++k) dst[n][k] = *(const PG8_LAS bf16x8*)(lds + PG8_SB(b, h) + boff + n * 2048 + k * 1024); } while (0)
#define PG8_MMA(ai, bj, At, Bt) do { __builtin_amdgcn_s_setprio(1); _Pragma("unroll") for (int m = 0; m < 4; ++m) _Pragma("unroll") for (int n = 0; n < 2; ++n) _Pragma("unroll") for (int k = 0; k < 2; ++k) \
        acc[ai][bj][m][n] = __builtin_amdgcn_mfma_f32_16x16x32_bf16(Bt[n][k], At[m][k], acc[ai][bj][m][n], 0, 0, 0); __builtin_amdgcn_s_setprio(0); } while (0)
#define PG8_WAIT_V(n) asm volatile("s_waitcnt vmcnt(" #n ")" ::: "memory")
#define PG8_WAIT_L(n) asm volatile("s_waitcnt lgkmcnt(" #n ")" ::: "memory")
#define PG8_BAR __builtin_amdgcn_s_barrier()
#define PG8_SCHED __builtin_amdgcn_sched_barrier(0)
    Unit cur, nxt; int ui = 0;
    if (!S.next(0, cur)) return;
    f32x4 acc[2][2][4][2];
#pragma unroll
    for (int a = 0; a < 2; ++a)
#pragma unroll
        for (int b = 0; b < 2; ++b)
#pragma unroll
            for (int m = 0; m < 4; ++m)
#pragma unroll
                for (int n = 0; n < 2; ++n) acc[a][b][m][n] = (f32x4){0.f, 0.f, 0.f, 0.f};
    bf16x8 At[4][2], B0[2][2], B1[2][2];
    const char* cA = (const char*)g.A + (size_t)cur.pm * tstep; const char* cB = (const char*)g.Bt + (size_t)cur.pn * tstep;
    S.a_ready(cur);
    if constexpr (SP2) {
        PG8_STAGE(PG8_SB(0, 0), cB, voffB); PG8_STAGE(PG8_SB(0, 1), cB + hstep, voffB); PG8_STAGE(PG8_SA(0, 0), cA, voffA); PG8_STAGE(PG8_SA(0, 1), cA + hstep, voffA);
        if (wr == 1) PG8_BAR;
        PG8_WAIT_V(2); PG8_BAR;
        PG8_STAGE(PG8_SB(1, 0), cB + kstep, voffB); PG8_STAGE(PG8_SA(1, 0), cA + kstep, voffA); PG8_STAGE(PG8_SB(1, 1), cB + hstep + kstep, voffB);
        PG8_WAIT_V(6); PG8_BAR;
    } else {
        PG8_STAGE(PG8_SB(0, 0), cB, voffB); PG8_STAGE(PG8_SA(0, 0), cA, voffA); PG8_STAGE(PG8_SB(0, 1), cB + hstep, voffB); PG8_STAGE(PG8_SA(0, 1), cA + hstep, voffA);
        if (wr == 1) PG8_BAR;
        PG8_WAIT_V(4); PG8_BAR;
        PG8_STAGE(PG8_SB(1, 0), cB + kstep, voffB); PG8_STAGE(PG8_SA(1, 0), cA + kstep, voffA); PG8_STAGE(PG8_SB(1, 1), cB + hstep + kstep, voffB);
        PG8_WAIT_V(6); PG8_BAR;
    }
    for (;;) {
        const bool has_next = S.next(ui + 1, nxt);
        const char* nA = has_next ? (const char*)g.A + (size_t)nxt.pm * tstep : cA; const char* nB = has_next ? (const char*)g.Bt + (size_t)nxt.pn * tstep : cB;
        for (int t = 0; t < nt; t += 2) {
            const bool last = (t == nt - 2);
            const char* a1 = cA + (size_t)(t + 1) * kstep;
            const char* a2 = last ? nA : cA + (size_t)(t + 2) * kstep; const char* b2 = last ? nB : cB + (size_t)(t + 2) * kstep;
            const char* a3 = a2 + kstep; const char* b3 = b2 + kstep;
            if (last && has_next) S.a_ready(nxt);
            if constexpr (SP2) {
            PG8_LDB(B0, 0, 0); PG8_LDB(B1, 0, 1); PG8_SCHED; PG8_LDA(At, 0, 0); PG8_STAGE(PG8_SA(1, 1), a1 + hstep, voffA);
            PG8_WAIT_V(8); PG8_WAIT_L(0); PG8_BAR; PG8_MMA(0, 0, At, B0); PG8_MMA(0, 1, At, B1); PG8_BAR; PG8_SCHED;
            PG8_LDA(At, 0, 1); PG8_STAGE(PG8_SB(0, 0), b2, voffB); PG8_STAGE(PG8_SB(0, 1), b2 + hstep, voffB); PG8_STAGE(PG8_SA(0, 0), a2, voffA);
            PG8_WAIT_V(8); PG8_WAIT_L(0); PG8_BAR; PG8_MMA(1, 0, At, B0); PG8_MMA(1, 1, At, B1); PG8_BAR; PG8_SCHED;
            PG8_LDB(B0, 1, 0); PG8_LDB(B1, 1, 1); PG8_SCHED; PG8_LDA(At, 1, 0); PG8_STAGE(PG8_SA(0, 1), a2 + hstep, voffA);
            PG8_WAIT_V(8); PG8_WAIT_L(0); PG8_BAR; PG8_MMA(0, 0, At, B0); PG8_MMA(0, 1, At, B1); PG8_BAR; PG8_SCHED;
            PG8_LDA(At, 1, 1); PG8_STAGE(PG8_SB(1, 0), b3, voffB); PG8_STAGE(PG8_SB(1, 1), b3 + hstep, voffB); PG8_STAGE(PG8_SA(1, 0), a3, voffA);
            PG8_WAIT_V(8); PG8_WAIT_L(0); PG8_BAR; PG8_MMA(1, 0, At, B0); PG8_MMA(1, 1, At, B1); PG8_BAR; PG8_SCHED;
            } else {
            PG8_LDB(B0, 0, 0); PG8_SCHED; PG8_LDA(At, 0, 0); PG8_STAGE(PG8_SA(1, 1), a1 + hstep, voffA);
            PG8_WAIT_L(8); PG8_BAR; PG8_WAIT_L(0); PG8_MMA(0, 0, At, B0); PG8_BAR; PG8_SCHED;
            PG8_LDB(B1, 0, 1); PG8_STAGE(PG8_SB(0, 0), b2, voffB);
            PG8_BAR; PG8_WAIT_L(0); PG8_MMA(0, 1, At, B1); PG8_BAR;
            PG8_LDA(At, 0, 1); PG8_STAGE(PG8_SA(0, 0), a2, voffA);
            PG8_BAR; PG8_WAIT_L(0); PG8_MMA(1, 0, At, B0); PG8_BAR; PG8_SCHED;
            PG8_STAGE(PG8_SB(0, 1), b2 + hstep, voffB);
            PG8_WAIT_V(6); PG8_BAR; PG8_MMA(1, 1, At, B1); PG8_BAR;
            PG8_LDB(B0, 1, 0); PG8_SCHED; PG8_LDA(At, 1, 0); PG8_STAGE(PG8_SA(0, 1), a2 + hstep, voffA);
            PG8_WAIT_L(8); PG8_BAR; PG8_WAIT_L(0); PG8_MMA(0, 0, At, B0); PG8_BAR; PG8_SCHED;
            PG8_LDB(B1, 1, 1); PG8_STAGE(PG8_SB(1, 0), b3, voffB);
            PG8_BAR; PG8_WAIT_L(0); PG8_MMA(0, 1, At, B1); PG8_BAR;
            PG8_LDA(At, 1, 1); PG8_STAGE(PG8_SA(1, 0), a3, voffA);
            PG8_BAR; PG8_WAIT_L(0); PG8_MMA(1, 0, At, B0); PG8_BAR; PG8_SCHED;
            PG8_STAGE(PG8_SB(1, 1), b3 + hstep, voffB);
            PG8_WAIT_V(6); PG8_BAR; PG8_MMA(1, 1, At, B1); PG8_BAR;
            }
        }
        if constexpr (ALIGN_EPI) { if (wr == 0) PG8_BAR; }
        if constexpr (!Epi::AFTER_DRAIN) { E(acc, cur, wr, wc, fr, fq); S.done(cur); }
        if (!has_next) break;
#pragma unroll
        for (int a = 0; a < 2; ++a)
#pragma unroll
            for (int b = 0; b < 2; ++b)
#pragma unroll
                for (int m = 0; m < 4; ++m)
#pragma unroll
                    for (int n = 0; n < 2; ++n) acc[a][b][m][n] = (f32x4){0.f, 0.f, 0.f, 0.f};
        cur = nxt; cA = nA; cB = nB; ++ui;
        if constexpr (ALIGN_EPI) { if (wr == 1) PG8_BAR; }
    }
    PG8_WAIT_V(0);
    if constexpr (!ALIGN_EPI) { if (wr == 0) PG8_BAR; }
    PG8_BAR;
    if constexpr (Epi::AFTER_DRAIN) { E.fused(acc, cur, wr, wc, fr, fq, lds, wid, lane); S.done(cur); }
#undef PG8_SA
#undef PG8_SB
#undef PG8_STAGE
#undef PG8_LDA
#undef PG8_LDB
#undef PG8_MMA
#undef PG8_WAIT_V
#undef PG8_WAIT_L
#undef PG8_BAR
#undef PG8_SCHED
}
}

namespace attn_body {
using bf16=__hip_bfloat16;
using bf16x8=__attribute__((ext_vector_type(8)))short;
using s16x4=__attribute__((ext_vector_type(4)))short;
using f32x16=__attribute__((ext_vector_type(16)))float;
using u32x4=__attribute__((ext_vector_type(4)))unsigned;
constexpr int NHEAD=16,D=64,DM=NHEAD*D,KVPITCH=256;
constexpr int NW=8,QBLK=32,QB=QBLK*NW,KVBLK=64;
constexpr int ATTN_PITCH=DM, ATTN_UNIT_ROWS=QB;
__device__ __forceinline__ int crow(int r,int hi){return (r&3)+8*(r>>2)+4*hi;}
#define SBAR() __builtin_amdgcn_sched_barrier(0)
__device__ __forceinline__ void cmask(f32x16&p0,f32x16&p1,int jb,int qrel,int hi){
  const float NEG=-INFINITY; int kb=64*jb+4*hi;
  #pragma unroll
  for(int r=0;r<16;++r){int kv=kb+(r&3)+8*(r>>2); if(kv>qrel)p0[r]=NEG; if(kv+32>qrel)p1[r]=NEG;}
}

constexpr int NSLOT=3, SLOTB=8192;
constexpr int LDS_K=0, LDS_V=NSLOT*SLOTB, LDS_WS=2*NSLOT*SLOTB, LDS_OST=LDS_WS+NW*64*4, LDS_BYTES=LDS_OST+NW*4096;
constexpr float C2=0.125f*1.4426950408889634f;
__device__ __forceinline__ void glds16(const void*gsrc,unsigned lds_dst){unsigned keep;
  asm volatile("s_mov_b32 %0, m0\n\ts_mov_b32 m0, %2\n\ts_nop 0\n\tglobal_load_lds_dwordx4 %1, off\n\ts_mov_b32 m0, %0":"=&s"(keep):"v"(gsrc),"s"(lds_dst):"memory");}
__device__ __forceinline__ float max3f(float a,float b,float c){float r;asm("v_max3_f32 %0, %1, %2, %3":"=v"(r):"v"(a),"v"(b),"v"(c));return r;}
__device__ __forceinline__ float max2f(float a,float b){float r;asm("v_max_f32_e32 %0, %1, %2":"=v"(r):"v"(a),"v"(b));return r;}
__device__ __forceinline__ float fadd_s(float a,float b){float r;asm("v_add_f32_e32 %0, %1, %2":"=v"(r):"v"(a),"v"(b));return r;}
__device__ __forceinline__ float fsub_s(float a,float b){float r;asm("v_sub_f32_e32 %0, %1, %2":"=v"(r):"v"(a),"v"(b));return r;}
typedef float f32x2_t __attribute__((ext_vector_type(2))); typedef __bf16 bf16x2_t __attribute__((ext_vector_type(2)));
__device__ __forceinline__ unsigned cvtpk_s(float lo,float hi){f32x2_t v={lo,hi};bf16x2_t b=__builtin_convertvector(v,bf16x2_t);return __builtin_bit_cast(unsigned,b);}
#define WAIT_BAR(N) asm volatile("s_waitcnt vmcnt(" #N ") lgkmcnt(0)\n\ts_barrier":::"memory")

__device__ __forceinline__ void qkt(f32x16&p0,f32x16&p1,const char*Kslot,const bf16x8*qr,const f32x16&negm,int r32,int hi){
  const char*kb=Kslot+hi*1024+r32*16;
  #pragma unroll
  for(int d0=0;d0<4;++d0){
    const bf16x8 b0=*reinterpret_cast<const bf16x8*>(kb+d0*2048);
    const bf16x8 b1=*reinterpret_cast<const bf16x8*>(kb+d0*2048+512);
    if(d0==0){p0=__builtin_amdgcn_mfma_f32_32x32x16_bf16(b0,qr[0],negm,0,0,0);p1=__builtin_amdgcn_mfma_f32_32x32x16_bf16(b1,qr[0],negm,0,0,0);}
    else{p0=__builtin_amdgcn_mfma_f32_32x32x16_bf16(b0,qr[d0],p0,0,0,0);p1=__builtin_amdgcn_mfma_f32_32x32x16_bf16(b1,qr[d0],p1,0,0,0);}}
}
typedef __attribute__((address_space(3))) const char* lds_cptr;
typedef short v4i16_t __attribute__((ext_vector_type(4)));
__device__ __forceinline__ void kload8(bf16x8*kf,lds_cptr kp){
  kf[0]=*(const __attribute__((address_space(3))) bf16x8*)(kp);      kf[1]=*(const __attribute__((address_space(3))) bf16x8*)(kp+512);
  kf[2]=*(const __attribute__((address_space(3))) bf16x8*)(kp+2048); kf[3]=*(const __attribute__((address_space(3))) bf16x8*)(kp+2560);
  kf[4]=*(const __attribute__((address_space(3))) bf16x8*)(kp+4096); kf[5]=*(const __attribute__((address_space(3))) bf16x8*)(kp+4608);
  kf[6]=*(const __attribute__((address_space(3))) bf16x8*)(kp+6144); kf[7]=*(const __attribute__((address_space(3))) bf16x8*)(kp+6656);
}
__device__ __forceinline__ void kload2(bf16x8*kf,lds_cptr kp,int j){ kf[2*j]=*(const __attribute__((address_space(3))) bf16x8*)(kp+j*2048); kf[2*j+1]=*(const __attribute__((address_space(3))) bf16x8*)(kp+j*2048+512); }
__device__ __forceinline__ s16x4 vtr(lds_cptr p){ return __builtin_bit_cast(s16x4,__builtin_amdgcn_ds_read_tr16_b64_v4i16((__attribute__((address_space(3))) v4i16_t*)p)); }
__device__ __forceinline__ float rowmax(const f32x16&p0,const f32x16&p1){
  float a=max3f(p0[0],p0[1],p1[0]),b=max3f(p0[2],p0[3],p1[1]);a=max3f(a,p1[2],p1[3]);
  #pragma unroll
  for(int r=4;r<16;r+=4){a=max3f(a,p0[r],p0[r+1]);b=max3f(b,p0[r+2],p0[r+3]);a=max3f(a,p1[r],p1[r+1]);b=max3f(b,p1[r+2],p1[r+3]);}
  const float m=max2f(a,b);
  auto rr=__builtin_amdgcn_permlane32_swap(__float_as_uint(m),__float_as_uint(m),false,false);
  return max2f(__uint_as_float(rr[0]),__uint_as_float(rr[1]));
}
__device__ __forceinline__ void pv(f32x16*o,int vb,bf16x8 pa0,bf16x8 pa1,bf16x8 pa2,bf16x8 pa3){
  #pragma unroll
  for(int d0=0;d0<2;++d0){s16x4 lo[4],hi[4];
    #pragma unroll
    for(int ks=0;ks<4;++ks){
      asm volatile("ds_read_b64_tr_b16 %0,%1 offset:%c2":"=&v"(lo[ks]):"v"(vb),"i"(d0*4096+ks*1024):"memory");
      asm volatile("ds_read_b64_tr_b16 %0,%1 offset:%c2":"=&v"(hi[ks]):"v"(vb),"i"(d0*4096+ks*1024+512):"memory");}
    asm volatile("s_waitcnt lgkmcnt(0)":::"memory");SBAR();
    #define PK(k) (bf16x8){lo[k][0],lo[k][1],lo[k][2],lo[k][3],hi[k][0],hi[k][1],hi[k][2],hi[k][3]}
    o[d0]=__builtin_amdgcn_mfma_f32_32x32x16_bf16(pa0,PK(0),o[d0],0,0,0);
    o[d0]=__builtin_amdgcn_mfma_f32_32x32x16_bf16(pa1,PK(1),o[d0],0,0,0);
    o[d0]=__builtin_amdgcn_mfma_f32_32x32x16_bf16(pa2,PK(2),o[d0],0,0,0);
    o[d0]=__builtin_amdgcn_mfma_f32_32x32x16_bf16(pa3,PK(3),o[d0],0,0,0);
    #undef PK
  }
}

#ifndef ATTN_STORE16
#define ATTN_STORE16(p,v) (*(u32x4*)(p)=(v))
#endif
template<int THRL> __device__ __forceinline__ void attn_unit(const bf16*Qu,const bf16*__restrict__ Kh,const bf16*__restrict__ Vh,bf16*Ou,const int NT,char*shm,const bool wr_=true){
  int tid_o=threadIdx.x; asm volatile("":"+v"(tid_o));
  const int tid=tid_o,lane=tid&63,r32=lane&31,hi=lane>>5; const int wid=__builtin_amdgcn_readfirstlane(tid>>6);
  const bf16*Qw=Qu+(long)(wid*QBLK)*DM;
  const unsigned lds0=(unsigned)(uintptr_t)shm;
  float*wsf=(float*)(shm+LDS_WS)+wid*64;
  const bf16*ksrc=Kh+(long)lane*KVPITCH+wid*8;
  const bf16*vsrc=Vh+(long)(16*(wid&3)+(lane>>2))*KVPITCH+(wid>>2)*32+(lane&3)*8;
  const unsigned kdst=lds0+LDS_K+wid*1024, vdst=lds0+LDS_V+wid*1024;
  #define DMA_K(t,slot) glds16(ksrc+(long)(t)*KVBLK*KVPITCH,(unsigned)__builtin_amdgcn_readfirstlane(kdst+(slot)))
  #define DMA_V(t,slot) glds16(vsrc+(long)(t)*KVBLK*KVPITCH,(unsigned)__builtin_amdgcn_readfirstlane(vdst+(slot)))
  const int vb0=(int)(lds0+LDS_V)+((lane>>4)&1)*32+(lane&3)*8+(4*hi+((lane&15)>>2))*64;
  const char*Kbase=shm+LDS_K; bf16x8 kf[8];
  const lds_cptr shm3=(lds_cptr)shm; const lds_cptr kp0=shm3+LDS_K+hi*1024+r32*16; const lds_cptr vp0=shm3+LDS_V+((lane>>4)&1)*32+(lane&3)*8+(4*hi+((lane&15)>>2))*64;
  DMA_K(0,0);DMA_V(0,0);DMA_K(1,SLOTB);
  bf16x8 qr[4];
  #pragma unroll
  for(int d0=0;d0<4;++d0)qr[d0]=*reinterpret_cast<const bf16x8*>(&Qw[(long)r32*DM+d0*16+hi*8]);
  float mhat=0.f,l_reg=0.f;f32x16 o[2];o[0]=f32x16{};o[1]=f32x16{};f32x16 negm=f32x16{};asm volatile("":"+v"(negm));
  #define CMASK(P0,P1,t) do{}while(0)
  bool resc=false;
  #define START(P0,P1) do{ const float rm=rowmax(P0,P1); resc=false; \
    { const float dl=rm; mhat=fadd_s(mhat,dl); \
      _Pragma("unroll") for(int r=0;r<16;++r){P0[r]=fsub_s(P0[r],dl);P1[r]=fsub_s(P1[r],dl);} \
      _Pragma("unroll") for(int r=0;r<16;++r)negm[r]=-mhat; asm volatile("":"+v"(negm)); } \
    _Pragma("unroll") for(int r=0;r<16;++r)P0[r]=__builtin_amdgcn_exp2f(P0[r]); }while(0)
  #define RESC() do{ if(resc){ asm volatile("s_waitcnt lgkmcnt(0)":::"memory"); \
      _Pragma("unroll") for(int d_=0;d_<2;++d_) _Pragma("unroll") for(int r=0;r<16;++r)o[d_][r]*=wsf[crow(r,hi)]; } }while(0)
  f32x16 pA0,pA1,pB0,pB1;
  int sl_prev=0,sl_cur=0,sl_next=SLOTB;
  #define ROT() do{sl_prev=sl_cur;sl_cur=sl_next;sl_next=(sl_next==(NSLOT-1)*SLOTB)?0:sl_next+SLOTB;}while(0)
  DMA_K(2,2*SLOTB);
  WAIT_BAR(3);
  qkt(pA0,pA1,Kbase,qr,negm,r32,hi);asm volatile("s_nop 15\n\ts_nop 7":"+v"(pA0),"+v"(pA1));CMASK(pA0,pA1,0);
  START(pA0,pA1);
  _Pragma("unroll") for(int r=0;r<16;++r)pA1[r]=__builtin_amdgcn_exp2f(pA1[r]);
  WAIT_BAR(0);
  DMA_K(3,0);DMA_V(1,SLOTB);
  ROT();
  kload8(kf,kp0+sl_cur);
  WAIT_BAR(2);
  s16x4 vlo[8],vhi[8]; u32x4 pw0,pw1,pw2,pw3;
  #define PKW(P,B) cvtpk_s(P[B],P[B+1])
  #define PAF(k) __builtin_bit_cast(bf16x8,pw##k)
  #define VFR(i) (bf16x8){vlo[i][0],vlo[i][1],vlo[i][2],vlo[i][3],vhi[i][0],vhi[i][1],vhi[i][2],vhi[i][3]}
  #define PIN(x) asm volatile("":"+v"(x))
  #define MX3(a,b,c) __builtin_fmaxf(__builtin_fmaxf((a),(b)),(c))
  #define GAPA(MF,A0,A1,A2,A3,W0,W1,PW) do{ MF; sacc+=A0; sacc+=A1; sacc+=A2; sacc+=A3; PIN(sacc); W0; W1; PIN(PW); SBAR(); }while(0)
  #define EX(v) __builtin_amdgcn_exp2f(v)
  #define GAPB(MF,X,B) do{ MF; X[B]=EX(X[B]); X[B+1]=EX(X[B+1]); X[B+2]=EX(X[B+2]); X[B+3]=EX(X[B+3]); PIN(X); SBAR(); }while(0)
  #define VRD(i) do{ vlo[i]=vtr(vp_+(((i)>>2)*4096+((i)&3)*1024)); vhi[i]=vtr(vp_+(((i)>>2)*4096+((i)&3)*1024+512)); }while(0)
  #define KRD(G,j) do{ if(G){ kload2(kf,kp0+sl_next,j); SBAR(); } }while(0)
  #define STEP(C0,C1,P0,P1,t,GK,GV,GL) do{ SBAR(); \
    const lds_cptr vp_=vp0+sl_prev; \
    VRD(0); SBAR(); float sacc=(P0[0]+P0[1]); \
    GAPA(C0=__builtin_amdgcn_mfma_f32_32x32x16_bf16(kf[0],qr[0],negm,0,0,0), P0[2],P0[3],P0[4],P0[5],     pw0[0]=PKW(P0,0), pw0[1]=PKW(P0,2), pw0); \
    VRD(4); SBAR(); GAPA(C1=__builtin_amdgcn_mfma_f32_32x32x16_bf16(kf[1],qr[0],negm,0,0,0), P0[6],P0[7],P0[8],P0[9],     pw0[2]=PKW(P0,4), pw0[3]=PKW(P0,6), pw0); \
    VRD(1); SBAR(); GAPA(C0=__builtin_amdgcn_mfma_f32_32x32x16_bf16(kf[2],qr[1],C0,0,0,0),   P0[10],P0[11],P0[12],P0[13], pw1[0]=PKW(P0,8), pw1[1]=PKW(P0,10), pw1); \
    VRD(5); SBAR(); GAPA(C1=__builtin_amdgcn_mfma_f32_32x32x16_bf16(kf[3],qr[1],C1,0,0,0),   P0[14],P0[15],P1[0],P1[1],   pw1[2]=PKW(P0,12),pw1[3]=PKW(P0,14), pw1); \
    VRD(2); SBAR(); GAPA(C0=__builtin_amdgcn_mfma_f32_32x32x16_bf16(kf[4],qr[2],C0,0,0,0),   P1[2],P1[3],P1[4],P1[5],     pw2[0]=PKW(P1,0), pw2[1]=PKW(P1,2), pw2); \
    VRD(6); SBAR(); GAPA(C1=__builtin_amdgcn_mfma_f32_32x32x16_bf16(kf[5],qr[2],C1,0,0,0),   P1[6],P1[7],P1[8],P1[9],     pw2[2]=PKW(P1,4), pw2[3]=PKW(P1,6), pw2); \
    VRD(3); SBAR(); GAPA(C0=__builtin_amdgcn_mfma_f32_32x32x16_bf16(kf[6],qr[3],C0,0,0,0),   P1[10],P1[11],P1[12],P1[13], pw3[0]=PKW(P1,8), pw3[1]=PKW(P1,10), pw3); \
    VRD(7); SBAR(); GAPA(C1=__builtin_amdgcn_mfma_f32_32x32x16_bf16(kf[7],qr[3],C1,0,0,0),   P1[14],P1[15],0.f,0.f,       pw3[2]=PKW(P1,12),pw3[3]=PKW(P1,14), pw3); \
    l_reg+=sacc; \
    if(GK){DMA_K((t)+3,sl_cur);} if(GV){DMA_V((t)+1,sl_next);} \
    CMASK(C0,C1,t); \
    { float a=MX3(C0[0],C0[1],C1[0]),b=MX3(C0[2],C0[3],C1[1]); a=MX3(a,C1[2],C1[3]); \
      _Pragma("unroll") for(int r=4;r<16;r+=4){a=MX3(a,C0[r],C0[r+1]);b=MX3(b,C0[r+2],C0[r+3]);a=MX3(a,C1[r],C1[r+1]);b=MX3(b,C1[r+2],C1[r+3]);} \
      float rm=__builtin_fmaxf(a,b); { auto rr=__builtin_amdgcn_permlane32_swap(__float_as_uint(rm),__float_as_uint(rm),false,false); rm=__builtin_fmaxf(__uint_as_float(rr[0]),__uint_as_float(rr[1])); } \
      resc=false; \
      if(__builtin_expect(__any(rm>(float)THRL),0)){ const float dl=__builtin_fmaxf(rm,0.f); mhat+=dl; \
        _Pragma("unroll") for(int r=0;r<16;++r){C0[r]-=dl;C1[r]-=dl;} \
        _Pragma("unroll") for(int r=0;r<16;++r)negm[r]=-mhat; asm volatile("":"+v"(negm)); \
        const float f=__builtin_amdgcn_exp2f(-dl); l_reg*=f; if(hi==0)wsf[r32]=f; resc=true; } } \
    SBAR(); \
    GAPB(o[0]=__builtin_amdgcn_mfma_f32_32x32x16_bf16(PAF(0),VFR(0),o[0],0,0,0), C0,0); \
    GAPB(o[1]=__builtin_amdgcn_mfma_f32_32x32x16_bf16(PAF(0),VFR(4),o[1],0,0,0), C0,4); \
    KRD(GL,0); GAPB(o[0]=__builtin_amdgcn_mfma_f32_32x32x16_bf16(PAF(1),VFR(1),o[0],0,0,0), C0,8); \
    KRD(GL,1); GAPB(o[1]=__builtin_amdgcn_mfma_f32_32x32x16_bf16(PAF(1),VFR(5),o[1],0,0,0), C0,12); \
    KRD(GL,2); GAPB(o[0]=__builtin_amdgcn_mfma_f32_32x32x16_bf16(PAF(2),VFR(2),o[0],0,0,0), C1,0); \
    KRD(GL,3); GAPB(o[1]=__builtin_amdgcn_mfma_f32_32x32x16_bf16(PAF(2),VFR(6),o[1],0,0,0), C1,4); \
    GAPB(o[0]=__builtin_amdgcn_mfma_f32_32x32x16_bf16(PAF(3),VFR(3),o[0],0,0,0), C1,8); \
    GAPB(o[1]=__builtin_amdgcn_mfma_f32_32x32x16_bf16(PAF(3),VFR(7),o[1],0,0,0), C1,12); \
    }while(0)
  int t=1;
  for(;t+5<NT;t+=2){
    STEP(pB0,pB1,pA0,pA1,t,true,true,true);     WAIT_BAR(2); RESC(); ROT();
    STEP(pA0,pA1,pB0,pB1,t+1,true,true,true);   WAIT_BAR(2); RESC(); ROT();
  }
  #define ENDW(tt) do{ if((tt)+3<NT){WAIT_BAR(2);} else if((tt)+2<NT){WAIT_BAR(1);} else {WAIT_BAR(0);} }while(0)
  for(;t+1<NT;t+=2){
    STEP(pB0,pB1,pA0,pA1,t,(t+3<NT),(t+1<NT),(t+1<NT));       ENDW(t);   RESC(); ROT();
    STEP(pA0,pA1,pB0,pB1,t+1,(t+4<NT),(t+2<NT),(t+2<NT));     ENDW(t+1); RESC(); ROT();
  }
  STEP(pB0,pB1,pA0,pA1,NT-1,false,false,false); RESC();
  { float sacc=pB0[0]+pB0[1]; _Pragma("unroll") for(int r=2;r<16;++r)sacc+=pB0[r]; _Pragma("unroll") for(int r=0;r<16;++r)sacc+=pB1[r]; l_reg+=sacc;
    pw0=(u32x4){PKW(pB0,0),PKW(pB0,2),PKW(pB0,4),PKW(pB0,6)};pw1=(u32x4){PKW(pB0,8),PKW(pB0,10),PKW(pB0,12),PKW(pB0,14)};pw2=(u32x4){PKW(pB1,0),PKW(pB1,2),PKW(pB1,4),PKW(pB1,6)};pw3=(u32x4){PKW(pB1,8),PKW(pB1,10),PKW(pB1,12),PKW(pB1,14)};
    SBAR(); pv(o,vb0+sl_cur,PAF(0),PAF(1),PAF(2),PAF(3)); }
  #undef PKW
  #undef PAF
  #undef VFR
  #undef PIN
  #undef MX3
  #undef GAPA
  #undef GAPB
  #undef EX
  #undef VRD
  #undef KRD
  #undef STEP
  #undef ENDW
  {auto rr=__builtin_amdgcn_permlane32_swap(__float_as_uint(l_reg),__float_as_uint(l_reg),false,false);l_reg=__uint_as_float(rr[0])+__uint_as_float(rr[1]);}
  if(hi==0)wsf[32+r32]=l_reg;asm volatile("s_waitcnt lgkmcnt(0)":::"memory");
  float rli[16];
  #pragma unroll
  for(int r=0;r<16;++r)rli[r]=__builtin_amdgcn_rcpf(wsf[32+crow(r,hi)]);
  bf16*Ow=Ou+(long)(wid*QBLK)*DM;
  { bf16*stg=(bf16*)(shm+LDS_OST)+wid*2048;
    #pragma unroll
    for(int r=0;r<16;++r){const int orow=crow(r,hi);
      #pragma unroll
      for(int d0=0;d0<2;++d0)stg[orow*64+d0*32+r32]=__float2bfloat16(o[d0][r]*rli[r]);}
    asm volatile("s_waitcnt lgkmcnt(0)":::"memory");
    #pragma unroll
    for(int i=0;i<4;++i){const int row=i*8+(lane>>3),ch=lane&7; const u32x4 v=*(const u32x4*)(stg+row*64+ch*8); if(wr_)ATTN_STORE16(Ow+(long)row*DM+ch*8,v);} }
  asm volatile("s_waitcnt lgkmcnt(0)\n\ts_barrier":::"memory");
  #undef DMA_K
  #undef DMA_V
  #undef CMASK
  #undef START
  #undef RESC
  #undef ROT
}
constexpr int ATTN_LDS_BYTES=LDS_BYTES;
#undef SBAR
#undef WAIT_BAR
}

#ifndef MK_SINGLE
#define MK_SINGLE 1
#endif
constexpr int NWAVES = 8, NTHR = 512;
constexpr size_t MiB = 1u << 20;
constexpr size_t WS_CTL = 0, WS_BAR = 8192, WS_MOD = 32768, WS_ROWSS = 262144, CTL_ZERO_BYTES = 262144 + 20480 * 4, WS_SHW = 1024 * 1024, WS_GAM = 1280 * 1024, WS_ROPE = 512 * 1024, WS_LBT = 528 * 1024, WS_MODB = 768 * 1024;
constexpr size_t WS_WIN = 2 * MiB, WS_WO = 19 * MiB, WS_WUP = 21 * MiB, WS_WDN = 32 * MiB;
constexpr size_t WS_H = 38 * MiB, WS_Q = 58 * MiB, WS_ZA = 78 * MiB, WS_RQ = 98 * MiB, WS_GF = 118 * MiB, WS_GB = 138 * MiB, WS_RI = 158 * MiB, WS_PP = 178 * MiB, WS_K = 243 * MiB, WS_V = 243 * MiB + 6400 * 1024;
constexpr size_t WS_U = 58 * MiB, WS_ACT = 168 * MiB, WS_H2 = 223 * MiB, WS_END = 256 * MiB;
constexpr int RING_BYTES = 131072, LDS_BYTES = 147456;
constexpr int N_PHASES = 21;

typedef unsigned v4u __attribute__((ext_vector_type(4)));
#define LDS_WAIT() asm volatile("s_waitcnt lgkmcnt(0)" ::: "memory")
__device__ __forceinline__ unsigned f2bf(float f) { unsigned u = __builtin_bit_cast(unsigned, f); return (u + 0x7fffu + ((u >> 16) & 1u)) >> 16; }
__device__ __forceinline__ unsigned pk2(float lo, float hi) { return pg8::cvt_pk_bf16(lo, hi); }

#define RLX_AGENT __ATOMIC_RELAXED, __HIP_MEMORY_SCOPE_AGENT
#define XB_TMO      128
#define XB_XCNT(j)  (256  + 64 * (j))
#define XB_XSUB(j)  (1280 + 64 * (j))
#define XB_XGEN(j)  (2304 + 64 * (j))
#define XB_TOP      3328
#define XB_TOPGEN   3392
#define XCD_BAR_WORDS 3456
#define XB_SPIN_CAP (1u << 18)

__device__ __forceinline__ unsigned xb_ld(unsigned* p)              { return __hip_atomic_load(p, __ATOMIC_RELAXED, __HIP_MEMORY_SCOPE_AGENT); }
__device__ __forceinline__ unsigned xb_add(unsigned* p, unsigned v) { return __hip_atomic_fetch_add(p, v, __ATOMIC_RELAXED, __HIP_MEMORY_SCOPE_AGENT); }
__device__ __forceinline__ unsigned xb_xcc_id() { return (unsigned)__builtin_amdgcn_s_getreg((3 << 11) | 20) & 0xFu; }
#define XB_SPIN(cond, bar) do { unsigned _sp = 0; while (cond) { __builtin_amdgcn_s_sleep(1); \
    if ((++_sp & 255u) == 0u) { if (xb_ld(&(bar)[XB_TMO])) break; if (_sp > XB_SPIN_CAP) { atomicAdd(&(bar)[XB_TMO], 1u); break; } } } } while (0)

struct XcdBarrier {
    unsigned* bar; unsigned x;
    volatile LAS unsigned* st;
};

__device__ __forceinline__ XcdBarrier xcd_barrier_post(unsigned* bar, volatile LAS unsigned* st) {
    XcdBarrier b; b.bar = bar; b.x = xb_xcc_id(); b.st = st;
    if (threadIdx.x == 0) (void)xb_add(&bar[XB_XCNT(b.x)], 1u);
    return b;
}
__device__ __forceinline__ void xcd_barrier_complete(unsigned* bar, unsigned x, unsigned& nloc, unsigned& nx) {
    const unsigned G = gridDim.x * gridDim.y * gridDim.z;
    unsigned sum, cnt, mine, sp = 0u;
    for (;;) {
        sum = 0u; cnt = 0u; mine = 0u;
#pragma unroll
        for (unsigned j = 0; j < 16; ++j) { const unsigned c = xb_ld(&bar[XB_XCNT(j)]); sum += c; cnt += (c > 0u) ? 1u : 0u; mine = (j == x) ? c : mine; }
        if (sum == G) break;
        __builtin_amdgcn_s_sleep(1);
        if ((++sp & 255u) == 0u) { if (xb_ld(&bar[XB_TMO])) break; if (sp > XB_SPIN_CAP) { atomicAdd(&bar[XB_TMO], 1u); break; } }
    }
    nloc = mine > 0u ? mine : 1u; nx = cnt > 0u ? cnt : 1u;
}

__device__ __forceinline__ void xcd_barrier(const XcdBarrier& b) {
    asm volatile("s_waitcnt vmcnt(0)" ::: "memory");
    __syncthreads();
    if (threadIdx.x == 0) {
        unsigned* bar = b.bar;
        __builtin_amdgcn_s_waitcnt(0);
        unsigned nloc = b.st[0], nx = b.st[1];
        if (nloc == 0u) { xcd_barrier_complete(bar, b.x, nloc, nx); b.st[0] = nloc; b.st[1] = nx; }
        const unsigned old = xb_add(&bar[XB_XSUB(b.x)], 1u);
        const unsigned gen = old / nloc;
        if (old + 1u == (gen + 1u) * nloc) {
            __builtin_amdgcn_fence(__ATOMIC_RELEASE, "agent");
            asm volatile("s_waitcnt vmcnt(0)" ::: "memory");
            const unsigned og = xb_add(&bar[XB_TOP], 1u);
            const unsigned tg = og / nx;
            if (og + 1u == (tg + 1u) * nx) xb_add(&bar[XB_TOPGEN], 1u);
            else XB_SPIN(xb_ld(&bar[XB_TOPGEN]) == tg, bar);
            __builtin_amdgcn_fence(__ATOMIC_ACQUIRE, "agent");
            xb_add(&bar[XB_XGEN(b.x)], 1u);
            asm volatile("s_waitcnt vmcnt(0)" ::: "memory");
        } else {
            XB_SPIN(xb_ld(&bar[XB_XGEN(b.x)]) == gen, bar);
            __builtin_amdgcn_fence(__ATOMIC_ACQUIRE, "agent");
            asm volatile("s_waitcnt vmcnt(0)" ::: "memory");
        }
    }
    __syncthreads();
}

struct Args { const float* in[22]; float* out; unsigned char* ws; int ph_lo, ph_hi; };

__device__ __forceinline__ void p0_transpose_item(const float* W, int K, int N, bf16_t* WT, int prow0, int lc0, LAS float* scr, int kb, int lane) {
    const int k0 = 64 * kb;
#pragma unroll 8
    for (int i = 0; i < 32; ++i) { const int kk = 2 * i + (lane >> 5); scr[kk * 33 + (lane & 31)] = W[(size_t)(k0 + kk) * N + lc0 + (lane & 31)]; }
    LDS_WAIT(); asm volatile("" ::: "memory");
    const int c = lane & 7;
#pragma unroll
    for (int j = 0; j < 4; ++j) { const int n = (lane >> 3) + 8 * j; const LAS float* s = scr + (8 * c) * 33 + n;
        v4u o; o.x = pk2(s[0 * 33], s[1 * 33]); o.y = pk2(s[2 * 33], s[3 * 33]); o.z = pk2(s[4 * 33], s[5 * 33]); o.w = pk2(s[6 * 33], s[7 * 33]);
        *(v4u*)(WT + (size_t)(prow0 + n) * K + k0 + 8 * c) = o; }
    LDS_WAIT(); asm volatile("" ::: "memory");
}

__device__ __forceinline__ void p0_prep(const __attribute__((address_space(4))) Args* a, LAS unsigned char* lds, int gw, int NGW, int wave, int lane, bool skip_ada = false) {
    LAS float* scr = (LAS float*)(lds + wave * 16384);
    unsigned char* ws = a->ws;
    const float* w_in = a->in[11]; const float* w_o = a->in[16]; const float* w_up = a->in[17]; const float* w_dn = a->in[20];
    constexpr int I_IN = 16 * 272, I_O = 16 * 32, I_UP = 16 * 176, I_DN = 44 * 32, I_T = I_IN + I_O + I_UP + I_DN, I_ADA = 96 * 16, I_ROPE = 16, I_LB = 32;
    for (int it = gw; it < I_T + I_ADA + I_ROPE + I_LB; it += NGW) {
        int r = it;
        if (r < I_T) {
            const float* W; int K, N, kb, pg; bf16_t* WT; bool isin = false;
            if (r < I_IN) { W = w_in; K = 1024; N = INW; kb = r / 272; pg = r % 272; WT = (bf16_t*)(ws + WS_WIN); isin = true; }
            else if ((r -= I_IN) < I_O) { W = w_o; K = 1024; N = 1024; kb = r / 32; pg = r % 32; WT = (bf16_t*)(ws + WS_WO); }
            else if ((r -= I_O) < I_UP) { W = w_up; K = 1024; N = UPW; kb = r / 176; pg = r % 176; WT = (bf16_t*)(ws + WS_WUP); }
            else { r -= I_UP; W = w_dn; K = DFF; N = 1024; kb = r / 32; pg = r % 32; WT = (bf16_t*)(ws + WS_WDN); }
            const int T = pg >> 3, g = pg & 7, bj = g >> 2, wc = g & 3;
            int lc0 = T * 256 + wc * 64 + bj * 32;
            if (isin && T >= 22) lc0 = (T < 26) ? 6656 + (T - 22) * 256 + wc * 64 + bj * 32 : (bj ? 7680 : 5632) + (T - 26) * 128 + wc * 32;
            p0_transpose_item(W, K, N, WT, pg * 32, lc0, scr, kb, lane);
        } else if ((r -= I_T) < I_ADA) {
            if (skip_ada) continue;
            const int g = r >> 4, kc = r & 15, n0 = g * 64 + lane, k0 = kc * 64;
            const float* c_in = a->in[2]; const float* cctx = a->in[6]; const float* adaw = a->in[7];
#pragma unroll
            for (int i = 0; i < 9; ++i) { const float cv = (i == 0) ? cctx[k0 + lane] : c_in[(i - 1) * 1024 + k0 + lane]; scr[lane * 12 + i] = fsilu(cv); }
            LDS_WAIT(); asm volatile("" ::: "memory");
            float acc[9];
#pragma unroll
            for (int i = 0; i < 9; ++i) acc[i] = 0.f;
#pragma unroll 8
            for (int kk = 0; kk < 64; ++kk) { const float w = adaw[(size_t)(k0 + kk) * 6144 + n0];
                const pg8::f32x4 s0 = *(const LAS pg8::f32x4*)(scr + kk * 12), s1 = *(const LAS pg8::f32x4*)(scr + kk * 12 + 4); const float s8 = scr[kk * 12 + 8];
                acc[0] += s0[0] * w; acc[1] += s0[1] * w; acc[2] += s0[2] * w; acc[3] += s0[3] * w; acc[4] += s1[0] * w; acc[5] += s1[1] * w; acc[6] += s1[2] * w; acc[7] += s1[3] * w; acc[8] += s8 * w; }
            float* mod = (float*)(ws + WS_MOD);
#pragma unroll
            for (int i = 0; i < 9; ++i) atomicAdd(mod + i * 6144 + n0, acc[i]);
            LDS_WAIT(); asm volatile("" ::: "memory");
        } else if ((r -= I_ADA) >= I_ROPE) {
            r -= I_ROPE; const int idx = r * 64 + lane, d = idx >> 10, cch = idx & 1023; const float* lg = a->in[14];
            ((float*)(ws + WS_LBT))[idx] = fsigmoid(lg[d * 2048 + cch] - lg[d * 2048 + 1024 + cch]);
        } else {
            const int idx = r * 64 + lane, pos = idx >> 4, i = idx & 15;
            const float invf = exp2f(-(float)i * 0.8304820237218406f); const float ang = (float)pos * invf;
            const float n = rintf(ang * 0.15915494309189535f); float rr = fmaf(-n, 6.2831854820251465f, ang); rr = fmaf(-n, -1.7484555e-7f, rr);
            float* rope = (float*)(ws + WS_ROPE); rope[idx * 2] = __cosf(rr); rope[idx * 2 + 1] = __sinf(rr);
        }
    }
}

template <int MODE> __device__ __forceinline__ void norm_row(const float* xrow, const float* gain, const float* mod, const float* adab, int shoff, int scoff, bf16_t* obf, float* of32, int lane) {
    const pg8::f32x4* xr = (const pg8::f32x4*)xrow + lane;
    pg8::f32x4 v[4]; float s = 0.f;
#pragma unroll
    for (int j = 0; j < 4; ++j) { v[j] = xr[64 * j]; s += (v[j][0] * v[j][0] + v[j][1] * v[j][1]) + (v[j][2] * v[j][2] + v[j][3] * v[j][3]); }
    const float rstd = __builtin_amdgcn_rsqf(wave_sum(s) * (1.0f / 1024.0f) + EPS);
#pragma unroll
    for (int j = 0; j < 4; ++j) { const int c = 4 * (lane + 64 * j); const pg8::f32x4 g = *(const pg8::f32x4*)(gain + c); pg8::f32x4 y = v[j] * rstd * g;
        if (MODE == 0) { const pg8::f32x4 sh = *(const pg8::f32x4*)(mod + shoff + c) + *(const pg8::f32x4*)(adab + shoff + c), sc = *(const pg8::f32x4*)(mod + scoff + c) + *(const pg8::f32x4*)(adab + scoff + c);
            y = y * (sc + 1.0f) + sh; u32x2 w; w.x = pk2(y[0], y[1]); w.y = pk2(y[2], y[3]); *(u32x2*)(obf + c) = w; }
        else *(pg8::f32x4*)(of32 + c) = y; }
}

constexpr int R_QD = 0, R_KD = 17408, R_K2T = 34816, R_VT = 53248, R_SC = 71680, R_ST = 80896, R_XCH = 115712, R_DEC = 119808;
__device__ __forceinline__ int crow(int r, int hi) { return (r & 3) + 8 * (r >> 2) + 4 * hi; }
__device__ __forceinline__ void rec_scan(LAS unsigned char* lds, const bf16_t* RQ, bf16_t* G, const bf16_t* RI, int lrow0, int L, int rh, int dir, const float* s0, float* sfin, const bool wr_ = true) {
    int tid_o = threadIdx.x; asm volatile("" : "+v"(tid_o));
    const int tid = tid_o, lane = tid & 63, w = __builtin_amdgcn_readfirstlane(tid >> 6), r32 = lane & 31, hi = lane >> 5;
    const int kb = w >> 1, dvt0 = (w & 1) * 2;
    const int colb = rh * 128;
    f32x16 S[2];
#pragma unroll
    for (int x = 0; x < 2; ++x)
#pragma unroll
        for (int r = 0; r < 16; ++r) S[x][r] = s0 ? s0[(size_t)(kb * 32 + crow(r, hi)) * 128 + (dvt0 + x) * 32 + r32] : 0.f;
#define REC_WRITE_ST() do { _Pragma("unroll") for (int x = 0; x < 2; ++x) _Pragma("unroll") for (int g = 0; g < 4; ++g) { u32x2 wv; wv.x = pk2(S[x][4 * g], S[x][4 * g + 1]); wv.y = pk2(S[x][4 * g + 2], S[x][4 * g + 3]); \
        *(LAS u32x2*)(lds + R_ST + ((dvt0 + x) * 32 + r32) * 272 + (kb * 32 + 8 * g + 4 * hi) * 2) = wv; } } while (0)
    REC_WRITE_ST();
    const int nc = L >> 6;
    unsigned gq[8], qq[8], vv[8];
#define REC_ROW(c, i) (dir ? (lrow0 + L - 1 - ((c) * 64 + (i))) : (lrow0 + (c) * 64 + (i)))
#define REC_LOAD(c) do { _Pragma("unroll") for (int i = 0; i < 8; ++i) { const size_t off = (size_t)REC_ROW(c, 8 * w + i) * DM + colb + 2 * lane; \
        gq[i] = *(const unsigned*)(G + off); qq[i] = *(const unsigned*)(RQ + off); vv[i] = *(const unsigned*)(RI + off); } } while (0)
    REC_LOAD(0);
    for (int c = 0; c < nc; ++c) {
        float g0[8], g1[8], q0[8], q1[8]; unsigned vk[8];
#pragma unroll
        for (int i = 0; i < 8; ++i) { g0[i] = h2f((unsigned short)(gq[i] & 0xffffu)); g1[i] = h2f((unsigned short)(gq[i] >> 16)); q0[i] = bflo(qq[i]); q1[i] = bfhi(qq[i]); vk[i] = vv[i]; }
        if (c + 1 < nc) REC_LOAD(c + 1);
        float b0[8], b1[8];
        b0[0] = g0[0]; b1[0] = g1[0];
#pragma unroll
        for (int i = 1; i < 8; ++i) { b0[i] = b0[i - 1] + g0[i]; b1[i] = b1[i - 1] + g1[i]; }
        *(LAS f32x2*)(lds + R_XCH + (w * 128 + 2 * lane) * 4) = (f32x2){b0[7], b1[7]};
        __syncthreads();
        float p0 = 0.f, p1 = 0.f, t0 = 0.f, t1 = 0.f;
#pragma unroll
        for (int ww = 0; ww < 8; ++ww) { const f32x2 x = *(const LAS f32x2*)(lds + R_XCH + (ww * 128 + 2 * lane) * 4); if (ww < w) { p0 += x[0]; p1 += x[1]; } t0 += x[0]; t1 += x[1]; }
        if (w == 0) *(LAS f32x2*)(lds + R_DEC + 2 * lane * 4) = (f32x2){__expf(t0), __expf(t1)};
        unsigned k2a[4], k2b[4], va[4], vb[4];
#pragma unroll
        for (int i = 0; i < 8; ++i) {
            const float bb0 = p0 + b0[i], bb1 = p1 + b1[i];
            const float kk0 = 1.0f - __expf(g0[i]), kk1 = 1.0f - __expf(g1[i]);
            const float qd0 = q0[i] * __expf(bb0), qd1 = q1[i] * __expf(bb1);
            const float kd0 = kk0 * __expf(-bb0), kd1 = kk1 * __expf(-bb1);
            const float kt0 = kk0 * __expf(t0 - bb0), kt1 = kk1 * __expf(t1 - bb1);
            const int ti = 8 * w + i;
            *(LAS unsigned*)(lds + R_QD + ti * 272 + lane * 4) = pk2(qd0, qd1);
            *(LAS unsigned*)(lds + R_KD + ti * 272 + lane * 4) = pk2(kd0, kd1);
            const unsigned f0 = f2bf(kt0), f1 = f2bf(kt1);
            if (i & 1) { k2a[i >> 1] |= f0 << 16; k2b[i >> 1] |= f1 << 16; va[i >> 1] |= (vk[i] & 0xffffu) << 16; vb[i >> 1] |= vk[i] & 0xffff0000u; }
            else { k2a[i >> 1] = f0; k2b[i >> 1] = f1; va[i >> 1] = vk[i] & 0xffffu; vb[i >> 1] = vk[i] >> 16; }
        }
        *(LAS v4u*)(lds + R_K2T + (2 * lane) * 144 + 16 * w) = (v4u){k2a[0], k2a[1], k2a[2], k2a[3]};
        *(LAS v4u*)(lds + R_K2T + (2 * lane + 1) * 144 + 16 * w) = (v4u){k2b[0], k2b[1], k2b[2], k2b[3]};
        *(LAS v4u*)(lds + R_VT + (2 * lane) * 144 + 16 * w) = (v4u){va[0], va[1], va[2], va[3]};
        *(LAS v4u*)(lds + R_VT + (2 * lane + 1) * 144 + 16 * w) = (v4u){vb[0], vb[1], vb[2], vb[3]};
        __syncthreads();
        if (w < 4) {
            const int ti = w >> 1, si = w & 1;
            f32x16 sc;
#pragma unroll
            for (int r = 0; r < 16; ++r) sc[r] = 0.f;
            if (w != 1) {
#pragma unroll
                for (int ks = 0; ks < 8; ++ks) {
                    const pg8::bf16x8 af = *(const LAS pg8::bf16x8*)(lds + R_QD + (ti * 32 + r32) * 272 + (16 * ks + 8 * hi) * 2);
                    const pg8::bf16x8 bf = *(const LAS pg8::bf16x8*)(lds + R_KD + (si * 32 + r32) * 272 + (16 * ks + 8 * hi) * 2);
                    sc = __builtin_amdgcn_mfma_f32_32x32x16_bf16(af, bf, sc, 0, 0, 0);
                }
            }
#pragma unroll
            for (int r = 0; r < 16; ++r) { const int t = ti * 32 + crow(r, hi), s = si * 32 + r32; const float v = (t >= s) ? sc[r] : 0.f;
                *(LAS unsigned short*)(lds + R_SC + t * 144 + s * 2) = (unsigned short)f2bf(v); }
        }
        __syncthreads();
        {
            const int to = w >> 2, dvo = w & 3;
            f32x16 o;
#pragma unroll
            for (int r = 0; r < 16; ++r) o[r] = 0.f;
#pragma unroll
            for (int ks = 0; ks < 4; ++ks) {
                const pg8::bf16x8 af = *(const LAS pg8::bf16x8*)(lds + R_SC + (to * 32 + r32) * 144 + (16 * ks + 8 * hi) * 2);
                const pg8::bf16x8 bf = *(const LAS pg8::bf16x8*)(lds + R_VT + (dvo * 32 + r32) * 144 + (16 * ks + 8 * hi) * 2);
                o = __builtin_amdgcn_mfma_f32_32x32x16_bf16(af, bf, o, 0, 0, 0);
            }
#pragma unroll
            for (int ks = 0; ks < 8; ++ks) {
                const pg8::bf16x8 af = *(const LAS pg8::bf16x8*)(lds + R_QD + (to * 32 + r32) * 272 + (16 * ks + 8 * hi) * 2);
                const pg8::bf16x8 bf = *(const LAS pg8::bf16x8*)(lds + R_ST + (dvo * 32 + r32) * 272 + (16 * ks + 8 * hi) * 2);
                o = __builtin_amdgcn_mfma_f32_32x32x16_bf16(af, bf, o, 0, 0, 0);
            }
            if (wr_)
#pragma unroll
            for (int r = 0; r < 16; ++r) { const int t = to * 32 + crow(r, hi); G[(size_t)REC_ROW(c, t) * DM + colb + dvo * 32 + r32] = (bf16_t)f2bf(o[r]); }
            float dec[16];
#pragma unroll
            for (int r = 0; r < 16; ++r) dec[r] = *(const LAS float*)(lds + R_DEC + (kb * 32 + crow(r, hi)) * 4);
#pragma unroll
            for (int x = 0; x < 2; ++x)
#pragma unroll
                for (int r = 0; r < 16; ++r) S[x][r] *= dec[r];
#pragma unroll
            for (int ks = 0; ks < 4; ++ks) {
                const pg8::bf16x8 af = *(const LAS pg8::bf16x8*)(lds + R_K2T + (kb * 32 + r32) * 144 + (16 * ks + 8 * hi) * 2);
#pragma unroll
                for (int x = 0; x < 2; ++x) {
                    const pg8::bf16x8 bf = *(const LAS pg8::bf16x8*)(lds + R_VT + ((dvt0 + x) * 32 + r32) * 144 + (16 * ks + 8 * hi) * 2);
                    S[x] = __builtin_amdgcn_mfma_f32_32x32x16_bf16(af, bf, S[x], 0, 0, 0);
                }
            }
        }
        __syncthreads();
        REC_WRITE_ST();
    }
    if (sfin && wr_) {
#pragma unroll
        for (int x = 0; x < 2; ++x)
#pragma unroll
            for (int r = 0; r < 16; ++r) sfin[(size_t)(kb * 32 + crow(r, hi)) * 128 + (dvt0 + x) * 32 + r32] = S[x][r];
    }
#undef REC_WRITE_ST
#undef REC_ROW
#undef REC_LOAD
}

typedef const __attribute__((address_space(4))) Args* KArgs;
#define WSB(off) ((bf16_t*)(ws + (off)))
#define WSF(off) ((float*)(ws + (off)))
__device__ __forceinline__ bf16_t* h1_buf(unsigned char* ws, float* dout, int hfx) { return hfx ? (bf16_t*)(dout + (size_t)MH * DM) : WSB(WS_H); }
__device__ __forceinline__ void do_norm1(KArgs ap, int hfx, int gwb, int ngwb, int lane) {
    unsigned char* const ws = ap->ws; const float* xp = ap->in[0]; const float* xs = ap->in[1]; const float* adab = ap->in[8]; const float* mod = WSF(WS_MOD);
    bf16_t* Hd = h1_buf(ws, ap->out, hfx); bf16_t* Kb = WSB(WS_K); bf16_t* Vb = WSB(WS_V);
    for (int r = gwb; r < MH; r += ngwb) { const int grow = hfx * MH + r; const float* src = grow < NPR ? xp + (size_t)grow * DM : xs + (size_t)(grow - NPR) * DM;
        norm_row<0>(src, ap->in[9], mod + mod_of_row(grow) * 6144, adab, 0, 1024, Hd + (size_t)r * DM, nullptr, lane); }
    const int nb = hfx ? 5 : 3, b0 = hfx ? 3 : 0;
    for (int r = gwb; r < 2 * nb * 512; r += ngwb) { const int kv = r / (nb * 512), rr = r % (nb * 512), b = rr >> 9, p = rr & 511;
        const float* src = (kv ? ap->in[4] : ap->in[3]) + ((size_t)(b0 + b) * 512 + p) * KVP + 4 * lane;
        bf16_t* dst = (kv ? Vb : Kb) + (size_t)((hfx ? b * 2560 : NPR + b * 2560) + 2048 + p) * KVP + 4 * lane;
        const pg8::f32x4 v = *(const pg8::f32x4*)src; u32x2 wv; wv.x = pk2(v[0], v[1]); wv.y = pk2(v[2], v[3]); *(u32x2*)dst = wv; }
}
__device__ __forceinline__ void do_final(KArgs ap, int hfx, int gwb, int ngwb, int lane) {
    float* dout = ap->out;
    for (int r = gwb; r < MH; r += ngwb) { float* row = dout + (size_t)(hfx * MH + r) * DM; norm_row<1>(row, ap->in[21], nullptr, nullptr, 0, 0, nullptr, row, lane); }
}

__global__ void __launch_bounds__(NTHR, 2) fwd_mega(Args args) {
    extern __shared__ __attribute__((aligned(16))) unsigned char lds_raw[];
    LAS unsigned char* lds = (LAS unsigned char*)lds_raw;
    const int G = gridDim.x, bx = blockIdx.x, NGW = G * NWAVES;
#define PH_IDS() int tid = threadIdx.x; asm volatile("" : "+v"(tid)); const int lane = tid & 63, wave = __builtin_amdgcn_readfirstlane(tid >> 6), gw = bx * NWAVES + wave; (void)lane; (void)gw; \
    KArgs ap = (KArgs)__builtin_amdgcn_kernarg_segment_ptr(); asm volatile("" : "+s"(ap)); unsigned char* const ws = ap->ws; float* const dout = ap->out; (void)ws; (void)dout;
#define AIN(i) (ap->in[i])
    const int lo = args.ph_lo, hi_ph = args.ph_hi;
    volatile LAS unsigned* bst = (volatile LAS unsigned*)(lds + RING_BYTES + 64);
    if (threadIdx.x < 2) bst[threadIdx.x] = 0u;
    __syncthreads();
    XcdBarrier xbar = xcd_barrier_post((unsigned*)(args.ws + WS_BAR), bst);
    cg::grid_group grid = cg::this_grid();
#ifndef PHMASK
#define PHMASK 0xFFFF
#endif
#define PEN(j) (((PHMASK) >> (j)) & 1)
#ifndef DUPMASK
#define DUPMASK 0
#endif
#define DUP(j) (((DUPMASK) >> (j)) & 1)
#define IN(k) (lo <= (k) && (k) < hi_ph)
#define SEAM(k) do { if (IN(k) && IN((k) + 1)) { if (lo < 0) grid.sync();     xcd_barrier(xbar); } } while (0)

    if (PEN(10) && IN(0)) { PH_IDS(); p0_prep(ap, lds, gw, NGW, wave, lane); if (DUP(10)) p0_prep(ap, lds, gw, NGW, wave, lane, true); SEAM(0); }

    for (int hf = 0; hf < 2; ++hf) {
        const int pb = 1 + hf * 10;
        if (PEN(0) && IN(pb + 0) && hf == 0) { PH_IDS(); for (int rep_ = 0; rep_ <= DUP(0); ++rep_) {
            const float* adab = AIN(8); const float* mod = WSF(WS_MOD);
            do_norm1(ap, 0, gw, NGW, lane);
            if (hf == 0) { float* modb = WSF(WS_MODB); for (int i = gw * 64 + lane; i < 9 * 6144; i += NGW * 64) modb[i] = mod[i] + adab[i % 6144];
                float* gam = WSF(WS_GAM); const float* n2 = AIN(10); for (int i = gw * 64 + lane; i < 9 * 1024; i += NGW * 64) { const int b = i >> 10, cc = i & 1023; gam[i] = n2[cc] * (1.0f + mod[b * 6144 + 4096 + cc] + adab[4096 + cc]); }
                float* shw = WSF(WS_SHW); const bf16_t* WUP = WSB(WS_WUP);
                for (int p = gw; p < UPW; p += NGW) {
                    const v4u w0 = *(const v4u*)(WUP + (size_t)p * DM + 16 * lane), w1 = *(const v4u*)(WUP + (size_t)p * DM + 16 * lane + 8);
                    float wv[16];
#pragma unroll
                    for (int q = 0; q < 4; ++q) { wv[2 * q] = bflo(w0[q]); wv[2 * q + 1] = bfhi(w0[q]); wv[8 + 2 * q] = bflo(w1[q]); wv[8 + 2 * q + 1] = bfhi(w1[q]); }
                    const int T = p >> 8, pl = p & 255, lc = T * 256 + ((pl >> 5) & 3) * 64 + (pl >> 7) * 32 + (pl & 31);
#pragma unroll 1
                    for (int b = 0; b < 9; ++b) { float s = 0.f;
#pragma unroll
                        for (int q = 0; q < 4; ++q) { const pg8::f32x4 a = *(const pg8::f32x4*)(mod + b * 6144 + 3072 + 16 * lane + 4 * q) + *(const pg8::f32x4*)(adab + 3072 + 16 * lane + 4 * q);
                            s += a[0] * wv[4 * q] + a[1] * wv[4 * q + 1] + a[2] * wv[4 * q + 2] + a[3] * wv[4 * q + 3]; }
                        s = wave_sum(s); if (lane == 0) shw[b * UPW + lc] = s; }
                }
            }
            }
            SEAM(pb + 0);
        }
        if (PEN(1) && IN(pb + 1)) { PH_IDS(); for (int rep_ = 0; rep_ <= DUP(1); ++rep_) {
            pg8::Gemm g{h1_buf(ws, dout, hf), WSB(WS_WIN), MH, INW, DM}; pg8::StaticOrder S; S.init(MH, INW, G, bx);
            float* nck = dout + (size_t)MTOT * DM; float* ncv = nck + (size_t)NPR * KVP;
            pg8::EpiInProj E{WSB(WS_Q), WSB(WS_K), WSB(WS_V), WSB(WS_RQ), WSB(WS_GF), WSB(WS_GB), WSB(WS_RI), WSB(WS_ZA), WSB(WS_PP), nck, ncv, AIN(12), AIN(13), WSF(WS_LBT), WSF(WS_ROPE), hf};
            pg8::gemm_phase<pg8::EpiInProj, pg8::StaticOrder, true, true>(lds, g, S, E);
            if (hf == 1) { const int rem = ((MH / 256) * (INW / 256)) % G;
                if (bx >= rem) do_final(ap, 0, (bx - rem) * NWAVES + wave, (G - rem) * NWAVES, lane); }
            }
            SEAM(pb + 1);
        }
        if (PEN(2) && IN(pb + 2)) { PH_IDS(); for (int rep_ = 0; rep_ <= DUP(2); ++rep_) {
            const int nlong = hf ? 80 : 48, nbig = hf ? 640 : 384, nshort = hf ? 0 : 256, nsmall = hf ? 0 : 256;
#ifndef DUPREC
#define DUPREC 0
#endif
#ifndef DUPATT
#define DUPATT 0
#endif
            const int ndl = DUPREC ? nlong : 0, nda = DUPATT ? nbig : 0;
            const int ntot = ndl + nda + nlong + nbig + nshort + nsmall;
            LAS int* slot = (LAS int*)(lds + RING_BYTES); unsigned* ctl = (unsigned*)(ws + WS_CTL);
            bf16_t* Qb = WSB(WS_Q); bf16_t* Kb = WSB(WS_K); bf16_t* Vb = WSB(WS_V); bf16_t* RQ = WSB(WS_RQ); bf16_t* GF = WSB(WS_GF); bf16_t* GB = WSB(WS_GB); bf16_t* RI = WSB(WS_RI);
            float* nst = dout + (size_t)MTOT * DM + 2 * (size_t)NPR * KVP;
            for (;;) {
                __syncthreads();
                if (tid == 0) *slot = (int)atomicAdd(ctl + 64 * hf + ((DUP(2) && rep_ == 0) ? 16 : 0), 1u);
                __syncthreads();
                int it = *slot;
                if (it >= ntot) break;
                bool wr = !(DUP(2) && rep_ == 0);
                if (it < ndl) wr = false; else { it -= ndl; if (it < nda) { wr = false; it += nlong; } else it -= nda; }
                if (it < nlong) {
                    const int b = it >> 4, rh = (it >> 1) & 7, dir = it & 1; const int bglob = hf ? 3 + b : b;
                    rec_scan(lds, RQ, dir ? GB : GF, RI, (hf ? 0 : NPR) + b * 2048, 2048, rh, dir, AIN(5) + (size_t)((bglob * 2 + dir) * 8 + rh) * 16384, nullptr, wr);
                } else if ((it -= nlong) < nbig) {
                    const int gq = it & 3, qb = (it >> 2) & 7, kvh = (it >> 5) & 3, b = it >> 7, h = kvh * 4 + gq;
                    const int lrow0 = (hf ? 0 : NPR) + b * 2048 + qb * 256, kvr0 = (hf ? 0 : NPR) + b * 2560;
                    attn_body::attn_unit<8>((const attn_body::bf16*)(Qb + (size_t)lrow0 * DM + h * 64), (const attn_body::bf16*)(Kb + (size_t)kvr0 * KVP + kvh * 64), (const attn_body::bf16*)(Vb + (size_t)kvr0 * KVP + kvh * 64),
                                            (attn_body::bf16*)(Qb + (size_t)lrow0 * DM + h * 64), 40, (char*)lds_raw, wr);
                } else if ((it -= nbig) < nshort) {
                    const int seq = it >> 4, rh = (it >> 1) & 7, dir = it & 1;
                    rec_scan(lds, RQ, dir ? GB : GF, RI, seq * 256, 256, rh, dir, nullptr, nst + (size_t)((seq * 2 + dir) * 8 + rh) * 16384, wr);
                } else {
                    it -= nshort; const int seq = it >> 4, h = it & 15, kvh = h >> 2;
                    attn_body::attn_unit<8>((const attn_body::bf16*)(Qb + (size_t)(seq * 256) * DM + h * 64), (const attn_body::bf16*)(Kb + (size_t)(seq * 256) * KVP + kvh * 64), (const attn_body::bf16*)(Vb + (size_t)(seq * 256) * KVP + kvh * 64),
                                            (attn_body::bf16*)(Qb + (size_t)(seq * 256) * DM + h * 64), 4, (char*)lds_raw, wr);
                }
            }
            if (DUP(2) && rep_ == 0) xcd_barrier(xbar);
            }
            SEAM(pb + 2);
        }
        if (PEN(3) && IN(pb + 3)) { PH_IDS(); for (int rep_ = 0; rep_ <= DUP(3); ++rep_) {
            const float* hg = AIN(15); bf16_t* Qb = WSB(WS_Q); bf16_t* ZA = WSB(WS_ZA); bf16_t* GF = WSB(WS_GF); bf16_t* GB = WSB(WS_GB); bf16_t* PP = WSB(WS_PP); bf16_t* H = WSB(WS_H);
            for (int r = gw; r < MH; r += NGW) {
                const size_t off = (size_t)r * DM + 16 * lane;
                v4u o[2], z[2], f[2], bq[2], p[2];
#pragma unroll
                for (int e = 0; e < 2; ++e) { o[e] = *(const v4u*)(Qb + off + 8 * e); z[e] = *(const v4u*)(ZA + off + 8 * e); f[e] = *(const v4u*)(GF + off + 8 * e); bq[e] = *(const v4u*)(GB + off + 8 * e); p[e] = *(const v4u*)(PP + off + 8 * e); }
                float s[16]; float ss = 0.f;
#pragma unroll
                for (int e = 0; e < 2; ++e)
#pragma unroll
                    for (int q = 0; q < 4; ++q) { s[8 * e + 2 * q] = bflo(f[e][q]) + bflo(bq[e][q]); s[8 * e + 2 * q + 1] = bfhi(f[e][q]) + bfhi(bq[e][q]); }
#pragma unroll
                for (int q = 0; q < 16; ++q) ss += s[q] * s[q];
                ss += __shfl_xor(ss, 1); ss += __shfl_xor(ss, 2); ss += __shfl_xor(ss, 4);
                const float rs = __builtin_amdgcn_rsqf(ss * (1.0f / 128.0f) + EPS);
                const int gc = (16 * lane) & 127;
                v4u outw[2];
#pragma unroll
                for (int e = 0; e < 2; ++e)
#pragma unroll
                    for (int q = 0; q < 4; ++q) {
                        const int i0 = 8 * e + 2 * q;
                        const float m0 = bflo(o[e][q]) * bflo(z[e][q]) + bflo(p[e][q]) * (s[i0] * rs * hg[gc + i0]);
                        const float m1 = bfhi(o[e][q]) * bfhi(z[e][q]) + bfhi(p[e][q]) * (s[i0 + 1] * rs * hg[gc + i0 + 1]);
                        outw[e][q] = pk2(m0, m1);
                    }
                *(v4u*)(H + off) = outw[0]; *(v4u*)(H + off + 8) = outw[1];
            }
            }
            SEAM(pb + 3);
        }
        if (PEN(4) && IN(pb + 4)) { PH_IDS(); for (int rep_ = 0; rep_ <= DUP(4); ++rep_) {
            pg8::Gemm g{WSB(WS_H), WSB(WS_WO), MH, DM, DM}; pg8::StaticOrder S; S.init(MH, DM, G, bx);
            pg8::EpiResidW E{AIN(0), AIN(1), dout, WSF(WS_MODB), WSF(WS_GAM), WSB(WS_H2), WSF(WS_ROWSS), 2048, hf};
            pg8::gemm_phase<pg8::EpiResidW, pg8::StaticOrder, true, true>(lds, g, S, E);
            }
            SEAM(pb + 4);
        }
        if (PEN(6) && IN(pb + 6)) { PH_IDS(); for (int rep_ = 0; rep_ <= DUP(6); ++rep_) {
            pg8::Gemm g{WSB(WS_H2), WSB(WS_WUP), MH, UPW, DM}; pg8::StaticOrder S; S.init(MH, UPW, G, bx);
            pg8::EpiUp E{WSB(WS_U), UPW, WSF(WS_ROWSS), WSF(WS_SHW), hf};
            pg8::gemm_phase<pg8::EpiUp, pg8::StaticOrder, true, true>(lds, g, S, E);
            }
            SEAM(pb + 6);
        }
        if (PEN(7) && IN(pb + 7)) { PH_IDS(); for (int rep_ = 0; rep_ <= DUP(7); ++rep_) {
            const float* cw = AIN(18); const float* cb = AIN(19); const bf16_t* U = WSB(WS_U); bf16_t* ACT = WSB(WS_ACT);
            for (int item = gw; item < (MH / 16) * 11; item += NGW) {
                const int run = item / 11, st = item - run * 11, r0 = run * 16, grow0 = hf * MH + r0;
                const int t0 = grow0 < NPR ? (grow0 & 255) : ((grow0 - NPR) & 2047); const int Ls = grow0 < NPR ? 256 : 2048;
                const int c = (st * 64 + lane) * 4;
                const pg8::f32x4 wa0 = *(const pg8::f32x4*)(cw + c), wa1 = *(const pg8::f32x4*)(cw + UPW + c), wa2 = *(const pg8::f32x4*)(cw + 2 * UPW + c), ba = *(const pg8::f32x4*)(cb + c);
                const pg8::f32x4 wb0 = *(const pg8::f32x4*)(cw + DFF + c), wb1 = *(const pg8::f32x4*)(cw + UPW + DFF + c), wb2 = *(const pg8::f32x4*)(cw + 2 * UPW + DFF + c), bb = *(const pg8::f32x4*)(cb + DFF + c);
                const bf16_t* up = U + (size_t)r0 * UPW + c;
                u32x2 pa = {0u, 0u}, pb2 = {0u, 0u};
                if (t0 > 0) { pa = *(const u32x2*)(up - UPW); pb2 = *(const u32x2*)(up - UPW + DFF); }
                u32x2 ca = *(const u32x2*)(up), cb2 = *(const u32x2*)(up + DFF);
#pragma unroll
                for (int i = 0; i < 16; ++i) {
                    u32x2 na = {0u, 0u}, nb = {0u, 0u};
                    if (t0 + i < Ls - 1) { na = *(const u32x2*)(up + (size_t)(i + 1) * UPW); nb = *(const u32x2*)(up + (size_t)(i + 1) * UPW + DFF); }
                    pg8::f32x4 a, b;
                    a[0] = wa0[0] * bflo(pa.x) + wa1[0] * bflo(ca.x) + wa2[0] * bflo(na.x) + ba[0]; a[1] = wa0[1] * bfhi(pa.x) + wa1[1] * bfhi(ca.x) + wa2[1] * bfhi(na.x) + ba[1];
                    a[2] = wa0[2] * bflo(pa.y) + wa1[2] * bflo(ca.y) + wa2[2] * bflo(na.y) + ba[2]; a[3] = wa0[3] * bfhi(pa.y) + wa1[3] * bfhi(ca.y) + wa2[3] * bfhi(na.y) + ba[3];
                    b[0] = wb0[0] * bflo(pb2.x) + wb1[0] * bflo(cb2.x) + wb2[0] * bflo(nb.x) + bb[0]; b[1] = wb0[1] * bfhi(pb2.x) + wb1[1] * bfhi(cb2.x) + wb2[1] * bfhi(nb.x) + bb[1];
                    b[2] = wb0[2] * bflo(pb2.y) + wb1[2] * bflo(cb2.y) + wb2[2] * bflo(nb.y) + bb[2]; b[3] = wb0[3] * bfhi(pb2.y) + wb1[3] * bfhi(cb2.y) + wb2[3] * bfhi(nb.y) + bb[3];
                    u32x2 wv; wv.x = pk2(fsilu(a[0]) * b[0], fsilu(a[1]) * b[1]); wv.y = pk2(fsilu(a[2]) * b[2], fsilu(a[3]) * b[3]);
                    *(u32x2*)(ACT + (size_t)(r0 + i) * DFF + c) = wv;
                    pa = ca; pb2 = cb2; ca = na; cb2 = nb;
                }
            }
            }
            SEAM(pb + 7);
        }
        if (PEN(8) && IN(pb + 8)) { PH_IDS(); for (int rep_ = 0; rep_ <= DUP(8); ++rep_) {
            pg8::Gemm g{WSB(WS_ACT), WSB(WS_WDN), MH, DM, DFF}; pg8::StaticOrder S; S.init(MH, DM, G, bx);
            pg8::EpiResid E{dout, dout + (size_t)NPR * DM, dout, WSF(WS_MODB), 5120, hf};
            pg8::gemm_phase<pg8::EpiResid, pg8::StaticOrder, true, true>(lds, g, S, E);
            if (hf == 0) { const int nun = (MH / 256) * (DM / 256); const int first = nun < G ? nun : 0;
                if (bx >= first) do_norm1(ap, 1, (bx - first) * NWAVES + wave, (G - first) * NWAVES, lane); }
            }
            SEAM(pb + 8);
        }
        if (PEN(9) && IN(pb + 9) && hf == 1) { PH_IDS(); do_final(ap, 1, gw, NGW, lane); }
    }
#undef IN
#undef SEAM
}

extern "C" void kernel_launch(void* const* d_in, const int* in_sizes, int n_in, void* d_out, int out_size, void* d_ws, size_t ws_size, hipStream_t stream) {
    static int grid = 0;
    if (grid == 0) {
        if (n_in != 22 || ws_size < WS_END) { fprintf(stderr, "kernel_launch: unexpected n_in %d / ws_size %zu\n", n_in, ws_size); grid = -1; return; }
        int dev = 0, cus = 0, per_cu = 0;
        hipGetDevice(&dev); hipDeviceGetAttribute(&cus, hipDeviceAttributeMultiprocessorCount, dev);
        if (hipFuncSetAttribute((const void*)fwd_mega, hipFuncAttributeMaxDynamicSharedMemorySize, LDS_BYTES) != hipSuccess) { fprintf(stderr, "kernel_launch: hipFuncSetAttribute failed\n"); grid = -1; return; }
        if (hipOccupancyMaxActiveBlocksPerMultiprocessor(&per_cu, (const void*)fwd_mega, NTHR, LDS_BYTES) != hipSuccess || per_cu < 1) { fprintf(stderr, "kernel_launch: occupancy query says %d\n", per_cu); per_cu = 1; }
        (void)hipGetLastError();
        grid = cus;
    }
    if (grid < 0) return;
    hipMemsetAsync((char*)d_ws + WS_CTL, 0, CTL_ZERO_BYTES, stream);
    Args a{};
    for (int i = 0; i < 22; ++i) a.in[i] = (const float*)d_in[i];
    a.out = (float*)d_out; a.ws = (unsigned char*)d_ws;
#if MK_SINGLE
    a.ph_lo = 0; a.ph_hi = N_PHASES;
    void* kargs[] = {&a};
    hipError_t e = hipLaunchCooperativeKernel((const void*)fwd_mega, dim3(grid), dim3(NTHR), kargs, LDS_BYTES, stream);
    if (e != hipSuccess) fprintf(stderr, "kernel_launch: cooperative launch failed: %s (grid %d)\n", hipGetErrorString(e), grid);
#else
    for (int p = 0; p < N_PHASES; ++p) { a.ph_lo = p; a.ph_hi = p + 1; hipLaunchKernelGGL(fwd_mega, dim3(grid), dim3(NTHR), LDS_BYTES, stream, a); }
#endif
}
```

```cpp
#include <hip/hip_runtime.h>
#include <hip/hip_cooperative_groups.h>
#include <hip/hip_bf16.h>
#include <cstdio>
#include <cstdint>
#include <cmath>
namespace cg = cooperative_groups;

constexpr int DM = 1024, NPR = 4096  , MTOT = 20480, MH = 10240  ;
constexpr int INW = 8704, DFF = 2816, UPW = 5632;
constexpr int KVP = 256;
constexpr float EPS = 1e-6f;
constexpr float QSCALE = 0.125f * 1.4426950408889634f;

#define GAS __attribute__((address_space(1)))
#define LAS __attribute__((address_space(3)))
typedef unsigned short bf16_t;
typedef float f32x2 __attribute__((ext_vector_type(2)));
typedef unsigned u32x2 __attribute__((ext_vector_type(2)));
typedef float f32x16 __attribute__((ext_vector_type(16)));

__device__ __forceinline__ float bf2f(unsigned short h) { return __uint_as_float(((unsigned)h) << 16); }
__device__ __forceinline__ float bflo(unsigned w) { return __uint_as_float(w << 16); }
__device__ __forceinline__ float bfhi(unsigned w) { return __uint_as_float(w & 0xffff0000u); }
__device__ __forceinline__ float fsigmoid(float x) { return __builtin_amdgcn_rcpf(1.0f + __expf(-x)); }
__device__ __forceinline__ float fsilu(float x) { return x * fsigmoid(x); }
__device__ __forceinline__ unsigned pkh2(float a, float b) { _Float16 ha = (_Float16)a, hb = (_Float16)b; return (unsigned)__builtin_bit_cast(unsigned short, ha) | ((unsigned)__builtin_bit_cast(unsigned short, hb) << 16); }
__device__ __forceinline__ float h2f(unsigned short h) { return (float)__builtin_bit_cast(_Float16, h); }
__device__ __forceinline__ float wave_sum(float v) {
#pragma unroll
    for (int o = 1; o < 64; o <<= 1) v += __shfl_xor(v, o);
    return v;
}
__device__ __forceinline__ int mod_of_row(int grow) { return grow < NPR ? 0 : 1 + ((grow - NPR) >> 11); }
__device__ __forceinline__ int kv_row(int grow, int hf) {
    if (grow < NPR) return grow;
    const int s = grow - NPR, b = s >> 11, t = s & 2047;
    return (hf ? (b - 3) * 2560 : NPR + b * 2560) + t;
}

namespace pg8 {
#define PG8_LAS __attribute__((address_space(3)))
typedef unsigned short bf16_t;
typedef short bf16x8 __attribute__((ext_vector_type(8)));
typedef float f32x4 __attribute__((ext_vector_type(4)));
typedef unsigned u32x4 __attribute__((ext_vector_type(4)));
constexpr int BM = 256, BK = 64, HALF = 128, HTB = HALF * BK * 2  , STAGE_BYTES = 8 * HTB, NXCD = 8, WGM = 8;

__host__ __device__ __forceinline__ int lds_byte(int r, int c) { const int st = (r >> 4) * 2 + (c >> 5), rr = r & 15, cc = c & 31, ob = rr * 64 + cc * 2; return st * 1024 + (ob ^ (((ob >> 9) & 1) << 5)); }
__host__ __device__ __forceinline__ void stage_rc(int b, int& R, int& C) { const int st = b / 1024, sb = b % 1024, swz = sb ^ (((sb >> 9) & 1) << 5); R = (st >> 1) * 16 + swz / 64; C = (st & 1) * 32 + (swz % 64) / 2; }
__host__ __device__ __forceinline__ int perm32(int rho) { const int n = rho >> 4, i = rho & 15; return 8 * (i >> 2) + 4 * n + (i & 3); }

struct Unit { int pm, pn; };
struct Gemm { const bf16_t* A; const bf16_t* Bt; int M, N, K; };

struct StaticOrder {
    int nM, nN, nwg, G, c;
    __host__ __device__ void init(int M, int N, int G_, int c_) { nM = M / BM; nN = N / BM; nwg = nM * nN; G = G_; c = c_; }
    __host__ __device__ bool next(int i, Unit& u) const {
        const long L = (long)i * G + c; if (L >= nwg) return false;
        int wgid = (int)L; { const int q = nwg / NXCD, r = nwg % NXCD, xcd = wgid % NXCD, off = wgid / NXCD; wgid = (xcd < r ? xcd * (q + 1) : r * (q + 1) + (xcd - r) * q) + off; }
        const int nig = WGM * nN, gid = wgid / nig, fm = gid * WGM, gsz = (nM - fm) < WGM ? (nM - fm) : WGM;
        u.pm = fm + ((wgid % nig) % gsz); u.pn = (wgid % nig) / gsz; return true;
    }
    __device__ __forceinline__ void a_ready(const Unit&) const {}
    __device__ __forceinline__ void done(const Unit&) const {}
};

__device__ __forceinline__ unsigned cvt_pk_bf16(float lo, float hi) { unsigned r; asm volatile("v_cvt_pk_bf16_f32 %0, %1, %2" : "=v"(r) : "v"(lo), "v"(hi)); return r; }
__device__ __forceinline__ u32x2 pk4(f32x4 v) { u32x2 w; w.x = cvt_pk_bf16(v[0], v[1]); w.y = cvt_pk_bf16(v[2], v[3]); return w; }

#define EPI_FENCE() asm volatile("" ::: "memory")
struct EpiInProj {
    static constexpr bool PERM = false, AFTER_DRAIN = false;
    bf16_t *Q, *Kb, *Vb, *RQ, *GF, *GB, *RI, *ZA, *PP; float *nck, *ncv; const float *qg, *kg, *lbt; const float* rope; int hf;
    __device__ __forceinline__ void operator()(const f32x4 (&acc)[2][2][4][2], const Unit& u, int wr, int wc, int fr, int fq) const {
        const int T = u.pn;
        const int lrow0 = u.pm * BM + wr * 64 + fr;
        if (T <= 4) {
            const bool isq = T < 4; const float* gain = (isq ? qg : kg) + 4 * fq;
#pragma unroll
            for (int ai = 0; ai < 2; ++ai)
#pragma unroll
                for (int m = 0; m < 4; ++m) {
                    const int lrow = lrow0 + ai * HALF + m * 16, grow = hf * MH + lrow;
                    float ss = 0.f;
#pragma unroll
                    for (int bj = 0; bj < 2; ++bj)
#pragma unroll
                        for (int n = 0; n < 2; ++n) { const f32x4 v = acc[ai][bj][m][n]; ss += (v[0] * v[0] + v[1] * v[1]) + (v[2] * v[2] + v[3] * v[3]); }
                    ss += __shfl_xor(ss, 16); ss += __shfl_xor(ss, 32);
                    const float rs = __builtin_amdgcn_rsqf(ss * (1.0f / 64.0f) + EPS);
                    const bool latent = grow >= NPR;
                    const int t = (grow - NPR) & 2047;
#pragma unroll
                    for (int bj = 0; bj < 2; ++bj) {
                        f32x4 x1 = acc[ai][bj][m][0] * rs * *(const f32x4*)(gain + 32 * bj), x2 = acc[ai][bj][m][1] * rs * *(const f32x4*)(gain + 32 * bj + 16);
                        if (latent) {
                            const int pos = bj ? (t & 63) : (t >> 6);
                            const f32x4 cs0 = *(const f32x4*)(rope + (pos * 16 + 4 * fq) * 2), cs1 = *(const f32x4*)(rope + (pos * 16 + 4 * fq) * 2 + 4);
                            const f32x4 c = {cs0[0], cs0[2], cs1[0], cs1[2]}, s = {cs0[1], cs0[3], cs1[1], cs1[3]};
                            const f32x4 y1 = x1 * c - x2 * s, y2 = x1 * s + x2 * c; x1 = y1; x2 = y2;
                        }
                        if (isq) {
                            bf16_t* qp = Q + (unsigned)(lrow * DM + (4 * T + wc) * 64 + 4 * fq + 32 * bj);
                            *(u32x2*)(qp) = pk4(x1 * QSCALE); *(u32x2*)(qp + 16) = pk4(x2 * QSCALE);
                        } else {
                            bf16_t* kp = Kb + (unsigned)(kv_row(grow, hf) * KVP + wc * 64 + 4 * fq + 32 * bj);
                            *(u32x2*)(kp) = pk4(x1); *(u32x2*)(kp + 16) = pk4(x2);
                            if (!latent) { float* op = nck + (unsigned)(grow * KVP + wc * 64 + 4 * fq + 32 * bj); *(f32x4*)(op) = x1; *(f32x4*)(op + 16) = x2; }
                        }
                    }
                    EPI_FENCE();
                }
        } else if (T == 5) {
#pragma unroll
            for (int ai = 0; ai < 2; ++ai)
#pragma unroll
                for (int m = 0; m < 4; ++m) {
                    const int lrow = lrow0 + ai * HALF + m * 16, grow = hf * MH + lrow;
                    bf16_t* vp = Vb + (unsigned)(kv_row(grow, hf) * KVP + wc * 64 + 4 * fq);
#pragma unroll
                    for (int bj = 0; bj < 2; ++bj)
#pragma unroll
                        for (int n = 0; n < 2; ++n) *(u32x2*)(vp + 32 * bj + 16 * n) = pk4(acc[ai][bj][m][n]);
                    if (grow < NPR) { float* op = ncv + (unsigned)(grow * KVP + wc * 64 + 4 * fq);
#pragma unroll
                        for (int bj = 0; bj < 2; ++bj)
#pragma unroll
                            for (int n = 0; n < 2; ++n) *(f32x4*)(op + 32 * bj + 16 * n) = acc[ai][bj][m][n]; }
                    EPI_FENCE();
                }
        } else if (T < 10) {
            bf16_t* base = RQ + (T - 6) * 256 + wc * 64;
#pragma unroll
            for (int ai = 0; ai < 2; ++ai)
#pragma unroll
                for (int m = 0; m < 4; ++m) { bf16_t* rp = base + (unsigned)((lrow0 + ai * HALF + m * 16) * DM + 4 * fq);
#pragma unroll
                    for (int bj = 0; bj < 2; ++bj)
#pragma unroll
                        for (int n = 0; n < 2; ++n) { const f32x4 v = acc[ai][bj][m][n]; f32x4 o;
#pragma unroll
                            for (int j = 0; j < 4; ++j) o[j] = fsilu(v[j]) * 0.08838834764831845f;
                            *(u32x2*)(rp + 32 * bj + 16 * n) = pk4(o); }
                    EPI_FENCE(); }
        } else if (T < 18) {
            const int d = T >= 14; const int colb = ((T - 10) & 3) * 256 + wc * 64;
            bf16_t* base = (d ? GB : GF) + colb; const float* lbp = lbt + d * 1024 + colb + 4 * fq;
#pragma unroll
            for (int ai = 0; ai < 2; ++ai)
#pragma unroll
                for (int m = 0; m < 4; ++m) { bf16_t* rp = base + (unsigned)((lrow0 + ai * HALF + m * 16) * DM + 4 * fq);
#pragma unroll
                    for (int bj = 0; bj < 2; ++bj)
#pragma unroll
                        for (int n = 0; n < 2; ++n) { const f32x4 v = acc[ai][bj][m][n]; const f32x4 lb = *(const f32x4*)(lbp + 32 * bj + 16 * n); float g[4];
#pragma unroll
                            for (int j = 0; j < 4; ++j) { const float l = lb[j]; g[j] = __logf(l + (1.0f - l) * fsigmoid(v[j])); }
                            u32x2 w; w.x = pkh2(g[0], g[1]); w.y = pkh2(g[2], g[3]); *(u32x2*)(rp + 32 * bj + 16 * n) = w; }
                    EPI_FENCE(); }
        } else if (T < 26) {
            const bool sig = T >= 22; bf16_t* base = (sig ? ZA : RI) + ((T - 18) & 3) * 256 + wc * 64;
#pragma unroll
            for (int ai = 0; ai < 2; ++ai)
#pragma unroll
                for (int m = 0; m < 4; ++m) { bf16_t* rp = base + (unsigned)((lrow0 + ai * HALF + m * 16) * DM + 4 * fq);
#pragma unroll
                    for (int bj = 0; bj < 2; ++bj)
#pragma unroll
                        for (int n = 0; n < 2; ++n) { f32x4 v = acc[ai][bj][m][n];
                            if (sig) {
#pragma unroll
                                for (int j = 0; j < 4; ++j) v[j] = fsigmoid(v[j]); }
                            *(u32x2*)(rp + 32 * bj + 16 * n) = pk4(v); }
                    EPI_FENCE(); }
        } else {
            bf16_t* base = PP + (T - 26) * 128 + wc * 32;
#pragma unroll
            for (int ai = 0; ai < 2; ++ai)
#pragma unroll
                for (int m = 0; m < 4; ++m) { bf16_t* rp = base + (unsigned)((lrow0 + ai * HALF + m * 16) * DM + 4 * fq);
#pragma unroll
                    for (int n = 0; n < 2; ++n) { const f32x4 a = acc[ai][0][m][n], b = acc[ai][1][m][n]; f32x4 o;
#pragma unroll
                        for (int j = 0; j < 4; ++j) o[j] = fsilu(a[j]) * fsigmoid(b[j]);
                        *(u32x2*)(rp + 16 * n) = pk4(o); }
                    EPI_FENCE(); }
        }
    }
};

struct EpiResid {
    static constexpr bool PERM = false, AFTER_DRAIN = false;
    const float* basep; const float* bases; float* out; const float* modb; int goff; int hf;
    __device__ __forceinline__ void operator()(const f32x4 (&acc)[2][2][4][2], const Unit& u, int wr, int wc, int fr, int fq) const {
        const int grow0 = hf * MH + u.pm * BM; const int mi = mod_of_row(grow0);
        const int col0 = u.pn * BM + wc * 64 + 4 * fq;
        const float* base = grow0 < NPR ? basep + (size_t)grow0 * DM : bases + (size_t)(grow0 - NPR) * DM;
        float* ob = out + (size_t)grow0 * DM;
        const float* gp = modb + mi * 6144 + goff + col0;
#pragma unroll
        for (int ai = 0; ai < 2; ++ai)
#pragma unroll
            for (int m = 0; m < 4; ++m) { const unsigned off = (unsigned)((ai * HALF + wr * 64 + m * 16 + fr) * DM + col0);
#pragma unroll
                for (int bj = 0; bj < 2; ++bj)
#pragma unroll
                    for (int n = 0; n < 2; ++n) { const f32x4 b = *(const f32x4*)(base + off + 32 * bj + 16 * n); const f32x4 gt = *(const f32x4*)(gp + 32 * bj + 16 * n);
                        *(f32x4*)(ob + off + 32 * bj + 16 * n) = b + gt * acc[ai][bj][m][n]; }
                EPI_FENCE(); }
    }
};

struct EpiResidW {
    static constexpr bool PERM = false, AFTER_DRAIN = false;
    const float* basep; const float* bases; float* out; const float* modb; const float* gam; bf16_t* Hn; float* rowss; int goff; int hf;
    __device__ __forceinline__ void operator()(const f32x4 (&acc)[2][2][4][2], const Unit& u, int wr, int wc, int fr, int fq) const {
        const int grow0 = hf * MH + u.pm * BM; const int mi = mod_of_row(grow0);
        const int col0 = u.pn * BM + wc * 64 + 4 * fq;
        const float* base = grow0 < NPR ? basep + (size_t)grow0 * DM : bases + (size_t)(grow0 - NPR) * DM;
        float* ob = out + (size_t)grow0 * DM; bf16_t* hb = Hn + (size_t)(u.pm * BM) * DM; float* rs = rowss + grow0;
        const float* gp = modb + mi * 6144 + goff + col0; const float* gm = gam + mi * 1024 + col0;
#pragma unroll
        for (int ai = 0; ai < 2; ++ai)
#pragma unroll
            for (int m = 0; m < 4; ++m) { const int r = ai * HALF + wr * 64 + m * 16 + fr; const unsigned off = (unsigned)(r * DM + col0); float ss = 0.f;
#pragma unroll
                for (int bj = 0; bj < 2; ++bj)
#pragma unroll
                    for (int n = 0; n < 2; ++n) { const f32x4 b = *(const f32x4*)(base + off + 32 * bj + 16 * n); const f32x4 gt = *(const f32x4*)(gp + 32 * bj + 16 * n); const f32x4 gg = *(const f32x4*)(gm + 32 * bj + 16 * n);
                        const f32x4 x1 = b + gt * acc[ai][bj][m][n];
                        *(f32x4*)(ob + off + 32 * bj + 16 * n) = x1; *(u32x2*)(hb + off + 32 * bj + 16 * n) = pk4(x1 * gg);
                        ss += (x1[0] * x1[0] + x1[1] * x1[1]) + (x1[2] * x1[2] + x1[3] * x1[3]); }
                ss += __shfl_xor(ss, 16); ss += __shfl_xor(ss, 32);
                if (fq == 0) atomicAdd(rs + r, ss);
                EPI_FENCE(); }
    }
};

struct EpiUp {
    static constexpr bool PERM = false, AFTER_DRAIN = false;
    bf16_t* O; int ldc; const float* rowss; const float* shw; int hf;
    __device__ __forceinline__ void operator()(const f32x4 (&acc)[2][2][4][2], const Unit& u, int wr, int wc, int fr, int fq) const {
        const int grow0 = hf * MH + u.pm * BM; const int mi = mod_of_row(grow0);
        bf16_t* base = O + (size_t)(u.pm * BM) * ldc + u.pn * BM + wc * 64; const float* sp = shw + mi * UPW + u.pn * BM + wc * 64 + 4 * fq; const float* rs = rowss + grow0;
#pragma unroll
        for (int ai = 0; ai < 2; ++ai)
#pragma unroll
            for (int m = 0; m < 4; ++m) { const int r = ai * HALF + wr * 64 + m * 16 + fr; bf16_t* rp = base + (unsigned)(r * ldc + 4 * fq);
                const float rstd = __builtin_amdgcn_rsqf(rs[r] * (1.0f / 1024.0f) + EPS);
#pragma unroll
                for (int bj = 0; bj < 2; ++bj)
#pragma unroll
                    for (int n = 0; n < 2; ++n) *(u32x2*)(rp + 32 * bj + 16 * n) = pk4(acc[ai][bj][m][n] * rstd + *(const f32x4*)(sp + 32 * bj + 16 * n));
                EPI_FENCE(); }
    }
};

struct EpiPlain {
    static constexpr bool PERM = false, AFTER_DRAIN = false;
    bf16_t* O; int ldc;
    __device__ __forceinline__ void operator()(const f32x4 (&acc)[2][2][4][2], const Unit& u, int wr, int wc, int fr, int fq) const {
        bf16_t* base = O + u.pn * BM + wc * 64 + 4 * fq;
#pragma unroll
        for (int ai = 0; ai < 2; ++ai)
#pragma unroll
            for (int m = 0; m < 4; ++m) { bf16_t* rp = base + (size_t)(u.pm * BM + ai * HALF + wr * 64 + m * 16 + fr) * ldc;
#pragma unroll
                for (int bj = 0; bj < 2; ++bj)
#pragma unroll
                    for (int n = 0; n < 2; ++n) *(u32x2*)(rp + 32 * bj + 16 * n) = pk4(acc[ai][bj][m][n]); }
    }
};

template <class Epi, class Sched, bool ALIGN_EPI = false, bool SP2 = false>
__device__ __forceinline__ void gemm_phase(PG8_LAS unsigned char* lds, const Gemm g, const Sched& S, const Epi& E) {
    int tid_o = threadIdx.x; asm volatile("" : "+v"(tid_o));
    const int tid = tid_o, wid = __builtin_amdgcn_readfirstlane(tid >> 6), lane = tid & 63, wr = wid >> 2, wc = wid & 3, fr = lane & 15, fq = lane >> 4;
    const int K = g.K, nt = K / BK;
    unsigned voffA[2], voffB[2];
#pragma unroll
    for (int i = 0; i < 2; ++i) { int R, C; stage_rc(tid * 16 + i * 8192, R, C); const int Rb = Epi::PERM ? ((R & ~31) + perm32(R & 31)) : R;
        voffA[i] = (unsigned)(R * K + C) * 2u; voffB[i] = (unsigned)(Rb * K + C) * 2u; }
    const size_t kstep = (size_t)(BK * 2);
    const size_t hstep = (size_t)HALF * K * 2;
    const size_t tstep = 2 * hstep;
    const unsigned ldsw = (unsigned)wid * 1024u;
    const int aoff = lds_byte(wr * 64 + fr, fq * 8), boff = lds_byte(wc * 32 + fr, fq * 8);
#define PG8_SA(b, h) (((b) * 2 + (h)) * HTB)
#define PG8_SB(b, h) ((4 + (b) * 2 + (h)) * HTB)
#define PG8_STAGE(bufoff, gbase, voff) do { _Pragma("unroll") for (int _i = 0; _i < 2; ++_i) \
        __builtin_amdgcn_global_load_lds((const unsigned*)((const char*)(gbase) + (voff)[_i]), (PG8_LAS unsigned*)(lds + (bufoff) + ldsw + _i * 8192), 16, 0, 0); } while (0)
#define PG8_LDA(dst, b, h) do { _Pragma("unroll") for (int m = 0; m < 4; ++m) _Pragma("unroll") for (int k = 0; k < 2; ++k) dst[m][k] = *(const PG8_LAS bf16x8*)(lds + PG8_SA(b, h) + aoff + m * 2048 + k * 1024); } while (0)
#define PG8_LDB(dst, b, h) do { _Pragma("unroll") for (int n = 0; n < 2; ++n) _Pragma("unroll") for (int k = 0; k < 2; ++k) dst[n][k] = *(const PG8_LAS bf16x8*)(lds + PG8_SB(b, h) + boff + n * 2048 + k * 1024); } while (0)
#define PG8_MMA(ai, bj, At, Bt) do { __builtin_amdgcn_s_setprio(1); _Pragma("unroll") for (int m = 0; m < 4; ++m) _Pragma("unroll") for (int n = 0; n < 2; ++n) _Pragma("unroll") for (int k = 0; k < 2; ++k) \
        acc[ai][bj][m][n] = __builtin_amdgcn_mfma_f32_16x16x32_bf16(Bt[n][k], At[m][k], acc[ai][bj][m][n], 0, 0, 0); __builtin_amdgcn_s_setprio(0); } while (0)
#define PG8_WAIT_V(n) asm volatile("s_waitcnt vmcnt(" #n ")" ::: "memory")
#define PG8_WAIT_L(n) asm volatile("s_waitcnt lgkmcnt(" #n ")" ::: "memory")
#define PG8_BAR __builtin_amdgcn_s_barrier()
#define PG8_SCHED __builtin_amdgcn_sched_barrier(0)
    Unit cur, nxt; int ui = 0;
    if (!S.next(0, cur)) return;
    f32x4 acc[2][2][4][2];
#pragma unroll
    for (int a = 0; a < 2; ++a)
#pragma unroll
        for (int b = 0; b < 2; ++b)
#pragma unroll
            for (int m = 0; m < 4; ++m)
#pragma unroll
                for (int n = 0; n < 2; ++n) acc[a][b][m][n] = (f32x4){0.f, 0.f, 0.f, 0.f};
    bf16x8 At[4][2], B0[2][2], B1[2][2];
    const char* cA = (const char*)g.A + (size_t)cur.pm * tstep; const char* cB = (const char*)g.Bt + (size_t)cur.pn * tstep;
    S.a_ready(cur);
    if constexpr (SP2) {
        PG8_STAGE(PG8_SB(0, 0), cB, voffB); PG8_STAGE(PG8_SB(0, 1), cB + hstep, voffB); PG8_STAGE(PG8_SA(0, 0), cA, voffA); PG8_STAGE(PG8_SA(0, 1), cA + hstep, voffA);
        if (wr == 1) PG8_BAR;
        PG8_WAIT_V(2); PG8_BAR;
        PG8_STAGE(PG8_SB(1, 0), cB + kstep, voffB); PG8_STAGE(PG8_SA(1, 0), cA + kstep, voffA); PG8_STAGE(PG8_SB(1, 1), cB + hstep + kstep, voffB);
        PG8_WAIT_V(6); PG8_BAR;
    } else {
        PG8_STAGE(PG8_SB(0, 0), cB, voffB); PG8_STAGE(PG8_SA(0, 0), cA, voffA); PG8_STAGE(PG8_SB(0, 1), cB + hstep, voffB); PG8_STAGE(PG8_SA(0, 1), cA + hstep, voffA);
        if (wr == 1) PG8_BAR;
        PG8_WAIT_V(4); PG8_BAR;
        PG8_STAGE(PG8_SB(1, 0), cB + kstep, voffB); PG8_STAGE(PG8_SA(1, 0), cA + kstep, voffA); PG8_STAGE(PG8_SB(1, 1), cB + hstep + kstep, voffB);
        PG8_WAIT_V(6); PG8_BAR;
    }
    for (;;) {
        const bool has_next = S.next(ui + 1, nxt);
        const char* nA = has_next ? (const char*)g.A + (size_t)nxt.pm * tstep : cA; const char* nB = has_next ? (const char*)g.Bt + (size_t)nxt.pn * tstep : cB;
        for (int t = 0; t < nt; t += 2) {
            const bool last = (t == nt - 2);
            const char* a1 = cA + (size_t)(t + 1) * kstep;
            const char* a2 = last ? nA : cA + (size_t)(t + 2) * kstep; const char* b2 = last ? nB : cB + (size_t)(t + 2) * kstep;
            const char* a3 = a2 + kstep; const char* b3 = b2 + kstep;
            if (last && has_next) S.a_ready(nxt);
            if constexpr (SP2) {
            PG8_LDB(B0, 0, 0); PG8_LDB(B1, 0, 1); PG8_SCHED; PG8_LDA(At, 0, 0); PG8_STAGE(PG8_SA(1, 1), a1 + hstep, voffA);
            PG8_WAIT_V(8); PG8_WAIT_L(0); PG8_BAR; PG8_MMA(0, 0, At, B0); PG8_MMA(0, 1, At, B1); PG8_BAR; PG8_SCHED;
            PG8_LDA(At, 0, 1); PG8_STAGE(PG8_SB(0, 0), b2, voffB); PG8_STAGE(PG8_SB(0, 1), b2 + hstep, voffB); PG8_STAGE(PG8_SA(0, 0), a2, voffA);
            PG8_WAIT_V(8); PG8_WAIT_L(0); PG8_BAR; PG8_MMA(1, 0, At, B0); PG8_MMA(1, 1, At, B1); PG8_BAR; PG8_SCHED;
            PG8_LDB(B0, 1, 0); PG8_LDB(B1, 1, 1); PG8_SCHED; PG8_LDA(At, 1, 0); PG8_STAGE(PG8_SA(0, 1), a2 + hstep, voffA);
            PG8_WAIT_V(8); PG8_WAIT_L(0); PG8_BAR; PG8_MMA(0, 0, At, B0); PG8_MMA(0, 1, At, B1); PG8_BAR; PG8_SCHED;
            PG8_LDA(At, 1, 1); PG8_STAGE(PG8_SB(1, 0), b3, voffB); PG8_STAGE(PG8_SB(1, 1), b3 + hstep, voffB); PG8_STAGE(PG8_SA(1, 0), a3, voffA);
            PG8_WAIT_V(8); PG8_WAIT_L(0); PG8_BAR; PG8_MMA(1, 0, At, B0); PG8_MMA(1, 1, At, B1); PG8_BAR; PG8_SCHED;
            } else {
            PG8_LDB(B0, 0, 0); PG8_SCHED; PG8_LDA(At, 0, 0); PG8_STAGE(PG8_SA(1, 1), a1 + hstep, voffA);
            PG8_WAIT_L(8); PG8_BAR; PG8_WAIT_L(0); PG8_MMA(0, 0, At, B0); PG8_BAR; PG8_SCHED;
            PG8_LDB(B1, 0, 1); PG8_STAGE(PG8_SB(0, 0), b2, voffB);
            PG8_BAR; PG8_WAIT_L(0); PG8_MMA(0, 1, At, B1); PG8_BAR;
            PG8_LDA(At, 0, 1); PG8_STAGE(PG8_SA(0, 0), a2, voffA);
            PG8_BAR; PG8_WAIT_L(0); PG8_MMA(1, 0, At, B0); PG8_BAR; PG8_SCHED;
            PG8_STAGE(PG8_SB(0, 1), b2 + hstep, voffB);
            PG8_WAIT_V(6); PG8_BAR; PG8_MMA(1, 1, At, B1); PG8_BAR;
            PG8_LDB(B0, 1, 0); PG8_SCHED; PG8_LDA(At, 1, 0); PG8_STAGE(PG8_SA(0, 1), a2 + hstep, voffA);
            PG8_WAIT_L(8); PG8_BAR; PG8_WAIT_L(0); PG8_MMA(0, 0, At, B0); PG8_BAR; PG8_SCHED;
            PG8_LDB(B1, 1, 1); PG8_STAGE(PG8_SB(1, 0), b3, voffB);
            PG8_BAR; PG8_WAIT_L(0); PG8_MMA(0, 1, At, B1); PG8_BAR;
            PG8_LDA(At, 1, 1); PG8_STAGE(PG8_SA(1, 0), a3, voffA);
            PG8_BAR; PG8_WAIT_L(0); PG8_MMA(1, 0, At, B0); PG8_BAR; PG8_SCHED;
            PG8_STAGE(PG8_SB(1, 1), b3 + hstep, voffB);
            PG8_WAIT_V(6); PG8_BAR; PG8_MMA(1, 1, At, B1); PG8_BAR;
            }
        }
        if constexpr (ALIGN_EPI) { if (wr == 0) PG8_BAR; }
        if constexpr (!Epi::AFTER_DRAIN) { E(acc, cur, wr, wc, fr, fq); S.done(cur); }
        if (!has_next) break;
#pragma unroll
        for (int a = 0; a < 2; ++a)
#pragma unroll
            for (int b = 0; b < 2; ++b)
#pragma unroll
                for (int m = 0; m < 4; ++m)
#pragma unroll
                    for (int n = 0; n < 2; ++n) acc[a][b][m][n] = (f32x4){0.f, 0.f, 0.f, 0.f};
        cur = nxt; cA = nA; cB = nB; ++ui;
        if constexpr (ALIGN_EPI) { if (wr == 1) PG8_BAR; }
    }
    PG8_WAIT_V(0);
    if constexpr (!ALIGN_EPI) { if (wr == 0) PG8_BAR; }
    PG8_BAR;
    if constexpr (Epi::AFTER_DRAIN) { E.fused(acc, cur, wr, wc, fr, fq, lds, wid, lane); S.done(cur); }
#undef PG8_SA
#undef PG8_SB
#undef PG8_STAGE
#undef PG8_LDA
#undef PG8_LDB
#undef PG8_MMA
#undef PG8_WAIT_V
#undef PG8_WAIT_L
#undef PG8_BAR
#undef PG8_SCHED
}
}

namespace attn_body {
using bf16=__hip_bfloat16;
using bf16x8=__attribute__((ext_vector_type(8)))short;
using s16x4=__attribute__((ext_vector_type(4)))short;
using f32x16=__attribute__((ext_vector_type(16)))float;
using u32x4=__attribute__((ext_vector_type(4)))unsigned;
constexpr int NHEAD=16,D=64,DM=NHEAD*D,KVPITCH=256;
constexpr int NW=8,QBLK=32,QB=QBLK*NW,KVBLK=64;
constexpr int ATTN_PITCH=DM, ATTN_UNIT_ROWS=QB;
__device__ __forceinline__ int crow(int r,int hi){return (r&3)+8*(r>>2)+4*hi;}
#define SBAR() __builtin_amdgcn_sched_barrier(0)
__device__ __forceinline__ void cmask(f32x16&p0,f32x16&p1,int jb,int qrel,int hi){
  const float NEG=-INFINITY; int kb=64*jb+4*hi;
  #pragma unroll
  for(int r=0;r<16;++r){int kv=kb+(r&3)+8*(r>>2); if(kv>qrel)p0[r]=NEG; if(kv+32>qrel)p1[r]=NEG;}
}

constexpr int NSLOT=3, SLOTB=8192;
constexpr int LDS_K=0, LDS_V=NSLOT*SLOTB, LDS_WS=2*NSLOT*SLOTB, LDS_OST=LDS_WS+NW*64*4, LDS_BYTES=LDS_OST+NW*4096;
constexpr float C2=0.125f*1.4426950408889634f;
__device__ __forceinline__ void glds16(const void*gsrc,unsigned lds_dst){unsigned keep;
  asm volatile("s_mov_b32 %0, m0\n\ts_mov_b32 m0, %2\n\ts_nop 0\n\tglobal_load_lds_dwordx4 %1, off\n\ts_mov_b32 m0, %0":"=&s"(keep):"v"(gsrc),"s"(lds_dst):"memory");}
__device__ __forceinline__ float max3f(float a,float b,float c){float r;asm("v_max3_f32 %0, %1, %2, %3":"=v"(r):"v"(a),"v"(b),"v"(c));return r;}
__device__ __forceinline__ float max2f(float a,float b){float r;asm("v_max_f32_e32 %0, %1, %2":"=v"(r):"v"(a),"v"(b));return r;}
__device__ __forceinline__ float fadd_s(float a,float b){float r;asm("v_add_f32_e32 %0, %1, %2":"=v"(r):"v"(a),"v"(b));return r;}
__device__ __forceinline__ float fsub_s(float a,float b){float r;asm("v_sub_f32_e32 %0, %1, %2":"=v"(r):"v"(a),"v"(b));return r;}
typedef float f32x2_t __attribute__((ext_vector_type(2))); typedef __bf16 bf16x2_t __attribute__((ext_vector_type(2)));
__device__ __forceinline__ unsigned cvtpk_s(float lo,float hi){f32x2_t v={lo,hi};bf16x2_t b=__builtin_convertvector(v,bf16x2_t);return __builtin_bit_cast(unsigned,b);}
#define WAIT_BAR(N) asm volatile("s_waitcnt vmcnt(" #N ") lgkmcnt(0)\n\ts_barrier":::"memory")

__device__ __forceinline__ void qkt(f32x16&p0,f32x16&p1,const char*Kslot,const bf16x8*qr,const f32x16&negm,int r32,int hi){
  const char*kb=Kslot+hi*1024+r32*16;
  #pragma unroll
  for(int d0=0;d0<4;++d0){
    const bf16x8 b0=*reinterpret_cast<const bf16x8*>(kb+d0*2048);
    const bf16x8 b1=*reinterpret_cast<const bf16x8*>(kb+d0*2048+512);
    if(d0==0){p0=__builtin_amdgcn_mfma_f32_32x32x16_bf16(b0,qr[0],negm,0,0,0);p1=__builtin_amdgcn_mfma_f32_32x32x16_bf16(b1,qr[0],negm,0,0,0);}
    else{p0=__builtin_amdgcn_mfma_f32_32x32x16_bf16(b0,qr[d0],p0,0,0,0);p1=__builtin_amdgcn_mfma_f32_32x32x16_bf16(b1,qr[d0],p1,0,0,0);}}
}
typedef __attribute__((address_space(3))) const char* lds_cptr;
typedef short v4i16_t __attribute__((ext_vector_type(4)));
__device__ __forceinline__ void kload8(bf16x8*kf,lds_cptr kp){
  kf[0]=*(const __attribute__((address_space(3))) bf16x8*)(kp);      kf[1]=*(const __attribute__((address_space(3))) bf16x8*)(kp+512);
  kf[2]=*(const __attribute__((address_space(3))) bf16x8*)(kp+2048); kf[3]=*(const __attribute__((address_space(3))) bf16x8*)(kp+2560);
  kf[4]=*(const __attribute__((address_space(3))) bf16x8*)(kp+4096); kf[5]=*(const __attribute__((address_space(3))) bf16x8*)(kp+4608);
  kf[6]=*(const __attribute__((address_space(3))) bf16x8*)(kp+6144); kf[7]=*(const __attribute__((address_space(3))) bf16x8*)(kp+6656);
}
__device__ __forceinline__ void kload2(bf16x8*kf,lds_cptr kp,int j){ kf[2*j]=*(const __attribute__((address_space(3))) bf16x8*)(kp+j*2048); kf[2*j+1]=*(const __attribute__((address_space(3))) bf16x8*)(kp+j*2048+512); }
__device__ __forceinline__ s16x4 vtr(lds_cptr p){ return __builtin_bit_cast(s16x4,__builtin_amdgcn_ds_read_tr16_b64_v4i16((__attribute__((address_space(3))) v4i16_t*)p)); }
__device__ __forceinline__ float rowmax(const f32x16&p0,const f32x16&p1){
  float a=max3f(p0[0],p0[1],p1[0]),b=max3f(p0[2],p0[3],p1[1]);a=max3f(a,p1[2],p1[3]);
  #pragma unroll
  for(int r=4;r<16;r+=4){a=max3f(a,p0[r],p0[r+1]);b=max3f(b,p0[r+2],p0[r+3]);a=max3f(a,p1[r],p1[r+1]);b=max3f(b,p1[r+2],p1[r+3]);}
  const float m=max2f(a,b);
  auto rr=__builtin_amdgcn_permlane32_swap(__float_as_uint(m),__float_as_uint(m),false,false);
  return max2f(__uint_as_float(rr[0]),__uint_as_float(rr[1]));
}
__device__ __forceinline__ void pv(f32x16*o,int vb,bf16x8 pa0,bf16x8 pa1,bf16x8 pa2,bf16x8 pa3){
  #pragma unroll
  for(int d0=0;d0<2;++d0){s16x4 lo[4],hi[4];
    #pragma unroll
    for(int ks=0;ks<4;++ks){
      asm volatile("ds_read_b64_tr_b16 %0,%1 offset:%c2":"=&v"(lo[ks]):"v"(vb),"i"(d0*4096+ks*1024):"memory");
      asm volatile("ds_read_b64_tr_b16 %0,%1 offset:%c2":"=&v"(hi[ks]):"v"(vb),"i"(d0*4096+ks*1024+512):"memory");}
    asm volatile("s_waitcnt lgkmcnt(0)":::"memory");SBAR();
    #define PK(k) (bf16x8){lo[k][0],lo[k][1],lo[k][2],lo[k][3],hi[k][0],hi[k][1],hi[k][2],hi[k][3]}
    o[d0]=__builtin_amdgcn_mfma_f32_32x32x16_bf16(pa0,PK(0),o[d0],0,0,0);
    o[d0]=__builtin_amdgcn_mfma_f32_32x32x16_bf16(pa1,PK(1),o[d0],0,0,0);
    o[d0]=__builtin_amdgcn_mfma_f32_32x32x16_bf16(pa2,PK(2),o[d0],0,0,0);
    o[d0]=__builtin_amdgcn_mfma_f32_32x32x16_bf16(pa3,PK(3),o[d0],0,0,0);
    #undef PK
  }
}

#ifndef ATTN_STORE16
#define ATTN_STORE16(p,v) (*(u32x4*)(p)=(v))
#endif
template<int THRL> __device__ __forceinline__ void attn_unit(const bf16*Qu,const bf16*__restrict__ Kh,const bf16*__restrict__ Vh,bf16*Ou,const int NT,char*shm,const bool wr_=true){
  int tid_o=threadIdx.x; asm volatile("":"+v"(tid_o));
  const int tid=tid_o,lane=tid&63,r32=lane&31,hi=lane>>5; const int wid=__builtin_amdgcn_readfirstlane(tid>>6);
  const bf16*Qw=Qu+(long)(wid*QBLK)*DM;
  const unsigned lds0=(unsigned)(uintptr_t)shm;
  float*wsf=(float*)(shm+LDS_WS)+wid*64;
  const bf16*ksrc=Kh+(long)lane*KVPITCH+wid*8;
  const bf16*vsrc=Vh+(long)(16*(wid&3)+(lane>>2))*KVPITCH+(wid>>2)*32+(lane&3)*8;
  const unsigned kdst=lds0+LDS_K+wid*1024, vdst=lds0+LDS_V+wid*1024;
  #define DMA_K(t,slot) glds16(ksrc+(long)(t)*KVBLK*KVPITCH,(unsigned)__builtin_amdgcn_readfirstlane(kdst+(slot)))
  #define DMA_V(t,slot) glds16(vsrc+(long)(t)*KVBLK*KVPITCH,(unsigned)__builtin_amdgcn_readfirstlane(vdst+(slot)))
  const int vb0=(int)(lds0+LDS_V)+((lane>>4)&1)*32+(lane&3)*8+(4*hi+((lane&15)>>2))*64;
  const char*Kbase=shm+LDS_K; bf16x8 kf[8];
  const lds_cptr shm3=(lds_cptr)shm; const lds_cptr kp0=shm3+LDS_K+hi*1024+r32*16; const lds_cptr vp0=shm3+LDS_V+((lane>>4)&1)*32+(lane&3)*8+(4*hi+((lane&15)>>2))*64;
  DMA_K(0,0);DMA_V(0,0);DMA_K(1,SLOTB);
  bf16x8 qr[4];
  #pragma unroll
  for(int d0=0;d0<4;++d0)qr[d0]=*reinterpret_cast<const bf16x8*>(&Qw[(long)r32*DM+d0*16+hi*8]);
  float mhat=0.f,l_reg=0.f;f32x16 o[2];o[0]=f32x16{};o[1]=f32x16{};f32x16 negm=f32x16{};asm volatile("":"+v"(negm));
  #define CMASK(P0,P1,t) do{}while(0)
  bool resc=false;
  #define START(P0,P1) do{ const float rm=rowmax(P0,P1); resc=false; \
    { const float dl=rm; mhat=fadd_s(mhat,dl); \
      _Pragma("unroll") for(int r=0;r<16;++r){P0[r]=fsub_s(P0[r],dl);P1[r]=fsub_s(P1[r],dl);} \
      _Pragma("unroll") for(int r=0;r<16;++r)negm[r]=-mhat; asm volatile("":"+v"(negm)); } \
    _Pragma("unroll") for(int r=0;r<16;++r)P0[r]=__builtin_amdgcn_exp2f(P0[r]); }while(0)
  #define RESC() do{ if(resc){ asm volatile("s_waitcnt lgkmcnt(0)":::"memory"); \
      _Pragma("unroll") for(int d_=0;d_<2;++d_) _Pragma("unroll") for(int r=0;r<16;++r)o[d_][r]*=wsf[crow(r,hi)]; } }while(0)
  f32x16 pA0,pA1,pB0,pB1;
  int sl_prev=0,sl_cur=0,sl_next=SLOTB;
  #define ROT() do{sl_prev=sl_cur;sl_cur=sl_next;sl_next=(sl_next==(NSLOT-1)*SLOTB)?0:sl_next+SLOTB;}while(0)
  DMA_K(2,2*SLOTB);
  WAIT_BAR(3);
  qkt(pA0,pA1,Kbase,qr,negm,r32,hi);asm volatile("s_nop 15\n\ts_nop 7":"+v"(pA0),"+v"(pA1));CMASK(pA0,pA1,0);
  START(pA0,pA1);
  _Pragma("unroll") for(int r=0;r<16;++r)pA1[r]=__builtin_amdgcn_exp2f(pA1[r]);
  WAIT_BAR(0);
  DMA_K(3,0);DMA_V(1,SLOTB);
  ROT();
  kload8(kf,kp0+sl_cur);
  WAIT_BAR(2);
  s16x4 vlo[8],vhi[8]; u32x4 pw0,pw1,pw2,pw3;
  #define PKW(P,B) cvtpk_s(P[B],P[B+1])
  #define PAF(k) __builtin_bit_cast(bf16x8,pw##k)
  #define VFR(i) (bf16x8){vlo[i][0],vlo[i][1],vlo[i][2],vlo[i][3],vhi[i][0],vhi[i][1],vhi[i][2],vhi[i][3]}
  #define PIN(x) asm volatile("":"+v"(x))
  #define MX3(a,b,c) __builtin_fmaxf(__builtin_fmaxf((a),(b)),(c))
  #define GAPA(MF,A0,A1,A2,A3,W0,W1,PW) do{ MF; sacc+=A0; sacc+=A1; sacc+=A2; sacc+=A3; PIN(sacc); W0; W1; PIN(PW); SBAR(); }while(0)
  #define EX(v) __builtin_amdgcn_exp2f(v)
  #define GAPB(MF,X,B) do{ MF; X[B]=EX(X[B]); X[B+1]=EX(X[B+1]); X[B+2]=EX(X[B+2]); X[B+3]=EX(X[B+3]); PIN(X); SBAR(); }while(0)
  #define VRD(i) do{ vlo[i]=vtr(vp_+(((i)>>2)*4096+((i)&3)*1024)); vhi[i]=vtr(vp_+(((i)>>2)*4096+((i)&3)*1024+512)); }while(0)
  #define KRD(G,j) do{ if(G){ kload2(kf,kp0+sl_next,j); SBAR(); } }while(0)
  #define STEP(C0,C1,P0,P1,t,GK,GV,GL) do{ SBAR(); \
    const lds_cptr vp_=vp0+sl_prev; \
    VRD(0); SBAR(); float sacc=(P0[0]+P0[1]); \
    GAPA(C0=__builtin_amdgcn_mfma_f32_32x32x16_bf16(kf[0],qr[0],negm,0,0,0), P0[2],P0[3],P0[4],P0[5],     pw0[0]=PKW(P0,0), pw0[1]=PKW(P0,2), pw0); \
    VRD(4); SBAR(); GAPA(C1=__builtin_amdgcn_mfma_f32_32x32x16_bf16(kf[1],qr[0],negm,0,0,0), P0[6],P0[7],P0[8],P0[9],     pw0[2]=PKW(P0,4), pw0[3]=PKW(P0,6), pw0); \
    VRD(1); SBAR(); GAPA(C0=__builtin_amdgcn_mfma_f32_32x32x16_bf16(kf[2],qr[1],C0,0,0,0),   P0[10],P0[11],P0[12],P0[13], pw1[0]=PKW(P0,8), pw1[1]=PKW(P0,10), pw1); \
    VRD(5); SBAR(); GAPA(C1=__builtin_amdgcn_mfma_f32_32x32x16_bf16(kf[3],qr[1],C1,0,0,0),   P0[14],P0[15],P1[0],P1[1],   pw1[2]=PKW(P0,12),pw1[3]=PKW(P0,14), pw1); \
    VRD(2); SBAR(); GAPA(C0=__builtin_amdgcn_mfma_f32_32x32x16_bf16(kf[4],qr[2],C0,0,0,0),   P1[2],P1[3],P1[4],P1[5],     pw2[0]=PKW(P1,0), pw2[1]=PKW(P1,2), pw2); \
    VRD(6); SBAR(); GAPA(C1=__builtin_amdgcn_mfma_f32_32x32x16_bf16(kf[5],qr[2],C1,0,0,0),   P1[6],P1[7],P1[8],P1[9],     pw2[2]=PKW(P1,4), pw2[3]=PKW(P1,6), pw2); \
    VRD(3); SBAR(); GAPA(C0=__builtin_amdgcn_mfma_f32_32x32x16_bf16(kf[6],qr[3],C0,0,0,0),   P1[10],P1[11],P1[12],P1[13], pw3[0]=PKW(P1,8), pw3[1]=PKW(P1,10), pw3); \
    VRD(7); SBAR(); GAPA(C1=__builtin_amdgcn_mfma_f32_32x32x16_bf16(kf[7],qr[3],C1,0,0,0),   P1[14],P1[15],0.f,0.f,       pw3[2]=PKW(P1,12),pw3[3]=PKW(P1,14), pw3); \
    l_reg+=sacc; \
    if(GK){DMA_K((t)+3,sl_cur);} if(GV){DMA_V((t)+1,sl_next);} \
    CMASK(C0,C1,t); \
    { float a=MX3(C0[0],C0[1],C1[0]),b=MX3(C0[2],C0[3],C1[1]); a=MX3(a,C1[2],C1[3]); \
      _Pragma("unroll") for(int r=4;r<16;r+=4){a=MX3(a,C0[r],C0[r+1]);b=MX3(b,C0[r+2],C0[r+3]);a=MX3(a,C1[r],C1[r+1]);b=MX3(b,C1[r+2],C1[r+3]);} \
      float rm=__builtin_fmaxf(a,b); { auto rr=__builtin_amdgcn_permlane32_swap(__float_as_uint(rm),__float_as_uint(rm),false,false); rm=__builtin_fmaxf(__uint_as_float(rr[0]),__uint_as_float(rr[1])); } \
      resc=false; \
      if(__builtin_expect(__any(rm>(float)THRL),0)){ const float dl=__builtin_fmaxf(rm,0.f); mhat+=dl; \
        _Pragma("unroll") for(int r=0;r<16;++r){C0[r]-=dl;C1[r]-=dl;} \
        _Pragma("unroll") for(int r=0;r<16;++r)negm[r]=-mhat; asm volatile("":"+v"(negm)); \
        const float f=__builtin_amdgcn_exp2f(-dl); l_reg*=f; if(hi==0)wsf[r32]=f; resc=true; } } \
    SBAR(); \
    GAPB(o[0]=__builtin_amdgcn_mfma_f32_32x32x16_bf16(PAF(0),VFR(0),o[0],0,0,0), C0,0); \
    GAPB(o[1]=__builtin_amdgcn_mfma_f32_32x32x16_bf16(PAF(0),VFR(4),o[1],0,0,0), C0,4); \
    KRD(GL,0); GAPB(o[0]=__builtin_amdgcn_mfma_f32_32x32x16_bf16(PAF(1),VFR(1),o[0],0,0,0), C0,8); \
    KRD(GL,1); GAPB(o[1]=__builtin_amdgcn_mfma_f32_32x32x16_bf16(PAF(1),VFR(5),o[1],0,0,0), C0,12); \
    KRD(GL,2); GAPB(o[0]=__builtin_amdgcn_mfma_f32_32x32x16_bf16(PAF(2),VFR(2),o[0],0,0,0), C1,0); \
    KRD(GL,3); GAPB(o[1]=__builtin_amdgcn_mfma_f32_32x32x16_bf16(PAF(2),VFR(6),o[1],0,0,0), C1,4); \
    GAPB(o[0]=__builtin_amdgcn_mfma_f32_32x32x16_bf16(PAF(3),VFR(3),o[0],0,0,0), C1,8); \
    GAPB(o[1]=__builtin_amdgcn_mfma_f32_32x32x16_bf16(PAF(3),VFR(7),o[1],0,0,0), C1,12); \
    }while(0)
  int t=1;
  for(;t+5<NT;t+=2){
    STEP(pB0,pB1,pA0,pA1,t,true,true,true);     WAIT_BAR(2); RESC(); ROT();
    STEP(pA0,pA1,pB0,pB1,t+1,true,true,true);   WAIT_BAR(2); RESC(); ROT();
  }
  #define ENDW(tt) do{ if((tt)+3<NT){WAIT_BAR(2);} else if((tt)+2<NT){WAIT_BAR(1);} else {WAIT_BAR(0);} }while(0)
  for(;t+1<NT;t+=2){
    STEP(pB0,pB1,pA0,pA1,t,(t+3<NT),(t+1<NT),(t+1<NT));       ENDW(t);   RESC(); ROT();
    STEP(pA0,pA1,pB0,pB1,t+1,(t+4<NT),(t+2<NT),(t+2<NT));     ENDW(t+1); RESC(); ROT();
  }
  STEP(pB0,pB1,pA0,pA1,NT-1,false,false,false); RESC();
  { float sacc=pB0[0]+pB0[1]; _Pragma("unroll") for(int r=2;r<16;++r)sacc+=pB0[r]; _Pragma("unroll") for(int r=0;r<16;++r)sacc+=pB1[r]; l_reg+=sacc;
    pw0=(u32x4){PKW(pB0,0),PKW(pB0,2),PKW(pB0,4),PKW(pB0,6)};pw1=(u32x4){PKW(pB0,8),PKW(pB0,10),PKW(pB0,12),PKW(pB0,14)};pw2=(u32x4){PKW(pB1,0),PKW(pB1,2),PKW(pB1,4),PKW(pB1,6)};pw3=(u32x4){PKW(pB1,8),PKW(pB1,10),PKW(pB1,12),PKW(pB1,14)};
    SBAR(); pv(o,vb0+sl_cur,PAF(0),PAF(1),PAF(2),PAF(3)); }
  #undef PKW
  #undef PAF
  #undef VFR
  #undef PIN
  #undef MX3
  #undef GAPA
  #undef GAPB
  #undef EX
  #undef VRD
  #undef KRD
  #undef STEP
  #undef ENDW
  {auto rr=__builtin_amdgcn_permlane32_swap(__float_as_uint(l_reg),__float_as_uint(l_reg),false,false);l_reg=__uint_as_float(rr[0])+__uint_as_float(rr[1]);}
  if(hi==0)wsf[32+r32]=l_reg;asm volatile("s_waitcnt lgkmcnt(0)":::"memory");
  float rli[16];
  #pragma unroll
  for(int r=0;r<16;++r)rli[r]=__builtin_amdgcn_rcpf(wsf[32+crow(r,hi)]);
  bf16*Ow=Ou+(long)(wid*QBLK)*DM;
  { bf16*stg=(bf16*)(shm+LDS_OST)+wid*2048;
    #pragma unroll
    for(int r=0;r<16;++r){const int orow=crow(r,hi);
      #pragma unroll
      for(int d0=0;d0<2;++d0)stg[orow*64+d0*32+r32]=__float2bfloat16(o[d0][r]*rli[r]);}
    asm volatile("s_waitcnt lgkmcnt(0)":::"memory");
    #pragma unroll
    for(int i=0;i<4;++i){const int row=i*8+(lane>>3),ch=lane&7; const u32x4 v=*(const u32x4*)(stg+row*64+ch*8); if(wr_)ATTN_STORE16(Ow+(long)row*DM+ch*8,v);} }
  asm volatile("s_waitcnt lgkmcnt(0)\n\ts_barrier":::"memory");
  #undef DMA_K
  #undef DMA_V
  #undef CMASK
  #undef START
  #undef RESC
  #undef ROT
}
constexpr int ATTN_LDS_BYTES=LDS_BYTES;
#undef SBAR
#undef WAIT_BAR
}

#ifndef MK_SINGLE
#define MK_SINGLE 1
#endif
constexpr int NWAVES = 8, NTHR = 512;
constexpr size_t MiB = 1u << 20;
constexpr size_t WS_CTL = 0, WS_BAR = 8192, WS_MOD = 32768, WS_ROWSS = 262144, CTL_ZERO_BYTES = 262144 + 20480 * 4, WS_SHW = 1024 * 1024, WS_GAM = 1280 * 1024, WS_ROPE = 512 * 1024, WS_LBT = 528 * 1024, WS_MODB = 768 * 1024;
constexpr size_t WS_WIN = 2 * MiB, WS_WO = 19 * MiB, WS_WUP = 21 * MiB, WS_WDN = 32 * MiB;
constexpr size_t WS_H = 38 * MiB, WS_Q = 58 * MiB, WS_ZA = 78 * MiB, WS_RQ = 98 * MiB, WS_GF = 118 * MiB, WS_GB = 138 * MiB, WS_RI = 158 * MiB, WS_PP = 178 * MiB, WS_K = 243 * MiB, WS_V = 243 * MiB + 6400 * 1024;
constexpr size_t WS_U = 58 * MiB, WS_ACT = 168 * MiB, WS_H2 = 223 * MiB, WS_END = 256 * MiB;
constexpr int RING_BYTES = 131072, LDS_BYTES = 147456;
constexpr int N_PHASES = 15;

typedef unsigned v4u __attribute__((ext_vector_type(4)));
#define LDS_WAIT() asm volatile("s_waitcnt lgkmcnt(0)" ::: "memory")
__device__ __forceinline__ unsigned f2bf(float f) { unsigned u = __builtin_bit_cast(unsigned, f); return (u + 0x7fffu + ((u >> 16) & 1u)) >> 16; }
__device__ __forceinline__ unsigned pk2(float lo, float hi) { return pg8::cvt_pk_bf16(lo, hi); }

#define RLX_AGENT __ATOMIC_RELAXED, __HIP_MEMORY_SCOPE_AGENT
#define XB_TMO      128
#define XB_XCNT(j)  (256  + 64 * (j))
#define XB_XSUB(j)  (1280 + 64 * (j))
#define XB_XGEN(j)  (2304 + 64 * (j))
#define XB_TOP      3328
#define XB_TOPGEN   3392
#define XCD_BAR_WORDS 3456
#define XB_SPIN_CAP (1u << 18)

__device__ __forceinline__ unsigned xb_ld(unsigned* p)              { return __hip_atomic_load(p, __ATOMIC_RELAXED, __HIP_MEMORY_SCOPE_AGENT); }
__device__ __forceinline__ unsigned xb_add(unsigned* p, unsigned v) { return __hip_atomic_fetch_add(p, v, __ATOMIC_RELAXED, __HIP_MEMORY_SCOPE_AGENT); }
__device__ __forceinline__ unsigned xb_xcc_id() { return (unsigned)__builtin_amdgcn_s_getreg((3 << 11) | 20) & 0xFu; }
#define XB_SPIN(cond, bar) do { unsigned _sp = 0; while (cond) { __builtin_amdgcn_s_sleep(1); \
    if ((++_sp & 255u) == 0u) { if (xb_ld(&(bar)[XB_TMO])) break; if (_sp > XB_SPIN_CAP) { atomicAdd(&(bar)[XB_TMO], 1u); break; } } } } while (0)

struct XcdBarrier {
    unsigned* bar; unsigned x;
    volatile LAS unsigned* st;
};

__device__ __forceinline__ XcdBarrier xcd_barrier_post(unsigned* bar, volatile LAS unsigned* st) {
    XcdBarrier b; b.bar = bar; b.x = xb_xcc_id(); b.st = st;
    if (threadIdx.x == 0) (void)xb_add(&bar[XB_XCNT(b.x)], 1u);
    return b;
}
__device__ __forceinline__ void xcd_barrier_complete(unsigned* bar, unsigned x, unsigned& nloc, unsigned& nx) {
    const unsigned G = gridDim.x * gridDim.y * gridDim.z;
    unsigned sum, cnt, mine, sp = 0u;
    for (;;) {
        sum = 0u; cnt = 0u; mine = 0u;
#pragma unroll
        for (unsigned j = 0; j < 16; ++j) { const unsigned c = xb_ld(&bar[XB_XCNT(j)]); sum += c; cnt += (c > 0u) ? 1u : 0u; mine = (j == x) ? c : mine; }
        if (sum == G) break;
        __builtin_amdgcn_s_sleep(1);
        if ((++sp & 255u) == 0u) { if (xb_ld(&bar[XB_TMO])) break; if (sp > XB_SPIN_CAP) { atomicAdd(&bar[XB_TMO], 1u); break; } }
    }
    nloc = mine > 0u ? mine : 1u; nx = cnt > 0u ? cnt : 1u;
}

__device__ __forceinline__ void xcd_barrier(const XcdBarrier& b) {
    asm volatile("s_waitcnt vmcnt(0)" ::: "memory");
    __syncthreads();
    if (threadIdx.x == 0) {
        unsigned* bar = b.bar;
        __builtin_amdgcn_s_waitcnt(0);
        unsigned nloc = b.st[0], nx = b.st[1];
        if (nloc == 0u) { xcd_barrier_complete(bar, b.x, nloc, nx); b.st[0] = nloc; b.st[1] = nx; }
        const unsigned old = xb_add(&bar[XB_XSUB(b.x)], 1u);
        const unsigned gen = old / nloc;
        if (old + 1u == (gen + 1u) * nloc) {
            __builtin_amdgcn_fence(__ATOMIC_RELEASE, "agent");
            asm volatile("s_waitcnt vmcnt(0)" ::: "memory");
            const unsigned og = xb_add(&bar[XB_TOP], 1u);
            const unsigned tg = og / nx;
            if (og + 1u == (tg + 1u) * nx) xb_add(&bar[XB_TOPGEN], 1u);
            else XB_SPIN(xb_ld(&bar[XB_TOPGEN]) == tg, bar);
            __builtin_amdgcn_fence(__ATOMIC_ACQUIRE, "agent");
            xb_add(&bar[XB_XGEN(b.x)], 1u);
            asm volatile("s_waitcnt vmcnt(0)" ::: "memory");
        } else {
            XB_SPIN(xb_ld(&bar[XB_XGEN(b.x)]) == gen, bar);
            __builtin_amdgcn_fence(__ATOMIC_ACQUIRE, "agent");
            asm volatile("s_waitcnt vmcnt(0)" ::: "memory");
        }
    }
    __syncthreads();
}

struct Args { const float* in[22]; float* out; unsigned char* ws; int ph_lo, ph_hi; };

__device__ __forceinline__ void p0_transpose_item(const float* W, int K, int N, bf16_t* WT, int prow0, int lc0, LAS float* scr, int kb, int lane) {
    const int k0 = 64 * kb;
#pragma unroll 8
    for (int i = 0; i < 32; ++i) { const int kk = 2 * i + (lane >> 5); scr[kk * 33 + (lane & 31)] = W[(size_t)(k0 + kk) * N + lc0 + (lane & 31)]; }
    LDS_WAIT(); asm volatile("" ::: "memory");
    const int c = lane & 7;
#pragma unroll
    for (int j = 0; j < 4; ++j) { const int n = (lane >> 3) + 8 * j; const LAS float* s = scr + (8 * c) * 33 + n;
        v4u o; o.x = pk2(s[0 * 33], s[1 * 33]); o.y = pk2(s[2 * 33], s[3 * 33]); o.z = pk2(s[4 * 33], s[5 * 33]); o.w = pk2(s[6 * 33], s[7 * 33]);
        *(v4u*)(WT + (size_t)(prow0 + n) * K + k0 + 8 * c) = o; }
    LDS_WAIT(); asm volatile("" ::: "memory");
}

__device__ __forceinline__ void p0_prep(const __attribute__((address_space(4))) Args* a, LAS unsigned char* lds, int gw, int NGW, int wave, int lane, bool skip_ada = false) {
    LAS float* scr = (LAS float*)(lds + wave * 16384);
    unsigned char* ws = a->ws;
    const float* w_in = a->in[11]; const float* w_o = a->in[16]; const float* w_up = a->in[17]; const float* w_dn = a->in[20];
    constexpr int I_IN = 16 * 272, I_O = 16 * 32, I_UP = 16 * 176, I_DN = 44 * 32, I_T = I_IN + I_O + I_UP + I_DN, I_ADA = 96 * 16, I_ROPE = 16, I_LB = 32;
    for (int it = gw; it < I_T + I_ADA + I_ROPE + I_LB; it += NGW) {
        int r = it;
        if (r < I_T) {
            const float* W; int K, N, kb, pg; bf16_t* WT; bool isin = false;
            if (r < I_IN) { W = w_in; K = 1024; N = INW; kb = r / 272; pg = r % 272; WT = (bf16_t*)(ws + WS_WIN); isin = true; }
            else if ((r -= I_IN) < I_O) { W = w_o; K = 1024; N = 1024; kb = r / 32; pg = r % 32; WT = (bf16_t*)(ws + WS_WO); }
            else if ((r -= I_O) < I_UP) { W = w_up; K = 1024; N = UPW; kb = r / 176; pg = r % 176; WT = (bf16_t*)(ws + WS_WUP); }
            else { r -= I_UP; W = w_dn; K = DFF; N = 1024; kb = r / 32; pg = r % 32; WT = (bf16_t*)(ws + WS_WDN); }
            const int T = pg >> 3, g = pg & 7, bj = g >> 2, wc = g & 3;
            int lc0 = T * 256 + wc * 64 + bj * 32;
            if (isin && T >= 22) lc0 = (T < 26) ? 6656 + (T - 22) * 256 + wc * 64 + bj * 32 : (bj ? 7680 : 5632) + (T - 26) * 128 + wc * 32;
            p0_transpose_item(W, K, N, WT, pg * 32, lc0, scr, kb, lane);
        } else if ((r -= I_T) < I_ADA) {
            if (skip_ada) continue;
            const int g = r >> 4, kc = r & 15, n0 = g * 64 + lane, k0 = kc * 64;
            const float* c_in = a->in[2]; const float* cctx = a->in[6]; const float* adaw = a->in[7];
#pragma unroll
            for (int i = 0; i < 9; ++i) { const float cv = (i == 0) ? cctx[k0 + lane] : c_in[(i - 1) * 1024 + k0 + lane]; scr[lane * 12 + i] = fsilu(cv); }
            LDS_WAIT(); asm volatile("" ::: "memory");
            float acc[9];
#pragma unroll
            for (int i = 0; i < 9; ++i) acc[i] = 0.f;
#pragma unroll 8
            for (int kk = 0; kk < 64; ++kk) { const float w = adaw[(size_t)(k0 + kk) * 6144 + n0];
                const pg8::f32x4 s0 = *(const LAS pg8::f32x4*)(scr + kk * 12), s1 = *(const LAS pg8::f32x4*)(scr + kk * 12 + 4); const float s8 = scr[kk * 12 + 8];
                acc[0] += s0[0] * w; acc[1] += s0[1] * w; acc[2] += s0[2] * w; acc[3] += s0[3] * w; acc[4] += s1[0] * w; acc[5] += s1[1] * w; acc[6] += s1[2] * w; acc[7] += s1[3] * w; acc[8] += s8 * w; }
            float* mod = (float*)(ws + WS_MOD);
#pragma unroll
            for (int i = 0; i < 9; ++i) atomicAdd(mod + i * 6144 + n0, acc[i]);
            LDS_WAIT(); asm volatile("" ::: "memory");
        } else if ((r -= I_ADA) >= I_ROPE) {
            r -= I_ROPE; const int idx = r * 64 + lane, d = idx >> 10, cch = idx & 1023; const float* lg = a->in[14];
            ((float*)(ws + WS_LBT))[idx] = fsigmoid(lg[d * 2048 + cch] - lg[d * 2048 + 1024 + cch]);
        } else {
            const int idx = r * 64 + lane, pos = idx >> 4, i = idx & 15;
            const float invf = exp2f(-(float)i * 0.8304820237218406f); const float ang = (float)pos * invf;
            const float n = rintf(ang * 0.15915494309189535f); float rr = fmaf(-n, 6.2831854820251465f, ang); rr = fmaf(-n, -1.7484555e-7f, rr);
            float* rope = (float*)(ws + WS_ROPE); rope[idx * 2] = __cosf(rr); rope[idx * 2 + 1] = __sinf(rr);
        }
    }
}

template <int MODE> __device__ __forceinline__ void norm_row(const float* xrow, const float* gain, const float* mod, const float* adab, int shoff, int scoff, bf16_t* obf, float* of32, int lane) {
    const pg8::f32x4* xr = (const pg8::f32x4*)xrow + lane;
    pg8::f32x4 v[4]; float s = 0.f;
#pragma unroll
    for (int j = 0; j < 4; ++j) { v[j] = xr[64 * j]; s += (v[j][0] * v[j][0] + v[j][1] * v[j][1]) + (v[j][2] * v[j][2] + v[j][3] * v[j][3]); }
    const float rstd = __builtin_amdgcn_rsqf(wave_sum(s) * (1.0f / 1024.0f) + EPS);
#pragma unroll
    for (int j = 0; j < 4; ++j) { const int c = 4 * (lane + 64 * j); const pg8::f32x4 g = *(const pg8::f32x4*)(gain + c); pg8::f32x4 y = v[j] * rstd * g;
        if (MODE == 0) { const pg8::f32x4 sh = *(const pg8::f32x4*)(mod + shoff + c) + *(const pg8::f32x4*)(adab + shoff + c), sc = *(const pg8::f32x4*)(mod + scoff + c) + *(const pg8::f32x4*)(adab + scoff + c);
            y = y * (sc + 1.0f) + sh; u32x2 w; w.x = pk2(y[0], y[1]); w.y = pk2(y[2], y[3]); *(u32x2*)(obf + c) = w; }
        else *(pg8::f32x4*)(of32 + c) = y; }
}

constexpr int R_QD = 0, R_KD = 17408, R_K2T = 34816, R_VT = 53248, R_SC = 71680, R_ST = 80896, R_XCH = 115712, R_DEC = 119808;
__device__ __forceinline__ int crow(int r, int hi) { return (r & 3) + 8 * (r >> 2) + 4 * hi; }
__device__ __forceinline__ void rec_scan(LAS unsigned char* lds, const bf16_t* RQ, bf16_t* G, const bf16_t* RI, int lrow0, int L, int rh, int dir, const float* s0, float* sfin, const bool wr_ = true) {
    int tid_o = threadIdx.x; asm volatile("" : "+v"(tid_o));
    const int tid = tid_o, lane = tid & 63, w = __builtin_amdgcn_readfirstlane(tid >> 6), r32 = lane & 31, hi = lane >> 5;
    const int kb = w >> 1, dvt0 = (w & 1) * 2;
    const int colb = rh * 128;
    f32x16 S[2];
#pragma unroll
    for (int x = 0; x < 2; ++x)
#pragma unroll
        for (int r = 0; r < 16; ++r) S[x][r] = s0 ? s0[(size_t)(kb * 32 + crow(r, hi)) * 128 + (dvt0 + x) * 32 + r32] : 0.f;
#define REC_WRITE_ST() do { _Pragma("unroll") for (int x = 0; x < 2; ++x) _Pragma("unroll") for (int g = 0; g < 4; ++g) { u32x2 wv; wv.x = pk2(S[x][4 * g], S[x][4 * g + 1]); wv.y = pk2(S[x][4 * g + 2], S[x][4 * g + 3]); \
        *(LAS u32x2*)(lds + R_ST + ((dvt0 + x) * 32 + r32) * 272 + (kb * 32 + 8 * g + 4 * hi) * 2) = wv; } } while (0)
    REC_WRITE_ST();
    const int nc = L >> 6;
    unsigned gq[8], qq[8], vv[8];
#define REC_ROW(c, i) (dir ? (lrow0 + L - 1 - ((c) * 64 + (i))) : (lrow0 + (c) * 64 + (i)))
#define REC_LOAD(c) do { _Pragma("unroll") for (int i = 0; i < 8; ++i) { const size_t off = (size_t)REC_ROW(c, 8 * w + i) * DM + colb + 2 * lane; \
        gq[i] = *(const unsigned*)(G + off); qq[i] = *(const unsigned*)(RQ + off); vv[i] = *(const unsigned*)(RI + off); } } while (0)
    REC_LOAD(0);
    for (int c = 0; c < nc; ++c) {
        float g0[8], g1[8], q0[8], q1[8]; unsigned vk[8];
#pragma unroll
        for (int i = 0; i < 8; ++i) { g0[i] = h2f((unsigned short)(gq[i] & 0xffffu)); g1[i] = h2f((unsigned short)(gq[i] >> 16)); q0[i] = bflo(qq[i]); q1[i] = bfhi(qq[i]); vk[i] = vv[i]; }
        if (c + 1 < nc) REC_LOAD(c + 1);
        float b0[8], b1[8];
        b0[0] = g0[0]; b1[0] = g1[0];
#pragma unroll
        for (int i = 1; i < 8; ++i) { b0[i] = b0[i - 1] + g0[i]; b1[i] = b1[i - 1] + g1[i]; }
        *(LAS f32x2*)(lds + R_XCH + (w * 128 + 2 * lane) * 4) = (f32x2){b0[7], b1[7]};
        __syncthreads();
        float p0 = 0.f, p1 = 0.f, t0 = 0.f, t1 = 0.f;
#pragma unroll
        for (int ww = 0; ww < 8; ++ww) { const f32x2 x = *(const LAS f32x2*)(lds + R_XCH + (ww * 128 + 2 * lane) * 4); if (ww < w) { p0 += x[0]; p1 += x[1]; } t0 += x[0]; t1 += x[1]; }
        if (w == 0) *(LAS f32x2*)(lds + R_DEC + 2 * lane * 4) = (f32x2){__expf(t0), __expf(t1)};
        unsigned k2a[4], k2b[4], va[4], vb[4];
#pragma unroll
        for (int i = 0; i < 8; ++i) {
            const float bb0 = p0 + b0[i], bb1 = p1 + b1[i];
            const float kk0 = 1.0f - __expf(g0[i]), kk1 = 1.0f - __expf(g1[i]);
            const float qd0 = q0[i] * __expf(bb0), qd1 = q1[i] * __expf(bb1);
            const float kd0 = kk0 * __expf(-bb0), kd1 = kk1 * __expf(-bb1);
            const float kt0 = kk0 * __expf(t0 - bb0), kt1 = kk1 * __expf(t1 - bb1);
            const int ti = 8 * w + i;
            *(LAS unsigned*)(lds + R_QD + ti * 272 + lane * 4) = pk2(qd0, qd1);
            *(LAS unsigned*)(lds + R_KD + ti * 272 + lane * 4) = pk2(kd0, kd1);
            const unsigned f0 = f2bf(kt0), f1 = f2bf(kt1);
            if (i & 1) { k2a[i >> 1] |= f0 << 16; k2b[i >> 1] |= f1 << 16; va[i >> 1] |= (vk[i] & 0xffffu) << 16; vb[i >> 1] |= vk[i] & 0xffff0000u; }
            else { k2a[i >> 1] = f0; k2b[i >> 1] = f1; va[i >> 1] = vk[i] & 0xffffu; vb[i >> 1] = vk[i] >> 16; }
        }
        *(LAS v4u*)(lds + R_K2T + (2 * lane) * 144 + 16 * w) = (v4u){k2a[0], k2a[1], k2a[2], k2a[3]};
        *(LAS v4u*)(lds + R_K2T + (2 * lane + 1) * 144 + 16 * w) = (v4u){k2b[0], k2b[1], k2b[2], k2b[3]};
        *(LAS v4u*)(lds + R_VT + (2 * lane) * 144 + 16 * w) = (v4u){va[0], va[1], va[2], va[3]};
        *(LAS v4u*)(lds + R_VT + (2 * lane + 1) * 144 + 16 * w) = (v4u){vb[0], vb[1], vb[2], vb[3]};
        __syncthreads();
        if (w < 4) {
            const int ti = w >> 1, si = w & 1;
            f32x16 sc;
#pragma unroll
            for (int r = 0; r < 16; ++r) sc[r] = 0.f;
            if (w != 1) {
#pragma unroll
                for (int ks = 0; ks < 8; ++ks) {
                    const pg8::bf16x8 af = *(const LAS pg8::bf16x8*)(lds + R_QD + (ti * 32 + r32) * 272 + (16 * ks + 8 * hi) * 2);
                    const pg8::bf16x8 bf = *(const LAS pg8::bf16x8*)(lds + R_KD + (si * 32 + r32) * 272 + (16 * ks + 8 * hi) * 2);
                    sc = __builtin_amdgcn_mfma_f32_32x32x16_bf16(af, bf, sc, 0, 0, 0);
                }
            }
#pragma unroll
            for (int r = 0; r < 16; ++r) { const int t = ti * 32 + crow(r, hi), s = si * 32 + r32; const float v = (t >= s) ? sc[r] : 0.f;
                *(LAS unsigned short*)(lds + R_SC + t * 144 + s * 2) = (unsigned short)f2bf(v); }
        }
        __syncthreads();
        {
            const int to = w >> 2, dvo = w & 3;
            f32x16 o;
#pragma unroll
            for (int r = 0; r < 16; ++r) o[r] = 0.f;
#pragma unroll
            for (int ks = 0; ks < 4; ++ks) {
                const pg8::bf16x8 af = *(const LAS pg8::bf16x8*)(lds + R_SC + (to * 32 + r32) * 144 + (16 * ks + 8 * hi) * 2);
                const pg8::bf16x8 bf = *(const LAS pg8::bf16x8*)(lds + R_VT + (dvo * 32 + r32) * 144 + (16 * ks + 8 * hi) * 2);
                o = __builtin_amdgcn_mfma_f32_32x32x16_bf16(af, bf, o, 0, 0, 0);
            }
#pragma unroll
            for (int ks = 0; ks < 8; ++ks) {
                const pg8::bf16x8 af = *(const LAS pg8::bf16x8*)(lds + R_QD + (to * 32 + r32) * 272 + (16 * ks + 8 * hi) * 2);
                const pg8::bf16x8 bf = *(const LAS pg8::bf16x8*)(lds + R_ST + (dvo * 32 + r32) * 272 + (16 * ks + 8 * hi) * 2);
                o = __builtin_amdgcn_mfma_f32_32x32x16_bf16(af, bf, o, 0, 0, 0);
            }
            if (wr_)
#pragma unroll
            for (int r = 0; r < 16; ++r) { const int t = to * 32 + crow(r, hi); G[(size_t)REC_ROW(c, t) * DM + colb + dvo * 32 + r32] = (bf16_t)f2bf(o[r]); }
            float dec[16];
#pragma unroll
            for (int r = 0; r < 16; ++r) dec[r] = *(const LAS float*)(lds + R_DEC + (kb * 32 + crow(r, hi)) * 4);
#pragma unroll
            for (int x = 0; x < 2; ++x)
#pragma unroll
                for (int r = 0; r < 16; ++r) S[x][r] *= dec[r];
#pragma unroll
            for (int ks = 0; ks < 4; ++ks) {
                const pg8::bf16x8 af = *(const LAS pg8::bf16x8*)(lds + R_K2T + (kb * 32 + r32) * 144 + (16 * ks + 8 * hi) * 2);
#pragma unroll
                for (int x = 0; x < 2; ++x) {
                    const pg8::bf16x8 bf = *(const LAS pg8::bf16x8*)(lds + R_VT + ((dvt0 + x) * 32 + r32) * 144 + (16 * ks + 8 * hi) * 2);
                    S[x] = __builtin_amdgcn_mfma_f32_32x32x16_bf16(af, bf, S[x], 0, 0, 0);
                }
            }
        }
        __syncthreads();
        REC_WRITE_ST();
    }
    if (sfin && wr_) {
#pragma unroll
        for (int x = 0; x < 2; ++x)
#pragma unroll
            for (int r = 0; r < 16; ++r) sfin[(size_t)(kb * 32 + crow(r, hi)) * 128 + (dvt0 + x) * 32 + r32] = S[x][r];
    }
#undef REC_WRITE_ST
#undef REC_ROW
#undef REC_LOAD
}

typedef const __attribute__((address_space(4))) Args* KArgs;
#define WSB(off) ((bf16_t*)(ws + (off)))
#define WSF(off) ((float*)(ws + (off)))
__device__ __forceinline__ bf16_t* h1_buf(unsigned char* ws, float* dout, int hfx) { return hfx ? (bf16_t*)(dout + (size_t)MH * DM) : WSB(WS_H); }
__device__ __forceinline__ void do_norm1(KArgs ap, int hfx, int gwb, int ngwb, int lane, bool rows, bool cache) {
    unsigned char* const ws = ap->ws; const float* xp = ap->in[0]; const float* xs = ap->in[1]; const float* adab = ap->in[8]; const float* mod = WSF(WS_MOD);
    bf16_t* Hd = h1_buf(ws, ap->out, hfx); bf16_t* Kb = WSB(WS_K); bf16_t* Vb = WSB(WS_V);
    if (rows) for (int r = gwb; r < MH; r += ngwb) { const int grow = hfx * MH + r; const float* src = grow < NPR ? xp + (size_t)grow * DM : xs + (size_t)(grow - NPR) * DM;
        norm_row<0>(src, ap->in[9], mod + mod_of_row(grow) * 6144, adab, 0, 1024, Hd + (size_t)r * DM, nullptr, lane); }
    const int nb = hfx ? 5 : 3, b0 = hfx ? 3 : 0;
    if (cache) for (int r = gwb; r < 2 * nb * 512; r += ngwb) { const int kv = r / (nb * 512), rr = r % (nb * 512), b = rr >> 9, p = rr & 511;
        const float* src = (kv ? ap->in[4] : ap->in[3]) + ((size_t)(b0 + b) * 512 + p) * KVP + 4 * lane;
        bf16_t* dst = (kv ? Vb : Kb) + (size_t)((hfx ? b * 2560 : NPR + b * 2560) + 2048 + p) * KVP + 4 * lane;
        const pg8::f32x4 v = *(const pg8::f32x4*)src; u32x2 wv; wv.x = pk2(v[0], v[1]); wv.y = pk2(v[2], v[3]); *(u32x2*)dst = wv; }
}
__device__ __forceinline__ void do_final(KArgs ap, int hfx, int gwb, int ngwb, int lane) {
    float* dout = ap->out;
    for (int r = gwb; r < MH; r += ngwb) { float* row = dout + (size_t)(hfx * MH + r) * DM; norm_row<1>(row, ap->in[21], nullptr, nullptr, 0, 0, nullptr, row, lane); }
}

__global__ void __launch_bounds__(NTHR, 2) fwd_mega(Args args) {
    extern __shared__ __attribute__((aligned(16))) unsigned char lds_raw[];
    LAS unsigned char* lds = (LAS unsigned char*)lds_raw;
    const int G = gridDim.x, bx = blockIdx.x, NGW = G * NWAVES;
#define PH_IDS() int tid = threadIdx.x; asm volatile("" : "+v"(tid)); const int lane = tid & 63, wave = __builtin_amdgcn_readfirstlane(tid >> 6), gw = bx * NWAVES + wave; (void)lane; (void)gw; \
    KArgs ap = (KArgs)__builtin_amdgcn_kernarg_segment_ptr(); asm volatile("" : "+s"(ap)); unsigned char* const ws = ap->ws; float* const dout = ap->out; (void)ws; (void)dout;
#define AIN(i) (ap->in[i])
    const int lo = args.ph_lo, hi_ph = args.ph_hi;
    volatile LAS unsigned* bst = (volatile LAS unsigned*)(lds + RING_BYTES + 64);
    if (threadIdx.x < 2) bst[threadIdx.x] = 0u;
    __syncthreads();
    XcdBarrier xbar = xcd_barrier_post((unsigned*)(args.ws + WS_BAR), bst);
    cg::grid_group grid = cg::this_grid();
#ifndef PHMASK
#define PHMASK 0xFFFF
#endif
#define PEN(j) (((PHMASK) >> (j)) & 1)
#ifndef DUPMASK
#define DUPMASK 0
#endif
#define DUP(j) (((DUPMASK) >> (j)) & 1)
#define IN(k) (lo <= (k) && (k) < hi_ph)
#define SEAM(k) do { if (IN(k) && IN((k) + 1)) { if (lo < 0) grid.sync();     xcd_barrier(xbar); } } while (0)

    if (IN(0)) { PH_IDS(); p0_prep(ap, lds, gw, NGW, wave, lane); SEAM(0); }

    if (IN(1)) { PH_IDS(); const int hf = 0; const int rep_ = 0; (void)hf; (void)rep_;

            const float* adab = AIN(8); const float* mod = WSF(WS_MOD);
            do_norm1(ap, 0, gw, NGW, lane, true, true);
            if (hf == 0) { float* modb = WSF(WS_MODB); for (int i = gw * 64 + lane; i < 9 * 6144; i += NGW * 64) modb[i] = mod[i] + adab[i % 6144];
                float* gam = WSF(WS_GAM); const float* n2 = AIN(10); for (int i = gw * 64 + lane; i < 9 * 1024; i += NGW * 64) { const int b = i >> 10, cc = i & 1023; gam[i] = n2[cc] * (1.0f + mod[b * 6144 + 4096 + cc] + adab[4096 + cc]); }
                float* shw = WSF(WS_SHW); const bf16_t* WUP = WSB(WS_WUP);
                for (int p = gw; p < UPW; p += NGW) {
                    const v4u w0 = *(const v4u*)(WUP + (size_t)p * DM + 16 * lane), w1 = *(const v4u*)(WUP + (size_t)p * DM + 16 * lane + 8);
                    float wv[16];
#pragma unroll
                    for (int q = 0; q < 4; ++q) { wv[2 * q] = bflo(w0[q]); wv[2 * q + 1] = bfhi(w0[q]); wv[8 + 2 * q] = bflo(w1[q]); wv[8 + 2 * q + 1] = bfhi(w1[q]); }
                    const int T = p >> 8, pl = p & 255, lc = T * 256 + ((pl >> 5) & 3) * 64 + (pl >> 7) * 32 + (pl & 31);
#pragma unroll 1
                    for (int b = 0; b < 9; ++b) { float s = 0.f;
#pragma unroll
                        for (int q = 0; q < 4; ++q) { const pg8::f32x4 a = *(const pg8::f32x4*)(mod + b * 6144 + 3072 + 16 * lane + 4 * q) + *(const pg8::f32x4*)(adab + 3072 + 16 * lane + 4 * q);
                            s += a[0] * wv[4 * q] + a[1] * wv[4 * q + 1] + a[2] * wv[4 * q + 2] + a[3] * wv[4 * q + 3]; }
                        s = wave_sum(s); if (lane == 0) shw[b * UPW + lc] = s; }
                }
            }
            SEAM(1);
    }
    if (IN(2)) { PH_IDS(); const int hf = 0; const int rep_ = 0; (void)hf; (void)rep_;

            pg8::Gemm g{h1_buf(ws, dout, hf), WSB(WS_WIN), MH, INW, DM}; pg8::StaticOrder S; S.init(MH, INW, G, bx);
            float* nck = dout + (size_t)MTOT * DM; float* ncv = nck + (size_t)NPR * KVP;
            pg8::EpiInProj E{WSB(WS_Q), WSB(WS_K), WSB(WS_V), WSB(WS_RQ), WSB(WS_GF), WSB(WS_GB), WSB(WS_RI), WSB(WS_ZA), WSB(WS_PP), nck, ncv, AIN(12), AIN(13), WSF(WS_LBT), WSF(WS_ROPE), hf};
            pg8::gemm_phase<pg8::EpiInProj, pg8::StaticOrder, true, true>(lds, g, S, E);
            { const int rem = ((MH / 256) * (INW / 256)) % G;
              if (bx >= rem) do_norm1(ap, 1, (bx - rem) * NWAVES + wave, (G - rem) * NWAVES, lane, true, false); }
            SEAM(2);
    }
    if (IN(3)) { PH_IDS(); const int hf = 0; const int rep_ = 0; (void)hf; (void)rep_;

            const int nlong = hf ? 80 : 48, nbig = hf ? 640 : 384, nshort = hf ? 0 : 256, nsmall = hf ? 0 : 256;
#ifndef DUPREC
#define DUPREC 0
#endif
#ifndef DUPATT
#define DUPATT 0
#endif
            const int ndl = DUPREC ? nlong : 0, nda = DUPATT ? nbig : 0;
            const int ntot = ndl + nda + nlong + nbig + nshort + nsmall;
            LAS int* slot = (LAS int*)(lds + RING_BYTES); unsigned* ctl = (unsigned*)(ws + WS_CTL);
            bf16_t* Qb = WSB(WS_Q); bf16_t* Kb = WSB(WS_K); bf16_t* Vb = WSB(WS_V); bf16_t* RQ = WSB(WS_RQ); bf16_t* GF = WSB(WS_GF); bf16_t* GB = WSB(WS_GB); bf16_t* RI = WSB(WS_RI);
            float* nst = dout + (size_t)MTOT * DM + 2 * (size_t)NPR * KVP;
            for (;;) {
                __syncthreads();
                if (tid == 0) *slot = (int)atomicAdd(ctl + 64 * hf + ((DUP(2) && rep_ == 0) ? 16 : 0), 1u);
                __syncthreads();
                int it = *slot;
                if (it >= ntot) break;
                bool wr = !(DUP(2) && rep_ == 0);
                if (it < ndl) wr = false; else { it -= ndl; if (it < nda) { wr = false; it += nlong; } else it -= nda; }
                if (it < nlong) {
                    const int b = it >> 4, rh = (it >> 1) & 7, dir = it & 1; const int bglob = hf ? 3 + b : b;
                    rec_scan(lds, RQ, dir ? GB : GF, RI, (hf ? 0 : NPR) + b * 2048, 2048, rh, dir, AIN(5) + (size_t)((bglob * 2 + dir) * 8 + rh) * 16384, nullptr, wr);
                } else if ((it -= nlong) < nbig) {
                    const int gq = it & 3, qb = (it >> 2) & 7, kvh = (it >> 5) & 3, b = it >> 7, h = kvh * 4 + gq;
                    const int lrow0 = (hf ? 0 : NPR) + b * 2048 + qb * 256, kvr0 = (hf ? 0 : NPR) + b * 2560;
                    attn_body::attn_unit<8>((const attn_body::bf16*)(Qb + (size_t)lrow0 * DM + h * 64), (const attn_body::bf16*)(Kb + (size_t)kvr0 * KVP + kvh * 64), (const attn_body::bf16*)(Vb + (size_t)kvr0 * KVP + kvh * 64),
                                            (attn_body::bf16*)(Qb + (size_t)lrow0 * DM + h * 64), 40, (char*)lds_raw, wr);
                } else if ((it -= nbig) < nshort) {
                    const int seq = it >> 4, rh = (it >> 1) & 7, dir = it & 1;
                    rec_scan(lds, RQ, dir ? GB : GF, RI, seq * 256, 256, rh, dir, nullptr, nst + (size_t)((seq * 2 + dir) * 8 + rh) * 16384, wr);
                } else {
                    it -= nshort; const int seq = it >> 4, h = it & 15, kvh = h >> 2;
                    attn_body::attn_unit<8>((const attn_body::bf16*)(Qb + (size_t)(seq * 256) * DM + h * 64), (const attn_body::bf16*)(Kb + (size_t)(seq * 256) * KVP + kvh * 64), (const attn_body::bf16*)(Vb + (size_t)(seq * 256) * KVP + kvh * 64),
                                            (attn_body::bf16*)(Qb + (size_t)(seq * 256) * DM + h * 64), 4, (char*)lds_raw, wr);
                }
            }
            if (DUP(2) && rep_ == 0) xcd_barrier(xbar);
            SEAM(3);
    }
    if (IN(4)) { PH_IDS(); const int hf = 0; const int rep_ = 0; (void)hf; (void)rep_;

            const float* hg = AIN(15); bf16_t* Qb = WSB(WS_Q); bf16_t* ZA = WSB(WS_ZA); bf16_t* GF = WSB(WS_GF); bf16_t* GB = WSB(WS_GB); bf16_t* PP = WSB(WS_PP); bf16_t* H = WSB(WS_H);
            for (int r = gw; r < MH; r += NGW) {
                const size_t off = (size_t)r * DM + 16 * lane;
                v4u o[2], z[2], f[2], bq[2], p[2];
#pragma unroll
                for (int e = 0; e < 2; ++e) { o[e] = *(const v4u*)(Qb + off + 8 * e); z[e] = *(const v4u*)(ZA + off + 8 * e); f[e] = *(const v4u*)(GF + off + 8 * e); bq[e] = *(const v4u*)(GB + off + 8 * e); p[e] = *(const v4u*)(PP + off + 8 * e); }
                float s[16]; float ss = 0.f;
#pragma unroll
                for (int e = 0; e < 2; ++e)
#pragma unroll
                    for (int q = 0; q < 4; ++q) { s[8 * e + 2 * q] = bflo(f[e][q]) + bflo(bq[e][q]); s[8 * e + 2 * q + 1] = bfhi(f[e][q]) + bfhi(bq[e][q]); }
#pragma unroll
                for (int q = 0; q < 16; ++q) ss += s[q] * s[q];
                ss += __shfl_xor(ss, 1); ss += __shfl_xor(ss, 2); ss += __shfl_xor(ss, 4);
                const float rs = __builtin_amdgcn_rsqf(ss * (1.0f / 128.0f) + EPS);
                const int gc = (16 * lane) & 127;
                v4u outw[2];
#pragma unroll
                for (int e = 0; e < 2; ++e)
#pragma unroll
                    for (int q = 0; q < 4; ++q) {
                        const int i0 = 8 * e + 2 * q;
                        const float m0 = bflo(o[e][q]) * bflo(z[e][q]) + bflo(p[e][q]) * (s[i0] * rs * hg[gc + i0]);
                        const float m1 = bfhi(o[e][q]) * bfhi(z[e][q]) + bfhi(p[e][q]) * (s[i0 + 1] * rs * hg[gc + i0 + 1]);
                        outw[e][q] = pk2(m0, m1);
                    }
                *(v4u*)(H + off) = outw[0]; *(v4u*)(H + off + 8) = outw[1];
            }
            do_norm1(ap, 1, gw, NGW, lane, false, true);
            SEAM(4);
    }
    if (IN(5)) { PH_IDS(); const int hf = 1; const int rep_ = 0; (void)hf; (void)rep_;

            pg8::Gemm g{h1_buf(ws, dout, hf), WSB(WS_WIN), MH, INW, DM}; pg8::StaticOrder S; S.init(MH, INW, G, bx);
            float* nck = dout + (size_t)MTOT * DM; float* ncv = nck + (size_t)NPR * KVP;
            pg8::EpiInProj E{WSB(WS_Q), WSB(WS_K), WSB(WS_V), WSB(WS_RQ), WSB(WS_GF), WSB(WS_GB), WSB(WS_RI), WSB(WS_ZA), WSB(WS_PP), nck, ncv, AIN(12), AIN(13), WSF(WS_LBT), WSF(WS_ROPE), hf};
            pg8::gemm_phase<pg8::EpiInProj, pg8::StaticOrder, true, true>(lds, g, S, E);
            { const int rem = ((MH / 256) * (INW / 256)) % G;
              if (bx >= rem) {
            { pg8::Gemm g{WSB(WS_H), WSB(WS_WO), MH, DM, DM}; pg8::StaticOrder S; S.init(MH, DM, G - rem, bx - rem);
              pg8::EpiResidW E{AIN(0), AIN(1), dout, WSF(WS_MODB), WSF(WS_GAM), WSB(WS_H2), WSF(WS_ROWSS), 2048, 0};
              pg8::gemm_phase<pg8::EpiResidW, pg8::StaticOrder, true, true>(lds, g, S, E); }
              } }
            SEAM(5);
    }
    if (IN(6)) { PH_IDS(); const int hf = 1; const int rep_ = 0; (void)hf; (void)rep_;

            const int nlong = hf ? 80 : 48, nbig = hf ? 640 : 384, nshort = hf ? 0 : 256, nsmall = hf ? 0 : 256;
#ifndef DUPREC
#define DUPREC 0
#endif
#ifndef DUPATT
#define DUPATT 0
#endif
            const int ndl = DUPREC ? nlong : 0, nda = DUPATT ? nbig : 0;
            const int ntot = ndl + nda + nlong + nbig + nshort + nsmall;
            LAS int* slot = (LAS int*)(lds + RING_BYTES); unsigned* ctl = (unsigned*)(ws + WS_CTL);
            bf16_t* Qb = WSB(WS_Q); bf16_t* Kb = WSB(WS_K); bf16_t* Vb = WSB(WS_V); bf16_t* RQ = WSB(WS_RQ); bf16_t* GF = WSB(WS_GF); bf16_t* GB = WSB(WS_GB); bf16_t* RI = WSB(WS_RI);
            float* nst = dout + (size_t)MTOT * DM + 2 * (size_t)NPR * KVP;
            for (;;) {
                __syncthreads();
                if (tid == 0) *slot = (int)atomicAdd(ctl + 64 * hf + ((DUP(2) && rep_ == 0) ? 16 : 0), 1u);
                __syncthreads();
                int it = *slot;
                if (it >= ntot) break;
                bool wr = !(DUP(2) && rep_ == 0);
                if (it < ndl) wr = false; else { it -= ndl; if (it < nda) { wr = false; it += nlong; } else it -= nda; }
                if (it < nlong) {
                    const int b = it >> 4, rh = (it >> 1) & 7, dir = it & 1; const int bglob = hf ? 3 + b : b;
                    rec_scan(lds, RQ, dir ? GB : GF, RI, (hf ? 0 : NPR) + b * 2048, 2048, rh, dir, AIN(5) + (size_t)((bglob * 2 + dir) * 8 + rh) * 16384, nullptr, wr);
                } else if ((it -= nlong) < nbig) {
                    const int gq = it & 3, qb = (it >> 2) & 7, kvh = (it >> 5) & 3, b = it >> 7, h = kvh * 4 + gq;
                    const int lrow0 = (hf ? 0 : NPR) + b * 2048 + qb * 256, kvr0 = (hf ? 0 : NPR) + b * 2560;
                    attn_body::attn_unit<8>((const attn_body::bf16*)(Qb + (size_t)lrow0 * DM + h * 64), (const attn_body::bf16*)(Kb + (size_t)kvr0 * KVP + kvh * 64), (const attn_body::bf16*)(Vb + (size_t)kvr0 * KVP + kvh * 64),
                                            (attn_body::bf16*)(Qb + (size_t)lrow0 * DM + h * 64), 40, (char*)lds_raw, wr);
                } else if ((it -= nbig) < nshort) {
                    const int seq = it >> 4, rh = (it >> 1) & 7, dir = it & 1;
                    rec_scan(lds, RQ, dir ? GB : GF, RI, seq * 256, 256, rh, dir, nullptr, nst + (size_t)((seq * 2 + dir) * 8 + rh) * 16384, wr);
                } else {
                    it -= nshort; const int seq = it >> 4, h = it & 15, kvh = h >> 2;
                    attn_body::attn_unit<8>((const attn_body::bf16*)(Qb + (size_t)(seq * 256) * DM + h * 64), (const attn_body::bf16*)(Kb + (size_t)(seq * 256) * KVP + kvh * 64), (const attn_body::bf16*)(Vb + (size_t)(seq * 256) * KVP + kvh * 64),
                                            (attn_body::bf16*)(Qb + (size_t)(seq * 256) * DM + h * 64), 4, (char*)lds_raw, wr);
                }
            }
            if (DUP(2) && rep_ == 0) xcd_barrier(xbar);
            SEAM(6);
    }
    if (IN(7)) { PH_IDS(); const int hf = 1; const int rep_ = 0; (void)hf; (void)rep_;

            const float* hg = AIN(15); bf16_t* Qb = WSB(WS_Q); bf16_t* ZA = WSB(WS_ZA); bf16_t* GF = WSB(WS_GF); bf16_t* GB = WSB(WS_GB); bf16_t* PP = WSB(WS_PP); bf16_t* H = WSB(WS_H);
            for (int r = gw; r < MH; r += NGW) {
                const size_t off = (size_t)r * DM + 16 * lane;
                v4u o[2], z[2], f[2], bq[2], p[2];
#pragma unroll
                for (int e = 0; e < 2; ++e) { o[e] = *(const v4u*)(Qb + off + 8 * e); z[e] = *(const v4u*)(ZA + off + 8 * e); f[e] = *(const v4u*)(GF + off + 8 * e); bq[e] = *(const v4u*)(GB + off + 8 * e); p[e] = *(const v4u*)(PP + off + 8 * e); }
                float s[16]; float ss = 0.f;
#pragma unroll
                for (int e = 0; e < 2; ++e)
#pragma unroll
                    for (int q = 0; q < 4; ++q) { s[8 * e + 2 * q] = bflo(f[e][q]) + bflo(bq[e][q]); s[8 * e + 2 * q + 1] = bfhi(f[e][q]) + bfhi(bq[e][q]); }
#pragma unroll
                for (int q = 0; q < 16; ++q) ss += s[q] * s[q];
                ss += __shfl_xor(ss, 1); ss += __shfl_xor(ss, 2); ss += __shfl_xor(ss, 4);
                const float rs = __builtin_amdgcn_rsqf(ss * (1.0f / 128.0f) + EPS);
                const int gc = (16 * lane) & 127;
                v4u outw[2];
#pragma unroll
                for (int e = 0; e < 2; ++e)
#pragma unroll
                    for (int q = 0; q < 4; ++q) {
                        const int i0 = 8 * e + 2 * q;
                        const float m0 = bflo(o[e][q]) * bflo(z[e][q]) + bflo(p[e][q]) * (s[i0] * rs * hg[gc + i0]);
                        const float m1 = bfhi(o[e][q]) * bfhi(z[e][q]) + bfhi(p[e][q]) * (s[i0 + 1] * rs * hg[gc + i0 + 1]);
                        outw[e][q] = pk2(m0, m1);
                    }
                *(v4u*)(H + off) = outw[0]; *(v4u*)(H + off + 8) = outw[1];
            }
            SEAM(7);
    }
    if (IN(8)) { PH_IDS(); const int hf = 0; const int rep_ = 0; (void)hf; (void)rep_;

            pg8::Gemm g{WSB(WS_H2), WSB(WS_WUP), MH, UPW, DM}; pg8::StaticOrder S; S.init(MH, UPW, G, bx);
            pg8::EpiUp E{WSB(WS_U), UPW, WSF(WS_ROWSS), WSF(WS_SHW), hf};
            pg8::gemm_phase<pg8::EpiUp, pg8::StaticOrder, true, true>(lds, g, S, E);
            SEAM(8);
    }
    if (IN(9)) { PH_IDS(); const int hf = 0; const int rep_ = 0; (void)hf; (void)rep_;

            const float* cw = AIN(18); const float* cb = AIN(19); const bf16_t* U = WSB(WS_U); bf16_t* ACT = WSB(WS_ACT);
            for (int item = gw; item < (MH / 16) * 11; item += NGW) {
                const int run = item / 11, st = item - run * 11, r0 = run * 16, grow0 = hf * MH + r0;
                const int t0 = grow0 < NPR ? (grow0 & 255) : ((grow0 - NPR) & 2047); const int Ls = grow0 < NPR ? 256 : 2048;
                const int c = (st * 64 + lane) * 4;
                const pg8::f32x4 wa0 = *(const pg8::f32x4*)(cw + c), wa1 = *(const pg8::f32x4*)(cw + UPW + c), wa2 = *(const pg8::f32x4*)(cw + 2 * UPW + c), ba = *(const pg8::f32x4*)(cb + c);
                const pg8::f32x4 wb0 = *(const pg8::f32x4*)(cw + DFF + c), wb1 = *(const pg8::f32x4*)(cw + UPW + DFF + c), wb2 = *(const pg8::f32x4*)(cw + 2 * UPW + DFF + c), bb = *(const pg8::f32x4*)(cb + DFF + c);
                const bf16_t* up = U + (size_t)r0 * UPW + c;
                u32x2 pa = {0u, 0u}, pb2 = {0u, 0u};
                if (t0 > 0) { pa = *(const u32x2*)(up - UPW); pb2 = *(const u32x2*)(up - UPW + DFF); }
                u32x2 ca = *(const u32x2*)(up), cb2 = *(const u32x2*)(up + DFF);
#pragma unroll
                for (int i = 0; i < 16; ++i) {
                    u32x2 na = {0u, 0u}, nb = {0u, 0u};
                    if (t0 + i < Ls - 1) { na = *(const u32x2*)(up + (size_t)(i + 1) * UPW); nb = *(const u32x2*)(up + (size_t)(i + 1) * UPW + DFF); }
                    pg8::f32x4 a, b;
                    a[0] = wa0[0] * bflo(pa.x) + wa1[0] * bflo(ca.x) + wa2[0] * bflo(na.x) + ba[0]; a[1] = wa0[1] * bfhi(pa.x) + wa1[1] * bfhi(ca.x) + wa2[1] * bfhi(na.x) + ba[1];
                    a[2] = wa0[2] * bflo(pa.y) + wa1[2] * bflo(ca.y) + wa2[2] * bflo(na.y) + ba[2]; a[3] = wa0[3] * bfhi(pa.y) + wa1[3] * bfhi(ca.y) + wa2[3] * bfhi(na.y) + ba[3];
                    b[0] = wb0[0] * bflo(pb2.x) + wb1[0] * bflo(cb2.x) + wb2[0] * bflo(nb.x) + bb[0]; b[1] = wb0[1] * bfhi(pb2.x) + wb1[1] * bfhi(cb2.x) + wb2[1] * bfhi(nb.x) + bb[1];
                    b[2] = wb0[2] * bflo(pb2.y) + wb1[2] * bflo(cb2.y) + wb2[2] * bflo(nb.y) + bb[2]; b[3] = wb0[3] * bfhi(pb2.y) + wb1[3] * bfhi(cb2.y) + wb2[3] * bfhi(nb.y) + bb[3];
                    u32x2 wv; wv.x = pk2(fsilu(a[0]) * b[0], fsilu(a[1]) * b[1]); wv.y = pk2(fsilu(a[2]) * b[2], fsilu(a[3]) * b[3]);
                    *(u32x2*)(ACT + (size_t)(r0 + i) * DFF + c) = wv;
                    pa = ca; pb2 = cb2; ca = na; cb2 = nb;
                }
            }
            SEAM(9);
    }
    if (IN(10)) { PH_IDS(); const int hf = 0; (void)hf;
            const int nun = (MH / 256) * (DM / 256); const int first = nun < G ? nun : 0;
            if (first == 0 || bx < first) {

            pg8::Gemm g{WSB(WS_ACT), WSB(WS_WDN), MH, DM, DFF}; pg8::StaticOrder S; S.init(MH, DM, G, bx);
            pg8::EpiResid E{dout, dout + (size_t)NPR * DM, dout, WSF(WS_MODB), 5120, hf};
            pg8::gemm_phase<pg8::EpiResid, pg8::StaticOrder, true, true>(lds, g, S, E);
            }
            if (bx >= first) {
            { pg8::Gemm g{WSB(WS_H), WSB(WS_WO), MH, DM, DM}; pg8::StaticOrder S; S.init(MH, DM, G - first, bx - first);
              pg8::EpiResidW E{AIN(0), AIN(1), dout, WSF(WS_MODB), WSF(WS_GAM), WSB(WS_H2), WSF(WS_ROWSS), 2048, 1};
              pg8::gemm_phase<pg8::EpiResidW, pg8::StaticOrder, true, true>(lds, g, S, E); }
            }
            SEAM(10);
    }
    if (IN(11)) { PH_IDS(); const int hf = 1; const int rep_ = 0; (void)hf; (void)rep_;

            pg8::Gemm g{WSB(WS_H2), WSB(WS_WUP), MH, UPW, DM}; pg8::StaticOrder S; S.init(MH, UPW, G, bx);
            pg8::EpiUp E{WSB(WS_U), UPW, WSF(WS_ROWSS), WSF(WS_SHW), hf};
            pg8::gemm_phase<pg8::EpiUp, pg8::StaticOrder, true, true>(lds, g, S, E);
            { const int rem = ((MH / 256) * (UPW / 256)) % G; if (bx >= rem) do_final(ap, 0, (bx - rem) * NWAVES + wave, (G - rem) * NWAVES, lane); }
            SEAM(11);
    }
    if (IN(12)) { PH_IDS(); const int hf = 1; const int rep_ = 0; (void)hf; (void)rep_;

            const float* cw = AIN(18); const float* cb = AIN(19); const bf16_t* U = WSB(WS_U); bf16_t* ACT = WSB(WS_ACT);
            for (int item = gw; item < (MH / 16) * 11; item += NGW) {
                const int run = item / 11, st = item - run * 11, r0 = run * 16, grow0 = hf * MH + r0;
                const int t0 = grow0 < NPR ? (grow0 & 255) : ((grow0 - NPR) & 2047); const int Ls = grow0 < NPR ? 256 : 2048;
                const int c = (st * 64 + lane) * 4;
                const pg8::f32x4 wa0 = *(const pg8::f32x4*)(cw + c), wa1 = *(const pg8::f32x4*)(cw + UPW + c), wa2 = *(const pg8::f32x4*)(cw + 2 * UPW + c), ba = *(const pg8::f32x4*)(cb + c);
                const pg8::f32x4 wb0 = *(const pg8::f32x4*)(cw + DFF + c), wb1 = *(const pg8::f32x4*)(cw + UPW + DFF + c), wb2 = *(const pg8::f32x4*)(cw + 2 * UPW + DFF + c), bb = *(const pg8::f32x4*)(cb + DFF + c);
                const bf16_t* up = U + (size_t)r0 * UPW + c;
                u32x2 pa = {0u, 0u}, pb2 = {0u, 0u};
                if (t0 > 0) { pa = *(const u32x2*)(up - UPW); pb2 = *(const u32x2*)(up - UPW + DFF); }
                u32x2 ca = *(const u32x2*)(up), cb2 = *(const u32x2*)(up + DFF);
#pragma unroll
                for (int i = 0; i < 16; ++i) {
                    u32x2 na = {0u, 0u}, nb = {0u, 0u};
                    if (t0 + i < Ls - 1) { na = *(const u32x2*)(up + (size_t)(i + 1) * UPW); nb = *(const u32x2*)(up + (size_t)(i + 1) * UPW + DFF); }
                    pg8::f32x4 a, b;
                    a[0] = wa0[0] * bflo(pa.x) + wa1[0] * bflo(ca.x) + wa2[0] * bflo(na.x) + ba[0]; a[1] = wa0[1] * bfhi(pa.x) + wa1[1] * bfhi(ca.x) + wa2[1] * bfhi(na.x) + ba[1];
                    a[2] = wa0[2] * bflo(pa.y) + wa1[2] * bflo(ca.y) + wa2[2] * bflo(na.y) + ba[2]; a[3] = wa0[3] * bfhi(pa.y) + wa1[3] * bfhi(ca.y) + wa2[3] * bfhi(na.y) + ba[3];
                    b[0] = wb0[0] * bflo(pb2.x) + wb1[0] * bflo(cb2.x) + wb2[0] * bflo(nb.x) + bb[0]; b[1] = wb0[1] * bfhi(pb2.x) + wb1[1] * bfhi(cb2.x) + wb2[1] * bfhi(nb.x) + bb[1];
                    b[2] = wb0[2] * bflo(pb2.y) + wb1[2] * bflo(cb2.y) + wb2[2] * bflo(nb.y) + bb[2]; b[3] = wb0[3] * bfhi(pb2.y) + wb1[3] * bfhi(cb2.y) + wb2[3] * bfhi(nb.y) + bb[3];
                    u32x2 wv; wv.x = pk2(fsilu(a[0]) * b[0], fsilu(a[1]) * b[1]); wv.y = pk2(fsilu(a[2]) * b[2], fsilu(a[3]) * b[3]);
                    *(u32x2*)(ACT + (size_t)(r0 + i) * DFF + c) = wv;
                    pa = ca; pb2 = cb2; ca = na; cb2 = nb;
                }
            }
            SEAM(12);
    }
    if (IN(13)) { PH_IDS(); const int hf = 1; const int rep_ = 0; (void)hf; (void)rep_;

            pg8::Gemm g{WSB(WS_ACT), WSB(WS_WDN), MH, DM, DFF}; pg8::StaticOrder S; S.init(MH, DM, G, bx);
            pg8::EpiResid E{dout, dout + (size_t)NPR * DM, dout, WSF(WS_MODB), 5120, hf};
            pg8::gemm_phase<pg8::EpiResid, pg8::StaticOrder, true, true>(lds, g, S, E);
            SEAM(13);
    }
    if (IN(14)) { PH_IDS(); do_final(ap, 1, gw, NGW, lane); }
#undef IN
#undef SEAM
}

extern "C" void kernel_launch(void* const* d_in, const int* in_sizes, int n_in, void* d_out, int out_size, void* d_ws, size_t ws_size, hipStream_t stream) {
    static int grid = 0;
    if (grid == 0) {
        if (n_in != 22 || ws_size < WS_END) { fprintf(stderr, "kernel_launch: unexpected n_in %d / ws_size %zu\n", n_in, ws_size); grid = -1; return; }
        int dev = 0, cus = 0, per_cu = 0;
        hipGetDevice(&dev); hipDeviceGetAttribute(&cus, hipDeviceAttributeMultiprocessorCount, dev);
        if (hipFuncSetAttribute((const void*)fwd_mega, hipFuncAttributeMaxDynamicSharedMemorySize, LDS_BYTES) != hipSuccess) { fprintf(stderr, "kernel_launch: hipFuncSetAttribute failed\n"); grid = -1; return; }
        if (hipOccupancyMaxActiveBlocksPerMultiprocessor(&per_cu, (const void*)fwd_mega, NTHR, LDS_BYTES) != hipSuccess || per_cu < 1) { fprintf(stderr, "kernel_launch: occupancy query says %d\n", per_cu); per_cu = 1; }
        (void)hipGetLastError();
        grid = cus;
    }
    if (grid < 0) return;
    hipMemsetAsync((char*)d_ws + WS_CTL, 0, CTL_ZERO_BYTES, stream);
    Args a{};
    for (int i = 0; i < 22; ++i) a.in[i] = (const float*)d_in[i];
    a.out = (float*)d_out; a.ws = (unsigned char*)d_ws;
#if MK_SINGLE
    a.ph_lo = 0; a.ph_hi = N_PHASES;
    void* kargs[] = {&a};
    hipError_t e = hipLaunchCooperativeKernel((const void*)fwd_mega, dim3(grid), dim3(NTHR), kargs, LDS_BYTES, stream);
    if (e != hipSuccess) fprintf(stderr, "kernel_launch: cooperative launch failed: %s (grid %d)\n", hipGetErrorString(e), grid);
#else
    for (int p = 0; p < N_PHASES; ++p) { a.ph_lo = p; a.ph_hi = p + 1; hipLaunchKernelGGL(fwd_mega, dim3(grid), dim3(NTHR), LDS_BYTES, stream, a); }
#endif
}
```

```cpp
#include <hip/hip_runtime.h>
#include <hip/hip_cooperative_groups.h>
#include <hip/hip_bf16.h>
#include <cstdio>
#include <cstdint>
#include <cmath>
namespace cg = cooperative_groups;

constexpr int DM = 1024, NPR = 4096  , MTOT = 20480, MH = 10240  ;
constexpr int INW = 8704, DFF = 2816, UPW = 5632;
constexpr int KVP = 256;
constexpr float EPS = 1e-6f;
constexpr float QSCALE = 0.125f * 1.4426950408889634f;

#define GAS __attribute__((address_space(1)))
#define LAS __attribute__((address_space(3)))
typedef unsigned short bf16_t;
typedef float f32x2 __attribute__((ext_vector_type(2)));
typedef unsigned u32x2 __attribute__((ext_vector_type(2)));
typedef float f32x16 __attribute__((ext_vector_type(16)));

__device__ __forceinline__ float bf2f(unsigned short h) { return __uint_as_float(((unsigned)h) << 16); }
__device__ __forceinline__ float bflo(unsigned w) { return __uint_as_float(w << 16); }
__device__ __forceinline__ float bfhi(unsigned w) { return __uint_as_float(w & 0xffff0000u); }
__device__ __forceinline__ float fsigmoid(float x) { return __builtin_amdgcn_rcpf(1.0f + __expf(-x)); }
__device__ __forceinline__ float fsilu(float x) { return x * fsigmoid(x); }
__device__ __forceinline__ unsigned pkh2(float a, float b) { _Float16 ha = (_Float16)a, hb = (_Float16)b; return (unsigned)__builtin_bit_cast(unsigned short, ha) | ((unsigned)__builtin_bit_cast(unsigned short, hb) << 16); }
__device__ __forceinline__ float h2f(unsigned short h) { return (float)__builtin_bit_cast(_Float16, h); }
__device__ __forceinline__ float wave_sum(float v) {
#pragma unroll
    for (int o = 1; o < 64; o <<= 1) v += __shfl_xor(v, o);
    return v;
}
__device__ __forceinline__ int mod_of_row(int grow) { return grow < NPR ? 0 : 1 + ((grow - NPR) >> 11); }
__device__ __forceinline__ int kv_row(int grow, int hf) {
    if (grow < NPR) return grow;
    const int s = grow - NPR, b = s >> 11, t = s & 2047;
    return (hf ? (b - 3) * 2560 : NPR + b * 2560) + t;
}

namespace pg8 {
#define PG8_LAS __attribute__((address_space(3)))
typedef unsigned short bf16_t;
typedef short bf16x8 __attribute__((ext_vector_type(8)));
typedef float f32x4 __attribute__((ext_vector_type(4)));
typedef unsigned u32x4 __attribute__((ext_vector_type(4)));
constexpr int BM = 256, BK = 64, HALF = 128, HTB = HALF * BK * 2  , STAGE_BYTES = 8 * HTB, NXCD = 8, WGM = 8;

__host__ __device__ __forceinline__ int lds_byte(int r, int c) { const int st = (r >> 4) * 2 + (c >> 5), rr = r & 15, cc = c & 31, ob = rr * 64 + cc * 2; return st * 1024 + (ob ^ (((ob >> 9) & 1) << 5)); }
__host__ __device__ __forceinline__ void stage_rc(int b, int& R, int& C) { const int st = b / 1024, sb = b % 1024, swz = sb ^ (((sb >> 9) & 1) << 5); R = (st >> 1) * 16 + swz / 64; C = (st & 1) * 32 + (swz % 64) / 2; }
__host__ __device__ __forceinline__ int perm32(int rho) { const int n = rho >> 4, i = rho & 15; return 8 * (i >> 2) + 4 * n + (i & 3); }

struct Unit { int pm, pn; };
struct Gemm { const bf16_t* A; const bf16_t* Bt; int M, N, K; };

struct StaticOrder {
    int nM, nN, nwg, G, c;
    __host__ __device__ void init(int M, int N, int G_, int c_) { nM = M / BM; nN = N / BM; nwg = nM * nN; G = G_; c = c_; }
    __host__ __device__ bool next(int i, Unit& u) const {
        const long L = (long)i * G + c; if (L >= nwg) return false;
        int wgid = (int)L; { const int q = nwg / NXCD, r = nwg % NXCD, xcd = wgid % NXCD, off = wgid / NXCD; wgid = (xcd < r ? xcd * (q + 1) : r * (q + 1) + (xcd - r) * q) + off; }
        const int nig = WGM * nN, gid = wgid / nig, fm = gid * WGM, gsz = (nM - fm) < WGM ? (nM - fm) : WGM;
        u.pm = fm + ((wgid % nig) % gsz); u.pn = (wgid % nig) / gsz; return true;
    }
    __device__ __forceinline__ void a_ready(const Unit&) const {}
    __device__ __forceinline__ void done(const Unit&) const {}
};

__device__ __forceinline__ unsigned cvt_pk_bf16(float lo, float hi) { unsigned r; asm volatile("v_cvt_pk_bf16_f32 %0, %1, %2" : "=v"(r) : "v"(lo), "v"(hi)); return r; }
__device__ __forceinline__ u32x2 pk4(f32x4 v) { u32x2 w; w.x = cvt_pk_bf16(v[0], v[1]); w.y = cvt_pk_bf16(v[2], v[3]); return w; }

#define EPI_FENCE() asm volatile("" ::: "memory")
struct EpiInProj {
    static constexpr bool PERM = false, AFTER_DRAIN = false;
    bf16_t *Q, *Kb, *Vb, *RQ, *GF, *GB, *RI, *ZA, *PP; float *nck, *ncv; const float *qg, *kg, *lbt; const float* rope; int hf;
    __device__ __forceinline__ void operator()(const f32x4 (&acc)[2][2][4][2], const Unit& u, int wr, int wc, int fr, int fq) const {
        const int T = u.pn;
        const int lrow0 = u.pm * BM + wr * 64 + fr;
        if (T <= 4) {
            const bool isq = T < 4; const float* gain = (isq ? qg : kg) + 4 * fq;
#pragma unroll
            for (int ai = 0; ai < 2; ++ai)
#pragma unroll
                for (int m = 0; m < 4; ++m) {
                    const int lrow = lrow0 + ai * HALF + m * 16, grow = hf * MH + lrow;
                    float ss = 0.f;
#pragma unroll
                    for (int bj = 0; bj < 2; ++bj)
#pragma unroll
                        for (int n = 0; n < 2; ++n) { const f32x4 v = acc[ai][bj][m][n]; ss += (v[0] * v[0] + v[1] * v[1]) + (v[2] * v[2] + v[3] * v[3]); }
                    ss += __shfl_xor(ss, 16); ss += __shfl_xor(ss, 32);
                    const float rs = __builtin_amdgcn_rsqf(ss * (1.0f / 64.0f) + EPS);
                    const bool latent = grow >= NPR;
                    const int t = (grow - NPR) & 2047;
#pragma unroll
                    for (int bj = 0; bj < 2; ++bj) {
                        f32x4 x1 = acc[ai][bj][m][0] * rs * *(const f32x4*)(gain + 32 * bj), x2 = acc[ai][bj][m][1] * rs * *(const f32x4*)(gain + 32 * bj + 16);
                        if (latent) {
                            const int pos = bj ? (t & 63) : (t >> 6);
                            const f32x4 cs0 = *(const f32x4*)(rope + (pos * 16 + 4 * fq) * 2), cs1 = *(const f32x4*)(rope + (pos * 16 + 4 * fq) * 2 + 4);
                            const f32x4 c = {cs0[0], cs0[2], cs1[0], cs1[2]}, s = {cs0[1], cs0[3], cs1[1], cs1[3]};
                            const f32x4 y1 = x1 * c - x2 * s, y2 = x1 * s + x2 * c; x1 = y1; x2 = y2;
                        }
                        if (isq) {
                            bf16_t* qp = Q + (unsigned)(lrow * DM + (4 * T + wc) * 64 + 4 * fq + 32 * bj);
                            *(u32x2*)(qp) = pk4(x1 * QSCALE); *(u32x2*)(qp + 16) = pk4(x2 * QSCALE);
                        } else {
                            bf16_t* kp = Kb + (unsigned)(kv_row(grow, hf) * KVP + wc * 64 + 4 * fq + 32 * bj);
                            *(u32x2*)(kp) = pk4(x1); *(u32x2*)(kp + 16) = pk4(x2);
                            if (!latent) { float* op = nck + (unsigned)(grow * KVP + wc * 64 + 4 * fq + 32 * bj); *(f32x4*)(op) = x1; *(f32x4*)(op + 16) = x2; }
                        }
                    }
                    EPI_FENCE();
                }
        } else if (T == 5) {
#pragma unroll
            for (int ai = 0; ai < 2; ++ai)
#pragma unroll
                for (int m = 0; m < 4; ++m) {
                    const int lrow = lrow0 + ai * HALF + m * 16, grow = hf * MH + lrow;
                    bf16_t* vp = Vb + (unsigned)(kv_row(grow, hf) * KVP + wc * 64 + 4 * fq);
#pragma unroll
                    for (int bj = 0; bj < 2; ++bj)
#pragma unroll
                        for (int n = 0; n < 2; ++n) *(u32x2*)(vp + 32 * bj + 16 * n) = pk4(acc[ai][bj][m][n]);
                    if (grow < NPR) { float* op = ncv + (unsigned)(grow * KVP + wc * 64 + 4 * fq);
#pragma unroll
                        for (int bj = 0; bj < 2; ++bj)
#pragma unroll
                            for (int n = 0; n < 2; ++n) *(f32x4*)(op + 32 * bj + 16 * n) = acc[ai][bj][m][n]; }
                    EPI_FENCE();
                }
        } else if (T < 10) {
            bf16_t* base = RQ + (T - 6) * 256 + wc * 64;
#pragma unroll
            for (int ai = 0; ai < 2; ++ai)
#pragma unroll
                for (int m = 0; m < 4; ++m) { bf16_t* rp = base + (unsigned)((lrow0 + ai * HALF + m * 16) * DM + 4 * fq);
#pragma unroll
                    for (int bj = 0; bj < 2; ++bj)
#pragma unroll
                        for (int n = 0; n < 2; ++n) { const f32x4 v = acc[ai][bj][m][n]; f32x4 o;
#pragma unroll
                            for (int j = 0; j < 4; ++j) o[j] = fsilu(v[j]) * 0.08838834764831845f;
                            *(u32x2*)(rp + 32 * bj + 16 * n) = pk4(o); }
                    EPI_FENCE(); }
        } else if (T < 18) {
            const int d = T >= 14; const int colb = ((T - 10) & 3) * 256 + wc * 64;
            bf16_t* base = (d ? GB : GF) + colb; const float* lbp = lbt + d * 1024 + colb + 4 * fq;
#pragma unroll
            for (int ai = 0; ai < 2; ++ai)
#pragma unroll
                for (int m = 0; m < 4; ++m) { bf16_t* rp = base + (unsigned)((lrow0 + ai * HALF + m * 16) * DM + 4 * fq);
#pragma unroll
                    for (int bj = 0; bj < 2; ++bj)
#pragma unroll
                        for (int n = 0; n < 2; ++n) { const f32x4 v = acc[ai][bj][m][n]; const f32x4 lb = *(const f32x4*)(lbp + 32 * bj + 16 * n); float g[4];
#pragma unroll
                            for (int j = 0; j < 4; ++j) { const float l = lb[j]; g[j] = __logf(l + (1.0f - l) * fsigmoid(v[j])); }
                            u32x2 w; w.x = pkh2(g[0], g[1]); w.y = pkh2(g[2], g[3]); *(u32x2*)(rp + 32 * bj + 16 * n) = w; }
                    EPI_FENCE(); }
        } else if (T < 26) {
            const bool sig = T >= 22; bf16_t* base = (sig ? ZA : RI) + ((T - 18) & 3) * 256 + wc * 64;
#pragma unroll
            for (int ai = 0; ai < 2; ++ai)
#pragma unroll
                for (int m = 0; m < 4; ++m) { bf16_t* rp = base + (unsigned)((lrow0 + ai * HALF + m * 16) * DM + 4 * fq);
#pragma unroll
                    for (int bj = 0; bj < 2; ++bj)
#pragma unroll
                        for (int n = 0; n < 2; ++n) { f32x4 v = acc[ai][bj][m][n];
                            if (sig) {
#pragma unroll
                                for (int j = 0; j < 4; ++j) v[j] = fsigmoid(v[j]); }
                            *(u32x2*)(rp + 32 * bj + 16 * n) = pk4(v); }
                    EPI_FENCE(); }
        } else {
            bf16_t* base = PP + (T - 26) * 128 + wc * 32;
#pragma unroll
            for (int ai = 0; ai < 2; ++ai)
#pragma unroll
                for (int m = 0; m < 4; ++m) { bf16_t* rp = base + (unsigned)((lrow0 + ai * HALF + m * 16) * DM + 4 * fq);
#pragma unroll
                    for (int n = 0; n < 2; ++n) { const f32x4 a = acc[ai][0][m][n], b = acc[ai][1][m][n]; f32x4 o;
#pragma unroll
                        for (int j = 0; j < 4; ++j) o[j] = fsilu(a[j]) * fsigmoid(b[j]);
                        *(u32x2*)(rp + 16 * n) = pk4(o); }
                    EPI_FENCE(); }
        }
    }
};

struct EpiResid {
    static constexpr bool PERM = false, AFTER_DRAIN = false;
    const float* basep; const float* bases; float* out; const float* modb; int goff; int hf;
    __device__ __forceinline__ void operator()(const f32x4 (&acc)[2][2][4][2], const Unit& u, int wr, int wc, int fr, int fq) const {
        const int grow0 = hf * MH + u.pm * BM; const int mi = mod_of_row(grow0);
        const int col0 = u.pn * BM + wc * 64 + 4 * fq;
        const float* base = grow0 < NPR ? basep + (size_t)grow0 * DM : bases + (size_t)(grow0 - NPR) * DM;
        float* ob = out + (size_t)grow0 * DM;
        const float* gp = modb + mi * 6144 + goff + col0;
#pragma unroll
        for (int ai = 0; ai < 2; ++ai)
#pragma unroll
            for (int m = 0; m < 4; ++m) { const unsigned off = (unsigned)((ai * HALF + wr * 64 + m * 16 + fr) * DM + col0);
#pragma unroll
                for (int bj = 0; bj < 2; ++bj)
#pragma unroll
                    for (int n = 0; n < 2; ++n) { const f32x4 b = *(const f32x4*)(base + off + 32 * bj + 16 * n); const f32x4 gt = *(const f32x4*)(gp + 32 * bj + 16 * n);
                        *(f32x4*)(ob + off + 32 * bj + 16 * n) = b + gt * acc[ai][bj][m][n]; }
                EPI_FENCE(); }
    }
};

struct EpiResidW {
    static constexpr bool PERM = false, AFTER_DRAIN = false;
    const float* basep; const float* bases; float* out; const float* modb; const float* gam; bf16_t* Hn; float* rowss; int goff; int hf;
    __device__ __forceinline__ void operator()(const f32x4 (&acc)[2][2][4][2], const Unit& u, int wr, int wc, int fr, int fq) const {
        const int grow0 = hf * MH + u.pm * BM; const int mi = mod_of_row(grow0);
        const int col0 = u.pn * BM + wc * 64 + 4 * fq;
        const float* base = grow0 < NPR ? basep + (size_t)grow0 * DM : bases + (size_t)(grow0 - NPR) * DM;
        float* ob = out + (size_t)grow0 * DM; bf16_t* hb = Hn + (size_t)(u.pm * BM) * DM; float* rs = rowss + grow0;
        const float* gp = modb + mi * 6144 + goff + col0; const float* gm = gam + mi * 1024 + col0;
#pragma unroll
        for (int ai = 0; ai < 2; ++ai)
#pragma unroll
            for (int m = 0; m < 4; ++m) { const int r = ai * HALF + wr * 64 + m * 16 + fr; const unsigned off = (unsigned)(r * DM + col0); float ss = 0.f;
#pragma unroll
                for (int bj = 0; bj < 2; ++bj)
#pragma unroll
                    for (int n = 0; n < 2; ++n) { const f32x4 b = *(const f32x4*)(base + off + 32 * bj + 16 * n); const f32x4 gt = *(const f32x4*)(gp + 32 * bj + 16 * n); const f32x4 gg = *(const f32x4*)(gm + 32 * bj + 16 * n);
                        const f32x4 x1 = b + gt * acc[ai][bj][m][n];
                        *(f32x4*)(ob + off + 32 * bj + 16 * n) = x1; *(u32x2*)(hb + off + 32 * bj + 16 * n) = pk4(x1 * gg);
                        ss += (x1[0] * x1[0] + x1[1] * x1[1]) + (x1[2] * x1[2] + x1[3] * x1[3]); }
                ss += __shfl_xor(ss, 16); ss += __shfl_xor(ss, 32);
                if (fq == 0) atomicAdd(rs + r, ss);
                EPI_FENCE(); }
    }
};

struct EpiUp {
    static constexpr bool PERM = false, AFTER_DRAIN = false;
    bf16_t* O; int ldc; const float* rowss; const float* shw; int hf;
    __device__ __forceinline__ void operator()(const f32x4 (&acc)[2][2][4][2], const Unit& u, int wr, int wc, int fr, int fq) const {
        const int grow0 = hf * MH + u.pm * BM; const int mi = mod_of_row(grow0);
        bf16_t* base = O + (size_t)(u.pm * BM) * ldc + u.pn * BM + wc * 64; const float* sp = shw + mi * UPW + u.pn * BM + wc * 64 + 4 * fq; const float* rs = rowss + grow0;
#pragma unroll
        for (int ai = 0; ai < 2; ++ai)
#pragma unroll
            for (int m = 0; m < 4; ++m) { const int r = ai * HALF + wr * 64 + m * 16 + fr; bf16_t* rp = base + (unsigned)(r * ldc + 4 * fq);
                const float rstd = __builtin_amdgcn_rsqf(rs[r] * (1.0f / 1024.0f) + EPS);
#pragma unroll
                for (int bj = 0; bj < 2; ++bj)
#pragma unroll
                    for (int n = 0; n < 2; ++n) *(u32x2*)(rp + 32 * bj + 16 * n) = pk4(acc[ai][bj][m][n] * rstd + *(const f32x4*)(sp + 32 * bj + 16 * n));
                EPI_FENCE(); }
    }
};

__device__ __forceinline__ float dpp_prev(float cur, float prevblk) {
    const int x = __builtin_amdgcn_update_dpp(0, __float_as_int(prevblk), 0x121, 0xf, 0xf, true);
    return __int_as_float(__builtin_amdgcn_update_dpp(x, __float_as_int(cur), 0x111, 0xf, 0xf, false)); }
__device__ __forceinline__ float dpp_next(float cur, float nextblk) {
    const int x = __builtin_amdgcn_update_dpp(0, __float_as_int(nextblk), 0x12F, 0xf, 0xf, true);
    return __int_as_float(__builtin_amdgcn_update_dpp(x, __float_as_int(cur), 0x101, 0xf, 0xf, false)); }
struct EpiUpAct {
    static constexpr bool PERM = false, AFTER_DRAIN = false;
    bf16_t* ACT; bf16_t* EB; const float* rowss; const float* shw; const float* cw; const float* cb; int hf;
    __device__ __forceinline__ void operator()(f32x4 (&acc)[2][2][4][2], const Unit& u, int wr, int wc, int fr, int fq) const {
        const int grow0 = hf * MH + u.pm * BM; const int mi = mod_of_row(grow0); const int T = u.pn;
        const float* sp = shw + mi * UPW + T * 256 + wc * 32 + 4 * fq; const float* rs = rowss + grow0;
#pragma unroll
        for (int ai = 0; ai < 2; ++ai)
#pragma unroll
            for (int m = 0; m < 4; ++m) { const float rstd = __builtin_amdgcn_rsqf(rs[ai * HALF + wr * 64 + m * 16 + fr] * (1.0f / 1024.0f) + EPS);
#pragma unroll
                for (int bj = 0; bj < 2; ++bj)
#pragma unroll
                    for (int n = 0; n < 2; ++n) acc[ai][bj][m][n] = acc[ai][bj][m][n] * rstd + *(const f32x4*)(sp + 128 * bj + 16 * n); }
        EPI_FENCE();
#pragma unroll
        for (int n = 0; n < 2; ++n) {
            const int ch = T * 128 + wc * 32 + 16 * n + 4 * fq;
            const f32x4 wa0 = *(const f32x4*)(cw + ch), wa1 = *(const f32x4*)(cw + UPW + ch), wa2 = *(const f32x4*)(cw + 2 * UPW + ch), ba = *(const f32x4*)(cb + ch);
            const f32x4 wb0 = *(const f32x4*)(cw + DFF + ch), wb1 = *(const f32x4*)(cw + UPW + DFF + ch), wb2 = *(const f32x4*)(cw + 2 * UPW + DFF + ch), bb = *(const f32x4*)(cb + DFF + ch);
#pragma unroll
            for (int ai = 0; ai < 2; ++ai)
#pragma unroll
                for (int m = 0; m < 4; ++m) {
                    const int mp = m > 0 ? m - 1 : m, mn = m < 3 ? m + 1 : m;
                    const f32x4 ua = acc[ai][0][m][n], ub = acc[ai][1][m][n];
                    f32x4 o;
#pragma unroll
                    for (int j = 0; j < 4; ++j) {
                        const float pa = dpp_prev(ua[j], acc[ai][0][mp][n][j]), na = dpp_next(ua[j], acc[ai][0][mn][n][j]);
                        const float pb = dpp_prev(ub[j], acc[ai][1][mp][n][j]), nb = dpp_next(ub[j], acc[ai][1][mn][n][j]);
                        const float ca = wa0[j] * pa + wa1[j] * ua[j] + wa2[j] * na + ba[j];
                        const float cbv = wb0[j] * pb + wb1[j] * ub[j] + wb2[j] * nb + bb[j];
                        o[j] = fsilu(ca) * cbv;
                    }
                    const int r64 = m * 16 + fr; const int lrow = u.pm * BM + ai * HALF + wr * 64 + r64;
                    if (r64 != 0 && r64 != 63) *(u32x2*)(ACT + (unsigned)(lrow * DFF + ch)) = pk4(o);
                    if (r64 < 2 || r64 > 61) { const int e = r64 < 2 ? r64 : r64 - 60; const unsigned eo = (unsigned)((((lrow >> 6) * 4 + e) * 2) * DFF + ch);
                        *(u32x2*)(EB + eo) = pk4(ua); *(u32x2*)(EB + eo + DFF) = pk4(ub); }
                    EPI_FENCE();
                }
        }
    }
};

struct EpiPlain {
    static constexpr bool PERM = false, AFTER_DRAIN = false;
    bf16_t* O; int ldc;
    __device__ __forceinline__ void operator()(const f32x4 (&acc)[2][2][4][2], const Unit& u, int wr, int wc, int fr, int fq) const {
        bf16_t* base = O + u.pn * BM + wc * 64 + 4 * fq;
#pragma unroll
        for (int ai = 0; ai < 2; ++ai)
#pragma unroll
            for (int m = 0; m < 4; ++m) { bf16_t* rp = base + (size_t)(u.pm * BM + ai * HALF + wr * 64 + m * 16 + fr) * ldc;
#pragma unroll
                for (int bj = 0; bj < 2; ++bj)
#pragma unroll
                    for (int n = 0; n < 2; ++n) *(u32x2*)(rp + 32 * bj + 16 * n) = pk4(acc[ai][bj][m][n]); }
    }
};

template <class Epi, class Sched, bool ALIGN_EPI = false, bool SP2 = false>
__device__ __forceinline__ void gemm_phase(PG8_LAS unsigned char* lds, const Gemm g, const Sched& S, const Epi& E) {
    int tid_o = threadIdx.x; asm volatile("" : "+v"(tid_o));
    const int tid = tid_o, wid = __builtin_amdgcn_readfirstlane(tid >> 6), lane = tid & 63, wr = wid >> 2, wc = wid & 3, fr = lane & 15, fq = lane >> 4;
    const int K = g.K, nt = K / BK;
    unsigned voffA[2], voffB[2];
#pragma unroll
    for (int i = 0; i < 2; ++i) { int R, C; stage_rc(tid * 16 + i * 8192, R, C); const int Rb = Epi::PERM ? ((R & ~31) + perm32(R & 31)) : R;
        voffA[i] = (unsigned)(R * K + C) * 2u; voffB[i] = (unsigned)(Rb * K + C) * 2u; }
    const size_t kstep = (size_t)(BK * 2);
    const size_t hstep = (size_t)HALF * K * 2;
    const size_t tstep = 2 * hstep;
    const unsigned ldsw = (unsigned)wid * 1024u;
    const int aoff = lds_byte(wr * 64 + fr, fq * 8), boff = lds_byte(wc * 32 + fr, fq * 8);
#define PG8_SA(b, h) (((b) * 2 + (h)) * HTB)
#define PG8_SB(b, h) ((4 + (b) * 2 + (h)) * HTB)
#define PG8_STAGE(bufoff, gbase, voff) do { _Pragma("unroll") for (int _i = 0; _i < 2; ++_i) \
        __builtin_amdgcn_global_load_lds((const unsigned*)((const char*)(gbase) + (voff)[_i]), (PG8_LAS unsigned*)(lds + (bufoff) + ldsw + _i * 8192), 16, 0, 0); } while (0)
#define PG8_LDA(dst, b, h) do { _Pragma("unroll") for (int m = 0; m < 4; ++m) _Pragma("unroll") for (int k = 0; k < 2; ++k) dst[m][k] = *(const PG8_LAS bf16x8*)(lds + PG8_SA(b, h) + aoff + m * 2048 + k * 1024); } while (0)
#define PG8_LDB(dst, b, h) do { _Pragma("unroll") for (int n = 0; n < 2; ++n) _Pragma("unroll") for (int k = 0; k < 2; ++k) dst[n][k] = *(const PG8_LAS bf16x8*)(lds + PG8_SB(b, h) + boff + n * 2048 + k * 1024); } while (0)
#define PG8_MMA(ai, bj, At, Bt) do { __builtin_amdgcn_s_setprio(1); _Pragma("unroll") for (int m = 0; m < 4; ++m) _Pragma("unroll") for (int n = 0; n < 2; ++n) _Pragma("unroll") for (int k = 0; k < 2; ++k) \
        acc[ai][bj][m][n] = __builtin_amdgcn_mfma_f32_16x16x32_bf16(Bt[n][k], At[m][k], acc[ai][bj][m][n], 0, 0, 0); __builtin_amdgcn_s_setprio(0); } while (0)
#define PG8_WAIT_V(n) asm volatile("s_waitcnt vmcnt(" #n ")" ::: "memory")
#define PG8_WAIT_L(n) asm volatile("s_waitcnt lgkmcnt(" #n ")" ::: "memory")
#define PG8_BAR __builtin_amdgcn_s_barrier()
#define PG8_SCHED __builtin_amdgcn_sched_barrier(0)
    Unit cur, nxt; int ui = 0;
    if (!S.next(0, cur)) return;
    f32x4 acc[2][2][4][2];
#pragma unroll
    for (int a = 0; a < 2; ++a)
#pragma unroll
        for (int b = 0; b < 2; ++b)
#pragma unroll
            for (int m = 0; m < 4; ++m)
#pragma unroll
                for (int n = 0; n < 2; ++n) acc[a][b][m][n] = (f32x4){0.f, 0.f, 0.f, 0.f};
    bf16x8 At[4][2], B0[2][2], B1[2][2];
    const char* cA = (const char*)g.A + (size_t)cur.pm * tstep; const char* cB = (const char*)g.Bt + (size_t)cur.pn * tstep;
    S.a_ready(cur);
    if constexpr (SP2) {
        PG8_STAGE(PG8_SB(0, 0), cB, voffB); PG8_STAGE(PG8_SB(0, 1), cB + hstep, voffB); PG8_STAGE(PG8_SA(0, 0), cA, voffA); PG8_STAGE(PG8_SA(0, 1), cA + hstep, voffA);
        if (wr == 1) PG8_BAR;
        PG8_WAIT_V(2); PG8_BAR;
        PG8_STAGE(PG8_SB(1, 0), cB + kstep, voffB); PG8_STAGE(PG8_SA(1, 0), cA + kstep, voffA); PG8_STAGE(PG8_SB(1, 1), cB + hstep + kstep, voffB);
        PG8_WAIT_V(6); PG8_BAR;
    } else {
        PG8_STAGE(PG8_SB(0, 0), cB, voffB); PG8_STAGE(PG8_SA(0, 0), cA, voffA); PG8_STAGE(PG8_SB(0, 1), cB + hstep, voffB); PG8_STAGE(PG8_SA(0, 1), cA + hstep, voffA);
        if (wr == 1) PG8_BAR;
        PG8_WAIT_V(4); PG8_BAR;
        PG8_STAGE(PG8_SB(1, 0), cB + kstep, voffB); PG8_STAGE(PG8_SA(1, 0), cA + kstep, voffA); PG8_STAGE(PG8_SB(1, 1), cB + hstep + kstep, voffB);
        PG8_WAIT_V(6); PG8_BAR;
    }
    for (;;) {
        const bool has_next = S.next(ui + 1, nxt);
        const char* nA = has_next ? (const char*)g.A + (size_t)nxt.pm * tstep : cA; const char* nB = has_next ? (const char*)g.Bt + (size_t)nxt.pn * tstep : cB;
        for (int t = 0; t < nt; t += 2) {
            const bool last = (t == nt - 2);
            const char* a1 = cA + (size_t)(t + 1) * kstep;
            const char* a2 = last ? nA : cA + (size_t)(t + 2) * kstep; const char* b2 = last ? nB : cB + (size_t)(t + 2) * kstep;
            const char* a3 = a2 + kstep; const char* b3 = b2 + kstep;
            if (last && has_next) S.a_ready(nxt);
            if constexpr (SP2) {
            PG8_LDB(B0, 0, 0); PG8_LDB(B1, 0, 1); PG8_SCHED; PG8_LDA(At, 0, 0); PG8_STAGE(PG8_SA(1, 1), a1 + hstep, voffA);
            PG8_WAIT_V(8); PG8_WAIT_L(0); PG8_BAR; PG8_MMA(0, 0, At, B0); PG8_MMA(0, 1, At, B1); PG8_BAR; PG8_SCHED;
            PG8_LDA(At, 0, 1); PG8_STAGE(PG8_SB(0, 0), b2, voffB); PG8_STAGE(PG8_SB(0, 1), b2 + hstep, voffB); PG8_STAGE(PG8_SA(0, 0), a2, voffA);
            PG8_WAIT_V(8); PG8_WAIT_L(0); PG8_BAR; PG8_MMA(1, 0, At, B0); PG8_MMA(1, 1, At, B1); PG8_BAR; PG8_SCHED;
            PG8_LDB(B0, 1, 0); PG8_LDB(B1, 1, 1); PG8_SCHED; PG8_LDA(At, 1, 0); PG8_STAGE(PG8_SA(0, 1), a2 + hstep, voffA);
            PG8_WAIT_V(8); PG8_WAIT_L(0); PG8_BAR; PG8_MMA(0, 0, At, B0); PG8_MMA(0, 1, At, B1); PG8_BAR; PG8_SCHED;
            PG8_LDA(At, 1, 1); PG8_STAGE(PG8_SB(1, 0), b3, voffB); PG8_STAGE(PG8_SB(1, 1), b3 + hstep, voffB); PG8_STAGE(PG8_SA(1, 0), a3, voffA);
            PG8_WAIT_V(8); PG8_WAIT_L(0); PG8_BAR; PG8_MMA(1, 0, At, B0); PG8_MMA(1, 1, At, B1); PG8_BAR; PG8_SCHED;
            } else {
            PG8_LDB(B0, 0, 0); PG8_SCHED; PG8_LDA(At, 0, 0); PG8_STAGE(PG8_SA(1, 1), a1 + hstep, voffA);
            PG8_WAIT_L(8); PG8_BAR; PG8_WAIT_L(0); PG8_MMA(0, 0, At, B0); PG8_BAR; PG8_SCHED;
            PG8_LDB(B1, 0, 1); PG8_STAGE(PG8_SB(0, 0), b2, voffB);
            PG8_BAR; PG8_WAIT_L(0); PG8_MMA(0, 1, At, B1); PG8_BAR;
            PG8_LDA(At, 0, 1); PG8_STAGE(PG8_SA(0, 0), a2, voffA);
            PG8_BAR; PG8_WAIT_L(0); PG8_MMA(1, 0, At, B0); PG8_BAR; PG8_SCHED;
            PG8_STAGE(PG8_SB(0, 1), b2 + hstep, voffB);
            PG8_WAIT_V(6); PG8_BAR; PG8_MMA(1, 1, At, B1); PG8_BAR;
            PG8_LDB(B0, 1, 0); PG8_SCHED; PG8_LDA(At, 1, 0); PG8_STAGE(PG8_SA(0, 1), a2 + hstep, voffA);
            PG8_WAIT_L(8); PG8_BAR; PG8_WAIT_L(0); PG8_MMA(0, 0, At, B0); PG8_BAR; PG8_SCHED;
            PG8_LDB(B1, 1, 1); PG8_STAGE(PG8_SB(1, 0), b3, voffB);
            PG8_BAR; PG8_WAIT_L(0); PG8_MMA(0, 1, At, B1); PG8_BAR;
            PG8_LDA(At, 1, 1); PG8_STAGE(PG8_SA(1, 0), a3, voffA);
            PG8_BAR; PG8_WAIT_L(0); PG8_MMA(1, 0, At, B0); PG8_BAR; PG8_SCHED;
            PG8_STAGE(PG8_SB(1, 1), b3 + hstep, voffB);
            PG8_WAIT_V(6); PG8_BAR; PG8_MMA(1, 1, At, B1); PG8_BAR;
            }
        }
        if constexpr (ALIGN_EPI) { if (wr == 0) PG8_BAR; }
        if constexpr (!Epi::AFTER_DRAIN) { E(acc, cur, wr, wc, fr, fq); S.done(cur); }
        if (!has_next) break;
#pragma unroll
        for (int a = 0; a < 2; ++a)
#pragma unroll
            for (int b = 0; b < 2; ++b)
#pragma unroll
                for (int m = 0; m < 4; ++m)
#pragma unroll
                    for (int n = 0; n < 2; ++n) acc[a][b][m][n] = (f32x4){0.f, 0.f, 0.f, 0.f};
        cur = nxt; cA = nA; cB = nB; ++ui;
        if constexpr (ALIGN_EPI) { if (wr == 1) PG8_BAR; }
    }
    PG8_WAIT_V(0);
    if constexpr (!ALIGN_EPI) { if (wr == 0) PG8_BAR; }
    PG8_BAR;
    if constexpr (Epi::AFTER_DRAIN) { E.fused(acc, cur, wr, wc, fr, fq, lds, wid, lane); S.done(cur); }
#undef PG8_SA
#undef PG8_SB
#undef PG8_STAGE
#undef PG8_LDA
#undef PG8_LDB
#undef PG8_MMA
#undef PG8_WAIT_V
#undef PG8_WAIT_L
#undef PG8_BAR
#undef PG8_SCHED
}
}

namespace attn_body {
using bf16=__hip_bfloat16;
using bf16x8=__attribute__((ext_vector_type(8)))short;
using s16x4=__attribute__((ext_vector_type(4)))short;
using f32x16=__attribute__((ext_vector_type(16)))float;
using u32x4=__attribute__((ext_vector_type(4)))unsigned;
constexpr int NHEAD=16,D=64,DM=NHEAD*D,KVPITCH=256;
constexpr int NW=8,QBLK=32,QB=QBLK*NW,KVBLK=64;
constexpr int ATTN_PITCH=DM, ATTN_UNIT_ROWS=QB;
__device__ __forceinline__ int crow(int r,int hi){return (r&3)+8*(r>>2)+4*hi;}
#define SBAR() __builtin_amdgcn_sched_barrier(0)
__device__ __forceinline__ void cmask(f32x16&p0,f32x16&p1,int jb,int qrel,int hi){
  const float NEG=-INFINITY; int kb=64*jb+4*hi;
  #pragma unroll
  for(int r=0;r<16;++r){int kv=kb+(r&3)+8*(r>>2); if(kv>qrel)p0[r]=NEG; if(kv+32>qrel)p1[r]=NEG;}
}

constexpr int NSLOT=3, SLOTB=8192;
constexpr int LDS_K=0, LDS_V=NSLOT*SLOTB, LDS_WS=2*NSLOT*SLOTB, LDS_OST=LDS_WS+NW*64*4, LDS_BYTES=LDS_OST+NW*4096;
constexpr float C2=0.125f*1.4426950408889634f;
__device__ __forceinline__ void glds16(const void*gsrc,unsigned lds_dst){unsigned keep;
  asm volatile("s_mov_b32 %0, m0\n\ts_mov_b32 m0, %2\n\ts_nop 0\n\tglobal_load_lds_dwordx4 %1, off\n\ts_mov_b32 m0, %0":"=&s"(keep):"v"(gsrc),"s"(lds_dst):"memory");}
__device__ __forceinline__ float max3f(float a,float b,float c){float r;asm("v_max3_f32 %0, %1, %2, %3":"=v"(r):"v"(a),"v"(b),"v"(c));return r;}
__device__ __forceinline__ float max2f(float a,float b){float r;asm("v_max_f32_e32 %0, %1, %2":"=v"(r):"v"(a),"v"(b));return r;}
__device__ __forceinline__ float fadd_s(float a,float b){float r;asm("v_add_f32_e32 %0, %1, %2":"=v"(r):"v"(a),"v"(b));return r;}
__device__ __forceinline__ float fsub_s(float a,float b){float r;asm("v_sub_f32_e32 %0, %1, %2":"=v"(r):"v"(a),"v"(b));return r;}
typedef float f32x2_t __attribute__((ext_vector_type(2))); typedef __bf16 bf16x2_t __attribute__((ext_vector_type(2)));
__device__ __forceinline__ unsigned cvtpk_s(float lo,float hi){f32x2_t v={lo,hi};bf16x2_t b=__builtin_convertvector(v,bf16x2_t);return __builtin_bit_cast(unsigned,b);}
#define WAIT_BAR(N) asm volatile("s_waitcnt vmcnt(" #N ") lgkmcnt(0)\n\ts_barrier":::"memory")

__device__ __forceinline__ void qkt(f32x16&p0,f32x16&p1,const char*Kslot,const bf16x8*qr,const f32x16&negm,int r32,int hi){
  const char*kb=Kslot+hi*1024+r32*16;
  #pragma unroll
  for(int d0=0;d0<4;++d0){
    const bf16x8 b0=*reinterpret_cast<const bf16x8*>(kb+d0*2048);
    const bf16x8 b1=*reinterpret_cast<const bf16x8*>(kb+d0*2048+512);
    if(d0==0){p0=__builtin_amdgcn_mfma_f32_32x32x16_bf16(b0,qr[0],negm,0,0,0);p1=__builtin_amdgcn_mfma_f32_32x32x16_bf16(b1,qr[0],negm,0,0,0);}
    else{p0=__builtin_amdgcn_mfma_f32_32x32x16_bf16(b0,qr[d0],p0,0,0,0);p1=__builtin_amdgcn_mfma_f32_32x32x16_bf16(b1,qr[d0],p1,0,0,0);}}
}
typedef __attribute__((address_space(3))) const char* lds_cptr;
typedef short v4i16_t __attribute__((ext_vector_type(4)));
__device__ __forceinline__ void kload8(bf16x8*kf,lds_cptr kp){
  kf[0]=*(const __attribute__((address_space(3))) bf16x8*)(kp);      kf[1]=*(const __attribute__((address_space(3))) bf16x8*)(kp+512);
  kf[2]=*(const __attribute__((address_space(3))) bf16x8*)(kp+2048); kf[3]=*(const __attribute__((address_space(3))) bf16x8*)(kp+2560);
  kf[4]=*(const __attribute__((address_space(3))) bf16x8*)(kp+4096); kf[5]=*(const __attribute__((address_space(3))) bf16x8*)(kp+4608);
  kf[6]=*(const __attribute__((address_space(3))) bf16x8*)(kp+6144); kf[7]=*(const __attribute__((address_space(3))) bf16x8*)(kp+6656);
}
__device__ __forceinline__ void kload2(bf16x8*kf,lds_cptr kp,int j){ kf[2*j]=*(const __attribute__((address_space(3))) bf16x8*)(kp+j*2048); kf[2*j+1]=*(const __attribute__((address_space(3))) bf16x8*)(kp+j*2048+512); }
__device__ __forceinline__ s16x4 vtr(lds_cptr p){ return __builtin_bit_cast(s16x4,__builtin_amdgcn_ds_read_tr16_b64_v4i16((__attribute__((address_space(3))) v4i16_t*)p)); }
__device__ __forceinline__ float rowmax(const f32x16&p0,const f32x16&p1){
  float a=max3f(p0[0],p0[1],p1[0]),b=max3f(p0[2],p0[3],p1[1]);a=max3f(a,p1[2],p1[3]);
  #pragma unroll
  for(int r=4;r<16;r+=4){a=max3f(a,p0[r],p0[r+1]);b=max3f(b,p0[r+2],p0[r+3]);a=max3f(a,p1[r],p1[r+1]);b=max3f(b,p1[r+2],p1[r+3]);}
  const float m=max2f(a,b);
  auto rr=__builtin_amdgcn_permlane32_swap(__float_as_uint(m),__float_as_uint(m),false,false);
  return max2f(__uint_as_float(rr[0]),__uint_as_float(rr[1]));
}
__device__ __forceinline__ void pv(f32x16*o,int vb,bf16x8 pa0,bf16x8 pa1,bf16x8 pa2,bf16x8 pa3){
  #pragma unroll
  for(int d0=0;d0<2;++d0){s16x4 lo[4],hi[4];
    #pragma unroll
    for(int ks=0;ks<4;++ks){
      asm volatile("ds_read_b64_tr_b16 %0,%1 offset:%c2":"=&v"(lo[ks]):"v"(vb),"i"(d0*4096+ks*1024):"memory");
      asm volatile("ds_read_b64_tr_b16 %0,%1 offset:%c2":"=&v"(hi[ks]):"v"(vb),"i"(d0*4096+ks*1024+512):"memory");}
    asm volatile("s_waitcnt lgkmcnt(0)":::"memory");SBAR();
    #define PK(k) (bf16x8){lo[k][0],lo[k][1],lo[k][2],lo[k][3],hi[k][0],hi[k][1],hi[k][2],hi[k][3]}
    o[d0]=__builtin_amdgcn_mfma_f32_32x32x16_bf16(pa0,PK(0),o[d0],0,0,0);
    o[d0]=__builtin_amdgcn_mfma_f32_32x32x16_bf16(pa1,PK(1),o[d0],0,0,0);
    o[d0]=__builtin_amdgcn_mfma_f32_32x32x16_bf16(pa2,PK(2),o[d0],0,0,0);
    o[d0]=__builtin_amdgcn_mfma_f32_32x32x16_bf16(pa3,PK(3),o[d0],0,0,0);
    #undef PK
  }
}

#ifndef ATTN_STORE16
#define ATTN_STORE16(p,v) (*(u32x4*)(p)=(v))
#endif
template<int THRL> __device__ __forceinline__ void attn_unit(const bf16*Qu,const bf16*__restrict__ Kh,const bf16*__restrict__ Vh,bf16*Ou,const int NT,char*shm,const bool wr_=true){
  int tid_o=threadIdx.x; asm volatile("":"+v"(tid_o));
  const int tid=tid_o,lane=tid&63,r32=lane&31,hi=lane>>5; const int wid=__builtin_amdgcn_readfirstlane(tid>>6);
  const bf16*Qw=Qu+(long)(wid*QBLK)*DM;
  const unsigned lds0=(unsigned)(uintptr_t)shm;
  float*wsf=(float*)(shm+LDS_WS)+wid*64;
  const bf16*ksrc=Kh+(long)lane*KVPITCH+wid*8;
  const bf16*vsrc=Vh+(long)(16*(wid&3)+(lane>>2))*KVPITCH+(wid>>2)*32+(lane&3)*8;
  const unsigned kdst=lds0+LDS_K+wid*1024, vdst=lds0+LDS_V+wid*1024;
  #define DMA_K(t,slot) glds16(ksrc+(long)(t)*KVBLK*KVPITCH,(unsigned)__builtin_amdgcn_readfirstlane(kdst+(slot)))
  #define DMA_V(t,slot) glds16(vsrc+(long)(t)*KVBLK*KVPITCH,(unsigned)__builtin_amdgcn_readfirstlane(vdst+(slot)))
  const int vb0=(int)(lds0+LDS_V)+((lane>>4)&1)*32+(lane&3)*8+(4*hi+((lane&15)>>2))*64;
  const char*Kbase=shm+LDS_K; bf16x8 kf[8];
  const lds_cptr shm3=(lds_cptr)shm; const lds_cptr kp0=shm3+LDS_K+hi*1024+r32*16; const lds_cptr vp0=shm3+LDS_V+((lane>>4)&1)*32+(lane&3)*8+(4*hi+((lane&15)>>2))*64;
  DMA_K(0,0);DMA_V(0,0);DMA_K(1,SLOTB);
  bf16x8 qr[4];
  #pragma unroll
  for(int d0=0;d0<4;++d0)qr[d0]=*reinterpret_cast<const bf16x8*>(&Qw[(long)r32*DM+d0*16+hi*8]);
  float mhat=0.f,l_reg=0.f;f32x16 o[2];o[0]=f32x16{};o[1]=f32x16{};f32x16 negm=f32x16{};asm volatile("":"+v"(negm));
  #define CMASK(P0,P1,t) do{}while(0)
  bool resc=false;
  #define START(P0,P1) do{ const float rm=rowmax(P0,P1); resc=false; \
    { const float dl=rm; mhat=fadd_s(mhat,dl); \
      _Pragma("unroll") for(int r=0;r<16;++r){P0[r]=fsub_s(P0[r],dl);P1[r]=fsub_s(P1[r],dl);} \
      _Pragma("unroll") for(int r=0;r<16;++r)negm[r]=-mhat; asm volatile("":"+v"(negm)); } \
    _Pragma("unroll") for(int r=0;r<16;++r)P0[r]=__builtin_amdgcn_exp2f(P0[r]); }while(0)
  #define RESC() do{ if(resc){ asm volatile("s_waitcnt lgkmcnt(0)":::"memory"); \
      _Pragma("unroll") for(int d_=0;d_<2;++d_) _Pragma("unroll") for(int r=0;r<16;++r)o[d_][r]*=wsf[crow(r,hi)]; } }while(0)
  f32x16 pA0,pA1,pB0,pB1;
  int sl_prev=0,sl_cur=0,sl_next=SLOTB;
  #define ROT() do{sl_prev=sl_cur;sl_cur=sl_next;sl_next=(sl_next==(NSLOT-1)*SLOTB)?0:sl_next+SLOTB;}while(0)
  DMA_K(2,2*SLOTB);
  WAIT_BAR(3);
  qkt(pA0,pA1,Kbase,qr,negm,r32,hi);asm volatile("s_nop 15\n\ts_nop 7":"+v"(pA0),"+v"(pA1));CMASK(pA0,pA1,0);
  START(pA0,pA1);
  _Pragma("unroll") for(int r=0;r<16;++r)pA1[r]=__builtin_amdgcn_exp2f(pA1[r]);
  WAIT_BAR(0);
  DMA_K(3,0);DMA_V(1,SLOTB);
  ROT();
  kload8(kf,kp0+sl_cur);
  WAIT_BAR(2);
  s16x4 vlo[8],vhi[8]; u32x4 pw0,pw1,pw2,pw3;
  #define PKW(P,B) cvtpk_s(P[B],P[B+1])
  #define PAF(k) __builtin_bit_cast(bf16x8,pw##k)
  #define VFR(i) (bf16x8){vlo[i][0],vlo[i][1],vlo[i][2],vlo[i][3],vhi[i][0],vhi[i][1],vhi[i][2],vhi[i][3]}
  #define PIN(x) asm volatile("":"+v"(x))
  #define MX3(a,b,c) __builtin_fmaxf(__builtin_fmaxf((a),(b)),(c))
  #define GAPA(MF,A0,A1,A2,A3,W0,W1,PW) do{ MF; sacc+=A0; sacc+=A1; sacc+=A2; sacc+=A3; PIN(sacc); W0; W1; PIN(PW); SBAR(); }while(0)
  #define EX(v) __builtin_amdgcn_exp2f(v)
  #define GAPB(MF,X,B) do{ MF; X[B]=EX(X[B]); X[B+1]=EX(X[B+1]); X[B+2]=EX(X[B+2]); X[B+3]=EX(X[B+3]); PIN(X); SBAR(); }while(0)
  #define VRD(i) do{ vlo[i]=vtr(vp_+(((i)>>2)*4096+((i)&3)*1024)); vhi[i]=vtr(vp_+(((i)>>2)*4096+((i)&3)*1024+512)); }while(0)
  #define KRD(G,j) do{ if(G){ kload2(kf,kp0+sl_next,j); SBAR(); } }while(0)
  #define STEP(C0,C1,P0,P1,t,GK,GV,GL) do{ SBAR(); \
    const lds_cptr vp_=vp0+sl_prev; \
    VRD(0); SBAR(); float sacc=(P0[0]+P0[1]); \
    GAPA(C0=__builtin_amdgcn_mfma_f32_32x32x16_bf16(kf[0],qr[0],negm,0,0,0), P0[2],P0[3],P0[4],P0[5],     pw0[0]=PKW(P0,0), pw0[1]=PKW(P0,2), pw0); \
    VRD(4); SBAR(); GAPA(C1=__builtin_amdgcn_mfma_f32_32x32x16_bf16(kf[1],qr[0],negm,0,0,0), P0[6],P0[7],P0[8],P0[9],     pw0[2]=PKW(P0,4), pw0[3]=PKW(P0,6), pw0); \
    VRD(1); SBAR(); GAPA(C0=__builtin_amdgcn_mfma_f32_32x32x16_bf16(kf[2],qr[1],C0,0,0,0),   P0[10],P0[11],P0[12],P0[13], pw1[0]=PKW(P0,8), pw1[1]=PKW(P0,10), pw1); \
    VRD(5); SBAR(); GAPA(C1=__builtin_amdgcn_mfma_f32_32x32x16_bf16(kf[3],qr[1],C1,0,0,0),   P0[14],P0[15],P1[0],P1[1],   pw1[2]=PKW(P0,12),pw1[3]=PKW(P0,14), pw1); \
    VRD(2); SBAR(); GAPA(C0=__builtin_amdgcn_mfma_f32_32x32x16_bf16(kf[4],qr[2],C0,0,0,0),   P1[2],P1[3],P1[4],P1[5],     pw2[0]=PKW(P1,0), pw2[1]=PKW(P1,2), pw2); \
    VRD(6); SBAR(); GAPA(C1=__builtin_amdgcn_mfma_f32_32x32x16_bf16(kf[5],qr[2],C1,0,0,0),   P1[6],P1[7],P1[8],P1[9],     pw2[2]=PKW(P1,4), pw2[3]=PKW(P1,6), pw2); \
    VRD(3); SBAR(); GAPA(C0=__builtin_amdgcn_mfma_f32_32x32x16_bf16(kf[6],qr[3],C0,0,0,0),   P1[10],P1[11],P1[12],P1[13], pw3[0]=PKW(P1,8), pw3[1]=PKW(P1,10), pw3); \
    VRD(7); SBAR(); GAPA(C1=__builtin_amdgcn_mfma_f32_32x32x16_bf16(kf[7],qr[3],C1,0,0,0),   P1[14],P1[15],0.f,0.f,       pw3[2]=PKW(P1,12),pw3[3]=PKW(P1,14), pw3); \
    l_reg+=sacc; \
    if(GK){DMA_K((t)+3,sl_cur);} if(GV){DMA_V((t)+1,sl_next);} \
    CMASK(C0,C1,t); \
    { float a=MX3(C0[0],C0[1],C1[0]),b=MX3(C0[2],C0[3],C1[1]); a=MX3(a,C1[2],C1[3]); \
      _Pragma("unroll") for(int r=4;r<16;r+=4){a=MX3(a,C0[r],C0[r+1]);b=MX3(b,C0[r+2],C0[r+3]);a=MX3(a,C1[r],C1[r+1]);b=MX3(b,C1[r+2],C1[r+3]);} \
      float rm=__builtin_fmaxf(a,b); { auto rr=__builtin_amdgcn_permlane32_swap(__float_as_uint(rm),__float_as_uint(rm),false,false); rm=__builtin_fmaxf(__uint_as_float(rr[0]),__uint_as_float(rr[1])); } \
      resc=false; \
      if(__builtin_expect(__any(rm>(float)THRL),0)){ const float dl=__builtin_fmaxf(rm,0.f); mhat+=dl; \
        _Pragma("unroll") for(int r=0;r<16;++r){C0[r]-=dl;C1[r]-=dl;} \
        _Pragma("unroll") for(int r=0;r<16;++r)negm[r]=-mhat; asm volatile("":"+v"(negm)); \
        const float f=__builtin_amdgcn_exp2f(-dl); l_reg*=f; if(hi==0)wsf[r32]=f; resc=true; } } \
    SBAR(); \
    GAPB(o[0]=__builtin_amdgcn_mfma_f32_32x32x16_bf16(PAF(0),VFR(0),o[0],0,0,0), C0,0); \
    GAPB(o[1]=__builtin_amdgcn_mfma_f32_32x32x16_bf16(PAF(0),VFR(4),o[1],0,0,0), C0,4); \
    KRD(GL,0); GAPB(o[0]=__builtin_amdgcn_mfma_f32_32x32x16_bf16(PAF(1),VFR(1),o[0],0,0,0), C0,8); \
    KRD(GL,1); GAPB(o[1]=__builtin_amdgcn_mfma_f32_32x32x16_bf16(PAF(1),VFR(5),o[1],0,0,0), C0,12); \
    KRD(GL,2); GAPB(o[0]=__builtin_amdgcn_mfma_f32_32x32x16_bf16(PAF(2),VFR(2),o[0],0,0,0), C1,0); \
    KRD(GL,3); GAPB(o[1]=__builtin_amdgcn_mfma_f32_32x32x16_bf16(PAF(2),VFR(6),o[1],0,0,0), C1,4); \
    GAPB(o[0]=__builtin_amdgcn_mfma_f32_32x32x16_bf16(PAF(3),VFR(3),o[0],0,0,0), C1,8); \
    GAPB(o[1]=__builtin_amdgcn_mfma_f32_32x32x16_bf16(PAF(3),VFR(7),o[1],0,0,0), C1,12); \
    }while(0)
  int t=1;
  for(;t+5<NT;t+=2){
    STEP(pB0,pB1,pA0,pA1,t,true,true,true);     WAIT_BAR(2); RESC(); ROT();
    STEP(pA0,pA1,pB0,pB1,t+1,true,true,true);   WAIT_BAR(2); RESC(); ROT();
  }
  #define ENDW(tt) do{ if((tt)+3<NT){WAIT_BAR(2);} else if((tt)+2<NT){WAIT_BAR(1);} else {WAIT_BAR(0);} }while(0)
  for(;t+1<NT;t+=2){
    STEP(pB0,pB1,pA0,pA1,t,(t+3<NT),(t+1<NT),(t+1<NT));       ENDW(t);   RESC(); ROT();
    STEP(pA0,pA1,pB0,pB1,t+1,(t+4<NT),(t+2<NT),(t+2<NT));     ENDW(t+1); RESC(); ROT();
  }
  STEP(pB0,pB1,pA0,pA1,NT-1,false,false,false); RESC();
  { float sacc=pB0[0]+pB0[1]; _Pragma("unroll") for(int r=2;r<16;++r)sacc+=pB0[r]; _Pragma("unroll") for(int r=0;r<16;++r)sacc+=pB1[r]; l_reg+=sacc;
    pw0=(u32x4){PKW(pB0,0),PKW(pB0,2),PKW(pB0,4),PKW(pB0,6)};pw1=(u32x4){PKW(pB0,8),PKW(pB0,10),PKW(pB0,12),PKW(pB0,14)};pw2=(u32x4){PKW(pB1,0),PKW(pB1,2),PKW(pB1,4),PKW(pB1,6)};pw3=(u32x4){PKW(pB1,8),PKW(pB1,10),PKW(pB1,12),PKW(pB1,14)};
    SBAR(); pv(o,vb0+sl_cur,PAF(0),PAF(1),PAF(2),PAF(3)); }
  #undef PKW
  #undef PAF
  #undef VFR
  #undef PIN
  #undef MX3
  #undef GAPA
  #undef GAPB
  #undef EX
  #undef VRD
  #undef KRD
  #undef STEP
  #undef ENDW
  {auto rr=__builtin_amdgcn_permlane32_swap(__float_as_uint(l_reg),__float_as_uint(l_reg),false,false);l_reg=__uint_as_float(rr[0])+__uint_as_float(rr[1]);}
  if(hi==0)wsf[32+r32]=l_reg;asm volatile("s_waitcnt lgkmcnt(0)":::"memory");
  float rli[16];
  #pragma unroll
  for(int r=0;r<16;++r)rli[r]=__builtin_amdgcn_rcpf(wsf[32+crow(r,hi)]);
  bf16*Ow=Ou+(long)(wid*QBLK)*DM;
  { bf16*stg=(bf16*)(shm+LDS_OST)+wid*2048;
    #pragma unroll
    for(int r=0;r<16;++r){const int orow=crow(r,hi);
      #pragma unroll
      for(int d0=0;d0<2;++d0)stg[orow*64+d0*32+r32]=__float2bfloat16(o[d0][r]*rli[r]);}
    asm volatile("s_waitcnt lgkmcnt(0)":::"memory");
    #pragma unroll
    for(int i=0;i<4;++i){const int row=i*8+(lane>>3),ch=lane&7; const u32x4 v=*(const u32x4*)(stg+row*64+ch*8); if(wr_)ATTN_STORE16(Ow+(long)row*DM+ch*8,v);} }
  asm volatile("s_waitcnt lgkmcnt(0)\n\ts_barrier":::"memory");
  #undef DMA_K
  #undef DMA_V
  #undef CMASK
  #undef START
  #undef RESC
  #undef ROT
}
constexpr int ATTN_LDS_BYTES=LDS_BYTES;
#undef SBAR
#undef WAIT_BAR
}

#ifndef MK_SINGLE
#define MK_SINGLE 1
#endif
constexpr int NWAVES = 8, NTHR = 512;
constexpr size_t MiB = 1u << 20;
constexpr size_t WS_CTL = 0, WS_BAR = 8192, WS_MOD = 32768, WS_ROWSS = 262144, CTL_ZERO_BYTES = 262144 + 20480 * 4, WS_SHW = 1024 * 1024, WS_GAM = 1280 * 1024, WS_ROPE = 512 * 1024, WS_LBT = 528 * 1024, WS_MODB = 768 * 1024;
constexpr size_t WS_WIN = 2 * MiB, WS_WO = 19 * MiB, WS_WUP = 21 * MiB, WS_WDN = 32 * MiB;
constexpr size_t WS_H = 38 * MiB, WS_Q = 58 * MiB, WS_ZA = 78 * MiB, WS_RQ = 98 * MiB, WS_GF = 118 * MiB, WS_GB = 138 * MiB, WS_RI = 158 * MiB, WS_PP = 178 * MiB, WS_K = 243 * MiB, WS_V = 243 * MiB + 6400 * 1024;
constexpr size_t WS_U = 58 * MiB, WS_ACT = 168 * MiB, WS_H2 = 223 * MiB, WS_END = 256 * MiB;
constexpr int RING_BYTES = 131072, LDS_BYTES = 147456;
constexpr int N_PHASES = 15;

typedef unsigned v4u __attribute__((ext_vector_type(4)));
#define LDS_WAIT() asm volatile("s_waitcnt lgkmcnt(0)" ::: "memory")
__device__ __forceinline__ unsigned f2bf(float f) { unsigned u = __builtin_bit_cast(unsigned, f); return (u + 0x7fffu + ((u >> 16) & 1u)) >> 16; }
__device__ __forceinline__ unsigned pk2(float lo, float hi) { return pg8::cvt_pk_bf16(lo, hi); }

#define RLX_AGENT __ATOMIC_RELAXED, __HIP_MEMORY_SCOPE_AGENT
#define XB_TMO      128
#define XB_XCNT(j)  (256  + 64 * (j))
#define XB_XSUB(j)  (1280 + 64 * (j))
#define XB_XGEN(j)  (2304 + 64 * (j))
#define XB_TOP      3328
#define XB_TOPGEN   3392
#define XCD_BAR_WORDS 3456
#define XB_SPIN_CAP (1u << 18)

__device__ __forceinline__ unsigned xb_ld(unsigned* p)              { return __hip_atomic_load(p, __ATOMIC_RELAXED, __HIP_MEMORY_SCOPE_AGENT); }
__device__ __forceinline__ unsigned xb_add(unsigned* p, unsigned v) { return __hip_atomic_fetch_add(p, v, __ATOMIC_RELAXED, __HIP_MEMORY_SCOPE_AGENT); }
__device__ __forceinline__ unsigned xb_xcc_id() { return (unsigned)__builtin_amdgcn_s_getreg((3 << 11) | 20) & 0xFu; }
#define XB_SPIN(cond, bar) do { unsigned _sp = 0; while (cond) { __builtin_amdgcn_s_sleep(1); \
    if ((++_sp & 255u) == 0u) { if (xb_ld(&(bar)[XB_TMO])) break; if (_sp > XB_SPIN_CAP) { atomicAdd(&(bar)[XB_TMO], 1u); break; } } } } while (0)

struct XcdBarrier {
    unsigned* bar; unsigned x;
    volatile LAS unsigned* st;
};

__device__ __forceinline__ XcdBarrier xcd_barrier_post(unsigned* bar, volatile LAS unsigned* st) {
    XcdBarrier b; b.bar = bar; b.x = xb_xcc_id(); b.st = st;
    if (threadIdx.x == 0) (void)xb_add(&bar[XB_XCNT(b.x)], 1u);
    return b;
}
__device__ __forceinline__ void xcd_barrier_complete(unsigned* bar, unsigned x, unsigned& nloc, unsigned& nx) {
    const unsigned G = gridDim.x * gridDim.y * gridDim.z;
    unsigned sum, cnt, mine, sp = 0u;
    for (;;) {
        sum = 0u; cnt = 0u; mine = 0u;
#pragma unroll
        for (unsigned j = 0; j < 16; ++j) { const unsigned c = xb_ld(&bar[XB_XCNT(j)]); sum += c; cnt += (c > 0u) ? 1u : 0u; mine = (j == x) ? c : mine; }
        if (sum == G) break;
        __builtin_amdgcn_s_sleep(1);
        if ((++sp & 255u) == 0u) { if (xb_ld(&bar[XB_TMO])) break; if (sp > XB_SPIN_CAP) { atomicAdd(&bar[XB_TMO], 1u); break; } }
    }
    nloc = mine > 0u ? mine : 1u; nx = cnt > 0u ? cnt : 1u;
}

__device__ __forceinline__ void xcd_barrier(const XcdBarrier& b) {
    asm volatile("s_waitcnt vmcnt(0)" ::: "memory");
    __syncthreads();
    if (threadIdx.x == 0) {
        unsigned* bar = b.bar;
        __builtin_amdgcn_s_waitcnt(0);
        unsigned nloc = b.st[0], nx = b.st[1];
        if (nloc == 0u) { xcd_barrier_complete(bar, b.x, nloc, nx); b.st[0] = nloc; b.st[1] = nx; }
        const unsigned old = xb_add(&bar[XB_XSUB(b.x)], 1u);
        const unsigned gen = old / nloc;
        if (old + 1u == (gen + 1u) * nloc) {
            __builtin_amdgcn_fence(__ATOMIC_RELEASE, "agent");
            asm volatile("s_waitcnt vmcnt(0)" ::: "memory");
            const unsigned og = xb_add(&bar[XB_TOP], 1u);
            const unsigned tg = og / nx;
            if (og + 1u == (tg + 1u) * nx) xb_add(&bar[XB_TOPGEN], 1u);
            else XB_SPIN(xb_ld(&bar[XB_TOPGEN]) == tg, bar);
            __builtin_amdgcn_fence(__ATOMIC_ACQUIRE, "agent");
            xb_add(&bar[XB_XGEN(b.x)], 1u);
            asm volatile("s_waitcnt vmcnt(0)" ::: "memory");
        } else {
            XB_SPIN(xb_ld(&bar[XB_XGEN(b.x)]) == gen, bar);
            __builtin_amdgcn_fence(__ATOMIC_ACQUIRE, "agent");
            asm volatile("s_waitcnt vmcnt(0)" ::: "memory");
        }
    }
    __syncthreads();
}

struct Args { const float* in[22]; float* out; unsigned char* ws; int ph_lo, ph_hi; };

__device__ __forceinline__ void p0_transpose_item(const float* W, int K, int N, bf16_t* WT, int prow0, int lc0, LAS float* scr, int kb, int lane) {
    const int k0 = 64 * kb;
#pragma unroll 8
    for (int i = 0; i < 32; ++i) { const int kk = 2 * i + (lane >> 5); scr[kk * 33 + (lane & 31)] = W[(size_t)(k0 + kk) * N + lc0 + (lane & 31)]; }
    LDS_WAIT(); asm volatile("" ::: "memory");
    const int c = lane & 7;
#pragma unroll
    for (int j = 0; j < 4; ++j) { const int n = (lane >> 3) + 8 * j; const LAS float* s = scr + (8 * c) * 33 + n;
        v4u o; o.x = pk2(s[0 * 33], s[1 * 33]); o.y = pk2(s[2 * 33], s[3 * 33]); o.z = pk2(s[4 * 33], s[5 * 33]); o.w = pk2(s[6 * 33], s[7 * 33]);
        *(v4u*)(WT + (size_t)(prow0 + n) * K + k0 + 8 * c) = o; }
    LDS_WAIT(); asm volatile("" ::: "memory");
}

__device__ __forceinline__ void p0_prep(const __attribute__((address_space(4))) Args* a, LAS unsigned char* lds, int gw, int NGW, int wave, int lane, bool skip_ada = false) {
    LAS float* scr = (LAS float*)(lds + wave * 16384);
    unsigned char* ws = a->ws;
    const float* w_in = a->in[11]; const float* w_o = a->in[16]; const float* w_up = a->in[17]; const float* w_dn = a->in[20];
    constexpr int I_IN = 16 * 272, I_O = 16 * 32, I_UP = 16 * 176, I_DN = 44 * 32, I_T = I_IN + I_O + I_UP + I_DN, I_ADA = 96 * 16, I_ROPE = 16, I_LB = 32;
    for (int it = gw; it < I_T + I_ADA + I_ROPE + I_LB; it += NGW) {
        int r = it;
        if (r < I_T) {
            const float* W; int K, N, kb, pg; bf16_t* WT; bool isin = false, isup = false;
            if (r < I_IN) { W = w_in; K = 1024; N = INW; kb = r / 272; pg = r % 272; WT = (bf16_t*)(ws + WS_WIN); isin = true; }
            else if ((r -= I_IN) < I_O) { W = w_o; K = 1024; N = 1024; kb = r / 32; pg = r % 32; WT = (bf16_t*)(ws + WS_WO); }
            else if ((r -= I_O) < I_UP) { W = w_up; K = 1024; N = UPW; kb = r / 176; pg = r % 176; WT = (bf16_t*)(ws + WS_WUP); isup = true; }
            else { r -= I_UP; W = w_dn; K = DFF; N = 1024; kb = r / 32; pg = r % 32; WT = (bf16_t*)(ws + WS_WDN); }
            const int T = pg >> 3, g = pg & 7, bj = g >> 2, wc = g & 3;
            int lc0 = T * 256 + wc * 64 + bj * 32;
            if (isin && T >= 22) lc0 = (T < 26) ? 6656 + (T - 22) * 256 + wc * 64 + bj * 32 : (bj ? 7680 : 5632) + (T - 26) * 128 + wc * 32;
            if (isup) lc0 = (bj ? DFF : 0) + T * 128 + wc * 32;
            p0_transpose_item(W, K, N, WT, pg * 32, lc0, scr, kb, lane);
        } else if ((r -= I_T) < I_ADA) {
            if (skip_ada) continue;
            const int g = r >> 4, kc = r & 15, n0 = g * 64 + lane, k0 = kc * 64;
            const float* c_in = a->in[2]; const float* cctx = a->in[6]; const float* adaw = a->in[7];
#pragma unroll
            for (int i = 0; i < 9; ++i) { const float cv = (i == 0) ? cctx[k0 + lane] : c_in[(i - 1) * 1024 + k0 + lane]; scr[lane * 12 + i] = fsilu(cv); }
            LDS_WAIT(); asm volatile("" ::: "memory");
            float acc[9];
#pragma unroll
            for (int i = 0; i < 9; ++i) acc[i] = 0.f;
#pragma unroll 8
            for (int kk = 0; kk < 64; ++kk) { const float w = adaw[(size_t)(k0 + kk) * 6144 + n0];
                const pg8::f32x4 s0 = *(const LAS pg8::f32x4*)(scr + kk * 12), s1 = *(const LAS pg8::f32x4*)(scr + kk * 12 + 4); const float s8 = scr[kk * 12 + 8];
                acc[0] += s0[0] * w; acc[1] += s0[1] * w; acc[2] += s0[2] * w; acc[3] += s0[3] * w; acc[4] += s1[0] * w; acc[5] += s1[1] * w; acc[6] += s1[2] * w; acc[7] += s1[3] * w; acc[8] += s8 * w; }
            float* mod = (float*)(ws + WS_MOD);
#pragma unroll
            for (int i = 0; i < 9; ++i) atomicAdd(mod + i * 6144 + n0, acc[i]);
            LDS_WAIT(); asm volatile("" ::: "memory");
        } else if ((r -= I_ADA) >= I_ROPE) {
            r -= I_ROPE; const int idx = r * 64 + lane, d = idx >> 10, cch = idx & 1023; const float* lg = a->in[14];
            ((float*)(ws + WS_LBT))[idx] = fsigmoid(lg[d * 2048 + cch] - lg[d * 2048 + 1024 + cch]);
        } else {
            const int idx = r * 64 + lane, pos = idx >> 4, i = idx & 15;
            const float invf = exp2f(-(float)i * 0.8304820237218406f); const float ang = (float)pos * invf;
            const float n = rintf(ang * 0.15915494309189535f); float rr = fmaf(-n, 6.2831854820251465f, ang); rr = fmaf(-n, -1.7484555e-7f, rr);
            float* rope = (float*)(ws + WS_ROPE); rope[idx * 2] = __cosf(rr); rope[idx * 2 + 1] = __sinf(rr);
        }
    }
}

template <int MODE> __device__ __forceinline__ void norm_row(const float* xrow, const float* gain, const float* mod, const float* adab, int shoff, int scoff, bf16_t* obf, float* of32, int lane) {
    const pg8::f32x4* xr = (const pg8::f32x4*)xrow + lane;
    pg8::f32x4 v[4]; float s = 0.f;
#pragma unroll
    for (int j = 0; j < 4; ++j) { v[j] = xr[64 * j]; s += (v[j][0] * v[j][0] + v[j][1] * v[j][1]) + (v[j][2] * v[j][2] + v[j][3] * v[j][3]); }
    const float rstd = __builtin_amdgcn_rsqf(wave_sum(s) * (1.0f / 1024.0f) + EPS);
#pragma unroll
    for (int j = 0; j < 4; ++j) { const int c = 4 * (lane + 64 * j); const pg8::f32x4 g = *(const pg8::f32x4*)(gain + c); pg8::f32x4 y = v[j] * rstd * g;
        if (MODE == 0) { const pg8::f32x4 sh = *(const pg8::f32x4*)(mod + shoff + c) + *(const pg8::f32x4*)(adab + shoff + c), sc = *(const pg8::f32x4*)(mod + scoff + c) + *(const pg8::f32x4*)(adab + scoff + c);
            y = y * (sc + 1.0f) + sh; u32x2 w; w.x = pk2(y[0], y[1]); w.y = pk2(y[2], y[3]); *(u32x2*)(obf + c) = w; }
        else *(pg8::f32x4*)(of32 + c) = y; }
}

constexpr int R_QD = 0, R_KD = 17408, R_K2T = 34816, R_VT = 53248, R_SC = 71680, R_ST = 80896, R_XCH = 115712, R_DEC = 119808;
__device__ __forceinline__ int crow(int r, int hi) { return (r & 3) + 8 * (r >> 2) + 4 * hi; }
__device__ __forceinline__ void rec_scan(LAS unsigned char* lds, const bf16_t* RQ, bf16_t* G, const bf16_t* RI, int lrow0, int L, int rh, int dir, const float* s0, float* sfin, const bool wr_ = true) {
    int tid_o = threadIdx.x; asm volatile("" : "+v"(tid_o));
    const int tid = tid_o, lane = tid & 63, w = __builtin_amdgcn_readfirstlane(tid >> 6), r32 = lane & 31, hi = lane >> 5;
    const int kb = w >> 1, dvt0 = (w & 1) * 2;
    const int colb = rh * 128;
    f32x16 S[2];
#pragma unroll
    for (int x = 0; x < 2; ++x)
#pragma unroll
        for (int r = 0; r < 16; ++r) S[x][r] = s0 ? s0[(size_t)(kb * 32 + crow(r, hi)) * 128 + (dvt0 + x) * 32 + r32] : 0.f;
#define REC_WRITE_ST() do { _Pragma("unroll") for (int x = 0; x < 2; ++x) _Pragma("unroll") for (int g = 0; g < 4; ++g) { u32x2 wv; wv.x = pk2(S[x][4 * g], S[x][4 * g + 1]); wv.y = pk2(S[x][4 * g + 2], S[x][4 * g + 3]); \
        *(LAS u32x2*)(lds + R_ST + ((dvt0 + x) * 32 + r32) * 272 + (kb * 32 + 8 * g + 4 * hi) * 2) = wv; } } while (0)
    REC_WRITE_ST();
    const int nc = L >> 6;
    unsigned gq[8], qq[8], vv[8];
#define REC_ROW(c, i) (dir ? (lrow0 + L - 1 - ((c) * 64 + (i))) : (lrow0 + (c) * 64 + (i)))
#define REC_LOAD(c) do { _Pragma("unroll") for (int i = 0; i < 8; ++i) { const size_t off = (size_t)REC_ROW(c, 8 * w + i) * DM + colb + 2 * lane; \
        gq[i] = *(const unsigned*)(G + off); qq[i] = *(const unsigned*)(RQ + off); vv[i] = *(const unsigned*)(RI + off); } } while (0)
    REC_LOAD(0);
    for (int c = 0; c < nc; ++c) {
        float g0[8], g1[8], q0[8], q1[8]; unsigned vk[8];
#pragma unroll
        for (int i = 0; i < 8; ++i) { g0[i] = h2f((unsigned short)(gq[i] & 0xffffu)); g1[i] = h2f((unsigned short)(gq[i] >> 16)); q0[i] = bflo(qq[i]); q1[i] = bfhi(qq[i]); vk[i] = vv[i]; }
        if (c + 1 < nc) REC_LOAD(c + 1);
        float b0[8], b1[8];
        b0[0] = g0[0]; b1[0] = g1[0];
#pragma unroll
        for (int i = 1; i < 8; ++i) { b0[i] = b0[i - 1] + g0[i]; b1[i] = b1[i - 1] + g1[i]; }
        *(LAS f32x2*)(lds + R_XCH + (w * 128 + 2 * lane) * 4) = (f32x2){b0[7], b1[7]};
        __syncthreads();
        float p0 = 0.f, p1 = 0.f, t0 = 0.f, t1 = 0.f;
#pragma unroll
        for (int ww = 0; ww < 8; ++ww) { const f32x2 x = *(const LAS f32x2*)(lds + R_XCH + (ww * 128 + 2 * lane) * 4); if (ww < w) { p0 += x[0]; p1 += x[1]; } t0 += x[0]; t1 += x[1]; }
        if (w == 0) *(LAS f32x2*)(lds + R_DEC + 2 * lane * 4) = (f32x2){__expf(t0), __expf(t1)};
        unsigned k2a[4], k2b[4], va[4], vb[4];
#pragma unroll
        for (int i = 0; i < 8; ++i) {
            const float bb0 = p0 + b0[i], bb1 = p1 + b1[i];
            const float kk0 = 1.0f - __expf(g0[i]), kk1 = 1.0f - __expf(g1[i]);
            const float qd0 = q0[i] * __expf(bb0), qd1 = q1[i] * __expf(bb1);
            const float kd0 = kk0 * __expf(-bb0), kd1 = kk1 * __expf(-bb1);
            const float kt0 = kk0 * __expf(t0 - bb0), kt1 = kk1 * __expf(t1 - bb1);
            const int ti = 8 * w + i;
            *(LAS unsigned*)(lds + R_QD + ti * 272 + lane * 4) = pk2(qd0, qd1);
            *(LAS unsigned*)(lds + R_KD + ti * 272 + lane * 4) = pk2(kd0, kd1);
            const unsigned f0 = f2bf(kt0), f1 = f2bf(kt1);
            if (i & 1) { k2a[i >> 1] |= f0 << 16; k2b[i >> 1] |= f1 << 16; va[i >> 1] |= (vk[i] & 0xffffu) << 16; vb[i >> 1] |= vk[i] & 0xffff0000u; }
            else { k2a[i >> 1] = f0; k2b[i >> 1] = f1; va[i >> 1] = vk[i] & 0xffffu; vb[i >> 1] = vk[i] >> 16; }
        }
        *(LAS v4u*)(lds + R_K2T + (2 * lane) * 144 + 16 * w) = (v4u){k2a[0], k2a[1], k2a[2], k2a[3]};
        *(LAS v4u*)(lds + R_K2T + (2 * lane + 1) * 144 + 16 * w) = (v4u){k2b[0], k2b[1], k2b[2], k2b[3]};
        *(LAS v4u*)(lds + R_VT + (2 * lane) * 144 + 16 * w) = (v4u){va[0], va[1], va[2], va[3]};
        *(LAS v4u*)(lds + R_VT + (2 * lane + 1) * 144 + 16 * w) = (v4u){vb[0], vb[1], vb[2], vb[3]};
        __syncthreads();
        if (w < 4) {
            const int ti = w >> 1, si = w & 1;
            f32x16 sc;
#pragma unroll
            for (int r = 0; r < 16; ++r) sc[r] = 0.f;
            if (w != 1) {
#pragma unroll
                for (int ks = 0; ks < 8; ++ks) {
                    const pg8::bf16x8 af = *(const LAS pg8::bf16x8*)(lds + R_QD + (ti * 32 + r32) * 272 + (16 * ks + 8 * hi) * 2);
                    const pg8::bf16x8 bf = *(const LAS pg8::bf16x8*)(lds + R_KD + (si * 32 + r32) * 272 + (16 * ks + 8 * hi) * 2);
                    sc = __builtin_amdgcn_mfma_f32_32x32x16_bf16(af, bf, sc, 0, 0, 0);
                }
            }
#pragma unroll
            for (int r = 0; r < 16; ++r) { const int t = ti * 32 + crow(r, hi), s = si * 32 + r32; const float v = (t >= s) ? sc[r] : 0.f;
                *(LAS unsigned short*)(lds + R_SC + t * 144 + s * 2) = (unsigned short)f2bf(v); }
        }
        __syncthreads();
        {
            const int to = w >> 2, dvo = w & 3;
            f32x16 o;
#pragma unroll
            for (int r = 0; r < 16; ++r) o[r] = 0.f;
#pragma unroll
            for (int ks = 0; ks < 4; ++ks) {
                const pg8::bf16x8 af = *(const LAS pg8::bf16x8*)(lds + R_SC + (to * 32 + r32) * 144 + (16 * ks + 8 * hi) * 2);
                const pg8::bf16x8 bf = *(const LAS pg8::bf16x8*)(lds + R_VT + (dvo * 32 + r32) * 144 + (16 * ks + 8 * hi) * 2);
                o = __builtin_amdgcn_mfma_f32_32x32x16_bf16(af, bf, o, 0, 0, 0);
            }
#pragma unroll
            for (int ks = 0; ks < 8; ++ks) {
                const pg8::bf16x8 af = *(const LAS pg8::bf16x8*)(lds + R_QD + (to * 32 + r32) * 272 + (16 * ks + 8 * hi) * 2);
                const pg8::bf16x8 bf = *(const LAS pg8::bf16x8*)(lds + R_ST + (dvo * 32 + r32) * 272 + (16 * ks + 8 * hi) * 2);
                o = __builtin_amdgcn_mfma_f32_32x32x16_bf16(af, bf, o, 0, 0, 0);
            }
            if (wr_)
#pragma unroll
            for (int r = 0; r < 16; ++r) { const int t = to * 32 + crow(r, hi); G[(size_t)REC_ROW(c, t) * DM + colb + dvo * 32 + r32] = (bf16_t)f2bf(o[r]); }
            float dec[16];
#pragma unroll
            for (int r = 0; r < 16; ++r) dec[r] = *(const LAS float*)(lds + R_DEC + (kb * 32 + crow(r, hi)) * 4);
#pragma unroll
            for (int x = 0; x < 2; ++x)
#pragma unroll
                for (int r = 0; r < 16; ++r) S[x][r] *= dec[r];
#pragma unroll
            for (int ks = 0; ks < 4; ++ks) {
                const pg8::bf16x8 af = *(const LAS pg8::bf16x8*)(lds + R_K2T + (kb * 32 + r32) * 144 + (16 * ks + 8 * hi) * 2);
#pragma unroll
                for (int x = 0; x < 2; ++x) {
                    const pg8::bf16x8 bf = *(const LAS pg8::bf16x8*)(lds + R_VT + ((dvt0 + x) * 32 + r32) * 144 + (16 * ks + 8 * hi) * 2);
                    S[x] = __builtin_amdgcn_mfma_f32_32x32x16_bf16(af, bf, S[x], 0, 0, 0);
                }
            }
        }
        __syncthreads();
        REC_WRITE_ST();
    }
    if (sfin && wr_) {
#pragma unroll
        for (int x = 0; x < 2; ++x)
#pragma unroll
            for (int r = 0; r < 16; ++r) sfin[(size_t)(kb * 32 + crow(r, hi)) * 128 + (dvt0 + x) * 32 + r32] = S[x][r];
    }
#undef REC_WRITE_ST
#undef REC_ROW
#undef REC_LOAD
}

typedef const __attribute__((address_space(4))) Args* KArgs;
#define WSB(off) ((bf16_t*)(ws + (off)))
#define WSF(off) ((float*)(ws + (off)))
__device__ __forceinline__ bf16_t* h1_buf(unsigned char* ws, float* dout, int hfx) { return hfx ? (bf16_t*)(dout + (size_t)MH * DM) : WSB(WS_H); }
__device__ __forceinline__ void do_norm1(KArgs ap, int hfx, int gwb, int ngwb, int lane, bool rows, bool cache) {
    unsigned char* const ws = ap->ws; const float* xp = ap->in[0]; const float* xs = ap->in[1]; const float* adab = ap->in[8]; const float* mod = WSF(WS_MOD);
    bf16_t* Hd = h1_buf(ws, ap->out, hfx); bf16_t* Kb = WSB(WS_K); bf16_t* Vb = WSB(WS_V);
    if (rows) for (int r = gwb; r < MH; r += ngwb) { const int grow = hfx * MH + r; const float* src = grow < NPR ? xp + (size_t)grow * DM : xs + (size_t)(grow - NPR) * DM;
        norm_row<0>(src, ap->in[9], mod + mod_of_row(grow) * 6144, adab, 0, 1024, Hd + (size_t)r * DM, nullptr, lane); }
    const int nb = hfx ? 5 : 3, b0 = hfx ? 3 : 0;
    if (cache) for (int r = gwb; r < 2 * nb * 512; r += ngwb) { const int kv = r / (nb * 512), rr = r % (nb * 512), b = rr >> 9, p = rr & 511;
        const float* src = (kv ? ap->in[4] : ap->in[3]) + ((size_t)(b0 + b) * 512 + p) * KVP + 4 * lane;
        bf16_t* dst = (kv ? Vb : Kb) + (size_t)((hfx ? b * 2560 : NPR + b * 2560) + 2048 + p) * KVP + 4 * lane;
        const pg8::f32x4 v = *(const pg8::f32x4*)src; u32x2 wv; wv.x = pk2(v[0], v[1]); wv.y = pk2(v[2], v[3]); *(u32x2*)dst = wv; }
}
__device__ __forceinline__ void do_final(KArgs ap, int hfx, int gwb, int ngwb, int lane) {
    float* dout = ap->out;
    for (int r = gwb; r < MH; r += ngwb) { float* row = dout + (size_t)(hfx * MH + r) * DM; norm_row<1>(row, ap->in[21], nullptr, nullptr, 0, 0, nullptr, row, lane); }
}

__global__ void __launch_bounds__(NTHR, 2) fwd_mega(Args args) {
    extern __shared__ __attribute__((aligned(16))) unsigned char lds_raw[];
    LAS unsigned char* lds = (LAS unsigned char*)lds_raw;
    const int G = gridDim.x, bx = blockIdx.x, NGW = G * NWAVES;
#define PH_IDS() int tid = threadIdx.x; asm volatile("" : "+v"(tid)); const int lane = tid & 63, wave = __builtin_amdgcn_readfirstlane(tid >> 6), gw = bx * NWAVES + wave; (void)lane; (void)gw; \
    KArgs ap = (KArgs)__builtin_amdgcn_kernarg_segment_ptr(); asm volatile("" : "+s"(ap)); unsigned char* const ws = ap->ws; float* const dout = ap->out; (void)ws; (void)dout;
#define AIN(i) (ap->in[i])
    const int lo = args.ph_lo, hi_ph = args.ph_hi;
    volatile LAS unsigned* bst = (volatile LAS unsigned*)(lds + RING_BYTES + 64);
    if (threadIdx.x < 2) bst[threadIdx.x] = 0u;
    __syncthreads();
    XcdBarrier xbar = xcd_barrier_post((unsigned*)(args.ws + WS_BAR), bst);
    cg::grid_group grid = cg::this_grid();
#ifndef PHMASK
#define PHMASK 0xFFFF
#endif
#define PEN(j) (((PHMASK) >> (j)) & 1)
#ifndef DUPMASK
#define DUPMASK 0
#endif
#define DUP(j) (((DUPMASK) >> (j)) & 1)
#define IN(k) (lo <= (k) && (k) < hi_ph)
#define SEAM(k) do { if (IN(k) && IN((k) + 1)) { if (lo < 0) grid.sync();     xcd_barrier(xbar); } } while (0)

    if (IN(0)) { PH_IDS(); p0_prep(ap, lds, gw, NGW, wave, lane); SEAM(0); }

    if (IN(1)) { PH_IDS(); const int hf = 0; const int rep_ = 0; (void)hf; (void)rep_;

            const float* adab = AIN(8); const float* mod = WSF(WS_MOD);
            do_norm1(ap, 0, gw, NGW, lane, true, true);
            if (hf == 0) { float* modb = WSF(WS_MODB); for (int i = gw * 64 + lane; i < 9 * 6144; i += NGW * 64) modb[i] = mod[i] + adab[i % 6144];
                float* gam = WSF(WS_GAM); const float* n2 = AIN(10); for (int i = gw * 64 + lane; i < 9 * 1024; i += NGW * 64) { const int b = i >> 10, cc = i & 1023; gam[i] = n2[cc] * (1.0f + mod[b * 6144 + 4096 + cc] + adab[4096 + cc]); }
                float* shw = WSF(WS_SHW); const bf16_t* WUP = WSB(WS_WUP);
                for (int p = gw; p < UPW; p += NGW) {
                    const v4u w0 = *(const v4u*)(WUP + (size_t)p * DM + 16 * lane), w1 = *(const v4u*)(WUP + (size_t)p * DM + 16 * lane + 8);
                    float wv[16];
#pragma unroll
                    for (int q = 0; q < 4; ++q) { wv[2 * q] = bflo(w0[q]); wv[2 * q + 1] = bfhi(w0[q]); wv[8 + 2 * q] = bflo(w1[q]); wv[8 + 2 * q + 1] = bfhi(w1[q]); }
                    #pragma unroll 1
                    for (int b = 0; b < 9; ++b) { float s = 0.f;
#pragma unroll
                        for (int q = 0; q < 4; ++q) { const pg8::f32x4 a = *(const pg8::f32x4*)(mod + b * 6144 + 3072 + 16 * lane + 4 * q) + *(const pg8::f32x4*)(adab + 3072 + 16 * lane + 4 * q);
                            s += a[0] * wv[4 * q] + a[1] * wv[4 * q + 1] + a[2] * wv[4 * q + 2] + a[3] * wv[4 * q + 3]; }
                        s = wave_sum(s); if (lane == 0) shw[b * UPW + p] = s; }
                }
            }
            SEAM(1);
    }
    if (IN(2)) { PH_IDS(); const int hf = 0; const int rep_ = 0; (void)hf; (void)rep_;

            pg8::Gemm g{h1_buf(ws, dout, hf), WSB(WS_WIN), MH, INW, DM}; pg8::StaticOrder S; S.init(MH, INW, G, bx);
            float* nck = dout + (size_t)MTOT * DM; float* ncv = nck + (size_t)NPR * KVP;
            pg8::EpiInProj E{WSB(WS_Q), WSB(WS_K), WSB(WS_V), WSB(WS_RQ), WSB(WS_GF), WSB(WS_GB), WSB(WS_RI), WSB(WS_ZA), WSB(WS_PP), nck, ncv, AIN(12), AIN(13), WSF(WS_LBT), WSF(WS_ROPE), hf};
            pg8::gemm_phase<pg8::EpiInProj, pg8::StaticOrder, true, true>(lds, g, S, E);
            { const int rem = ((MH / 256) * (INW / 256)) % G;
              if (bx >= rem) do_norm1(ap, 1, (bx - rem) * NWAVES + wave, (G - rem) * NWAVES, lane, true, false); }
            SEAM(2);
    }
    if (IN(3)) { PH_IDS(); const int hf = 0; const int rep_ = 0; (void)hf; (void)rep_;

            const int nlong = hf ? 80 : 48, nbig = hf ? 640 : 384, nshort = hf ? 0 : 256, nsmall = hf ? 0 : 256;
#ifndef DUPREC
#define DUPREC 0
#endif
#ifndef DUPATT
#define DUPATT 0
#endif
            const int ndl = DUPREC ? nlong : 0, nda = DUPATT ? nbig : 0;
            const int ntot = ndl + nda + nlong + nbig + nshort + nsmall;
            LAS int* slot = (LAS int*)(lds + RING_BYTES); unsigned* ctl = (unsigned*)(ws + WS_CTL);
            bf16_t* Qb = WSB(WS_Q); bf16_t* Kb = WSB(WS_K); bf16_t* Vb = WSB(WS_V); bf16_t* RQ = WSB(WS_RQ); bf16_t* GF = WSB(WS_GF); bf16_t* GB = WSB(WS_GB); bf16_t* RI = WSB(WS_RI);
            float* nst = dout + (size_t)MTOT * DM + 2 * (size_t)NPR * KVP;
            for (;;) {
                __syncthreads();
                if (tid == 0) *slot = (int)atomicAdd(ctl + 64 * hf + ((DUP(2) && rep_ == 0) ? 16 : 0), 1u);
                __syncthreads();
                int it = *slot;
                if (it >= ntot) break;
                bool wr = !(DUP(2) && rep_ == 0);
                if (it < ndl) wr = false; else { it -= ndl; if (it < nda) { wr = false; it += nlong; } else it -= nda; }
                if (it < nlong) {
                    const int b = it >> 4, rh = (it >> 1) & 7, dir = it & 1; const int bglob = hf ? 3 + b : b;
                    rec_scan(lds, RQ, dir ? GB : GF, RI, (hf ? 0 : NPR) + b * 2048, 2048, rh, dir, AIN(5) + (size_t)((bglob * 2 + dir) * 8 + rh) * 16384, nullptr, wr);
                } else if ((it -= nlong) < nbig) {
                    const int gq = it & 3, qb = (it >> 2) & 7, kvh = (it >> 5) & 3, b = it >> 7, h = kvh * 4 + gq;
                    const int lrow0 = (hf ? 0 : NPR) + b * 2048 + qb * 256, kvr0 = (hf ? 0 : NPR) + b * 2560;
                    attn_body::attn_unit<8>((const attn_body::bf16*)(Qb + (size_t)lrow0 * DM + h * 64), (const attn_body::bf16*)(Kb + (size_t)kvr0 * KVP + kvh * 64), (const attn_body::bf16*)(Vb + (size_t)kvr0 * KVP + kvh * 64),
                                            (attn_body::bf16*)(Qb + (size_t)lrow0 * DM + h * 64), 40, (char*)lds_raw, wr);
                } else if ((it -= nbig) < nshort) {
                    const int seq = it >> 4, rh = (it >> 1) & 7, dir = it & 1;
                    rec_scan(lds, RQ, dir ? GB : GF, RI, seq * 256, 256, rh, dir, nullptr, nst + (size_t)((seq * 2 + dir) * 8 + rh) * 16384, wr);
                } else {
                    it -= nshort; const int seq = it >> 4, h = it & 15, kvh = h >> 2;
                    attn_body::attn_unit<8>((const attn_body::bf16*)(Qb + (size_t)(seq * 256) * DM + h * 64), (const attn_body::bf16*)(Kb + (size_t)(seq * 256) * KVP + kvh * 64), (const attn_body::bf16*)(Vb + (size_t)(seq * 256) * KVP + kvh * 64),
                                            (attn_body::bf16*)(Qb + (size_t)(seq * 256) * DM + h * 64), 4, (char*)lds_raw, wr);
                }
            }
            if (DUP(2) && rep_ == 0) xcd_barrier(xbar);
            SEAM(3);
    }
    if (IN(4)) { PH_IDS(); const int hf = 0; const int rep_ = 0; (void)hf; (void)rep_;

            const float* hg = AIN(15); bf16_t* Qb = WSB(WS_Q); bf16_t* ZA = WSB(WS_ZA); bf16_t* GF = WSB(WS_GF); bf16_t* GB = WSB(WS_GB); bf16_t* PP = WSB(WS_PP); bf16_t* H = WSB(WS_H);
            for (int r = gw; r < MH; r += NGW) {
                const size_t off = (size_t)r * DM + 16 * lane;
                v4u o[2], z[2], f[2], bq[2], p[2];
#pragma unroll
                for (int e = 0; e < 2; ++e) { o[e] = *(const v4u*)(Qb + off + 8 * e); z[e] = *(const v4u*)(ZA + off + 8 * e); f[e] = *(const v4u*)(GF + off + 8 * e); bq[e] = *(const v4u*)(GB + off + 8 * e); p[e] = *(const v4u*)(PP + off + 8 * e); }
                float s[16]; float ss = 0.f;
#pragma unroll
                for (int e = 0; e < 2; ++e)
#pragma unroll
                    for (int q = 0; q < 4; ++q) { s[8 * e + 2 * q] = bflo(f[e][q]) + bflo(bq[e][q]); s[8 * e + 2 * q + 1] = bfhi(f[e][q]) + bfhi(bq[e][q]); }
#pragma unroll
                for (int q = 0; q < 16; ++q) ss += s[q] * s[q];
                ss += __shfl_xor(ss, 1); ss += __shfl_xor(ss, 2); ss += __shfl_xor(ss, 4);
                const float rs = __builtin_amdgcn_rsqf(ss * (1.0f / 128.0f) + EPS);
                const int gc = (16 * lane) & 127;
                v4u outw[2];
#pragma unroll
                for (int e = 0; e < 2; ++e)
#pragma unroll
                    for (int q = 0; q < 4; ++q) {
                        const int i0 = 8 * e + 2 * q;
                        const float m0 = bflo(o[e][q]) * bflo(z[e][q]) + bflo(p[e][q]) * (s[i0] * rs * hg[gc + i0]);
                        const float m1 = bfhi(o[e][q]) * bfhi(z[e][q]) + bfhi(p[e][q]) * (s[i0 + 1] * rs * hg[gc + i0 + 1]);
                        outw[e][q] = pk2(m0, m1);
                    }
                *(v4u*)(H + off) = outw[0]; *(v4u*)(H + off + 8) = outw[1];
            }
            do_norm1(ap, 1, gw, NGW, lane, false, true);
            SEAM(4);
    }
    if (IN(5)) { PH_IDS(); const int hf = 1; const int rep_ = 0; (void)hf; (void)rep_;

            pg8::Gemm g{h1_buf(ws, dout, hf), WSB(WS_WIN), MH, INW, DM}; pg8::StaticOrder S; S.init(MH, INW, G, bx);
            float* nck = dout + (size_t)MTOT * DM; float* ncv = nck + (size_t)NPR * KVP;
            pg8::EpiInProj E{WSB(WS_Q), WSB(WS_K), WSB(WS_V), WSB(WS_RQ), WSB(WS_GF), WSB(WS_GB), WSB(WS_RI), WSB(WS_ZA), WSB(WS_PP), nck, ncv, AIN(12), AIN(13), WSF(WS_LBT), WSF(WS_ROPE), hf};
            pg8::gemm_phase<pg8::EpiInProj, pg8::StaticOrder, true, true>(lds, g, S, E);
            { const int rem = ((MH / 256) * (INW / 256)) % G;
              if (bx >= rem) {
            { pg8::Gemm g{WSB(WS_H), WSB(WS_WO), MH, DM, DM}; pg8::StaticOrder S; S.init(MH, DM, G - rem, bx - rem);
              pg8::EpiResidW E{AIN(0), AIN(1), dout, WSF(WS_MODB), WSF(WS_GAM), WSB(WS_H2), WSF(WS_ROWSS), 2048, 0};
              pg8::gemm_phase<pg8::EpiResidW, pg8::StaticOrder, true, true>(lds, g, S, E); }
              } }
            SEAM(5);
    }
    if (IN(6)) { PH_IDS(); const int hf = 1; const int rep_ = 0; (void)hf; (void)rep_;

            const int nlong = hf ? 80 : 48, nbig = hf ? 640 : 384, nshort = hf ? 0 : 256, nsmall = hf ? 0 : 256;
#ifndef DUPREC
#define DUPREC 0
#endif
#ifndef DUPATT
#define DUPATT 0
#endif
            const int ndl = DUPREC ? nlong : 0, nda = DUPATT ? nbig : 0;
            const int ntot = ndl + nda + nlong + nbig + nshort + nsmall;
            LAS int* slot = (LAS int*)(lds + RING_BYTES); unsigned* ctl = (unsigned*)(ws + WS_CTL);
            bf16_t* Qb = WSB(WS_Q); bf16_t* Kb = WSB(WS_K); bf16_t* Vb = WSB(WS_V); bf16_t* RQ = WSB(WS_RQ); bf16_t* GF = WSB(WS_GF); bf16_t* GB = WSB(WS_GB); bf16_t* RI = WSB(WS_RI);
            float* nst = dout + (size_t)MTOT * DM + 2 * (size_t)NPR * KVP;
            for (;;) {
                __syncthreads();
                if (tid == 0) *slot = (int)atomicAdd(ctl + 64 * hf + ((DUP(2) && rep_ == 0) ? 16 : 0), 1u);
                __syncthreads();
                int it = *slot;
                if (it >= ntot) break;
                bool wr = !(DUP(2) && rep_ == 0);
                if (it < ndl) wr = false; else { it -= ndl; if (it < nda) { wr = false; it += nlong; } else it -= nda; }
                if (it < nlong) {
                    const int b = it >> 4, rh = (it >> 1) & 7, dir = it & 1; const int bglob = hf ? 3 + b : b;
                    rec_scan(lds, RQ, dir ? GB : GF, RI, (hf ? 0 : NPR) + b * 2048, 2048, rh, dir, AIN(5) + (size_t)((bglob * 2 + dir) * 8 + rh) * 16384, nullptr, wr);
                } else if ((it -= nlong) < nbig) {
                    const int gq = it & 3, qb = (it >> 2) & 7, kvh = (it >> 5) & 3, b = it >> 7, h = kvh * 4 + gq;
                    const int lrow0 = (hf ? 0 : NPR) + b * 2048 + qb * 256, kvr0 = (hf ? 0 : NPR) + b * 2560;
                    attn_body::attn_unit<8>((const attn_body::bf16*)(Qb + (size_t)lrow0 * DM + h * 64), (const attn_body::bf16*)(Kb + (size_t)kvr0 * KVP + kvh * 64), (const attn_body::bf16*)(Vb + (size_t)kvr0 * KVP + kvh * 64),
                                            (attn_body::bf16*)(Qb + (size_t)lrow0 * DM + h * 64), 40, (char*)lds_raw, wr);
                } else if ((it -= nbig) < nshort) {
                    const int seq = it >> 4, rh = (it >> 1) & 7, dir = it & 1;
                    rec_scan(lds, RQ, dir ? GB : GF, RI, seq * 256, 256, rh, dir, nullptr, nst + (size_t)((seq * 2 + dir) * 8 + rh) * 16384, wr);
                } else {
                    it -= nshort; const int seq = it >> 4, h = it & 15, kvh = h >> 2;
                    attn_body::attn_unit<8>((const attn_body::bf16*)(Qb + (size_t)(seq * 256) * DM + h * 64), (const attn_body::bf16*)(Kb + (size_t)(seq * 256) * KVP + kvh * 64), (const attn_body::bf16*)(Vb + (size_t)(seq * 256) * KVP + kvh * 64),
                                            (attn_body::bf16*)(Qb + (size_t)(seq * 256) * DM + h * 64), 4, (char*)lds_raw, wr);
                }
            }
            if (DUP(2) && rep_ == 0) xcd_barrier(xbar);
            SEAM(6);
    }
    if (IN(7)) { PH_IDS(); const int hf = 1; const int rep_ = 0; (void)hf; (void)rep_;

            const float* hg = AIN(15); bf16_t* Qb = WSB(WS_Q); bf16_t* ZA = WSB(WS_ZA); bf16_t* GF = WSB(WS_GF); bf16_t* GB = WSB(WS_GB); bf16_t* PP = WSB(WS_PP); bf16_t* H = WSB(WS_H);
            for (int r = gw; r < MH; r += NGW) {
                const size_t off = (size_t)r * DM + 16 * lane;
                v4u o[2], z[2], f[2], bq[2], p[2];
#pragma unroll
                for (int e = 0; e < 2; ++e) { o[e] = *(const v4u*)(Qb + off + 8 * e); z[e] = *(const v4u*)(ZA + off + 8 * e); f[e] = *(const v4u*)(GF + off + 8 * e); bq[e] = *(const v4u*)(GB + off + 8 * e); p[e] = *(const v4u*)(PP + off + 8 * e); }
                float s[16]; float ss = 0.f;
#pragma unroll
                for (int e = 0; e < 2; ++e)
#pragma unroll
                    for (int q = 0; q < 4; ++q) { s[8 * e + 2 * q] = bflo(f[e][q]) + bflo(bq[e][q]); s[8 * e + 2 * q + 1] = bfhi(f[e][q]) + bfhi(bq[e][q]); }
#pragma unroll
                for (int q = 0; q < 16; ++q) ss += s[q] * s[q];
                ss += __shfl_xor(ss, 1); ss += __shfl_xor(ss, 2); ss += __shfl_xor(ss, 4);
                const float rs = __builtin_amdgcn_rsqf(ss * (1.0f / 128.0f) + EPS);
                const int gc = (16 * lane) & 127;
                v4u outw[2];
#pragma unroll
                for (int e = 0; e < 2; ++e)
#pragma unroll
                    for (int q = 0; q < 4; ++q) {
                        const int i0 = 8 * e + 2 * q;
                        const float m0 = bflo(o[e][q]) * bflo(z[e][q]) + bflo(p[e][q]) * (s[i0] * rs * hg[gc + i0]);
                        const float m1 = bfhi(o[e][q]) * bfhi(z[e][q]) + bfhi(p[e][q]) * (s[i0 + 1] * rs * hg[gc + i0 + 1]);
                        outw[e][q] = pk2(m0, m1);
                    }
                *(v4u*)(H + off) = outw[0]; *(v4u*)(H + off + 8) = outw[1];
            }
            SEAM(7);
    }
    if (IN(8)) { PH_IDS(); const int hf = 0; const int rep_ = 0; (void)hf; (void)rep_;

            pg8::Gemm g{WSB(WS_H2), WSB(WS_WUP), MH, UPW, DM}; pg8::StaticOrder S; S.init(MH, UPW, G, bx);
            pg8::EpiUpAct E{WSB(WS_ACT), WSB(WS_U), WSF(WS_ROWSS), WSF(WS_SHW), AIN(18), AIN(19), hf};
            pg8::gemm_phase<pg8::EpiUpAct, pg8::StaticOrder, true, true>(lds, g, S, E);
            SEAM(8);
    }
    if (IN(9)) { PH_IDS(); const int hf = 0; const int rep_ = 0; (void)hf; (void)rep_;

            const float* cw = AIN(18); const float* cb = AIN(19); const bf16_t* EB = WSB(WS_U); bf16_t* ACT = WSB(WS_ACT);
            for (int item = gw; item < (MH / 64) * 2 * 11; item += NGW) {
                const int st = item % 11, re = item / 11, blk = re >> 1, last = re & 1;
                const int lrow = blk * 64 + (last ? 63 : 0), grow = hf * MH + lrow;
                const int t = grow < NPR ? (grow & 255) : ((grow - NPR) & 2047); const int Ls = grow < NPR ? 256 : 2048;
                const int c = (st * 64 + lane) * 4;
                const bool hp = last || t > 0, hn = !last || t < Ls - 1;
                const bf16_t* ecur = EB + (ptrdiff_t)((blk * 4 + (last ? 3 : 0)) * 2) * DFF + c;
                const bf16_t* eprev = EB + (ptrdiff_t)((last ? blk * 4 + 2 : (blk - 1) * 4 + 3) * 2) * DFF + c;
                const bf16_t* enext = EB + (ptrdiff_t)((last ? (blk + 1) * 4 : blk * 4 + 1) * 2) * DFF + c;
                u32x2 pa = {0u, 0u}, pb2 = {0u, 0u}, na = {0u, 0u}, nb = {0u, 0u};
                const u32x2 ca = *(const u32x2*)ecur, cb2 = *(const u32x2*)(ecur + DFF);
                if (hp) { pa = *(const u32x2*)eprev; pb2 = *(const u32x2*)(eprev + DFF); }
                if (hn) { na = *(const u32x2*)enext; nb = *(const u32x2*)(enext + DFF); }
                const pg8::f32x4 wa0 = *(const pg8::f32x4*)(cw + c), wa1 = *(const pg8::f32x4*)(cw + UPW + c), wa2 = *(const pg8::f32x4*)(cw + 2 * UPW + c), ba = *(const pg8::f32x4*)(cb + c);
                const pg8::f32x4 wb0 = *(const pg8::f32x4*)(cw + DFF + c), wb1 = *(const pg8::f32x4*)(cw + UPW + DFF + c), wb2 = *(const pg8::f32x4*)(cw + 2 * UPW + DFF + c), bb = *(const pg8::f32x4*)(cb + DFF + c);
                pg8::f32x4 a, b;
                a[0] = wa0[0] * bflo(pa.x) + wa1[0] * bflo(ca.x) + wa2[0] * bflo(na.x) + ba[0]; a[1] = wa0[1] * bfhi(pa.x) + wa1[1] * bfhi(ca.x) + wa2[1] * bfhi(na.x) + ba[1];
                a[2] = wa0[2] * bflo(pa.y) + wa1[2] * bflo(ca.y) + wa2[2] * bflo(na.y) + ba[2]; a[3] = wa0[3] * bfhi(pa.y) + wa1[3] * bfhi(ca.y) + wa2[3] * bfhi(na.y) + ba[3];
                b[0] = wb0[0] * bflo(pb2.x) + wb1[0] * bflo(cb2.x) + wb2[0] * bflo(nb.x) + bb[0]; b[1] = wb0[1] * bfhi(pb2.x) + wb1[1] * bfhi(cb2.x) + wb2[1] * bfhi(nb.x) + bb[1];
                b[2] = wb0[2] * bflo(pb2.y) + wb1[2] * bflo(cb2.y) + wb2[2] * bflo(nb.y) + bb[2]; b[3] = wb0[3] * bfhi(pb2.y) + wb1[3] * bfhi(cb2.y) + wb2[3] * bfhi(nb.y) + bb[3];
                u32x2 wv; wv.x = pk2(fsilu(a[0]) * b[0], fsilu(a[1]) * b[1]); wv.y = pk2(fsilu(a[2]) * b[2], fsilu(a[3]) * b[3]);
                *(u32x2*)(ACT + (size_t)lrow * DFF + c) = wv;
            }
            SEAM(9);
    }
    if (IN(10)) { PH_IDS(); const int hf = 0; (void)hf;
            const int nun = (MH / 256) * (DM / 256); const int first = nun < G ? nun : 0;
            if (first == 0 || bx < first) {

            pg8::Gemm g{WSB(WS_ACT), WSB(WS_WDN), MH, DM, DFF}; pg8::StaticOrder S; S.init(MH, DM, G, bx);
            pg8::EpiResid E{dout, dout + (size_t)NPR * DM, dout, WSF(WS_MODB), 5120, hf};
            pg8::gemm_phase<pg8::EpiResid, pg8::StaticOrder, true, true>(lds, g, S, E);
            }
            if (bx >= first) {
            { pg8::Gemm g{WSB(WS_H), WSB(WS_WO), MH, DM, DM}; pg8::StaticOrder S; S.init(MH, DM, G - first, bx - first);
              pg8::EpiResidW E{AIN(0), AIN(1), dout, WSF(WS_MODB), WSF(WS_GAM), WSB(WS_H2), WSF(WS_ROWSS), 2048, 1};
              pg8::gemm_phase<pg8::EpiResidW, pg8::StaticOrder, true, true>(lds, g, S, E); }
            }
            SEAM(10);
    }
    if (IN(11)) { PH_IDS(); const int hf = 1; const int rep_ = 0; (void)hf; (void)rep_;

            pg8::Gemm g{WSB(WS_H2), WSB(WS_WUP), MH, UPW, DM}; pg8::StaticOrder S; S.init(MH, UPW, G, bx);
            pg8::EpiUpAct E{WSB(WS_ACT), WSB(WS_U), WSF(WS_ROWSS), WSF(WS_SHW), AIN(18), AIN(19), hf};
            pg8::gemm_phase<pg8::EpiUpAct, pg8::StaticOrder, true, true>(lds, g, S, E);
            { const int rem = ((MH / 256) * (UPW / 256)) % G; if (bx >= rem) do_final(ap, 0, (bx - rem) * NWAVES + wave, (G - rem) * NWAVES, lane); }
            SEAM(11);
    }
    if (IN(12)) { PH_IDS(); const int hf = 1; const int rep_ = 0; (void)hf; (void)rep_;

            const float* cw = AIN(18); const float* cb = AIN(19); const bf16_t* EB = WSB(WS_U); bf16_t* ACT = WSB(WS_ACT);
            for (int item = gw; item < (MH / 64) * 2 * 11; item += NGW) {
                const int st = item % 11, re = item / 11, blk = re >> 1, last = re & 1;
                const int lrow = blk * 64 + (last ? 63 : 0), grow = hf * MH + lrow;
                const int t = grow < NPR ? (grow & 255) : ((grow - NPR) & 2047); const int Ls = grow < NPR ? 256 : 2048;
                const int c = (st * 64 + lane) * 4;
                const bool hp = last || t > 0, hn = !last || t < Ls - 1;
                const bf16_t* ecur = EB + (ptrdiff_t)((blk * 4 + (last ? 3 : 0)) * 2) * DFF + c;
                const bf16_t* eprev = EB + (ptrdiff_t)((last ? blk * 4 + 2 : (blk - 1) * 4 + 3) * 2) * DFF + c;
                const bf16_t* enext = EB + (ptrdiff_t)((last ? (blk + 1) * 4 : blk * 4 + 1) * 2) * DFF + c;
                u32x2 pa = {0u, 0u}, pb2 = {0u, 0u}, na = {0u, 0u}, nb = {0u, 0u};
                const u32x2 ca = *(const u32x2*)ecur, cb2 = *(const u32x2*)(ecur + DFF);
                if (hp) { pa = *(const u32x2*)eprev; pb2 = *(const u32x2*)(eprev + DFF); }
                if (hn) { na = *(const u32x2*)enext; nb = *(const u32x2*)(enext + DFF); }
                const pg8::f32x4 wa0 = *(const pg8::f32x4*)(cw + c), wa1 = *(const pg8::f32x4*)(cw + UPW + c), wa2 = *(const pg8::f32x4*)(cw + 2 * UPW + c), ba = *(const pg8::f32x4*)(cb + c);
                const pg8::f32x4 wb0 = *(const pg8::f32x4*)(cw + DFF + c), wb1 = *(const pg8::f32x4*)(cw + UPW + DFF + c), wb2 = *(const pg8::f32x4*)(cw + 2 * UPW + DFF + c), bb = *(const pg8::f32x4*)(cb + DFF + c);
                pg8::f32x4 a, b;
                a[0] = wa0[0] * bflo(pa.x) + wa1[0] * bflo(ca.x) + wa2[0] * bflo(na.x) + ba[0]; a[1] = wa0[1] * bfhi(pa.x) + wa1[1] * bfhi(ca.x) + wa2[1] * bfhi(na.x) + ba[1];
                a[2] = wa0[2] * bflo(pa.y) + wa1[2] * bflo(ca.y) + wa2[2] * bflo(na.y) + ba[2]; a[3] = wa0[3] * bfhi(pa.y) + wa1[3] * bfhi(ca.y) + wa2[3] * bfhi(na.y) + ba[3];
                b[0] = wb0[0] * bflo(pb2.x) + wb1[0] * bflo(cb2.x) + wb2[0] * bflo(nb.x) + bb[0]; b[1] = wb0[1] * bfhi(pb2.x) + wb1[1] * bfhi(cb2.x) + wb2[1] * bfhi(nb.x) + bb[1];
                b[2] = wb0[2] * bflo(pb2.y) + wb1[2] * bflo(cb2.y) + wb2[2] * bflo(nb.y) + bb[2]; b[3] = wb0[3] * bfhi(pb2.y) + wb1[3] * bfhi(cb2.y) + wb2[3] * bfhi(nb.y) + bb[3];
                u32x2 wv; wv.x = pk2(fsilu(a[0]) * b[0], fsilu(a[1]) * b[1]); wv.y = pk2(fsilu(a[2]) * b[2], fsilu(a[3]) * b[3]);
                *(u32x2*)(ACT + (size_t)lrow * DFF + c) = wv;
            }
            SEAM(12);
    }
    if (IN(13)) { PH_IDS(); const int hf = 1; const int rep_ = 0; (void)hf; (void)rep_;

            pg8::Gemm g{WSB(WS_ACT), WSB(WS_WDN), MH, DM, DFF}; pg8::StaticOrder S; S.init(MH, DM, G, bx);
            pg8::EpiResid E{dout, dout + (size_t)NPR * DM, dout, WSF(WS_MODB), 5120, hf};
            pg8::gemm_phase<pg8::EpiResid, pg8::StaticOrder, true, true>(lds, g, S, E);
            SEAM(13);
    }
    if (IN(14)) { PH_IDS(); do_final(ap, 1, gw, NGW, lane); }
#undef IN
#undef SEAM
}

extern "C" void kernel_launch(void* const* d_in, const int* in_sizes, int n_in, void* d_out, int out_size, void* d_ws, size_t ws_size, hipStream_t stream) {
    static int grid = 0;
    if (grid == 0) {
        if (n_in != 22 || ws_size < WS_END) { fprintf(stderr, "kernel_launch: unexpected n_in %d / ws_size %zu\n", n_in, ws_size); grid = -1; return; }
        int dev = 0, cus = 0, per_cu = 0;
        hipGetDevice(&dev); hipDeviceGetAttribute(&cus, hipDeviceAttributeMultiprocessorCount, dev);
        if (hipFuncSetAttribute((const void*)fwd_mega, hipFuncAttributeMaxDynamicSharedMemorySize, LDS_BYTES) != hipSuccess) { fprintf(stderr, "kernel_launch: hipFuncSetAttribute failed\n"); grid = -1; return; }
        if (hipOccupancyMaxActiveBlocksPerMultiprocessor(&per_cu, (const void*)fwd_mega, NTHR, LDS_BYTES) != hipSuccess || per_cu < 1) { fprintf(stderr, "kernel_launch: occupancy query says %d\n", per_cu); per_cu = 1; }
        (void)hipGetLastError();
        grid = cus;
    }
    if (grid < 0) return;
    hipMemsetAsync((char*)d_ws + WS_CTL, 0, CTL_ZERO_BYTES, stream);
    Args a{};
    for (int i = 0; i < 22; ++i) a.in[i] = (const float*)d_in[i];
    a.out = (float*)d_out; a.ws = (unsigned char*)d_ws;
#if MK_SINGLE
    a.ph_lo = 0; a.ph_hi = N_PHASES;
    void* kargs[] = {&a};
    hipError_t e = hipLaunchCooperativeKernel((const void*)fwd_mega, dim3(grid), dim3(NTHR), kargs, LDS_BYTES, stream);
    if (e != hipSuccess) fprintf(stderr, "kernel_launch: cooperative launch failed: %s (grid %d)\n", hipGetErrorString(e), grid);
#else
    for (int p = 0; p < N_PHASES; ++p) { a.ph_lo = p; a.ph_hi = p + 1; hipLaunchKernelGGL(fwd_mega, dim3(grid), dim3(NTHR), LDS_BYTES, stream, a); }
#endif
}
```

```cpp
#include <hip/hip_runtime.h>
#include <hip/hip_cooperative_groups.h>
#include <hip/hip_bf16.h>
#include <cstdio>
#include <cstdint>
#include <cmath>
namespace cg = cooperative_groups;

constexpr int DM = 1024, NPR = 4096  , MTOT = 20480, MH = 10240  ;
constexpr int INW = 8704, DFF = 2816, UPW = 5632;
constexpr int KVP = 256;
constexpr float EPS = 1e-6f;
constexpr float QSCALE = 0.125f * 1.4426950408889634f;

#define GAS __attribute__((address_space(1)))
#define LAS __attribute__((address_space(3)))
typedef unsigned short bf16_t;
typedef float f32x2 __attribute__((ext_vector_type(2)));
typedef unsigned u32x2 __attribute__((ext_vector_type(2)));
typedef float f32x16 __attribute__((ext_vector_type(16)));

__device__ __forceinline__ float bf2f(unsigned short h) { return __uint_as_float(((unsigned)h) << 16); }
__device__ __forceinline__ float bflo(unsigned w) { return __uint_as_float(w << 16); }
__device__ __forceinline__ float bfhi(unsigned w) { return __uint_as_float(w & 0xffff0000u); }
__device__ __forceinline__ float fsigmoid(float x) { return __builtin_amdgcn_rcpf(1.0f + __expf(-x)); }
__device__ __forceinline__ float fsilu(float x) { return x * fsigmoid(x); }
__device__ __forceinline__ unsigned pkh2(float a, float b) { _Float16 ha = (_Float16)a, hb = (_Float16)b; return (unsigned)__builtin_bit_cast(unsigned short, ha) | ((unsigned)__builtin_bit_cast(unsigned short, hb) << 16); }
__device__ __forceinline__ float h2f(unsigned short h) { return (float)__builtin_bit_cast(_Float16, h); }
__device__ __forceinline__ float wave_sum(float v) {
#pragma unroll
    for (int o = 1; o < 64; o <<= 1) v += __shfl_xor(v, o);
    return v;
}
__device__ __forceinline__ int mod_of_row(int grow) { return grow < NPR ? 0 : 1 + ((grow - NPR) >> 11); }
__device__ __forceinline__ int kv_row(int grow, int hf) {
    if (grow < NPR) return grow;
    const int s = grow - NPR, b = s >> 11, t = s & 2047;
    return (hf ? (b - 3) * 2560 : NPR + b * 2560) + t;
}

namespace pg8 {
#define PG8_LAS __attribute__((address_space(3)))
typedef unsigned short bf16_t;
typedef short bf16x8 __attribute__((ext_vector_type(8)));
typedef float f32x4 __attribute__((ext_vector_type(4)));
typedef unsigned u32x4 __attribute__((ext_vector_type(4)));
constexpr int BM = 256, BK = 64, HALF = 128, HTB = HALF * BK * 2  , STAGE_BYTES = 8 * HTB, NXCD = 8, WGM = 8;

__host__ __device__ __forceinline__ int lds_byte(int r, int c) { const int st = (r >> 4) * 2 + (c >> 5), rr = r & 15, cc = c & 31, ob = rr * 64 + cc * 2; return st * 1024 + (ob ^ (((ob >> 9) & 1) << 5)); }
__host__ __device__ __forceinline__ void stage_rc(int b, int& R, int& C) { const int st = b / 1024, sb = b % 1024, swz = sb ^ (((sb >> 9) & 1) << 5); R = (st >> 1) * 16 + swz / 64; C = (st & 1) * 32 + (swz % 64) / 2; }
__host__ __device__ __forceinline__ int perm32(int rho) { const int n = rho >> 4, i = rho & 15; return 8 * (i >> 2) + 4 * n + (i & 3); }

struct Unit { int pm, pn; };
struct Gemm { const bf16_t* A; const bf16_t* Bt; int M, N, K; };

struct StaticOrder {
    int nM, nN, nwg, G, c;
    __host__ __device__ __forceinline__ void init(int M, int N, int G_, int c_) { nM = M / BM; nN = N / BM; nwg = nM * nN; G = G_; c = c_; }
    __host__ __device__ __forceinline__ bool next(int i, Unit& u) const {
        const long L = (long)i * G + c; if (L >= nwg) return false;
        int wgid = (int)L; { const int q = nwg / NXCD, r = nwg % NXCD, xcd = wgid % NXCD, off = wgid / NXCD; wgid = (xcd < r ? xcd * (q + 1) : r * (q + 1) + (xcd - r) * q) + off; }
        const int nig = WGM * nN, gid = wgid / nig, fm = gid * WGM, gsz = (nM - fm) < WGM ? (nM - fm) : WGM;
        u.pm = fm + ((wgid % nig) % gsz); u.pn = (wgid % nig) / gsz; return true;
    }
    __device__ __forceinline__ void a_ready(const Unit&) const {}
    __device__ __forceinline__ void done(const Unit&) const {}
};

__device__ __forceinline__ unsigned cvt_pk_bf16(float lo, float hi) { unsigned r; asm volatile("v_cvt_pk_bf16_f32 %0, %1, %2" : "=v"(r) : "v"(lo), "v"(hi)); return r; }
__device__ __forceinline__ u32x2 pk4(f32x4 v) { u32x2 w; w.x = cvt_pk_bf16(v[0], v[1]); w.y = cvt_pk_bf16(v[2], v[3]); return w; }

#define EPI_FENCE() asm volatile("" ::: "memory")
struct EpiInProj {
    static constexpr bool PERM = false, AFTER_DRAIN = false;
    bf16_t *Q, *Kb, *Vb, *RQ, *GF, *GB, *RI, *ZA, *PP; float *nck, *ncv; const float *qg, *kg, *lbt; const float* rope; int hf;
    __device__ __forceinline__ void operator()(const f32x4 (&acc)[2][2][4][2], const Unit& u, int wr, int wc, int fr, int fq) const {
        const int T = u.pn;
        const int lrow0 = u.pm * BM + wr * 64 + fr;
        if (T <= 4) {
            const bool isq = T < 4; const float* gain = (isq ? qg : kg) + 4 * fq;
#pragma unroll
            for (int ai = 0; ai < 2; ++ai)
#pragma unroll
                for (int m = 0; m < 4; ++m) {
                    const int lrow = lrow0 + ai * HALF + m * 16, grow = hf * MH + lrow;
                    float ss = 0.f;
#pragma unroll
                    for (int bj = 0; bj < 2; ++bj)
#pragma unroll
                        for (int n = 0; n < 2; ++n) { const f32x4 v = acc[ai][bj][m][n]; ss += (v[0] * v[0] + v[1] * v[1]) + (v[2] * v[2] + v[3] * v[3]); }
                    ss += __shfl_xor(ss, 16); ss += __shfl_xor(ss, 32);
                    const float rs = __builtin_amdgcn_rsqf(ss * (1.0f / 64.0f) + EPS);
                    const bool latent = grow >= NPR;
                    const int t = (grow - NPR) & 2047;
#pragma unroll
                    for (int bj = 0; bj < 2; ++bj) {
                        f32x4 x1 = acc[ai][bj][m][0] * rs * *(const f32x4*)(gain + 32 * bj), x2 = acc[ai][bj][m][1] * rs * *(const f32x4*)(gain + 32 * bj + 16);
                        if (latent) {
                            const int pos = bj ? (t & 63) : (t >> 6);
                            const f32x4 cs0 = *(const f32x4*)(rope + (pos * 16 + 4 * fq) * 2), cs1 = *(const f32x4*)(rope + (pos * 16 + 4 * fq) * 2 + 4);
                            const f32x4 c = {cs0[0], cs0[2], cs1[0], cs1[2]}, s = {cs0[1], cs0[3], cs1[1], cs1[3]};
                            const f32x4 y1 = x1 * c - x2 * s, y2 = x1 * s + x2 * c; x1 = y1; x2 = y2;
                        }
                        if (isq) {
                            bf16_t* qp = Q + (unsigned)(lrow * DM + (4 * T + wc) * 64 + 4 * fq + 32 * bj);
                            *(u32x2*)(qp) = pk4(x1 * QSCALE); *(u32x2*)(qp + 16) = pk4(x2 * QSCALE);
                        } else {
                            bf16_t* kp = Kb + (unsigned)(kv_row(grow, hf) * KVP + wc * 64 + 4 * fq + 32 * bj);
                            *(u32x2*)(kp) = pk4(x1); *(u32x2*)(kp + 16) = pk4(x2);
                            if (!latent) { float* op = nck + (unsigned)(grow * KVP + wc * 64 + 4 * fq + 32 * bj); *(f32x4*)(op) = x1; *(f32x4*)(op + 16) = x2; }
                        }
                    }
                    EPI_FENCE();
                }
        } else if (T == 5) {
#pragma unroll
            for (int ai = 0; ai < 2; ++ai)
#pragma unroll
                for (int m = 0; m < 4; ++m) {
                    const int lrow = lrow0 + ai * HALF + m * 16, grow = hf * MH + lrow;
                    bf16_t* vp = Vb + (unsigned)(kv_row(grow, hf) * KVP + wc * 64 + 4 * fq);
#pragma unroll
                    for (int bj = 0; bj < 2; ++bj)
#pragma unroll
                        for (int n = 0; n < 2; ++n) *(u32x2*)(vp + 32 * bj + 16 * n) = pk4(acc[ai][bj][m][n]);
                    if (grow < NPR) { float* op = ncv + (unsigned)(grow * KVP + wc * 64 + 4 * fq);
#pragma unroll
                        for (int bj = 0; bj < 2; ++bj)
#pragma unroll
                            for (int n = 0; n < 2; ++n) *(f32x4*)(op + 32 * bj + 16 * n) = acc[ai][bj][m][n]; }
                    EPI_FENCE();
                }
        } else if (T < 10) {
            bf16_t* base = RQ + (T - 6) * 256 + wc * 64;
#pragma unroll
            for (int ai = 0; ai < 2; ++ai)
#pragma unroll
                for (int m = 0; m < 4; ++m) { bf16_t* rp = base + (unsigned)((lrow0 + ai * HALF + m * 16) * DM + 4 * fq);
#pragma unroll
                    for (int bj = 0; bj < 2; ++bj)
#pragma unroll
                        for (int n = 0; n < 2; ++n) { const f32x4 v = acc[ai][bj][m][n]; f32x4 o;
#pragma unroll
                            for (int j = 0; j < 4; ++j) o[j] = fsilu(v[j]) * 0.08838834764831845f;
                            *(u32x2*)(rp + 32 * bj + 16 * n) = pk4(o); }
                    EPI_FENCE(); }
        } else if (T < 18) {
            const int d = T >= 14; const int colb = ((T - 10) & 3) * 256 + wc * 64;
            bf16_t* base = (d ? GB : GF) + colb; const float* lbp = lbt + d * 1024 + colb + 4 * fq;
#pragma unroll
            for (int ai = 0; ai < 2; ++ai)
#pragma unroll
                for (int m = 0; m < 4; ++m) { bf16_t* rp = base + (unsigned)((lrow0 + ai * HALF + m * 16) * DM + 4 * fq);
#pragma unroll
                    for (int bj = 0; bj < 2; ++bj)
#pragma unroll
                        for (int n = 0; n < 2; ++n) { const f32x4 v = acc[ai][bj][m][n]; const f32x4 lb = *(const f32x4*)(lbp + 32 * bj + 16 * n); float g[4];
#pragma unroll
                            for (int j = 0; j < 4; ++j) { const float l = lb[j]; g[j] = __logf(l + (1.0f - l) * fsigmoid(v[j])); }
                            u32x2 w; w.x = pkh2(g[0], g[1]); w.y = pkh2(g[2], g[3]); *(u32x2*)(rp + 32 * bj + 16 * n) = w; }
                    EPI_FENCE(); }
        } else if (T < 26) {
            const bool sig = T >= 22; bf16_t* base = (sig ? ZA : RI) + ((T - 18) & 3) * 256 + wc * 64;
#pragma unroll
            for (int ai = 0; ai < 2; ++ai)
#pragma unroll
                for (int m = 0; m < 4; ++m) { bf16_t* rp = base + (unsigned)((lrow0 + ai * HALF + m * 16) * DM + 4 * fq);
#pragma unroll
                    for (int bj = 0; bj < 2; ++bj)
#pragma unroll
                        for (int n = 0; n < 2; ++n) { f32x4 v = acc[ai][bj][m][n];
                            if (sig) {
#pragma unroll
                                for (int j = 0; j < 4; ++j) v[j] = fsigmoid(v[j]); }
                            *(u32x2*)(rp + 32 * bj + 16 * n) = pk4(v); }
                    EPI_FENCE(); }
        } else {
            bf16_t* base = PP + (T - 26) * 128 + wc * 32;
#pragma unroll
            for (int ai = 0; ai < 2; ++ai)
#pragma unroll
                for (int m = 0; m < 4; ++m) { bf16_t* rp = base + (unsigned)((lrow0 + ai * HALF + m * 16) * DM + 4 * fq);
#pragma unroll
                    for (int n = 0; n < 2; ++n) { const f32x4 a = acc[ai][0][m][n], b = acc[ai][1][m][n]; f32x4 o;
#pragma unroll
                        for (int j = 0; j < 4; ++j) o[j] = fsilu(a[j]) * fsigmoid(b[j]);
                        *(u32x2*)(rp + 16 * n) = pk4(o); }
                    EPI_FENCE(); }
        }
    }
};

struct EpiResid {
    static constexpr bool PERM = false, AFTER_DRAIN = false;
    const float* basep; const float* bases; float* out; const float* modb; int goff; int hf;
    __device__ __forceinline__ void operator()(const f32x4 (&acc)[2][2][4][2], const Unit& u, int wr, int wc, int fr, int fq) const {
        const int grow0 = hf * MH + u.pm * BM; const int mi = mod_of_row(grow0);
        const int col0 = u.pn * BM + wc * 64 + 4 * fq;
        const float* base = grow0 < NPR ? basep + (size_t)grow0 * DM : bases + (size_t)(grow0 - NPR) * DM;
        float* ob = out + (size_t)grow0 * DM;
        const float* gp = modb + mi * 6144 + goff + col0;
#pragma unroll
        for (int ai = 0; ai < 2; ++ai)
#pragma unroll
            for (int m = 0; m < 4; ++m) { const unsigned off = (unsigned)((ai * HALF + wr * 64 + m * 16 + fr) * DM + col0);
#pragma unroll
                for (int bj = 0; bj < 2; ++bj)
#pragma unroll
                    for (int n = 0; n < 2; ++n) { const f32x4 b = *(const f32x4*)(base + off + 32 * bj + 16 * n); const f32x4 gt = *(const f32x4*)(gp + 32 * bj + 16 * n);
                        *(f32x4*)(ob + off + 32 * bj + 16 * n) = b + gt * acc[ai][bj][m][n]; }
                EPI_FENCE(); }
    }
};

struct EpiResidW {
    static constexpr bool PERM = false, AFTER_DRAIN = false;
    const float* basep; const float* bases; float* out; const float* modb; const float* gam; bf16_t* Hn; float* rowss; int goff; int hf;
    __device__ __forceinline__ void operator()(const f32x4 (&acc)[2][2][4][2], const Unit& u, int wr, int wc, int fr, int fq) const {
        const int grow0 = hf * MH + u.pm * BM; const int mi = mod_of_row(grow0);
        const int col0 = u.pn * BM + wc * 64 + 4 * fq;
        const float* base = grow0 < NPR ? basep + (size_t)grow0 * DM : bases + (size_t)(grow0 - NPR) * DM;
        float* ob = out + (size_t)grow0 * DM; bf16_t* hb = Hn + (size_t)(u.pm * BM) * DM; float* rs = rowss + grow0;
        const float* gp = modb + mi * 6144 + goff + col0; const float* gm = gam + mi * 1024 + col0;
#pragma unroll
        for (int ai = 0; ai < 2; ++ai)
#pragma unroll
            for (int m = 0; m < 4; ++m) { const int r = ai * HALF + wr * 64 + m * 16 + fr; const unsigned off = (unsigned)(r * DM + col0); float ss = 0.f;
#pragma unroll
                for (int bj = 0; bj < 2; ++bj)
#pragma unroll
                    for (int n = 0; n < 2; ++n) { const f32x4 b = *(const f32x4*)(base + off + 32 * bj + 16 * n); const f32x4 gt = *(const f32x4*)(gp + 32 * bj + 16 * n); const f32x4 gg = *(const f32x4*)(gm + 32 * bj + 16 * n);
                        const f32x4 x1 = b + gt * acc[ai][bj][m][n];
                        *(f32x4*)(ob + off + 32 * bj + 16 * n) = x1; *(u32x2*)(hb + off + 32 * bj + 16 * n) = pk4(x1 * gg);
                        ss += (x1[0] * x1[0] + x1[1] * x1[1]) + (x1[2] * x1[2] + x1[3] * x1[3]); }
                ss += __shfl_xor(ss, 16); ss += __shfl_xor(ss, 32);
                if (fq == 0) atomicAdd(rs + r, ss);
                EPI_FENCE(); }
    }
};

struct EpiUp {
    static constexpr bool PERM = false, AFTER_DRAIN = false;
    bf16_t* O; int ldc; const float* rowss; const float* shw; int hf;
    __device__ __forceinline__ void operator()(const f32x4 (&acc)[2][2][4][2], const Unit& u, int wr, int wc, int fr, int fq) const {
        const int grow0 = hf * MH + u.pm * BM; const int mi = mod_of_row(grow0);
        bf16_t* base = O + (size_t)(u.pm * BM) * ldc + u.pn * BM + wc * 64; const float* sp = shw + mi * UPW + u.pn * BM + wc * 64 + 4 * fq; const float* rs = rowss + grow0;
#pragma unroll
        for (int ai = 0; ai < 2; ++ai)
#pragma unroll
            for (int m = 0; m < 4; ++m) { const int r = ai * HALF + wr * 64 + m * 16 + fr; bf16_t* rp = base + (unsigned)(r * ldc + 4 * fq);
                const float rstd = __builtin_amdgcn_rsqf(rs[r] * (1.0f / 1024.0f) + EPS);
#pragma unroll
                for (int bj = 0; bj < 2; ++bj)
#pragma unroll
                    for (int n = 0; n < 2; ++n) *(u32x2*)(rp + 32 * bj + 16 * n) = pk4(acc[ai][bj][m][n] * rstd + *(const f32x4*)(sp + 32 * bj + 16 * n));
                EPI_FENCE(); }
    }
};

__device__ __forceinline__ float dpp_prev(float cur, float prevblk) {
    const int x = __builtin_amdgcn_update_dpp(0, __float_as_int(prevblk), 0x121, 0xf, 0xf, true);
    return __int_as_float(__builtin_amdgcn_update_dpp(x, __float_as_int(cur), 0x111, 0xf, 0xf, false)); }
__device__ __forceinline__ float dpp_next(float cur, float nextblk) {
    const int x = __builtin_amdgcn_update_dpp(0, __float_as_int(nextblk), 0x12F, 0xf, 0xf, true);
    return __int_as_float(__builtin_amdgcn_update_dpp(x, __float_as_int(cur), 0x101, 0xf, 0xf, false)); }
struct EpiUpAct {
    static constexpr bool PERM = false, AFTER_DRAIN = false;
    bf16_t* ACT; bf16_t* EB; const float* rowss; const float* shw; const float* cw; const float* cb; int hf;
    __device__ __forceinline__ void operator()(f32x4 (&acc)[2][2][4][2], const Unit& u, int wr, int wc, int fr, int fq) const {
        const int grow0 = hf * MH + u.pm * BM; const int mi = mod_of_row(grow0); const int T = u.pn;
        const float* sp = shw + mi * UPW + T * 256 + wc * 32 + 4 * fq; const float* rs = rowss + grow0;
#pragma unroll
        for (int ai = 0; ai < 2; ++ai)
#pragma unroll
            for (int m = 0; m < 4; ++m) { const float rstd = __builtin_amdgcn_rsqf(rs[ai * HALF + wr * 64 + m * 16 + fr] * (1.0f / 1024.0f) + EPS);
#pragma unroll
                for (int bj = 0; bj < 2; ++bj)
#pragma unroll
                    for (int n = 0; n < 2; ++n) acc[ai][bj][m][n] = acc[ai][bj][m][n] * rstd + *(const f32x4*)(sp + 128 * bj + 16 * n); }
        EPI_FENCE();
#pragma unroll
        for (int n = 0; n < 2; ++n) {
            const int ch = T * 128 + wc * 32 + 16 * n + 4 * fq;
            const f32x4 wa0 = *(const f32x4*)(cw + ch), wa1 = *(const f32x4*)(cw + UPW + ch), wa2 = *(const f32x4*)(cw + 2 * UPW + ch), ba = *(const f32x4*)(cb + ch);
            const f32x4 wb0 = *(const f32x4*)(cw + DFF + ch), wb1 = *(const f32x4*)(cw + UPW + DFF + ch), wb2 = *(const f32x4*)(cw + 2 * UPW + DFF + ch), bb = *(const f32x4*)(cb + DFF + ch);
#pragma unroll
            for (int ai = 0; ai < 2; ++ai)
#pragma unroll
                for (int m = 0; m < 4; ++m) {
                    const int mp = m > 0 ? m - 1 : m, mn = m < 3 ? m + 1 : m;
                    const f32x4 ua = acc[ai][0][m][n], ub = acc[ai][1][m][n];
                    f32x4 o;
#pragma unroll
                    for (int j = 0; j < 4; ++j) {
                        const float pa = dpp_prev(ua[j], acc[ai][0][mp][n][j]), na = dpp_next(ua[j], acc[ai][0][mn][n][j]);
                        const float pb = dpp_prev(ub[j], acc[ai][1][mp][n][j]), nb = dpp_next(ub[j], acc[ai][1][mn][n][j]);
                        const float ca = wa0[j] * pa + wa1[j] * ua[j] + wa2[j] * na + ba[j];
                        const float cbv = wb0[j] * pb + wb1[j] * ub[j] + wb2[j] * nb + bb[j];
                        o[j] = fsilu(ca) * cbv;
                    }
                    const int r64 = m * 16 + fr; const int lrow = u.pm * BM + ai * HALF + wr * 64 + r64;
                    if (r64 != 0 && r64 != 63) *(u32x2*)(ACT + (unsigned)(lrow * DFF + ch)) = pk4(o);
                    if (r64 < 2 || r64 > 61) { const int e = r64 < 2 ? r64 : r64 - 60; const unsigned eo = (unsigned)((((lrow >> 6) * 4 + e) * 2) * DFF + ch);
                        *(u32x2*)(EB + eo) = pk4(ua); *(u32x2*)(EB + eo + DFF) = pk4(ub); }
                    EPI_FENCE();
                }
        }
    }
};

struct EpiPlain {
    static constexpr bool PERM = false, AFTER_DRAIN = false;
    bf16_t* O; int ldc;
    __device__ __forceinline__ void operator()(const f32x4 (&acc)[2][2][4][2], const Unit& u, int wr, int wc, int fr, int fq) const {
        bf16_t* base = O + u.pn * BM + wc * 64 + 4 * fq;
#pragma unroll
        for (int ai = 0; ai < 2; ++ai)
#pragma unroll
            for (int m = 0; m < 4; ++m) { bf16_t* rp = base + (size_t)(u.pm * BM + ai * HALF + wr * 64 + m * 16 + fr) * ldc;
#pragma unroll
                for (int bj = 0; bj < 2; ++bj)
#pragma unroll
                    for (int n = 0; n < 2; ++n) *(u32x2*)(rp + 32 * bj + 16 * n) = pk4(acc[ai][bj][m][n]); }
    }
};

template <class Epi, class Sched, bool ALIGN_EPI = false, bool SP2 = false>
__device__ __forceinline__ void gemm_phase(PG8_LAS unsigned char* lds, const Gemm g, const Sched& S, const Epi& E) {
    int tid_o = threadIdx.x; asm volatile("" : "+v"(tid_o));
    const int tid = tid_o, wid = __builtin_amdgcn_readfirstlane(tid >> 6), lane = tid & 63, wr = wid >> 2, wc = wid & 3, fr = lane & 15, fq = lane >> 4;
    const int K = g.K, nt = K / BK;
    unsigned voffA[2], voffB[2];
#pragma unroll
    for (int i = 0; i < 2; ++i) { int R, C; stage_rc(tid * 16 + i * 8192, R, C); const int Rb = Epi::PERM ? ((R & ~31) + perm32(R & 31)) : R;
        voffA[i] = (unsigned)(R * K + C) * 2u; voffB[i] = (unsigned)(Rb * K + C) * 2u; }
    const size_t kstep = (size_t)(BK * 2);
    const size_t hstep = (size_t)HALF * K * 2;
    const size_t tstep = 2 * hstep;
    const unsigned ldsw = (unsigned)wid * 1024u;
    const int aoff = lds_byte(wr * 64 + fr, fq * 8), boff = lds_byte(wc * 32 + fr, fq * 8);
#define PG8_SA(b, h) (((b) * 2 + (h)) * HTB)
#define PG8_SB(b, h) ((4 + (b) * 2 + (h)) * HTB)
#define PG8_STAGE(bufoff, gbase, voff) do { _Pragma("unroll") for (int _i = 0; _i < 2; ++_i) \
        __builtin_amdgcn_global_load_lds((const unsigned*)((const char*)(gbase) + (voff)[_i]), (PG8_LAS unsigned*)(lds + (bufoff) + ldsw + _i * 8192), 16, 0, 0); } while (0)
#define PG8_LDA(dst, b, h) do { _Pragma("unroll") for (int m = 0; m < 4; ++m) _Pragma("unroll") for (int k = 0; k < 2; ++k) dst[m][k] = *(const PG8_LAS bf16x8*)(lds + PG8_SA(b, h) + aoff + m * 2048 + k * 1024); } while (0)
#define PG8_LDB(dst, b, h) do { _Pragma("unroll") for (int n = 0; n < 2; ++n) _Pragma("unroll") for (int k = 0; k < 2; ++k) dst[n][k] = *(const PG8_LAS bf16x8*)(lds + PG8_SB(b, h) + boff + n * 2048 + k * 1024); } while (0)
#define PG8_MMA(ai, bj, At, Bt) do { __builtin_amdgcn_s_setprio(1); _Pragma("unroll") for (int m = 0; m < 4; ++m) _Pragma("unroll") for (int n = 0; n < 2; ++n) _Pragma("unroll") for (int k = 0; k < 2; ++k) \
        acc[ai][bj][m][n] = __builtin_amdgcn_mfma_f32_16x16x32_bf16(Bt[n][k], At[m][k], acc[ai][bj][m][n], 0, 0, 0); __builtin_amdgcn_s_setprio(0); } while (0)
#define PG8_WAIT_V(n) asm volatile("s_waitcnt vmcnt(" #n ")" ::: "memory")
#define PG8_WAIT_L(n) asm volatile("s_waitcnt lgkmcnt(" #n ")" ::: "memory")
#define PG8_BAR __builtin_amdgcn_s_barrier()
#define PG8_SCHED __builtin_amdgcn_sched_barrier(0)
    Unit cur, nxt; int ui = 0;
    if (!S.next(0, cur)) return;
    f32x4 acc[2][2][4][2];
#pragma unroll
    for (int a = 0; a < 2; ++a)
#pragma unroll
        for (int b = 0; b < 2; ++b)
#pragma unroll
            for (int m = 0; m < 4; ++m)
#pragma unroll
                for (int n = 0; n < 2; ++n) acc[a][b][m][n] = (f32x4){0.f, 0.f, 0.f, 0.f};
    bf16x8 At[4][2], B0[2][2], B1[2][2];
    const char* cA = (const char*)g.A + (size_t)cur.pm * tstep; const char* cB = (const char*)g.Bt + (size_t)cur.pn * tstep;
    S.a_ready(cur);
    if constexpr (SP2) {
        PG8_STAGE(PG8_SB(0, 0), cB, voffB); PG8_STAGE(PG8_SB(0, 1), cB + hstep, voffB); PG8_STAGE(PG8_SA(0, 0), cA, voffA); PG8_STAGE(PG8_SA(0, 1), cA + hstep, voffA);
        if (wr == 1) PG8_BAR;
        PG8_WAIT_V(2); PG8_BAR;
        PG8_STAGE(PG8_SB(1, 0), cB + kstep, voffB); PG8_STAGE(PG8_SA(1, 0), cA + kstep, voffA); PG8_STAGE(PG8_SB(1, 1), cB + hstep + kstep, voffB);
        PG8_WAIT_V(6); PG8_BAR;
    } else {
        PG8_STAGE(PG8_SB(0, 0), cB, voffB); PG8_STAGE(PG8_SA(0, 0), cA, voffA); PG8_STAGE(PG8_SB(0, 1), cB + hstep, voffB); PG8_STAGE(PG8_SA(0, 1), cA + hstep, voffA);
        if (wr == 1) PG8_BAR;
        PG8_WAIT_V(4); PG8_BAR;
        PG8_STAGE(PG8_SB(1, 0), cB + kstep, voffB); PG8_STAGE(PG8_SA(1, 0), cA + kstep, voffA); PG8_STAGE(PG8_SB(1, 1), cB + hstep + kstep, voffB);
        PG8_WAIT_V(6); PG8_BAR;
    }
    for (;;) {
        const bool has_next = S.next(ui + 1, nxt);
        const char* nA = has_next ? (const char*)g.A + (size_t)nxt.pm * tstep : cA; const char* nB = has_next ? (const char*)g.Bt + (size_t)nxt.pn * tstep : cB;
        for (int t = 0; t < nt; t += 2) {
            const bool last = (t == nt - 2);
            const char* a1 = cA + (size_t)(t + 1) * kstep;
            const char* a2 = last ? nA : cA + (size_t)(t + 2) * kstep; const char* b2 = last ? nB : cB + (size_t)(t + 2) * kstep;
            const char* a3 = a2 + kstep; const char* b3 = b2 + kstep;
            if (last && has_next) S.a_ready(nxt);
            if constexpr (SP2) {
            PG8_LDB(B0, 0, 0); PG8_LDB(B1, 0, 1); PG8_SCHED; PG8_LDA(At, 0, 0); PG8_STAGE(PG8_SA(1, 1), a1 + hstep, voffA);
            PG8_WAIT_V(8); PG8_WAIT_L(0); PG8_BAR; PG8_MMA(0, 0, At, B0); PG8_MMA(0, 1, At, B1); PG8_BAR; PG8_SCHED;
            PG8_LDA(At, 0, 1); PG8_STAGE(PG8_SB(0, 0), b2, voffB); PG8_STAGE(PG8_SB(0, 1), b2 + hstep, voffB); PG8_STAGE(PG8_SA(0, 0), a2, voffA);
            PG8_WAIT_V(8); PG8_WAIT_L(0); PG8_BAR; PG8_MMA(1, 0, At, B0); PG8_MMA(1, 1, At, B1); PG8_BAR; PG8_SCHED;
            PG8_LDB(B0, 1, 0); PG8_LDB(B1, 1, 1); PG8_SCHED; PG8_LDA(At, 1, 0); PG8_STAGE(PG8_SA(0, 1), a2 + hstep, voffA);
            PG8_WAIT_V(8); PG8_WAIT_L(0); PG8_BAR; PG8_MMA(0, 0, At, B0); PG8_MMA(0, 1, At, B1); PG8_BAR; PG8_SCHED;
            PG8_LDA(At, 1, 1); PG8_STAGE(PG8_SB(1, 0), b3, voffB); PG8_STAGE(PG8_SB(1, 1), b3 + hstep, voffB); PG8_STAGE(PG8_SA(1, 0), a3, voffA);
            PG8_WAIT_V(8); PG8_WAIT_L(0); PG8_BAR; PG8_MMA(1, 0, At, B0); PG8_MMA(1, 1, At, B1); PG8_BAR; PG8_SCHED;
            } else {
            PG8_LDB(B0, 0, 0); PG8_SCHED; PG8_LDA(At, 0, 0); PG8_STAGE(PG8_SA(1, 1), a1 + hstep, voffA);
            PG8_WAIT_L(8); PG8_BAR; PG8_WAIT_L(0); PG8_MMA(0, 0, At, B0); PG8_BAR; PG8_SCHED;
            PG8_LDB(B1, 0, 1); PG8_STAGE(PG8_SB(0, 0), b2, voffB);
            PG8_BAR; PG8_WAIT_L(0); PG8_MMA(0, 1, At, B1); PG8_BAR;
            PG8_LDA(At, 0, 1); PG8_STAGE(PG8_SA(0, 0), a2, voffA);
            PG8_BAR; PG8_WAIT_L(0); PG8_MMA(1, 0, At, B0); PG8_BAR; PG8_SCHED;
            PG8_STAGE(PG8_SB(0, 1), b2 + hstep, voffB);
            PG8_WAIT_V(6); PG8_BAR; PG8_MMA(1, 1, At, B1); PG8_BAR;
            PG8_LDB(B0, 1, 0); PG8_SCHED; PG8_LDA(At, 1, 0); PG8_STAGE(PG8_SA(0, 1), a2 + hstep, voffA);
            PG8_WAIT_L(8); PG8_BAR; PG8_WAIT_L(0); PG8_MMA(0, 0, At, B0); PG8_BAR; PG8_SCHED;
            PG8_LDB(B1, 1, 1); PG8_STAGE(PG8_SB(1, 0), b3, voffB);
            PG8_BAR; PG8_WAIT_L(0); PG8_MMA(0, 1, At, B1); PG8_BAR;
            PG8_LDA(At, 1, 1); PG8_STAGE(PG8_SA(1, 0), a3, voffA);
            PG8_BAR; PG8_WAIT_L(0); PG8_MMA(1, 0, At, B0); PG8_BAR; PG8_SCHED;
            PG8_STAGE(PG8_SB(1, 1), b3 + hstep, voffB);
            PG8_WAIT_V(6); PG8_BAR; PG8_MMA(1, 1, At, B1); PG8_BAR;
            }
        }
        if constexpr (ALIGN_EPI) { if (wr == 0) PG8_BAR; }
        if constexpr (!Epi::AFTER_DRAIN) { E(acc, cur, wr, wc, fr, fq); S.done(cur); }
        if (!has_next) break;
#pragma unroll
        for (int a = 0; a < 2; ++a)
#pragma unroll
            for (int b = 0; b < 2; ++b)
#pragma unroll
                for (int m = 0; m < 4; ++m)
#pragma unroll
                    for (int n = 0; n < 2; ++n) acc[a][b][m][n] = (f32x4){0.f, 0.f, 0.f, 0.f};
        cur = nxt; cA = nA; cB = nB; ++ui;
        if constexpr (ALIGN_EPI) { if (wr == 1) PG8_BAR; }
    }
    PG8_WAIT_V(0);
    if constexpr (!ALIGN_EPI) { if (wr == 0) PG8_BAR; }
    PG8_BAR;
    if constexpr (Epi::AFTER_DRAIN) { E.fused(acc, cur, wr, wc, fr, fq, lds, wid, lane); S.done(cur); }
#undef PG8_SA
#undef PG8_SB
#undef PG8_STAGE
#undef PG8_LDA
#undef PG8_LDB
#undef PG8_MMA
#undef PG8_WAIT_V
#undef PG8_WAIT_L
#undef PG8_BAR
#undef PG8_SCHED
}
}

namespace attn_body {
using bf16=__hip_bfloat16;
using bf16x8=__attribute__((ext_vector_type(8)))short;
using s16x4=__attribute__((ext_vector_type(4)))short;
using f32x16=__attribute__((ext_vector_type(16)))float;
using u32x4=__attribute__((ext_vector_type(4)))unsigned;
constexpr int NHEAD=16,D=64,DM=NHEAD*D,KVPITCH=256;
constexpr int NW=8,QBLK=32,QB=QBLK*NW,KVBLK=64;
constexpr int ATTN_PITCH=DM, ATTN_UNIT_ROWS=QB;
__device__ __forceinline__ int crow(int r,int hi){return (r&3)+8*(r>>2)+4*hi;}
#define SBAR() __builtin_amdgcn_sched_barrier(0)
__device__ __forceinline__ void cmask(f32x16&p0,f32x16&p1,int jb,int qrel,int hi){
  const float NEG=-INFINITY; int kb=64*jb+4*hi;
  #pragma unroll
  for(int r=0;r<16;++r){int kv=kb+(r&3)+8*(r>>2); if(kv>qrel)p0[r]=NEG; if(kv+32>qrel)p1[r]=NEG;}
}

constexpr int NSLOT=3, SLOTB=8192;
constexpr int LDS_K=0, LDS_V=NSLOT*SLOTB, LDS_WS=2*NSLOT*SLOTB, LDS_OST=LDS_WS+NW*64*4, LDS_BYTES=LDS_OST+NW*4096;
constexpr float C2=0.125f*1.4426950408889634f;
__device__ __forceinline__ void glds16(const void*gsrc,unsigned lds_dst){unsigned keep;
  asm volatile("s_mov_b32 %0, m0\n\ts_mov_b32 m0, %2\n\ts_nop 0\n\tglobal_load_lds_dwordx4 %1, off\n\ts_mov_b32 m0, %0":"=&s"(keep):"v"(gsrc),"s"(lds_dst):"memory");}
__device__ __forceinline__ float max3f(float a,float b,float c){float r;asm("v_max3_f32 %0, %1, %2, %3":"=v"(r):"v"(a),"v"(b),"v"(c));return r;}
__device__ __forceinline__ float max2f(float a,float b){float r;asm("v_max_f32_e32 %0, %1, %2":"=v"(r):"v"(a),"v"(b));return r;}
__device__ __forceinline__ float fadd_s(float a,float b){float r;asm("v_add_f32_e32 %0, %1, %2":"=v"(r):"v"(a),"v"(b));return r;}
__device__ __forceinline__ float fsub_s(float a,float b){float r;asm("v_sub_f32_e32 %0, %1, %2":"=v"(r):"v"(a),"v"(b));return r;}
typedef float f32x2_t __attribute__((ext_vector_type(2))); typedef __bf16 bf16x2_t __attribute__((ext_vector_type(2)));
__device__ __forceinline__ unsigned cvtpk_s(float lo,float hi){f32x2_t v={lo,hi};bf16x2_t b=__builtin_convertvector(v,bf16x2_t);return __builtin_bit_cast(unsigned,b);}
#define WAIT_BAR(N) asm volatile("s_waitcnt vmcnt(" #N ") lgkmcnt(0)\n\ts_barrier":::"memory")

__device__ __forceinline__ void qkt(f32x16&p0,f32x16&p1,const char*Kslot,const bf16x8*qr,const f32x16&negm,int r32,int hi){
  const char*kb=Kslot+hi*1024+r32*16;
  #pragma unroll
  for(int d0=0;d0<4;++d0){
    const bf16x8 b0=*reinterpret_cast<const bf16x8*>(kb+d0*2048);
    const bf16x8 b1=*reinterpret_cast<const bf16x8*>(kb+d0*2048+512);
    if(d0==0){p0=__builtin_amdgcn_mfma_f32_32x32x16_bf16(b0,qr[0],negm,0,0,0);p1=__builtin_amdgcn_mfma_f32_32x32x16_bf16(b1,qr[0],negm,0,0,0);}
    else{p0=__builtin_amdgcn_mfma_f32_32x32x16_bf16(b0,qr[d0],p0,0,0,0);p1=__builtin_amdgcn_mfma_f32_32x32x16_bf16(b1,qr[d0],p1,0,0,0);}}
}
typedef __attribute__((address_space(3))) const char* lds_cptr;
typedef short v4i16_t __attribute__((ext_vector_type(4)));
__device__ __forceinline__ void kload8(bf16x8*kf,lds_cptr kp){
  kf[0]=*(const __attribute__((address_space(3))) bf16x8*)(kp);      kf[1]=*(const __attribute__((address_space(3))) bf16x8*)(kp+512);
  kf[2]=*(const __attribute__((address_space(3))) bf16x8*)(kp+2048); kf[3]=*(const __attribute__((address_space(3))) bf16x8*)(kp+2560);
  kf[4]=*(const __attribute__((address_space(3))) bf16x8*)(kp+4096); kf[5]=*(const __attribute__((address_space(3))) bf16x8*)(kp+4608);
  kf[6]=*(const __attribute__((address_space(3))) bf16x8*)(kp+6144); kf[7]=*(const __attribute__((address_space(3))) bf16x8*)(kp+6656);
}
__device__ __forceinline__ void kload2(bf16x8*kf,lds_cptr kp,int j){ kf[2*j]=*(const __attribute__((address_space(3))) bf16x8*)(kp+j*2048); kf[2*j+1]=*(const __attribute__((address_space(3))) bf16x8*)(kp+j*2048+512); }
__device__ __forceinline__ s16x4 vtr(lds_cptr p){ return __builtin_bit_cast(s16x4,__builtin_amdgcn_ds_read_tr16_b64_v4i16((__attribute__((address_space(3))) v4i16_t*)p)); }
__device__ __forceinline__ float rowmax(const f32x16&p0,const f32x16&p1){
  float a=max3f(p0[0],p0[1],p1[0]),b=max3f(p0[2],p0[3],p1[1]);a=max3f(a,p1[2],p1[3]);
  #pragma unroll
  for(int r=4;r<16;r+=4){a=max3f(a,p0[r],p0[r+1]);b=max3f(b,p0[r+2],p0[r+3]);a=max3f(a,p1[r],p1[r+1]);b=max3f(b,p1[r+2],p1[r+3]);}
  const float m=max2f(a,b);
  auto rr=__builtin_amdgcn_permlane32_swap(__float_as_uint(m),__float_as_uint(m),false,false);
  return max2f(__uint_as_float(rr[0]),__uint_as_float(rr[1]));
}
__device__ __forceinline__ void pv(f32x16*o,int vb,bf16x8 pa0,bf16x8 pa1,bf16x8 pa2,bf16x8 pa3){
  #pragma unroll
  for(int d0=0;d0<2;++d0){s16x4 lo[4],hi[4];
    #pragma unroll
    for(int ks=0;ks<4;++ks){
      asm volatile("ds_read_b64_tr_b16 %0,%1 offset:%c2":"=&v"(lo[ks]):"v"(vb),"i"(d0*4096+ks*1024):"memory");
      asm volatile("ds_read_b64_tr_b16 %0,%1 offset:%c2":"=&v"(hi[ks]):"v"(vb),"i"(d0*4096+ks*1024+512):"memory");}
    asm volatile("s_waitcnt lgkmcnt(0)":::"memory");SBAR();
    #define PK(k) (bf16x8){lo[k][0],lo[k][1],lo[k][2],lo[k][3],hi[k][0],hi[k][1],hi[k][2],hi[k][3]}
    o[d0]=__builtin_amdgcn_mfma_f32_32x32x16_bf16(pa0,PK(0),o[d0],0,0,0);
    o[d0]=__builtin_amdgcn_mfma_f32_32x32x16_bf16(pa1,PK(1),o[d0],0,0,0);
    o[d0]=__builtin_amdgcn_mfma_f32_32x32x16_bf16(pa2,PK(2),o[d0],0,0,0);
    o[d0]=__builtin_amdgcn_mfma_f32_32x32x16_bf16(pa3,PK(3),o[d0],0,0,0);
    #undef PK
  }
}

#ifndef ATTN_STORE16
#define ATTN_STORE16(p,v) (*(u32x4*)(p)=(v))
#endif
template<int THRL> __device__ __forceinline__ void attn_unit(const bf16*Qu,const bf16*__restrict__ Kh,const bf16*__restrict__ Vh,bf16*Ou,const int NT,char*shm,const bool wr_=true){
  int tid_o=threadIdx.x; asm volatile("":"+v"(tid_o));
  const int tid=tid_o,lane=tid&63,r32=lane&31,hi=lane>>5; const int wid=__builtin_amdgcn_readfirstlane(tid>>6);
  const bf16*Qw=Qu+(long)(wid*QBLK)*DM;
  const unsigned lds0=(unsigned)(uintptr_t)shm;
  float*wsf=(float*)(shm+LDS_WS)+wid*64;
  const bf16*ksrc=Kh+(long)lane*KVPITCH+wid*8;
  const bf16*vsrc=Vh+(long)(16*(wid&3)+(lane>>2))*KVPITCH+(wid>>2)*32+(lane&3)*8;
  const unsigned kdst=lds0+LDS_K+wid*1024, vdst=lds0+LDS_V+wid*1024;
  #define DMA_K(t,slot) glds16(ksrc+(long)(t)*KVBLK*KVPITCH,(unsigned)__builtin_amdgcn_readfirstlane(kdst+(slot)))
  #define DMA_V(t,slot) glds16(vsrc+(long)(t)*KVBLK*KVPITCH,(unsigned)__builtin_amdgcn_readfirstlane(vdst+(slot)))
  const int vb0=(int)(lds0+LDS_V)+((lane>>4)&1)*32+(lane&3)*8+(4*hi+((lane&15)>>2))*64;
  const char*Kbase=shm+LDS_K; bf16x8 kf[8];
  const lds_cptr shm3=(lds_cptr)shm; const lds_cptr kp0=shm3+LDS_K+hi*1024+r32*16; const lds_cptr vp0=shm3+LDS_V+((lane>>4)&1)*32+(lane&3)*8+(4*hi+((lane&15)>>2))*64;
  DMA_K(0,0);DMA_V(0,0);DMA_K(1,SLOTB);
  bf16x8 qr[4];
  #pragma unroll
  for(int d0=0;d0<4;++d0)qr[d0]=*reinterpret_cast<const bf16x8*>(&Qw[(long)r32*DM+d0*16+hi*8]);
  float mhat=0.f,l_reg=0.f;f32x16 o[2];o[0]=f32x16{};o[1]=f32x16{};f32x16 negm=f32x16{};asm volatile("":"+v"(negm));
  #define CMASK(P0,P1,t) do{}while(0)
  bool resc=false;
  #define START(P0,P1) do{ const float rm=rowmax(P0,P1); resc=false; \
    { const float dl=rm; mhat=fadd_s(mhat,dl); \
      _Pragma("unroll") for(int r=0;r<16;++r){P0[r]=fsub_s(P0[r],dl);P1[r]=fsub_s(P1[r],dl);} \
      _Pragma("unroll") for(int r=0;r<16;++r)negm[r]=-mhat; asm volatile("":"+v"(negm)); } \
    _Pragma("unroll") for(int r=0;r<16;++r)P0[r]=__builtin_amdgcn_exp2f(P0[r]); }while(0)
  #define RESC() do{ if(resc){ asm volatile("s_waitcnt lgkmcnt(0)":::"memory"); \
      _Pragma("unroll") for(int d_=0;d_<2;++d_) _Pragma("unroll") for(int r=0;r<16;++r)o[d_][r]*=wsf[crow(r,hi)]; } }while(0)
  f32x16 pA0,pA1,pB0,pB1;
  int sl_prev=0,sl_cur=0,sl_next=SLOTB;
  #define ROT() do{sl_prev=sl_cur;sl_cur=sl_next;sl_next=(sl_next==(NSLOT-1)*SLOTB)?0:sl_next+SLOTB;}while(0)
  DMA_K(2,2*SLOTB);
  WAIT_BAR(3);
  qkt(pA0,pA1,Kbase,qr,negm,r32,hi);asm volatile("s_nop 15\n\ts_nop 7":"+v"(pA0),"+v"(pA1));CMASK(pA0,pA1,0);
  START(pA0,pA1);
  _Pragma("unroll") for(int r=0;r<16;++r)pA1[r]=__builtin_amdgcn_exp2f(pA1[r]);
  WAIT_BAR(0);
  DMA_K(3,0);DMA_V(1,SLOTB);
  ROT();
  kload8(kf,kp0+sl_cur);
  WAIT_BAR(2);
  s16x4 vlo[8],vhi[8]; u32x4 pw0,pw1,pw2,pw3;
  #define PKW(P,B) cvtpk_s(P[B],P[B+1])
  #define PAF(k) __builtin_bit_cast(bf16x8,pw##k)
  #define VFR(i) (bf16x8){vlo[i][0],vlo[i][1],vlo[i][2],vlo[i][3],vhi[i][0],vhi[i][1],vhi[i][2],vhi[i][3]}
  #define PIN(x) asm volatile("":"+v"(x))
  #define MX3(a,b,c) __builtin_fmaxf(__builtin_fmaxf((a),(b)),(c))
  #define GAPA(MF,A0,A1,A2,A3,W0,W1,PW) do{ MF; sacc+=A0; sacc+=A1; sacc+=A2; sacc+=A3; PIN(sacc); W0; W1; PIN(PW); SBAR(); }while(0)
  #define EX(v) __builtin_amdgcn_exp2f(v)
  #define GAPB(MF,X,B) do{ MF; X[B]=EX(X[B]); X[B+1]=EX(X[B+1]); X[B+2]=EX(X[B+2]); X[B+3]=EX(X[B+3]); PIN(X); SBAR(); }while(0)
  #define VRD(i) do{ vlo[i]=vtr(vp_+(((i)>>2)*4096+((i)&3)*1024)); vhi[i]=vtr(vp_+(((i)>>2)*4096+((i)&3)*1024+512)); }while(0)
  #define KRD(G,j) do{ if(G){ kload2(kf,kp0+sl_next,j); SBAR(); } }while(0)
  #define STEP(C0,C1,P0,P1,t,GK,GV,GL) do{ SBAR(); \
    const lds_cptr vp_=vp0+sl_prev; \
    VRD(0); SBAR(); float sacc=(P0[0]+P0[1]); \
    GAPA(C0=__builtin_amdgcn_mfma_f32_32x32x16_bf16(kf[0],qr[0],negm,0,0,0), P0[2],P0[3],P0[4],P0[5],     pw0[0]=PKW(P0,0), pw0[1]=PKW(P0,2), pw0); \
    VRD(4); SBAR(); GAPA(C1=__builtin_amdgcn_mfma_f32_32x32x16_bf16(kf[1],qr[0],negm,0,0,0), P0[6],P0[7],P0[8],P0[9],     pw0[2]=PKW(P0,4), pw0[3]=PKW(P0,6), pw0); \
    VRD(1); SBAR(); GAPA(C0=__builtin_amdgcn_mfma_f32_32x32x16_bf16(kf[2],qr[1],C0,0,0,0),   P0[10],P0[11],P0[12],P0[13], pw1[0]=PKW(P0,8), pw1[1]=PKW(P0,10), pw1); \
    VRD(5); SBAR(); GAPA(C1=__builtin_amdgcn_mfma_f32_32x32x16_bf16(kf[3],qr[1],C1,0,0,0),   P0[14],P0[15],P1[0],P1[1],   pw1[2]=PKW(P0,12),pw1[3]=PKW(P0,14), pw1); \
    VRD(2); SBAR(); GAPA(C0=__builtin_amdgcn_mfma_f32_32x32x16_bf16(kf[4],qr[2],C0,0,0,0),   P1[2],P1[3],P1[4],P1[5],     pw2[0]=PKW(P1,0), pw2[1]=PKW(P1,2), pw2); \
    VRD(6); SBAR(); GAPA(C1=__builtin_amdgcn_mfma_f32_32x32x16_bf16(kf[5],qr[2],C1,0,0,0),   P1[6],P1[7],P1[8],P1[9],     pw2[2]=PKW(P1,4), pw2[3]=PKW(P1,6), pw2); \
    VRD(3); SBAR(); GAPA(C0=__builtin_amdgcn_mfma_f32_32x32x16_bf16(kf[6],qr[3],C0,0,0,0),   P1[10],P1[11],P1[12],P1[13], pw3[0]=PKW(P1,8), pw3[1]=PKW(P1,10), pw3); \
    VRD(7); SBAR(); GAPA(C1=__builtin_amdgcn_mfma_f32_32x32x16_bf16(kf[7],qr[3],C1,0,0,0),   P1[14],P1[15],0.f,0.f,       pw3[2]=PKW(P1,12),pw3[3]=PKW(P1,14), pw3); \
    l_reg+=sacc; \
    if(GK){DMA_K((t)+3,sl_cur);} if(GV){DMA_V((t)+1,sl_next);} \
    CMASK(C0,C1,t); \
    { float a=MX3(C0[0],C0[1],C1[0]),b=MX3(C0[2],C0[3],C1[1]); a=MX3(a,C1[2],C1[3]); \
      _Pragma("unroll") for(int r=4;r<16;r+=4){a=MX3(a,C0[r],C0[r+1]);b=MX3(b,C0[r+2],C0[r+3]);a=MX3(a,C1[r],C1[r+1]);b=MX3(b,C1[r+2],C1[r+3]);} \
      float rm=__builtin_fmaxf(a,b); { auto rr=__builtin_amdgcn_permlane32_swap(__float_as_uint(rm),__float_as_uint(rm),false,false); rm=__builtin_fmaxf(__uint_as_float(rr[0]),__uint_as_float(rr[1])); } \
      resc=false; \
      if(__builtin_expect(__any(rm>(float)THRL),0)){ const float dl=__builtin_fmaxf(rm,0.f); mhat+=dl; \
        _Pragma("unroll") for(int r=0;r<16;++r){C0[r]-=dl;C1[r]-=dl;} \
        _Pragma("unroll") for(int r=0;r<16;++r)negm[r]=-mhat; asm volatile("":"+v"(negm)); \
        const float f=__builtin_amdgcn_exp2f(-dl); l_reg*=f; if(hi==0)wsf[r32]=f; resc=true; } } \
    SBAR(); \
    GAPB(o[0]=__builtin_amdgcn_mfma_f32_32x32x16_bf16(PAF(0),VFR(0),o[0],0,0,0), C0,0); \
    GAPB(o[1]=__builtin_amdgcn_mfma_f32_32x32x16_bf16(PAF(0),VFR(4),o[1],0,0,0), C0,4); \
    KRD(GL,0); GAPB(o[0]=__builtin_amdgcn_mfma_f32_32x32x16_bf16(PAF(1),VFR(1),o[0],0,0,0), C0,8); \
    KRD(GL,1); GAPB(o[1]=__builtin_amdgcn_mfma_f32_32x32x16_bf16(PAF(1),VFR(5),o[1],0,0,0), C0,12); \
    KRD(GL,2); GAPB(o[0]=__builtin_amdgcn_mfma_f32_32x32x16_bf16(PAF(2),VFR(2),o[0],0,0,0), C1,0); \
    KRD(GL,3); GAPB(o[1]=__builtin_amdgcn_mfma_f32_32x32x16_bf16(PAF(2),VFR(6),o[1],0,0,0), C1,4); \
    GAPB(o[0]=__builtin_amdgcn_mfma_f32_32x32x16_bf16(PAF(3),VFR(3),o[0],0,0,0), C1,8); \
    GAPB(o[1]=__builtin_amdgcn_mfma_f32_32x32x16_bf16(PAF(3),VFR(7),o[1],0,0,0), C1,12); \
    }while(0)
  int t=1;
  for(;t+5<NT;t+=2){
    STEP(pB0,pB1,pA0,pA1,t,true,true,true);     WAIT_BAR(2); RESC(); ROT();
    STEP(pA0,pA1,pB0,pB1,t+1,true,true,true);   WAIT_BAR(2); RESC(); ROT();
  }
  #define ENDW(tt) do{ if((tt)+3<NT){WAIT_BAR(2);} else if((tt)+2<NT){WAIT_BAR(1);} else {WAIT_BAR(0);} }while(0)
  for(;t+1<NT;t+=2){
    STEP(pB0,pB1,pA0,pA1,t,(t+3<NT),(t+1<NT),(t+1<NT));       ENDW(t);   RESC(); ROT();
    STEP(pA0,pA1,pB0,pB1,t+1,(t+4<NT),(t+2<NT),(t+2<NT));     ENDW(t+1); RESC(); ROT();
  }
  STEP(pB0,pB1,pA0,pA1,NT-1,false,false,false); RESC();
  { float sacc=pB0[0]+pB0[1]; _Pragma("unroll") for(int r=2;r<16;++r)sacc+=pB0[r]; _Pragma("unroll") for(int r=0;r<16;++r)sacc+=pB1[r]; l_reg+=sacc;
    pw0=(u32x4){PKW(pB0,0),PKW(pB0,2),PKW(pB0,4),PKW(pB0,6)};pw1=(u32x4){PKW(pB0,8),PKW(pB0,10),PKW(pB0,12),PKW(pB0,14)};pw2=(u32x4){PKW(pB1,0),PKW(pB1,2),PKW(pB1,4),PKW(pB1,6)};pw3=(u32x4){PKW(pB1,8),PKW(pB1,10),PKW(pB1,12),PKW(pB1,14)};
    SBAR(); pv(o,vb0+sl_cur,PAF(0),PAF(1),PAF(2),PAF(3)); }
  #undef PKW
  #undef PAF
  #undef VFR
  #undef PIN
  #undef MX3
  #undef GAPA
  #undef GAPB
  #undef EX
  #undef VRD
  #undef KRD
  #undef STEP
  #undef ENDW
  {auto rr=__builtin_amdgcn_permlane32_swap(__float_as_uint(l_reg),__float_as_uint(l_reg),false,false);l_reg=__uint_as_float(rr[0])+__uint_as_float(rr[1]);}
  if(hi==0)wsf[32+r32]=l_reg;asm volatile("s_waitcnt lgkmcnt(0)":::"memory");
  float rli[16];
  #pragma unroll
  for(int r=0;r<16;++r)rli[r]=__builtin_amdgcn_rcpf(wsf[32+crow(r,hi)]);
  bf16*Ow=Ou+(long)(wid*QBLK)*DM;
  { bf16*stg=(bf16*)(shm+LDS_OST)+wid*2048;
    #pragma unroll
    for(int r=0;r<16;++r){const int orow=crow(r,hi);
      #pragma unroll
      for(int d0=0;d0<2;++d0)stg[orow*64+d0*32+r32]=__float2bfloat16(o[d0][r]*rli[r]);}
    asm volatile("s_waitcnt lgkmcnt(0)":::"memory");
    #pragma unroll
    for(int i=0;i<4;++i){const int row=i*8+(lane>>3),ch=lane&7; const u32x4 v=*(const u32x4*)(stg+row*64+ch*8); if(wr_)ATTN_STORE16(Ow+(long)row*DM+ch*8,v);} }
  asm volatile("s_waitcnt lgkmcnt(0)\n\ts_barrier":::"memory");
  #undef DMA_K
  #undef DMA_V
  #undef CMASK
  #undef START
  #undef RESC
  #undef ROT
}
constexpr int ATTN_LDS_BYTES=LDS_BYTES;
#undef SBAR
#undef WAIT_BAR
}

#ifndef MK_SINGLE
#define MK_SINGLE 1
#endif
constexpr int NWAVES = 8, NTHR = 512;
constexpr size_t MiB = 1u << 20;
constexpr size_t WS_CTL = 0, WS_BAR = 8192, WS_MOD = 32768, WS_ROWSS = 262144, CTL_ZERO_BYTES = 262144 + 20480 * 4, WS_SHW = 1024 * 1024, WS_GAM = 1280 * 1024, WS_ROPE = 512 * 1024, WS_LBT = 528 * 1024, WS_MODB = 768 * 1024;
constexpr size_t WS_WIN = 2 * MiB, WS_WO = 19 * MiB, WS_WUP = 21 * MiB, WS_WDN = 32 * MiB;
constexpr size_t WS_H = 38 * MiB, WS_Q = 58 * MiB, WS_ZA = 78 * MiB, WS_RQ = 98 * MiB, WS_GF = 118 * MiB, WS_GB = 138 * MiB, WS_RI = 158 * MiB, WS_PP = 178 * MiB, WS_K = 243 * MiB, WS_V = 243 * MiB + 6400 * 1024;
constexpr size_t WS_U = 58 * MiB, WS_ACT = 168 * MiB, WS_H2 = 223 * MiB, WS_END = 256 * MiB;
constexpr int RING_BYTES = 131072, LDS_BYTES = 147456;
constexpr int N_PHASES = 15;

typedef unsigned v4u __attribute__((ext_vector_type(4)));
#define LDS_WAIT() asm volatile("s_waitcnt lgkmcnt(0)" ::: "memory")
__device__ __forceinline__ unsigned f2bf(float f) { unsigned u = __builtin_bit_cast(unsigned, f); return (u + 0x7fffu + ((u >> 16) & 1u)) >> 16; }
__device__ __forceinline__ unsigned pk2(float lo, float hi) { return pg8::cvt_pk_bf16(lo, hi); }

#define RLX_AGENT __ATOMIC_RELAXED, __HIP_MEMORY_SCOPE_AGENT
#define XB_TMO      128
#define XB_XCNT(j)  (256  + 64 * (j))
#define XB_XSUB(j)  (1280 + 64 * (j))
#define XB_XGEN(j)  (2304 + 64 * (j))
#define XB_TOP      3328
#define XB_TOPGEN   3392
#define XCD_BAR_WORDS 3456
#define XB_SPIN_CAP (1u << 18)

__device__ __forceinline__ unsigned xb_ld(unsigned* p)              { return __hip_atomic_load(p, __ATOMIC_RELAXED, __HIP_MEMORY_SCOPE_AGENT); }
__device__ __forceinline__ unsigned xb_add(unsigned* p, unsigned v) { return __hip_atomic_fetch_add(p, v, __ATOMIC_RELAXED, __HIP_MEMORY_SCOPE_AGENT); }
__device__ __forceinline__ unsigned xb_xcc_id() { return (unsigned)__builtin_amdgcn_s_getreg((3 << 11) | 20) & 0xFu; }
#define XB_SPIN(cond, bar) do { unsigned _sp = 0; while (cond) { __builtin_amdgcn_s_sleep(1); \
    if ((++_sp & 255u) == 0u) { if (xb_ld(&(bar)[XB_TMO])) break; if (_sp > XB_SPIN_CAP) { atomicAdd(&(bar)[XB_TMO], 1u); break; } } } } while (0)

struct XcdBarrier {
    unsigned* bar; unsigned x;
    volatile LAS unsigned* st;
};

__device__ __forceinline__ XcdBarrier xcd_barrier_post(unsigned* bar, volatile LAS unsigned* st) {
    XcdBarrier b; b.bar = bar; b.x = xb_xcc_id(); b.st = st;
    if (threadIdx.x == 0) (void)xb_add(&bar[XB_XCNT(b.x)], 1u);
    return b;
}
__device__ __forceinline__ void xcd_barrier_complete(unsigned* bar, unsigned x, unsigned& nloc, unsigned& nx) {
    const unsigned G = gridDim.x * gridDim.y * gridDim.z;
    unsigned sum, cnt, mine, sp = 0u;
    for (;;) {
        sum = 0u; cnt = 0u; mine = 0u;
#pragma unroll
        for (unsigned j = 0; j < 16; ++j) { const unsigned c = xb_ld(&bar[XB_XCNT(j)]); sum += c; cnt += (c > 0u) ? 1u : 0u; mine = (j == x) ? c : mine; }
        if (sum == G) break;
        __builtin_amdgcn_s_sleep(1);
        if ((++sp & 255u) == 0u) { if (xb_ld(&bar[XB_TMO])) break; if (sp > XB_SPIN_CAP) { atomicAdd(&bar[XB_TMO], 1u); break; } }
    }
    nloc = mine > 0u ? mine : 1u; nx = cnt > 0u ? cnt : 1u;
}

__device__ __forceinline__ void xcd_barrier(const XcdBarrier& b) {
    asm volatile("s_waitcnt vmcnt(0)" ::: "memory");
    __syncthreads();
    if (threadIdx.x == 0) {
        unsigned* bar = b.bar;
        __builtin_amdgcn_s_waitcnt(0);
        unsigned nloc = b.st[0], nx = b.st[1];
        if (nloc == 0u) { xcd_barrier_complete(bar, b.x, nloc, nx); b.st[0] = nloc; b.st[1] = nx; }
        const unsigned old = xb_add(&bar[XB_XSUB(b.x)], 1u);
        const unsigned gen = old / nloc;
        if (old + 1u == (gen + 1u) * nloc) {
            __builtin_amdgcn_fence(__ATOMIC_RELEASE, "agent");
            asm volatile("s_waitcnt vmcnt(0)" ::: "memory");
            const unsigned og = xb_add(&bar[XB_TOP], 1u);
            const unsigned tg = og / nx;
            if (og + 1u == (tg + 1u) * nx) xb_add(&bar[XB_TOPGEN], 1u);
            else XB_SPIN(xb_ld(&bar[XB_TOPGEN]) == tg, bar);
            __builtin_amdgcn_fence(__ATOMIC_ACQUIRE, "agent");
            xb_add(&bar[XB_XGEN(b.x)], 1u);
            asm volatile("s_waitcnt vmcnt(0)" ::: "memory");
        } else {
            XB_SPIN(xb_ld(&bar[XB_XGEN(b.x)]) == gen, bar);
            __builtin_amdgcn_fence(__ATOMIC_ACQUIRE, "agent");
            asm volatile("s_waitcnt vmcnt(0)" ::: "memory");
        }
    }
    __syncthreads();
}

struct Args { const float* in[22]; float* out; unsigned char* ws; int ph_lo, ph_hi; };

__device__ __forceinline__ void p0_transpose_item(const float* W, int K, int N, bf16_t* WT, int prow0, int lc0, LAS float* scr, int kb, int lane) {
    const int k0 = 64 * kb;
#pragma unroll 8
    for (int i = 0; i < 32; ++i) { const int kk = 2 * i + (lane >> 5); scr[kk * 33 + (lane & 31)] = W[(size_t)(k0 + kk) * N + lc0 + (lane & 31)]; }
    LDS_WAIT(); asm volatile("" ::: "memory");
    const int c = lane & 7;
#pragma unroll
    for (int j = 0; j < 4; ++j) { const int n = (lane >> 3) + 8 * j; const LAS float* s = scr + (8 * c) * 33 + n;
        v4u o; o.x = pk2(s[0 * 33], s[1 * 33]); o.y = pk2(s[2 * 33], s[3 * 33]); o.z = pk2(s[4 * 33], s[5 * 33]); o.w = pk2(s[6 * 33], s[7 * 33]);
        *(v4u*)(WT + (size_t)(prow0 + n) * K + k0 + 8 * c) = o; }
    LDS_WAIT(); asm volatile("" ::: "memory");
}

__device__ __forceinline__ void p0_prep(const __attribute__((address_space(4))) Args* a, LAS unsigned char* lds, int gw, int NGW, int wave, int lane, bool skip_ada = false) {
    LAS float* scr = (LAS float*)(lds + wave * 16384);
    unsigned char* ws = a->ws;
    const float* w_in = a->in[11]; const float* w_o = a->in[16]; const float* w_up = a->in[17]; const float* w_dn = a->in[20];
    constexpr int I_IN = 16 * 272, I_O = 16 * 32, I_UP = 16 * 176, I_DN = 44 * 32, I_T = I_IN + I_O + I_UP + I_DN, I_ADA = 96 * 16, I_ROPE = 16, I_LB = 32;
    for (int it = gw; it < I_T + I_ADA + I_ROPE + I_LB; it += NGW) {
        int r = it;
        if (r < I_T) {
            const float* W; int K, N, kb, pg; bf16_t* WT; bool isin = false, isup = false;
            if (r < I_IN) { W = w_in; K = 1024; N = INW; kb = r / 272; pg = r % 272; WT = (bf16_t*)(ws + WS_WIN); isin = true; }
            else if ((r -= I_IN) < I_O) { W = w_o; K = 1024; N = 1024; kb = r / 32; pg = r % 32; WT = (bf16_t*)(ws + WS_WO); }
            else if ((r -= I_O) < I_UP) { W = w_up; K = 1024; N = UPW; kb = r / 176; pg = r % 176; WT = (bf16_t*)(ws + WS_WUP); isup = true; }
            else { r -= I_UP; W = w_dn; K = DFF; N = 1024; kb = r / 32; pg = r % 32; WT = (bf16_t*)(ws + WS_WDN); }
            const int T = pg >> 3, g = pg & 7, bj = g >> 2, wc = g & 3;
            int lc0 = T * 256 + wc * 64 + bj * 32;
            if (isin && T >= 22) lc0 = (T < 26) ? 6656 + (T - 22) * 256 + wc * 64 + bj * 32 : (bj ? 7680 : 5632) + (T - 26) * 128 + wc * 32;
            if (isup) lc0 = (bj ? DFF : 0) + T * 128 + wc * 32;
            p0_transpose_item(W, K, N, WT, pg * 32, lc0, scr, kb, lane);
        } else if ((r -= I_T) < I_ADA) {
            if (skip_ada) continue;
            const int g = r >> 4, kc = r & 15, n0 = g * 64 + lane, k0 = kc * 64;
            const float* c_in = a->in[2]; const float* cctx = a->in[6]; const float* adaw = a->in[7];
#pragma unroll
            for (int i = 0; i < 9; ++i) { const float cv = (i == 0) ? cctx[k0 + lane] : c_in[(i - 1) * 1024 + k0 + lane]; scr[lane * 12 + i] = fsilu(cv); }
            LDS_WAIT(); asm volatile("" ::: "memory");
            float acc[9];
#pragma unroll
            for (int i = 0; i < 9; ++i) acc[i] = 0.f;
#pragma unroll 8
            for (int kk = 0; kk < 64; ++kk) { const float w = adaw[(size_t)(k0 + kk) * 6144 + n0];
                const pg8::f32x4 s0 = *(const LAS pg8::f32x4*)(scr + kk * 12), s1 = *(const LAS pg8::f32x4*)(scr + kk * 12 + 4); const float s8 = scr[kk * 12 + 8];
                acc[0] += s0[0] * w; acc[1] += s0[1] * w; acc[2] += s0[2] * w; acc[3] += s0[3] * w; acc[4] += s1[0] * w; acc[5] += s1[1] * w; acc[6] += s1[2] * w; acc[7] += s1[3] * w; acc[8] += s8 * w; }
            float* mod = (float*)(ws + WS_MOD);
#pragma unroll
            for (int i = 0; i < 9; ++i) atomicAdd(mod + i * 6144 + n0, acc[i]);
            LDS_WAIT(); asm volatile("" ::: "memory");
        } else if ((r -= I_ADA) >= I_ROPE) {
            r -= I_ROPE; const int idx = r * 64 + lane, d = idx >> 10, cch = idx & 1023; const float* lg = a->in[14];
            ((float*)(ws + WS_LBT))[idx] = fsigmoid(lg[d * 2048 + cch] - lg[d * 2048 + 1024 + cch]);
        } else {
            const int idx = r * 64 + lane, pos = idx >> 4, i = idx & 15;
            const float invf = exp2f(-(float)i * 0.8304820237218406f); const float ang = (float)pos * invf;
            const float n = rintf(ang * 0.15915494309189535f); float rr = fmaf(-n, 6.2831854820251465f, ang); rr = fmaf(-n, -1.7484555e-7f, rr);
            float* rope = (float*)(ws + WS_ROPE); rope[idx * 2] = __cosf(rr); rope[idx * 2 + 1] = __sinf(rr);
        }
    }
}

template <int MODE> __device__ __forceinline__ void norm_row(const float* xrow, const float* gain, const float* mod, const float* adab, int shoff, int scoff, bf16_t* obf, float* of32, int lane) {
    const pg8::f32x4* xr = (const pg8::f32x4*)xrow + lane;
    pg8::f32x4 v[4]; float s = 0.f;
#pragma unroll
    for (int j = 0; j < 4; ++j) { v[j] = xr[64 * j]; s += (v[j][0] * v[j][0] + v[j][1] * v[j][1]) + (v[j][2] * v[j][2] + v[j][3] * v[j][3]); }
    const float rstd = __builtin_amdgcn_rsqf(wave_sum(s) * (1.0f / 1024.0f) + EPS);
#pragma unroll
    for (int j = 0; j < 4; ++j) { const int c = 4 * (lane + 64 * j); const pg8::f32x4 g = *(const pg8::f32x4*)(gain + c); pg8::f32x4 y = v[j] * rstd * g;
        if (MODE == 0) { const pg8::f32x4 sh = *(const pg8::f32x4*)(mod + shoff + c) + *(const pg8::f32x4*)(adab + shoff + c), sc = *(const pg8::f32x4*)(mod + scoff + c) + *(const pg8::f32x4*)(adab + scoff + c);
            y = y * (sc + 1.0f) + sh; u32x2 w; w.x = pk2(y[0], y[1]); w.y = pk2(y[2], y[3]); *(u32x2*)(obf + c) = w; }
        else *(pg8::f32x4*)(of32 + c) = y; }
}

constexpr int R_QD = 0, R_KD = 17408, R_K2T = 34816, R_VT = 53248, R_SC = 71680, R_ST = 80896, R_XCH = 115712, R_DEC = 119808;
__device__ __forceinline__ int crow(int r, int hi) { return (r & 3) + 8 * (r >> 2) + 4 * hi; }
__device__ __forceinline__ void rec_scan(LAS unsigned char* lds, const bf16_t* RQ, bf16_t* G, const bf16_t* RI, int lrow0, int L, int rh, int dir, const float* s0, float* sfin, const bool wr_ = true) {
    int tid_o = threadIdx.x; asm volatile("" : "+v"(tid_o));
    const int tid = tid_o, lane = tid & 63, w = __builtin_amdgcn_readfirstlane(tid >> 6), r32 = lane & 31, hi = lane >> 5;
    const int kb = w >> 1, dvt0 = (w & 1) * 2;
    const int colb = rh * 128;
    f32x16 S[2];
#pragma unroll
    for (int x = 0; x < 2; ++x)
#pragma unroll
        for (int r = 0; r < 16; ++r) S[x][r] = s0 ? s0[(size_t)(kb * 32 + crow(r, hi)) * 128 + (dvt0 + x) * 32 + r32] : 0.f;
#define REC_WRITE_ST() do { _Pragma("unroll") for (int x = 0; x < 2; ++x) _Pragma("unroll") for (int g = 0; g < 4; ++g) { u32x2 wv; wv.x = pk2(S[x][4 * g], S[x][4 * g + 1]); wv.y = pk2(S[x][4 * g + 2], S[x][4 * g + 3]); \
        *(LAS u32x2*)(lds + R_ST + ((dvt0 + x) * 32 + r32) * 272 + (kb * 32 + 8 * g + 4 * hi) * 2) = wv; } } while (0)
    REC_WRITE_ST();
    const int nc = L >> 6;
    unsigned gq[8], qq[8], vv[8];
#define REC_ROW(c, i) (dir ? (lrow0 + L - 1 - ((c) * 64 + (i))) : (lrow0 + (c) * 64 + (i)))
#define REC_LOAD(c) do { _Pragma("unroll") for (int i = 0; i < 8; ++i) { const size_t off = (size_t)REC_ROW(c, 8 * w + i) * DM + colb + 2 * lane; \
        gq[i] = *(const unsigned*)(G + off); qq[i] = *(const unsigned*)(RQ + off); vv[i] = *(const unsigned*)(RI + off); } } while (0)
    REC_LOAD(0);
    for (int c = 0; c < nc; ++c) {
        float g0[8], g1[8], q0[8], q1[8]; unsigned vk[8];
#pragma unroll
        for (int i = 0; i < 8; ++i) { g0[i] = h2f((unsigned short)(gq[i] & 0xffffu)); g1[i] = h2f((unsigned short)(gq[i] >> 16)); q0[i] = bflo(qq[i]); q1[i] = bfhi(qq[i]); vk[i] = vv[i]; }
        if (c + 1 < nc) REC_LOAD(c + 1);
        float b0[8], b1[8];
        b0[0] = g0[0]; b1[0] = g1[0];
#pragma unroll
        for (int i = 1; i < 8; ++i) { b0[i] = b0[i - 1] + g0[i]; b1[i] = b1[i - 1] + g1[i]; }
        *(LAS f32x2*)(lds + R_XCH + (w * 128 + 2 * lane) * 4) = (f32x2){b0[7], b1[7]};
        __syncthreads();
        float p0 = 0.f, p1 = 0.f, t0 = 0.f, t1 = 0.f;
#pragma unroll
        for (int ww = 0; ww < 8; ++ww) { const f32x2 x = *(const LAS f32x2*)(lds + R_XCH + (ww * 128 + 2 * lane) * 4); if (ww < w) { p0 += x[0]; p1 += x[1]; } t0 += x[0]; t1 += x[1]; }
        if (w == 0) *(LAS f32x2*)(lds + R_DEC + 2 * lane * 4) = (f32x2){__expf(t0), __expf(t1)};
        unsigned k2a[4], k2b[4], va[4], vb[4];
#pragma unroll
        for (int i = 0; i < 8; ++i) {
            const float bb0 = p0 + b0[i], bb1 = p1 + b1[i];
            const float kk0 = 1.0f - __expf(g0[i]), kk1 = 1.0f - __expf(g1[i]);
            const float qd0 = q0[i] * __expf(bb0), qd1 = q1[i] * __expf(bb1);
            const float kd0 = kk0 * __expf(-bb0), kd1 = kk1 * __expf(-bb1);
            const float kt0 = kk0 * __expf(t0 - bb0), kt1 = kk1 * __expf(t1 - bb1);
            const int ti = 8 * w + i;
            *(LAS unsigned*)(lds + R_QD + ti * 272 + lane * 4) = pk2(qd0, qd1);
            *(LAS unsigned*)(lds + R_KD + ti * 272 + lane * 4) = pk2(kd0, kd1);
            const unsigned f0 = f2bf(kt0), f1 = f2bf(kt1);
            if (i & 1) { k2a[i >> 1] |= f0 << 16; k2b[i >> 1] |= f1 << 16; va[i >> 1] |= (vk[i] & 0xffffu) << 16; vb[i >> 1] |= vk[i] & 0xffff0000u; }
            else { k2a[i >> 1] = f0; k2b[i >> 1] = f1; va[i >> 1] = vk[i] & 0xffffu; vb[i >> 1] = vk[i] >> 16; }
        }
        *(LAS v4u*)(lds + R_K2T + (2 * lane) * 144 + 16 * w) = (v4u){k2a[0], k2a[1], k2a[2], k2a[3]};
        *(LAS v4u*)(lds + R_K2T + (2 * lane + 1) * 144 + 16 * w) = (v4u){k2b[0], k2b[1], k2b[2], k2b[3]};
        *(LAS v4u*)(lds + R_VT + (2 * lane) * 144 + 16 * w) = (v4u){va[0], va[1], va[2], va[3]};
        *(LAS v4u*)(lds + R_VT + (2 * lane + 1) * 144 + 16 * w) = (v4u){vb[0], vb[1], vb[2], vb[3]};
        __syncthreads();
        if (w < 4) {
            const int ti = w >> 1, si = w & 1;
            f32x16 sc;
#pragma unroll
            for (int r = 0; r < 16; ++r) sc[r] = 0.f;
            if (w != 1) {
#pragma unroll
                for (int ks = 0; ks < 8; ++ks) {
                    const pg8::bf16x8 af = *(const LAS pg8::bf16x8*)(lds + R_QD + (ti * 32 + r32) * 272 + (16 * ks + 8 * hi) * 2);
                    const pg8::bf16x8 bf = *(const LAS pg8::bf16x8*)(lds + R_KD + (si * 32 + r32) * 272 + (16 * ks + 8 * hi) * 2);
                    sc = __builtin_amdgcn_mfma_f32_32x32x16_bf16(af, bf, sc, 0, 0, 0);
                }
            }
#pragma unroll
            for (int r = 0; r < 16; ++r) { const int t = ti * 32 + crow(r, hi), s = si * 32 + r32; const float v = (t >= s) ? sc[r] : 0.f;
                *(LAS unsigned short*)(lds + R_SC + t * 144 + s * 2) = (unsigned short)f2bf(v); }
        }
        __syncthreads();
        {
            const int to = w >> 2, dvo = w & 3;
            f32x16 o;
#pragma unroll
            for (int r = 0; r < 16; ++r) o[r] = 0.f;
#pragma unroll
            for (int ks = 0; ks < 4; ++ks) {
                const pg8::bf16x8 af = *(const LAS pg8::bf16x8*)(lds + R_SC + (to * 32 + r32) * 144 + (16 * ks + 8 * hi) * 2);
                const pg8::bf16x8 bf = *(const LAS pg8::bf16x8*)(lds + R_VT + (dvo * 32 + r32) * 144 + (16 * ks + 8 * hi) * 2);
                o = __builtin_amdgcn_mfma_f32_32x32x16_bf16(af, bf, o, 0, 0, 0);
            }
#pragma unroll
            for (int ks = 0; ks < 8; ++ks) {
                const pg8::bf16x8 af = *(const LAS pg8::bf16x8*)(lds + R_QD + (to * 32 + r32) * 272 + (16 * ks + 8 * hi) * 2);
                const pg8::bf16x8 bf = *(const LAS pg8::bf16x8*)(lds + R_ST + (dvo * 32 + r32) * 272 + (16 * ks + 8 * hi) * 2);
                o = __builtin_amdgcn_mfma_f32_32x32x16_bf16(af, bf, o, 0, 0, 0);
            }
            if (wr_)
#pragma unroll
            for (int r = 0; r < 16; ++r) { const int t = to * 32 + crow(r, hi); G[(size_t)REC_ROW(c, t) * DM + colb + dvo * 32 + r32] = (bf16_t)f2bf(o[r]); }
            float dec[16];
#pragma unroll
            for (int r = 0; r < 16; ++r) dec[r] = *(const LAS float*)(lds + R_DEC + (kb * 32 + crow(r, hi)) * 4);
#pragma unroll
            for (int x = 0; x < 2; ++x)
#pragma unroll
                for (int r = 0; r < 16; ++r) S[x][r] *= dec[r];
#pragma unroll
            for (int ks = 0; ks < 4; ++ks) {
                const pg8::bf16x8 af = *(const LAS pg8::bf16x8*)(lds + R_K2T + (kb * 32 + r32) * 144 + (16 * ks + 8 * hi) * 2);
#pragma unroll
                for (int x = 0; x < 2; ++x) {
                    const pg8::bf16x8 bf = *(const LAS pg8::bf16x8*)(lds + R_VT + ((dvt0 + x) * 32 + r32) * 144 + (16 * ks + 8 * hi) * 2);
                    S[x] = __builtin_amdgcn_mfma_f32_32x32x16_bf16(af, bf, S[x], 0, 0, 0);
                }
            }
        }
        __syncthreads();
        REC_WRITE_ST();
    }
    if (sfin && wr_) {
#pragma unroll
        for (int x = 0; x < 2; ++x)
#pragma unroll
            for (int r = 0; r < 16; ++r) sfin[(size_t)(kb * 32 + crow(r, hi)) * 128 + (dvt0 + x) * 32 + r32] = S[x][r];
    }
#undef REC_WRITE_ST
#undef REC_ROW
#undef REC_LOAD
}

typedef const __attribute__((address_space(4))) Args* KArgs;
#define WSB(off) ((bf16_t*)(ws + (off)))
#define WSF(off) ((float*)(ws + (off)))
__device__ __forceinline__ bf16_t* h1_buf(unsigned char* ws, float* dout, int hfx) { return hfx ? (bf16_t*)(dout + (size_t)MH * DM) : WSB(WS_H); }
__device__ __forceinline__ void do_norm1(KArgs ap, int hfx, int gwb, int ngwb, int lane, bool rows, bool cache) {
    unsigned char* const ws = ap->ws; const float* xp = ap->in[0]; const float* xs = ap->in[1]; const float* adab = ap->in[8]; const float* mod = WSF(WS_MOD);
    bf16_t* Hd = h1_buf(ws, ap->out, hfx); bf16_t* Kb = WSB(WS_K); bf16_t* Vb = WSB(WS_V);
    if (rows) for (int r = gwb; r < MH; r += ngwb) { const int grow = hfx * MH + r; const float* src = grow < NPR ? xp + (size_t)grow * DM : xs + (size_t)(grow - NPR) * DM;
        norm_row<0>(src, ap->in[9], mod + mod_of_row(grow) * 6144, adab, 0, 1024, Hd + (size_t)r * DM, nullptr, lane); }
    const int nb = hfx ? 5 : 3, b0 = hfx ? 3 : 0;
    if (cache) for (int r = gwb; r < 2 * nb * 512; r += ngwb) { const int kv = r / (nb * 512), rr = r % (nb * 512), b = rr >> 9, p = rr & 511;
        const float* src = (kv ? ap->in[4] : ap->in[3]) + ((size_t)(b0 + b) * 512 + p) * KVP + 4 * lane;
        bf16_t* dst = (kv ? Vb : Kb) + (size_t)((hfx ? b * 2560 : NPR + b * 2560) + 2048 + p) * KVP + 4 * lane;
        const pg8::f32x4 v = *(const pg8::f32x4*)src; u32x2 wv; wv.x = pk2(v[0], v[1]); wv.y = pk2(v[2], v[3]); *(u32x2*)dst = wv; }
}
__device__ __forceinline__ void do_final(KArgs ap, int hfx, int gwb, int ngwb, int lane) {
    float* dout = ap->out;
    for (int r = gwb; r < MH; r += ngwb) { float* row = dout + (size_t)(hfx * MH + r) * DM; norm_row<1>(row, ap->in[21], nullptr, nullptr, 0, 0, nullptr, row, lane); }
}

__device__ __forceinline__ void fix_edges(KArgs ap, int hf, int blk0, int nblk, int wv0, int nwv, int lane) {
    unsigned char* const ws = ap->ws;
    const float* cw = ap->in[18]; const float* cb = ap->in[19]; const bf16_t* EB = WSB(WS_U); bf16_t* ACT = WSB(WS_ACT);
    for (int item = wv0; item < nblk * 2 * 11; item += nwv) {
        const int st = item % 11, re = item / 11, blk = blk0 + (re >> 1), last = re & 1;
                const int lrow = blk * 64 + (last ? 63 : 0), grow = hf * MH + lrow;
                const int t = grow < NPR ? (grow & 255) : ((grow - NPR) & 2047); const int Ls = grow < NPR ? 256 : 2048;
                const int c = (st * 64 + lane) * 4;
                const bool hp = last || t > 0, hn = !last || t < Ls - 1;
                const bf16_t* ecur = EB + (ptrdiff_t)((blk * 4 + (last ? 3 : 0)) * 2) * DFF + c;
                const bf16_t* eprev = EB + (ptrdiff_t)((last ? blk * 4 + 2 : (blk - 1) * 4 + 3) * 2) * DFF + c;
                const bf16_t* enext = EB + (ptrdiff_t)((last ? (blk + 1) * 4 : blk * 4 + 1) * 2) * DFF + c;
                u32x2 pa = {0u, 0u}, pb2 = {0u, 0u}, na = {0u, 0u}, nb = {0u, 0u};
                const u32x2 ca = *(const u32x2*)ecur, cb2 = *(const u32x2*)(ecur + DFF);
                if (hp) { pa = *(const u32x2*)eprev; pb2 = *(const u32x2*)(eprev + DFF); }
                if (hn) { na = *(const u32x2*)enext; nb = *(const u32x2*)(enext + DFF); }
                const pg8::f32x4 wa0 = *(const pg8::f32x4*)(cw + c), wa1 = *(const pg8::f32x4*)(cw + UPW + c), wa2 = *(const pg8::f32x4*)(cw + 2 * UPW + c), ba = *(const pg8::f32x4*)(cb + c);
                const pg8::f32x4 wb0 = *(const pg8::f32x4*)(cw + DFF + c), wb1 = *(const pg8::f32x4*)(cw + UPW + DFF + c), wb2 = *(const pg8::f32x4*)(cw + 2 * UPW + DFF + c), bb = *(const pg8::f32x4*)(cb + DFF + c);
                pg8::f32x4 a, b;
                a[0] = wa0[0] * bflo(pa.x) + wa1[0] * bflo(ca.x) + wa2[0] * bflo(na.x) + ba[0]; a[1] = wa0[1] * bfhi(pa.x) + wa1[1] * bfhi(ca.x) + wa2[1] * bfhi(na.x) + ba[1];
                a[2] = wa0[2] * bflo(pa.y) + wa1[2] * bflo(ca.y) + wa2[2] * bflo(na.y) + ba[2]; a[3] = wa0[3] * bfhi(pa.y) + wa1[3] * bfhi(ca.y) + wa2[3] * bfhi(na.y) + ba[3];
                b[0] = wb0[0] * bflo(pb2.x) + wb1[0] * bflo(cb2.x) + wb2[0] * bflo(nb.x) + bb[0]; b[1] = wb0[1] * bfhi(pb2.x) + wb1[1] * bfhi(cb2.x) + wb2[1] * bfhi(nb.x) + bb[1];
                b[2] = wb0[2] * bflo(pb2.y) + wb1[2] * bflo(cb2.y) + wb2[2] * bflo(nb.y) + bb[2]; b[3] = wb0[3] * bfhi(pb2.y) + wb1[3] * bfhi(cb2.y) + wb2[3] * bfhi(nb.y) + bb[3];
                u32x2 wv; wv.x = pk2(fsilu(a[0]) * b[0], fsilu(a[1]) * b[1]); wv.y = pk2(fsilu(a[2]) * b[2], fsilu(a[3]) * b[3]);
                *(u32x2*)(ACT + (size_t)lrow * DFF + c) = wv;
    }
}
__device__ __forceinline__ void fix_panel(KArgs ap, int hf, int pm, int wave, int lane) {
    unsigned char* const ws = ap->ws;
    const float* cw = ap->in[18]; const float* cb = ap->in[19]; const bf16_t* EB = WSB(WS_U); bf16_t* ACT = WSB(WS_ACT);
    for (int st = wave; st < 11; st += NWAVES) {
        const int c = (st * 64 + lane) * 4;
        const pg8::f32x4 wa0 = *(const pg8::f32x4*)(cw + c), wa1 = *(const pg8::f32x4*)(cw + UPW + c), wa2 = *(const pg8::f32x4*)(cw + 2 * UPW + c), ba = *(const pg8::f32x4*)(cb + c);
        const pg8::f32x4 wb0 = *(const pg8::f32x4*)(cw + DFF + c), wb1 = *(const pg8::f32x4*)(cw + UPW + DFF + c), wb2 = *(const pg8::f32x4*)(cw + 2 * UPW + DFF + c), bb = *(const pg8::f32x4*)(cb + DFF + c);
        u32x2 pa[8], pb[8], ca[8], cbv[8], na[8], nb[8];
#pragma unroll
        for (int e = 0; e < 8; ++e) {
            const int blk = pm * 4 + (e >> 1), last = e & 1; const int lrow = blk * 64 + (last ? 63 : 0), grow = hf * MH + lrow;
            const int t = grow < NPR ? (grow & 255) : ((grow - NPR) & 2047); const int Ls = grow < NPR ? 256 : 2048;
            const bool hp = last || t > 0, hn = !last || t < Ls - 1;
            const bf16_t* ecur = EB + (ptrdiff_t)((blk * 4 + (last ? 3 : 0)) * 2) * DFF + c;
            const bf16_t* eprev = EB + (ptrdiff_t)((last ? blk * 4 + 2 : (blk - 1) * 4 + 3) * 2) * DFF + c;
            const bf16_t* enext = EB + (ptrdiff_t)((last ? (blk + 1) * 4 : blk * 4 + 1) * 2) * DFF + c;
            pa[e] = (u32x2){0u, 0u}; pb[e] = (u32x2){0u, 0u}; na[e] = (u32x2){0u, 0u}; nb[e] = (u32x2){0u, 0u};
            ca[e] = *(const u32x2*)ecur; cbv[e] = *(const u32x2*)(ecur + DFF);
            if (hp) { pa[e] = *(const u32x2*)eprev; pb[e] = *(const u32x2*)(eprev + DFF); }
            if (hn) { na[e] = *(const u32x2*)enext; nb[e] = *(const u32x2*)(enext + DFF); }
        }
#pragma unroll
        for (int e = 0; e < 8; ++e) {
            const int lrow = (pm * 4 + (e >> 1)) * 64 + ((e & 1) ? 63 : 0);
            pg8::f32x4 a, b;
            a[0] = wa0[0] * bflo(pa[e].x) + wa1[0] * bflo(ca[e].x) + wa2[0] * bflo(na[e].x) + ba[0]; a[1] = wa0[1] * bfhi(pa[e].x) + wa1[1] * bfhi(ca[e].x) + wa2[1] * bfhi(na[e].x) + ba[1];
            a[2] = wa0[2] * bflo(pa[e].y) + wa1[2] * bflo(ca[e].y) + wa2[2] * bflo(na[e].y) + ba[2]; a[3] = wa0[3] * bfhi(pa[e].y) + wa1[3] * bfhi(ca[e].y) + wa2[3] * bfhi(na[e].y) + ba[3];
            b[0] = wb0[0] * bflo(pb[e].x) + wb1[0] * bflo(cbv[e].x) + wb2[0] * bflo(nb[e].x) + bb[0]; b[1] = wb0[1] * bfhi(pb[e].x) + wb1[1] * bfhi(cbv[e].x) + wb2[1] * bfhi(nb[e].x) + bb[1];
            b[2] = wb0[2] * bflo(pb[e].y) + wb1[2] * bflo(cbv[e].y) + wb2[2] * bflo(nb[e].y) + bb[2]; b[3] = wb0[3] * bfhi(pb[e].y) + wb1[3] * bfhi(cbv[e].y) + wb2[3] * bfhi(nb[e].y) + bb[3];
            u32x2 wv; wv.x = pk2(fsilu(a[0]) * b[0], fsilu(a[1]) * b[1]); wv.y = pk2(fsilu(a[2]) * b[2], fsilu(a[3]) * b[3]);
            *(u32x2*)(ACT + (size_t)lrow * DFF + c) = wv;
        }
    }
}

__global__ void __launch_bounds__(NTHR, 2) fwd_mega(Args args) {
    extern __shared__ __attribute__((aligned(16))) unsigned char lds_raw[];
    LAS unsigned char* lds = (LAS unsigned char*)lds_raw;
    const int G = gridDim.x, bx = blockIdx.x, NGW = G * NWAVES;
#define PH_IDS() int tid = threadIdx.x; asm volatile("" : "+v"(tid)); const int lane = tid & 63, wave = __builtin_amdgcn_readfirstlane(tid >> 6), gw = bx * NWAVES + wave; (void)lane; (void)gw; \
    KArgs ap = (KArgs)__builtin_amdgcn_kernarg_segment_ptr(); asm volatile("" : "+s"(ap)); unsigned char* const ws = ap->ws; float* const dout = ap->out; (void)ws; (void)dout;
#define AIN(i) (ap->in[i])
    const int lo = args.ph_lo, hi_ph = args.ph_hi;
    volatile LAS unsigned* bst = (volatile LAS unsigned*)(lds + RING_BYTES + 64);
    if (threadIdx.x < 2) bst[threadIdx.x] = 0u;
    __syncthreads();
    XcdBarrier xbar = xcd_barrier_post((unsigned*)(args.ws + WS_BAR), bst);
    cg::grid_group grid = cg::this_grid();
#ifndef PHMASK
#define PHMASK 0xFFFF
#endif
#define PEN(j) (((PHMASK) >> (j)) & 1)
#ifndef DUPMASK
#define DUPMASK 0
#endif
#define DUP(j) (((DUPMASK) >> (j)) & 1)
#define IN(k) (lo <= (k) && (k) < hi_ph)
#define SEAM(k) do { if (IN(k) && IN((k) + 1)) { if (lo < 0) grid.sync();     xcd_barrier(xbar); } } while (0)

    if (IN(0)) { PH_IDS(); p0_prep(ap, lds, gw, NGW, wave, lane); SEAM(0); }

    if (IN(1)) { PH_IDS(); const int hf = 0; const int rep_ = 0; (void)hf; (void)rep_;

            const float* adab = AIN(8); const float* mod = WSF(WS_MOD);
            do_norm1(ap, 0, gw, NGW, lane, true, true);
            if (hf == 0) { float* modb = WSF(WS_MODB); for (int i = gw * 64 + lane; i < 9 * 6144; i += NGW * 64) modb[i] = mod[i] + adab[i % 6144];
                float* gam = WSF(WS_GAM); const float* n2 = AIN(10); for (int i = gw * 64 + lane; i < 9 * 1024; i += NGW * 64) { const int b = i >> 10, cc = i & 1023; gam[i] = n2[cc] * (1.0f + mod[b * 6144 + 4096 + cc] + adab[4096 + cc]); }
                float* shw = WSF(WS_SHW); const bf16_t* WUP = WSB(WS_WUP);
                for (int p = gw; p < UPW; p += NGW) {
                    const v4u w0 = *(const v4u*)(WUP + (size_t)p * DM + 16 * lane), w1 = *(const v4u*)(WUP + (size_t)p * DM + 16 * lane + 8);
                    float wv[16];
#pragma unroll
                    for (int q = 0; q < 4; ++q) { wv[2 * q] = bflo(w0[q]); wv[2 * q + 1] = bfhi(w0[q]); wv[8 + 2 * q] = bflo(w1[q]); wv[8 + 2 * q + 1] = bfhi(w1[q]); }
                    #pragma unroll
                    for (int b = 0; b < 9; ++b) { float s = 0.f;
#pragma unroll
                        for (int q = 0; q < 4; ++q) { const pg8::f32x4 a = *(const pg8::f32x4*)(mod + b * 6144 + 3072 + 16 * lane + 4 * q) + *(const pg8::f32x4*)(adab + 3072 + 16 * lane + 4 * q);
                            s += a[0] * wv[4 * q] + a[1] * wv[4 * q + 1] + a[2] * wv[4 * q + 2] + a[3] * wv[4 * q + 3]; }
                        s = wave_sum(s); if (lane == 0) shw[b * UPW + p] = s; }
                }
            }
            SEAM(1);
    }
    if (IN(2)) { PH_IDS(); const int hf = 0; const int rep_ = 0; (void)hf; (void)rep_;

            pg8::Gemm g{h1_buf(ws, dout, hf), WSB(WS_WIN), MH, INW, DM}; pg8::StaticOrder S; S.init(MH, INW, G, bx);
            float* nck = dout + (size_t)MTOT * DM; float* ncv = nck + (size_t)NPR * KVP;
            pg8::EpiInProj E{WSB(WS_Q), WSB(WS_K), WSB(WS_V), WSB(WS_RQ), WSB(WS_GF), WSB(WS_GB), WSB(WS_RI), WSB(WS_ZA), WSB(WS_PP), nck, ncv, AIN(12), AIN(13), WSF(WS_LBT), WSF(WS_ROPE), hf};
            pg8::gemm_phase<pg8::EpiInProj, pg8::StaticOrder, true, true>(lds, g, S, E);
            { const int rem = ((MH / 256) * (INW / 256)) % G;
              if (bx >= rem) do_norm1(ap, 1, (bx - rem) * NWAVES + wave, (G - rem) * NWAVES, lane, true, false); }
            SEAM(2);
    }
    if (IN(3)) { PH_IDS(); const int hf = 0; const int rep_ = 0; (void)hf; (void)rep_;

            const int nlong = hf ? 80 : 48, nbig = hf ? 640 : 384, nshort = hf ? 0 : 256, nsmall = hf ? 0 : 256;
#ifndef DUPREC
#define DUPREC 0
#endif
#ifndef DUPATT
#define DUPATT 0
#endif
            const int ndl = DUPREC ? nlong : 0, nda = DUPATT ? nbig : 0;
            const int ntot = ndl + nda + nlong + nbig + nshort + nsmall;
            LAS int* slot = (LAS int*)(lds + RING_BYTES); unsigned* ctl = (unsigned*)(ws + WS_CTL);
            bf16_t* Qb = WSB(WS_Q); bf16_t* Kb = WSB(WS_K); bf16_t* Vb = WSB(WS_V); bf16_t* RQ = WSB(WS_RQ); bf16_t* GF = WSB(WS_GF); bf16_t* GB = WSB(WS_GB); bf16_t* RI = WSB(WS_RI);
            float* nst = dout + (size_t)MTOT * DM + 2 * (size_t)NPR * KVP;
            for (;;) {
                __syncthreads();
                if (tid == 0) *slot = (int)atomicAdd(ctl + 64 * hf + ((DUP(2) && rep_ == 0) ? 16 : 0), 1u);
                __syncthreads();
                int it = *slot;
                if (it >= ntot) break;
                bool wr = !(DUP(2) && rep_ == 0);
                if (it < ndl) wr = false; else { it -= ndl; if (it < nda) { wr = false; it += nlong; } else it -= nda; }
                if (it < nlong) {
                    const int b = it >> 4, rh = (it >> 1) & 7, dir = it & 1; const int bglob = hf ? 3 + b : b;
                    rec_scan(lds, RQ, dir ? GB : GF, RI, (hf ? 0 : NPR) + b * 2048, 2048, rh, dir, AIN(5) + (size_t)((bglob * 2 + dir) * 8 + rh) * 16384, nullptr, wr);
                } else if ((it -= nlong) < nbig) {
                    const int gq = it & 3, qb = (it >> 2) & 7, kvh = (it >> 5) & 3, b = it >> 7, h = kvh * 4 + gq;
                    const int lrow0 = (hf ? 0 : NPR) + b * 2048 + qb * 256, kvr0 = (hf ? 0 : NPR) + b * 2560;
                    attn_body::attn_unit<8>((const attn_body::bf16*)(Qb + (size_t)lrow0 * DM + h * 64), (const attn_body::bf16*)(Kb + (size_t)kvr0 * KVP + kvh * 64), (const attn_body::bf16*)(Vb + (size_t)kvr0 * KVP + kvh * 64),
                                            (attn_body::bf16*)(Qb + (size_t)lrow0 * DM + h * 64), 40, (char*)lds_raw, wr);
                } else if ((it -= nbig) < nshort) {
                    const int seq = it >> 4, rh = (it >> 1) & 7, dir = it & 1;
                    rec_scan(lds, RQ, dir ? GB : GF, RI, seq * 256, 256, rh, dir, nullptr, nst + (size_t)((seq * 2 + dir) * 8 + rh) * 16384, wr);
                } else {
                    it -= nshort; const int seq = it >> 4, h = it & 15, kvh = h >> 2;
                    attn_body::attn_unit<8>((const attn_body::bf16*)(Qb + (size_t)(seq * 256) * DM + h * 64), (const attn_body::bf16*)(Kb + (size_t)(seq * 256) * KVP + kvh * 64), (const attn_body::bf16*)(Vb + (size_t)(seq * 256) * KVP + kvh * 64),
                                            (attn_body::bf16*)(Qb + (size_t)(seq * 256) * DM + h * 64), 4, (char*)lds_raw, wr);
                }
            }
            if (DUP(2) && rep_ == 0) xcd_barrier(xbar);
            SEAM(3);
    }
    if (IN(4)) { PH_IDS(); const int hf = 0; const int rep_ = 0; (void)hf; (void)rep_;

            const float* hg = AIN(15); bf16_t* Qb = WSB(WS_Q); bf16_t* ZA = WSB(WS_ZA); bf16_t* GF = WSB(WS_GF); bf16_t* GB = WSB(WS_GB); bf16_t* PP = WSB(WS_PP); bf16_t* H = WSB(WS_H);
            for (int r = gw; r < MH; r += NGW) {
                const size_t off = (size_t)r * DM + 16 * lane;
                v4u o[2], z[2], f[2], bq[2], p[2];
#pragma unroll
                for (int e = 0; e < 2; ++e) { o[e] = *(const v4u*)(Qb + off + 8 * e); z[e] = *(const v4u*)(ZA + off + 8 * e); f[e] = *(const v4u*)(GF + off + 8 * e); bq[e] = *(const v4u*)(GB + off + 8 * e); p[e] = *(const v4u*)(PP + off + 8 * e); }
                float s[16]; float ss = 0.f;
#pragma unroll
                for (int e = 0; e < 2; ++e)
#pragma unroll
                    for (int q = 0; q < 4; ++q) { s[8 * e + 2 * q] = bflo(f[e][q]) + bflo(bq[e][q]); s[8 * e + 2 * q + 1] = bfhi(f[e][q]) + bfhi(bq[e][q]); }
#pragma unroll
                for (int q = 0; q < 16; ++q) ss += s[q] * s[q];
                ss += __shfl_xor(ss, 1); ss += __shfl_xor(ss, 2); ss += __shfl_xor(ss, 4);
                const float rs = __builtin_amdgcn_rsqf(ss * (1.0f / 128.0f) + EPS);
                const int gc = (16 * lane) & 127;
                v4u outw[2];
#pragma unroll
                for (int e = 0; e < 2; ++e)
#pragma unroll
                    for (int q = 0; q < 4; ++q) {
                        const int i0 = 8 * e + 2 * q;
                        const float m0 = bflo(o[e][q]) * bflo(z[e][q]) + bflo(p[e][q]) * (s[i0] * rs * hg[gc + i0]);
                        const float m1 = bfhi(o[e][q]) * bfhi(z[e][q]) + bfhi(p[e][q]) * (s[i0 + 1] * rs * hg[gc + i0 + 1]);
                        outw[e][q] = pk2(m0, m1);
                    }
                *(v4u*)(H + off) = outw[0]; *(v4u*)(H + off + 8) = outw[1];
            }
            do_norm1(ap, 1, gw, NGW, lane, false, true);
            SEAM(4);
    }
    if (IN(5)) { PH_IDS(); const int hf = 1; const int rep_ = 0; (void)hf; (void)rep_;

            pg8::Gemm g{h1_buf(ws, dout, hf), WSB(WS_WIN), MH, INW, DM}; pg8::StaticOrder S; S.init(MH, INW, G, bx);
            float* nck = dout + (size_t)MTOT * DM; float* ncv = nck + (size_t)NPR * KVP;
            pg8::EpiInProj E{WSB(WS_Q), WSB(WS_K), WSB(WS_V), WSB(WS_RQ), WSB(WS_GF), WSB(WS_GB), WSB(WS_RI), WSB(WS_ZA), WSB(WS_PP), nck, ncv, AIN(12), AIN(13), WSF(WS_LBT), WSF(WS_ROPE), hf};
            pg8::gemm_phase<pg8::EpiInProj, pg8::StaticOrder, true, true>(lds, g, S, E);
            { const int rem = ((MH / 256) * (INW / 256)) % G;
              if (bx >= rem) {
            { pg8::Gemm g{WSB(WS_H), WSB(WS_WO), MH, DM, DM}; pg8::StaticOrder S; S.init(MH, DM, G - rem, bx - rem);
              pg8::EpiResidW E{AIN(0), AIN(1), dout, WSF(WS_MODB), WSF(WS_GAM), WSB(WS_H2), WSF(WS_ROWSS), 2048, 0};
              pg8::gemm_phase<pg8::EpiResidW, pg8::StaticOrder, true, true>(lds, g, S, E); }
              } }
            SEAM(5);
    }
    if (IN(6)) { PH_IDS(); const int hf = 1; const int rep_ = 0; (void)hf; (void)rep_;

            const int nlong = hf ? 80 : 48, nbig = hf ? 640 : 384, nshort = hf ? 0 : 256, nsmall = hf ? 0 : 256;
#ifndef DUPREC
#define DUPREC 0
#endif
#ifndef DUPATT
#define DUPATT 0
#endif
            const int ndl = DUPREC ? nlong : 0, nda = DUPATT ? nbig : 0;
            const int ntot = ndl + nda + nlong + nbig + nshort + nsmall;
            LAS int* slot = (LAS int*)(lds + RING_BYTES); unsigned* ctl = (unsigned*)(ws + WS_CTL);
            bf16_t* Qb = WSB(WS_Q); bf16_t* Kb = WSB(WS_K); bf16_t* Vb = WSB(WS_V); bf16_t* RQ = WSB(WS_RQ); bf16_t* GF = WSB(WS_GF); bf16_t* GB = WSB(WS_GB); bf16_t* RI = WSB(WS_RI);
            float* nst = dout + (size_t)MTOT * DM + 2 * (size_t)NPR * KVP;
            for (;;) {
                __syncthreads();
                if (tid == 0) *slot = (int)atomicAdd(ctl + 64 * hf + ((DUP(2) && rep_ == 0) ? 16 : 0), 1u);
                __syncthreads();
                int it = *slot;
                if (it >= ntot) break;
                bool wr = !(DUP(2) && rep_ == 0);
                if (it < ndl) wr = false; else { it -= ndl; if (it < nda) { wr = false; it += nlong; } else it -= nda; }
                if (it < nlong) {
                    const int b = it >> 4, rh = (it >> 1) & 7, dir = it & 1; const int bglob = hf ? 3 + b : b;
                    rec_scan(lds, RQ, dir ? GB : GF, RI, (hf ? 0 : NPR) + b * 2048, 2048, rh, dir, AIN(5) + (size_t)((bglob * 2 + dir) * 8 + rh) * 16384, nullptr, wr);
                } else if ((it -= nlong) < nbig) {
                    const int gq = it & 3, qb = (it >> 2) & 7, kvh = (it >> 5) & 3, b = it >> 7, h = kvh * 4 + gq;
                    const int lrow0 = (hf ? 0 : NPR) + b * 2048 + qb * 256, kvr0 = (hf ? 0 : NPR) + b * 2560;
                    attn_body::attn_unit<8>((const attn_body::bf16*)(Qb + (size_t)lrow0 * DM + h * 64), (const attn_body::bf16*)(Kb + (size_t)kvr0 * KVP + kvh * 64), (const attn_body::bf16*)(Vb + (size_t)kvr0 * KVP + kvh * 64),
                                            (attn_body::bf16*)(Qb + (size_t)lrow0 * DM + h * 64), 40, (char*)lds_raw, wr);
                } else if ((it -= nbig) < nshort) {
                    const int seq = it >> 4, rh = (it >> 1) & 7, dir = it & 1;
                    rec_scan(lds, RQ, dir ? GB : GF, RI, seq * 256, 256, rh, dir, nullptr, nst + (size_t)((seq * 2 + dir) * 8 + rh) * 16384, wr);
                } else {
                    it -= nshort; const int seq = it >> 4, h = it & 15, kvh = h >> 2;
                    attn_body::attn_unit<8>((const attn_body::bf16*)(Qb + (size_t)(seq * 256) * DM + h * 64), (const attn_body::bf16*)(Kb + (size_t)(seq * 256) * KVP + kvh * 64), (const attn_body::bf16*)(Vb + (size_t)(seq * 256) * KVP + kvh * 64),
                                            (attn_body::bf16*)(Qb + (size_t)(seq * 256) * DM + h * 64), 4, (char*)lds_raw, wr);
                }
            }
            if (DUP(2) && rep_ == 0) xcd_barrier(xbar);
            SEAM(6);
    }
    if (IN(7)) { PH_IDS(); const int hf = 1; const int rep_ = 0; (void)hf; (void)rep_;

            const float* hg = AIN(15); bf16_t* Qb = WSB(WS_Q); bf16_t* ZA = WSB(WS_ZA); bf16_t* GF = WSB(WS_GF); bf16_t* GB = WSB(WS_GB); bf16_t* PP = WSB(WS_PP); bf16_t* H = WSB(WS_H);
            for (int r = gw; r < MH; r += NGW) {
                const size_t off = (size_t)r * DM + 16 * lane;
                v4u o[2], z[2], f[2], bq[2], p[2];
#pragma unroll
                for (int e = 0; e < 2; ++e) { o[e] = *(const v4u*)(Qb + off + 8 * e); z[e] = *(const v4u*)(ZA + off + 8 * e); f[e] = *(const v4u*)(GF + off + 8 * e); bq[e] = *(const v4u*)(GB + off + 8 * e); p[e] = *(const v4u*)(PP + off + 8 * e); }
                float s[16]; float ss = 0.f;
#pragma unroll
                for (int e = 0; e < 2; ++e)
#pragma unroll
                    for (int q = 0; q < 4; ++q) { s[8 * e + 2 * q] = bflo(f[e][q]) + bflo(bq[e][q]); s[8 * e + 2 * q + 1] = bfhi(f[e][q]) + bfhi(bq[e][q]); }
#pragma unroll
                for (int q = 0; q < 16; ++q) ss += s[q] * s[q];
                ss += __shfl_xor(ss, 1); ss += __shfl_xor(ss, 2); ss += __shfl_xor(ss, 4);
                const float rs = __builtin_amdgcn_rsqf(ss * (1.0f / 128.0f) + EPS);
                const int gc = (16 * lane) & 127;
                v4u outw[2];
#pragma unroll
                for (int e = 0; e < 2; ++e)
#pragma unroll
                    for (int q = 0; q < 4; ++q) {
                        const int i0 = 8 * e + 2 * q;
                        const float m0 = bflo(o[e][q]) * bflo(z[e][q]) + bflo(p[e][q]) * (s[i0] * rs * hg[gc + i0]);
                        const float m1 = bfhi(o[e][q]) * bfhi(z[e][q]) + bfhi(p[e][q]) * (s[i0 + 1] * rs * hg[gc + i0 + 1]);
                        outw[e][q] = pk2(m0, m1);
                    }
                *(v4u*)(H + off) = outw[0]; *(v4u*)(H + off + 8) = outw[1];
            }
            SEAM(7);
    }
    if (IN(8)) { PH_IDS(); const int hf = 0; const int rep_ = 0; (void)hf; (void)rep_;

            pg8::Gemm g{WSB(WS_H2), WSB(WS_WUP), MH, UPW, DM}; pg8::StaticOrder S; S.init(MH, UPW, G, bx);
            pg8::EpiUpAct E{WSB(WS_ACT), WSB(WS_U), WSF(WS_ROWSS), WSF(WS_SHW), AIN(18), AIN(19), hf};
            pg8::gemm_phase<pg8::EpiUpAct, pg8::StaticOrder, true, true>(lds, g, S, E);
            SEAM(8);
    }
    if (IN(10)) { PH_IDS(); const int hf = 0; (void)hf;
            const int nun = (MH / 256) * (DM / 256); const int first = nun < G ? nun : 0;
            if (first == 0 || bx < first) {
                { pg8::StaticOrder S0; S0.init(MH, DM, G, bx); pg8::Unit u0;
                  for (int i = 0; S0.next(i, u0); ++i) fix_panel(ap, 0, u0.pm, wave, lane);
                  asm volatile("s_waitcnt vmcnt(0)" ::: "memory"); __syncthreads(); }

            pg8::Gemm g{WSB(WS_ACT), WSB(WS_WDN), MH, DM, DFF}; pg8::StaticOrder S; S.init(MH, DM, G, bx);
            pg8::EpiResid E{dout, dout + (size_t)NPR * DM, dout, WSF(WS_MODB), 5120, hf};
            pg8::gemm_phase<pg8::EpiResid, pg8::StaticOrder, true, true>(lds, g, S, E);
            }
            if (bx >= first) {
            { pg8::Gemm g{WSB(WS_H), WSB(WS_WO), MH, DM, DM}; pg8::StaticOrder S; S.init(MH, DM, G - first, bx - first);
              pg8::EpiResidW E{AIN(0), AIN(1), dout, WSF(WS_MODB), WSF(WS_GAM), WSB(WS_H2), WSF(WS_ROWSS), 2048, 1};
              pg8::gemm_phase<pg8::EpiResidW, pg8::StaticOrder, true, true>(lds, g, S, E); }
            }
            SEAM(10);
    }
    if (IN(11)) { PH_IDS(); const int hf = 1; const int rep_ = 0; (void)hf; (void)rep_;

            pg8::Gemm g{WSB(WS_H2), WSB(WS_WUP), MH, UPW, DM}; pg8::StaticOrder S; S.init(MH, UPW, G, bx);
            pg8::EpiUpAct E{WSB(WS_ACT), WSB(WS_U), WSF(WS_ROWSS), WSF(WS_SHW), AIN(18), AIN(19), hf};
            pg8::gemm_phase<pg8::EpiUpAct, pg8::StaticOrder, true, true>(lds, g, S, E);
            { const int rem = ((MH / 256) * (UPW / 256)) % G; if (bx >= rem) do_final(ap, 0, (bx - rem) * NWAVES + wave, (G - rem) * NWAVES, lane); }
            SEAM(11);
    }
    if (IN(13)) { PH_IDS(); const int hf = 1; const int rep_ = 0; (void)hf; (void)rep_;

            { pg8::StaticOrder S0; S0.init(MH, DM, G, bx); pg8::Unit u0;
              for (int i = 0; S0.next(i, u0); ++i) fix_panel(ap, 1, u0.pm, wave, lane);
              asm volatile("s_waitcnt vmcnt(0)" ::: "memory"); __syncthreads(); }
            pg8::Gemm g{WSB(WS_ACT), WSB(WS_WDN), MH, DM, DFF}; pg8::StaticOrder S; S.init(MH, DM, G, bx);
            pg8::EpiResid E{dout, dout + (size_t)NPR * DM, dout, WSF(WS_MODB), 5120, hf};
            pg8::gemm_phase<pg8::EpiResid, pg8::StaticOrder, true, true>(lds, g, S, E);
            SEAM(13);
    }
    if (IN(14)) { PH_IDS(); do_final(ap, 1, gw, NGW, lane); }
#undef IN
#undef SEAM
}

extern "C" void kernel_launch(void* const* d_in, const int* in_sizes, int n_in, void* d_out, int out_size, void* d_ws, size_t ws_size, hipStream_t stream) {
    static int grid = 0;
    if (grid == 0) {
        if (n_in != 22 || ws_size < WS_END) { fprintf(stderr, "kernel_launch: unexpected n_in %d / ws_size %zu\n", n_in, ws_size); grid = -1; return; }
        int dev = 0, cus = 0, per_cu = 0;
        hipGetDevice(&dev); hipDeviceGetAttribute(&cus, hipDeviceAttributeMultiprocessorCount, dev);
        if (hipFuncSetAttribute((const void*)fwd_mega, hipFuncAttributeMaxDynamicSharedMemorySize, LDS_BYTES) != hipSuccess) { fprintf(stderr, "kernel_launch: hipFuncSetAttribute failed\n"); grid = -1; return; }
        if (hipOccupancyMaxActiveBlocksPerMultiprocessor(&per_cu, (const void*)fwd_mega, NTHR, LDS_BYTES) != hipSuccess || per_cu < 1) { fprintf(stderr, "kernel_launch: occupancy query says %d\n", per_cu); per_cu = 1; }
        (void)hipGetLastError();
        grid = cus;
    }
    if (grid < 0) return;
    hipMemsetAsync((char*)d_ws + WS_CTL, 0, CTL_ZERO_BYTES, stream);
    Args a{};
    for (int i = 0; i < 22; ++i) a.in[i] = (const float*)d_in[i];
    a.out = (float*)d_out; a.ws = (unsigned char*)d_ws;
#if MK_SINGLE
    a.ph_lo = 0; a.ph_hi = N_PHASES;
    void* kargs[] = {&a};
    hipError_t e = hipLaunchCooperativeKernel((const void*)fwd_mega, dim3(grid), dim3(NTHR), kargs, LDS_BYTES, stream);
    if (e != hipSuccess) fprintf(stderr, "kernel_launch: cooperative launch failed: %s (grid %d)\n", hipGetErrorString(e), grid);
#else
    for (int p = 0; p < N_PHASES; ++p) { a.ph_lo = p; a.ph_hi = p + 1; hipLaunchKernelGGL(fwd_mega, dim3(grid), dim3(NTHR), LDS_BYTES, stream, a); }
#endif
}
```
